# Optimizing an MI355X kernel written in HIP

```python
import math
import jax, jax.numpy as jnp
from jax import lax
import numpy as np

D_MODEL = 1024
BATCH = 16
SEQ = 4096
DEPTH = 2

GRID_W = 64
CTX_LEN = 256
EPS = 1e-6
N_MOD = 6
N_BRANCH = 3
CHUNK = 128
A_GROUPS = 8
A_GROUP_DIM = 64
A_WIDTH = A_GROUPS * A_GROUP_DIM
B_GROUPS = 8
B_WIDTH = 512
CONV_W = 3
C_HEADS = 8
C_HEAD_DIM = 64
C_V_DIM = 2 * C_HEAD_DIM
C_QK_WIDTH = C_HEADS * 2 * C_HEAD_DIM
C_V_WIDTH = C_HEADS * C_V_DIM
Q_BLOCK = 128
ROPE_BASE = 10000.0
OFF_AU = 0
OFF_AV = OFF_AU + A_WIDTH
OFF_BB = OFF_AV + A_WIDTH
OFF_BC = OFF_BB + B_WIDTH
OFF_BH = OFF_BC + B_WIDTH
OFF_CQ = OFF_BH + B_WIDTH
OFF_CK = OFF_CQ + C_QK_WIDTH
OFF_CV = OFF_CK + C_QK_WIDTH
OFF_GATE = OFF_CV + C_V_WIDTH
IN_COLS = OFF_GATE + N_BRANCH * D_MODEL
SPLITS = [OFF_AV, OFF_BB, OFF_BC, OFF_BH, OFF_CQ, OFF_CK, OFF_CV, OFF_GATE]
D_FF_DENSE = 2816
N_EXPERTS = 8
TOP_K = 2
D_FF_EXPERT = 3584
N_DENSE_LAYERS = (DEPTH + 1) // 2
N_MOE_LAYERS = DEPTH // 2

kernel_name = 'hybrid_gated_diffusion_block'


def rmsnorm(x, g):
    xf = x.astype(jnp.float32)
    y = xf * lax.rsqrt(jnp.mean(xf * xf, axis=-1, keepdims=True) + EPS)
    return (y * g).astype(x.dtype)


def layernorm(x, g, b):
    xf = x.astype(jnp.float32)
    mu = jnp.mean(xf, axis=-1, keepdims=True)
    var = jnp.mean(jnp.square(xf - mu), axis=-1, keepdims=True)
    return ((xf - mu) * lax.rsqrt(var + EPS) * g + b).astype(x.dtype)


def modulate(x, g, shift, scale):
    return rmsnorm(x, g) * (1 + scale) + shift


def axial_rope_tables(n):
    rows = n // GRID_W
    r = jnp.repeat(jnp.arange(rows, dtype=jnp.float32), GRID_W)
    col = jnp.tile(jnp.arange(GRID_W, dtype=jnp.float32), rows)
    quarter = C_HEAD_DIM // 4
    inv = ROPE_BASE ** (-jnp.arange(quarter, dtype=jnp.float32) / quarter)
    ar = r[:, None] * inv
    ac = col[:, None] * inv
    ang = jnp.concatenate([ar, ar, ac, ac], axis=-1)
    return jnp.cos(ang), jnp.sin(ang)


def apply_rope(t, cos, sin):
    ts = t.reshape(t.shape[:-1] + (2, 2, C_HEAD_DIM // 4))
    rot = jnp.stack([-ts[..., 1, :], ts[..., 0, :]], axis=-2).reshape(t.shape)
    cb = cos[None, :, None, None, :]
    sb = sin[None, :, None, None, :]
    return (t * cb + rot * sb).astype(t.dtype)


def qk_heads(t):
    b, n, _ = t.shape
    return t.reshape(b, n, C_HEADS, 2, C_HEAD_DIM)


def v_heads(t):
    b, n, _ = t.shape
    return t.reshape(b, n, C_HEADS, C_V_DIM)


def diff_attention(q, k, v, lam):
    s = jnp.einsum('bqhmd,bkhmd->bhmqk', q, k).astype(jnp.float32) * (C_HEAD_DIM ** -0.5)
    p = jax.nn.softmax(s, axis=-1)
    a = p[:, :, 0] - lam * p[:, :, 1]
    return jnp.einsum('bhqk,bkhe->bqhe', a.astype(v.dtype), v)


def diff_attention_latent(q, k_lat, v_lat, k_ctx, v_ctx, lam):
    k = jnp.concatenate([k_lat, k_ctx], axis=1)
    v = jnp.concatenate([v_lat, v_ctx], axis=1)
    b, n = q.shape[:2]
    qb = jnp.moveaxis(q.reshape((b, n // Q_BLOCK, Q_BLOCK) + q.shape[2:]), 1, 0)
    out = lax.map(lambda qblk: diff_attention(qblk, k, v, lam), qb)
    return jnp.moveaxis(out, 0, 1).reshape(b, n, C_HEADS, C_V_DIM)


def diff_head_out(o, g, lam_init):
    b, n = o.shape[:2]
    return (rmsnorm(o, g) * (1 - lam_init)).reshape(b, n, C_V_WIDTH)


def chunk_spatial_gate(u, v, ln_g, ln_b, ws, bs):
    b, n, _ = v.shape
    vc = layernorm(v, ln_g, ln_b).reshape(b, n // CHUNK, CHUNK, A_GROUPS, A_GROUP_DIM)
    mixed = jnp.einsum('gts,bcsge->bctge', ws, vc) + bs.T[:, :, None]
    return u * mixed.reshape(b, n, A_WIDTH)


def short_gated_conv(bg, cg, h, w):
    z = cg * h
    n = z.shape[1]
    pad = CONV_W // 2
    zp = jnp.pad(z, ((0, 0), (pad, pad), (0, 0)))
    conv = w[0] * zp[:, 0:n]
    for j in range(1, CONV_W):
        conv = conv + w[j] * zp[:, j:j + n]
    return bg * conv


def local_mixers(p, ln_g, ln_b, ws, bs, conv_w):
    ya = chunk_spatial_gate(jax.nn.gelu(p[0]), jax.nn.gelu(p[1]), ln_g, ln_b, ws, bs)
    yb = short_gated_conv(p[2], p[3], p[4], conv_w)
    return ya, yb


def merge_branches(ya, yb, yc, gate_pre, b_gate, w_a_out, w_b_out, w_c_out, w_o):
    ga, gb, gc = jnp.split(jax.nn.sigmoid(gate_pre + b_gate), N_BRANCH, axis=-1)
    y = ga * (ya @ w_a_out) + gb * (yb @ w_b_out) + gc * (yc @ w_c_out)
    return y @ w_o


def swiglu(h, wg, wu, wd):
    return (jax.nn.silu(h @ wg) * (h @ wu)) @ wd


def moe_swiglu(h, w_router, wg, wu, wd):
    logits = (h @ w_router).astype(jnp.float32)
    top_v, top_i = lax.top_k(logits, TOP_K)
    top_w = jax.nn.softmax(top_v, axis=-1)
    comb = jnp.sum(jax.nn.one_hot(top_i, N_EXPERTS, dtype=jnp.float32) * top_w[..., None], axis=-2)
    comb = comb.astype(h.dtype)
    out = jnp.zeros_like(h)
    for e in range(N_EXPERTS):
        out = out + comb[..., e:e + 1] * swiglu(h, wg[e], wu[e], wd[e])
    return out


def channel_mixer(h, l, ff_w_gate, ff_w_up, ff_w_down, moe_w_router, moe_w_gate, moe_w_up, moe_w_down):
    i = l // 2
    if l % 2 == 0:
        return swiglu(h, ff_w_gate[i], ff_w_up[i], ff_w_down[i])
    return moe_swiglu(h, moe_w_router[i], moe_w_gate[i], moe_w_up[i], moe_w_down[i])


def _normal(key, shape, scale):
    return jax.random.normal(key, shape, jnp.float32) * scale


def setup_inputs(seed: int = 0) -> dict:
    key = jax.random.key(seed)
    ks = iter(jax.random.split(key, 32))
    D = D_MODEL
    L = DEPTH
    return {
        'x': _normal(next(ks), (BATCH, SEQ, D), 1.0),
        'c': _normal(next(ks), (BATCH, D), 1.0),
        'ctx': _normal(next(ks), (BATCH, CTX_LEN, D), 1.0),
        'c_ctx': _normal(next(ks), (D,), 1.0),
        'w_ada': _normal(next(ks), (L, D, N_MOD * D), 0.5 * D ** -0.5),
        'b_ada': _normal(next(ks), (L, N_MOD * D), 0.02),
        'norm1_g': 1.0 + _normal(next(ks), (L, D), 0.02),
        'norm2_g': 1.0 + _normal(next(ks), (L, D), 0.02),
        'w_in': _normal(next(ks), (L, D, IN_COLS), D ** -0.5),
        'b_gate': _normal(next(ks), (L, N_BRANCH * D), 0.02),
        'a_ln_g': 1.0 + _normal(next(ks), (L, A_WIDTH), 0.02),
        'a_ln_b': _normal(next(ks), (L, A_WIDTH), 0.02),
        'a_ws': _normal(next(ks), (L, A_GROUPS, CHUNK, CHUNK), CHUNK ** -0.5),
        'a_bs': 1.0 + _normal(next(ks), (L, A_GROUPS, CHUNK), 0.02),
        'b_conv': _normal(next(ks), (L, CONV_W, B_WIDTH), CONV_W ** -0.5),
        'c_lambda': _normal(next(ks), (L, 4, C_HEAD_DIM), 0.1),
        'c_subln_g': 1.0 + _normal(next(ks), (L, C_V_DIM), 0.02),
        'w_a_out': _normal(next(ks), (L, A_WIDTH, D), A_WIDTH ** -0.5),
        'w_b_out': _normal(next(ks), (L, B_WIDTH, D), B_WIDTH ** -0.5),
        'w_c_out': _normal(next(ks), (L, C_V_WIDTH, D), C_V_WIDTH ** -0.5),
        'w_o': _normal(next(ks), (L, D, D), D ** -0.5),
        'ff_w_gate': _normal(next(ks), (N_DENSE_LAYERS, D, D_FF_DENSE), D ** -0.5),
        'ff_w_up': _normal(next(ks), (N_DENSE_LAYERS, D, D_FF_DENSE), D ** -0.5),
        'ff_w_down': _normal(next(ks), (N_DENSE_LAYERS, D_FF_DENSE, D), D_FF_DENSE ** -0.5),
        'moe_w_router': _normal(next(ks), (N_MOE_LAYERS, D, N_EXPERTS), D ** -0.5),
        'moe_w_gate': _normal(next(ks), (N_MOE_LAYERS, N_EXPERTS, D, D_FF_EXPERT), D ** -0.5),
        'moe_w_up': _normal(next(ks), (N_MOE_LAYERS, N_EXPERTS, D, D_FF_EXPERT), D ** -0.5),
        'moe_w_down': _normal(next(ks), (N_MOE_LAYERS, N_EXPERTS, D_FF_EXPERT, D), D_FF_EXPERT ** -0.5),
        'final_norm_g': 1.0 + _normal(next(ks), (D,), 0.02),
    }


def reference(x, c, ctx, c_ctx, w_ada, b_ada, norm1_g, norm2_g, w_in, b_gate, a_ln_g, a_ln_b,
              a_ws, a_bs, b_conv, c_lambda, c_subln_g, w_a_out, w_b_out, w_c_out, w_o,
              ff_w_gate, ff_w_up, ff_w_down, moe_w_router, moe_w_gate, moe_w_up, moe_w_down,
              final_norm_g):
    n = x.shape[1]
    cos, sin = axial_rope_tables(n)
    xc = ctx
    for l in range(DEPTH):
        last = l == DEPTH - 1
        mod = jax.nn.silu(c) @ w_ada[l] + b_ada[l]
        mod_c = jax.nn.silu(c_ctx) @ w_ada[l] + b_ada[l]
        sh1, sc1, g1, sh2, sc2, g2 = jnp.split(mod[:, None, :], N_MOD, axis=-1)
        csh1, csc1, cg1, csh2, csc2, cg2 = jnp.split(mod_c, N_MOD, axis=-1)
        lam_init = 0.8 - 0.6 * math.exp(-0.3 * l)
        lq1, lk1, lq2, lk2 = c_lambda[l]
        lam = jnp.exp(jnp.sum(lq1 * lk1)) - jnp.exp(jnp.sum(lq2 * lk2)) + lam_init

        h = modulate(x, norm1_g[l], sh1, sc1)
        hc = modulate(xc, norm1_g[l], csh1, csc1)
        p = jnp.split(h @ w_in[l], SPLITS, axis=-1)
        if last:
            kv_c = hc @ w_in[l][:, OFF_CK:OFF_GATE]
            kc_raw, vc_raw = jnp.split(kv_c, [C_QK_WIDTH], axis=-1)
        else:
            pc = jnp.split(hc @ w_in[l], SPLITS, axis=-1)
            kc_raw, vc_raw = pc[6], pc[7]
        k_ctx = qk_heads(kc_raw)
        v_ctx = v_heads(vc_raw)

        ya, yb = local_mixers(p, a_ln_g[l], a_ln_b[l], a_ws[l], a_bs[l], b_conv[l])
        q = apply_rope(qk_heads(p[5]), cos, sin)
        k = apply_rope(qk_heads(p[6]), cos, sin)
        yc = diff_attention_latent(q, k, v_heads(p[7]), k_ctx, v_ctx, lam)
        yc = diff_head_out(yc, c_subln_g[l], lam_init)
        x = x + g1 * merge_branches(ya, yb, yc, p[8], b_gate[l], w_a_out[l], w_b_out[l], w_c_out[l], w_o[l])

        x = x + g2 * channel_mixer(modulate(x, norm2_g[l], sh2, sc2), l, ff_w_gate, ff_w_up, ff_w_down,
                                   moe_w_router, moe_w_gate, moe_w_up, moe_w_down)

        if not last:
            ya_c, yb_c = local_mixers(pc, a_ln_g[l], a_ln_b[l], a_ws[l], a_bs[l], b_conv[l])
            yc_c = diff_head_out(diff_attention(qk_heads(pc[5]), k_ctx, v_ctx, lam), c_subln_g[l], lam_init)
            xc = xc + cg1 * merge_branches(ya_c, yb_c, yc_c, pc[8], b_gate[l], w_a_out[l], w_b_out[l],
                                           w_c_out[l], w_o[l])
            xc = xc + cg2 * channel_mixer(modulate(xc, norm2_g[l], csh2, csc2), l, ff_w_gate, ff_w_up,
                                          ff_w_down, moe_w_router, moe_w_gate, moe_w_up, moe_w_down)
    return rmsnorm(x, final_norm_g)
```

```cpp
#include <hip/hip_runtime.h>
#include <cstdio>
#include <cstdint>
namespace pg8 {
#define PG8_LAS __attribute__((address_space(3)))
typedef unsigned short bf16_t;
typedef short bf16x8 __attribute__((ext_vector_type(8)));
typedef float f32x4 __attribute__((ext_vector_type(4)));
typedef unsigned u32x4 __attribute__((ext_vector_type(4)));
constexpr int BM = 256, BK = 64, HALF = 128, HTB = HALF * BK * 2  , STAGE_BYTES = 8 * HTB, NXCD = 8, WGM = 8;

__host__ __device__ __forceinline__ int lds_byte(int r, int c) { const int st = (r >> 4) * 2 + (c >> 5), rr = r & 15, cc = c & 31, ob = rr * 64 + cc * 2; return st * 1024 + (ob ^ (((ob >> 9) & 1) << 5)); }
__host__ __device__ __forceinline__ void stage_rc(int b, int& R, int& C) { const int st = b / 1024, sb = b % 1024, swz = sb ^ (((sb >> 9) & 1) << 5); R = (st >> 1) * 16 + swz / 64; C = (st & 1) * 32 + (swz % 64) / 2; }
__host__ __device__ __forceinline__ int perm32(int rho) { const int n = rho >> 4, i = rho & 15; return 8 * (i >> 2) + 4 * n + (i & 3); }

struct Unit { int pm, pn; };
struct Gemm { const bf16_t* A; const bf16_t* Bt; int M, N, K; };

struct StaticOrder {
    int nM, nN, nwg, G, c;
    __host__ __device__ void init(int M, int N, int G_, int c_) { nM = M / BM; nN = N / BM; nwg = nM * nN; G = G_; c = c_; }
    __host__ __device__ bool next(int i, Unit& u) const {
        const long L = (long)i * G + c; if (L >= nwg) return false;
        int wgid = (int)L; { const int q = nwg / NXCD, r = nwg % NXCD, xcd = wgid % NXCD, off = wgid / NXCD; wgid = (xcd < r ? xcd * (q + 1) : r * (q + 1) + (xcd - r) * q) + off; }
        const int nig = WGM * nN, gid = wgid / nig, fm = gid * WGM, gsz = (nM - fm) < WGM ? (nM - fm) : WGM;
        u.pm = fm + ((wgid % nig) % gsz); u.pn = (wgid % nig) / gsz; return true;
    }
    __device__ __forceinline__ void a_ready(const Unit&) const {}
    __device__ __forceinline__ void done(const Unit&) const {}
};

typedef float cvt_f32x2 __attribute__((ext_vector_type(2))); typedef __bf16 cvt_bf16x2 __attribute__((ext_vector_type(2)));
__device__ __forceinline__ unsigned cvt_pk_bf16(float lo, float hi) { const cvt_f32x2 v = {lo, hi}; const cvt_bf16x2 b = __builtin_convertvector(v, cvt_bf16x2); return __builtin_bit_cast(unsigned, b); }
typedef float f32x2 __attribute__((ext_vector_type(2)));
__device__ __forceinline__ f32x2 gelu_pk(f32x2 v) {
    const f32x2 av = __builtin_elementwise_abs(v), d = av * 0.2316418882f + 1.0f;
    f32x2 t; t.x = __builtin_amdgcn_rcpf(d.x); t.y = __builtin_amdgcn_rcpf(d.y);
    f32x2 q = t * 0.5307027145f + (-0.7265760135f); q = q * t + 0.7107068705f; q = q * t + (-0.142248368f); q = q * t + 0.127414796f; q = q * t;
    const f32x2 s = (v * v) * (-0.72134752044f);
    f32x2 e; e.x = __builtin_amdgcn_exp2f(s.x); e.y = __builtin_amdgcn_exp2f(s.y);
    const f32x2 m = v * (q * e), r = v - m;
    f32x2 o; o.x = v.x < 0.f ? m.x : r.x; o.y = v.y < 0.f ? m.y : r.y; return o;
}


template <class Epi, class Sched, bool ALIGN_EPI = false, bool SP2 = false>
__device__ __forceinline__ void gemm_phase(PG8_LAS unsigned char* lds, const Gemm g, const Sched& S, const Epi& E) {
    const int tid = threadIdx.x, wid = __builtin_amdgcn_readfirstlane(tid >> 6), lane = tid & 63, wr = wid >> 2, wc = wid & 3, fr = lane & 15, fq = lane >> 4;
    const int K = g.K, nt = K / BK;
    unsigned voffA[2], voffB[2];
#pragma unroll
    for (int i = 0; i < 2; ++i) { int R, C; stage_rc(tid * 16 + i * 8192, R, C); const int Rb = Epi::PERM ? ((R & ~31) + perm32(R & 31)) : R;
        voffA[i] = (unsigned)(R * K + C) * 2u; voffB[i] = (unsigned)(Rb * K + C) * 2u; }
    const size_t kstep = (size_t)(BK * 2);
    const size_t hstep = (size_t)HALF * K * 2;
    const size_t tstep = 2 * hstep;
    const unsigned ldsw = (unsigned)wid * 1024u;
    const int aoff = lds_byte(wr * 64 + fr, fq * 8), boff = lds_byte(wc * 32 + fr, fq * 8);
#define PG8_SA(b, h) (((b) * 2 + (h)) * HTB)
#define PG8_SB(b, h) ((4 + (b) * 2 + (h)) * HTB)
#define PG8_STAGE(bufoff, gbase, voff) do { _Pragma("unroll") for (int _i = 0; _i < 2; ++_i) \
        __builtin_amdgcn_global_load_lds((const unsigned*)((const char*)(gbase) + (voff)[_i]), (PG8_LAS unsigned*)(lds + (bufoff) + ldsw + _i * 8192), 16, 0, 0); } while (0)
#define PG8_LDA(dst, b, h) do { _Pragma("unroll") for (int m = 0; m < 4; ++m) _Pragma("unroll") for (int k = 0; k < 2; ++k) dst[m][k] = *(const PG8_LAS bf16x8*)(lds + PG8_SA(b, h) + aoff + m * 2048 + k * 1024); } while (0)
#define PG8_LDB(dst, b, h) do { _Pragma("unroll") for (int n = 0; n < 2; ++n) _Pragma("unroll") for (int k = 0; k < 2; ++k) dst[n][k] = *(const PG8_LAS bf16x8*)(lds + PG8_SB(b, h) + boff + n * 2048 + k * 1024); } while (0)
#define PG8_MMA(ai, bj, At, Bt) do { __builtin_amdgcn_s_setprio(1); _Pragma("unroll") for (int m = 0; m < 4; ++m) _Pragma("unroll") for (int n = 0; n < 2; ++n) _Pragma("unroll") for (int k = 0; k < 2; ++k) \
        acc[ai][bj][m][n] = __builtin_amdgcn_mfma_f32_16x16x32_bf16(Bt[n][k], At[m][k], acc[ai][bj][m][n], 0, 0, 0); __builtin_amdgcn_s_setprio(0); } while (0)
#define PG8_WAIT_V(n) asm volatile("s_waitcnt vmcnt(" #n ")" ::: "memory")
#define PG8_WAIT_L(n) asm volatile("s_waitcnt lgkmcnt(" #n ")" ::: "memory")
#define PG8_BAR __builtin_amdgcn_s_barrier()
#define PG8_SCHED __builtin_amdgcn_sched_barrier(0)
    Unit cur, nxt; int ui = 0;
    if (!S.next(0, cur)) return;
    f32x4 acc[2][2][4][2];
#pragma unroll
    for (int a = 0; a < 2; ++a)
#pragma unroll
        for (int b = 0; b < 2; ++b)
#pragma unroll
            for (int m = 0; m < 4; ++m)
#pragma unroll
                for (int n = 0; n < 2; ++n) acc[a][b][m][n] = (f32x4){0.f, 0.f, 0.f, 0.f};
    bf16x8 At[4][2], B0[2][2], B1[2][2];
    const char* cA = (const char*)g.A + (size_t)cur.pm * tstep; const char* cB = (const char*)g.Bt + (size_t)cur.pn * tstep;
    S.a_ready(cur);
    if constexpr (SP2) {
        PG8_STAGE(PG8_SB(0, 0), cB, voffB); PG8_STAGE(PG8_SB(0, 1), cB + hstep, voffB); PG8_STAGE(PG8_SA(0, 0), cA, voffA); PG8_STAGE(PG8_SA(0, 1), cA + hstep, voffA);
        if (wr == 1) PG8_BAR;
        PG8_WAIT_V(2); PG8_BAR;
        PG8_STAGE(PG8_SB(1, 0), cB + kstep, voffB); PG8_STAGE(PG8_SA(1, 0), cA + kstep, voffA); PG8_STAGE(PG8_SB(1, 1), cB + hstep + kstep, voffB);
        PG8_WAIT_V(6); PG8_BAR;
    } else {
        PG8_STAGE(PG8_SB(0, 0), cB, voffB); PG8_STAGE(PG8_SA(0, 0), cA, voffA); PG8_STAGE(PG8_SB(0, 1), cB + hstep, voffB); PG8_STAGE(PG8_SA(0, 1), cA + hstep, voffA);
        if (wr == 1) PG8_BAR;
        PG8_WAIT_V(4); PG8_BAR;
        PG8_STAGE(PG8_SB(1, 0), cB + kstep, voffB); PG8_STAGE(PG8_SA(1, 0), cA + kstep, voffA); PG8_STAGE(PG8_SB(1, 1), cB + hstep + kstep, voffB);
        PG8_WAIT_V(6); PG8_BAR;
    }
    for (;;) {
        const bool has_next = S.next(ui + 1, nxt);
        const char* nA = has_next ? (const char*)g.A + (size_t)nxt.pm * tstep : cA; const char* nB = has_next ? (const char*)g.Bt + (size_t)nxt.pn * tstep : cB;
        for (int t = 0; t < nt; t += 2) {
            const bool last = (t == nt - 2);
            const char* a1 = cA + (size_t)(t + 1) * kstep;
            const char* a2 = last ? nA : cA + (size_t)(t + 2) * kstep; const char* b2 = last ? nB : cB + (size_t)(t + 2) * kstep;
            const char* a3 = a2 + kstep; const char* b3 = b2 + kstep;
            if (last && has_next) S.a_ready(nxt);
            if constexpr (SP2) {
            PG8_LDB(B0, 0, 0); PG8_LDB(B1, 0, 1); PG8_SCHED; PG8_LDA(At, 0, 0); PG8_STAGE(PG8_SA(1, 1), a1 + hstep, voffA);
            PG8_WAIT_V(8); PG8_WAIT_L(0); PG8_BAR; PG8_MMA(0, 0, At, B0); PG8_MMA(0, 1, At, B1); PG8_BAR; PG8_SCHED;
            PG8_LDA(At, 0, 1); PG8_STAGE(PG8_SB(0, 0), b2, voffB); PG8_STAGE(PG8_SB(0, 1), b2 + hstep, voffB); PG8_STAGE(PG8_SA(0, 0), a2, voffA);
            PG8_WAIT_V(8); PG8_WAIT_L(0); PG8_BAR; PG8_MMA(1, 0, At, B0); PG8_MMA(1, 1, At, B1); PG8_BAR; PG8_SCHED;
            PG8_LDB(B0, 1, 0); PG8_LDB(B1, 1, 1); PG8_SCHED; PG8_LDA(At, 1, 0); PG8_STAGE(PG8_SA(0, 1), a2 + hstep, voffA);
            PG8_WAIT_V(8); PG8_WAIT_L(0); PG8_BAR; PG8_MMA(0, 0, At, B0); PG8_MMA(0, 1, At, B1); PG8_BAR; PG8_SCHED;
            PG8_LDA(At, 1, 1); PG8_STAGE(PG8_SB(1, 0), b3, voffB); PG8_STAGE(PG8_SB(1, 1), b3 + hstep, voffB); PG8_STAGE(PG8_SA(1, 0), a3, voffA);
            PG8_WAIT_V(8); PG8_WAIT_L(0); PG8_BAR; PG8_MMA(1, 0, At, B0); PG8_MMA(1, 1, At, B1); PG8_BAR; PG8_SCHED;
            } else {
            PG8_LDB(B0, 0, 0); PG8_SCHED; PG8_LDA(At, 0, 0); PG8_STAGE(PG8_SA(1, 1), a1 + hstep, voffA);
            PG8_WAIT_L(8); PG8_BAR; PG8_WAIT_L(0); PG8_MMA(0, 0, At, B0); PG8_BAR; PG8_SCHED;
            PG8_LDB(B1, 0, 1); PG8_STAGE(PG8_SB(0, 0), b2, voffB);
            PG8_BAR; PG8_WAIT_L(0); PG8_MMA(0, 1, At, B1); PG8_BAR;
            PG8_LDA(At, 0, 1); PG8_STAGE(PG8_SA(0, 0), a2, voffA);
            PG8_BAR; PG8_WAIT_L(0); PG8_MMA(1, 0, At, B0); PG8_BAR; PG8_SCHED;
            PG8_STAGE(PG8_SB(0, 1), b2 + hstep, voffB);
            PG8_WAIT_V(6); PG8_BAR; PG8_MMA(1, 1, At, B1); PG8_BAR;
            PG8_LDB(B0, 1, 0); PG8_SCHED; PG8_LDA(At, 1, 0); PG8_STAGE(PG8_SA(0, 1), a2 + hstep, voffA);
            PG8_WAIT_L(8); PG8_BAR; PG8_WAIT_L(0); PG8_MMA(0, 0, At, B0); PG8_BAR; PG8_SCHED;
            PG8_LDB(B1, 1, 1); PG8_STAGE(PG8_SB(1, 0), b3, voffB);
            PG8_BAR; PG8_WAIT_L(0); PG8_MMA(0, 1, At, B1); PG8_BAR;
            PG8_LDA(At, 1, 1); PG8_STAGE(PG8_SA(1, 0), a3, voffA);
            PG8_BAR; PG8_WAIT_L(0); PG8_MMA(1, 0, At, B0); PG8_BAR; PG8_SCHED;
            PG8_STAGE(PG8_SB(1, 1), b3 + hstep, voffB);
            PG8_WAIT_V(6); PG8_BAR; PG8_MMA(1, 1, At, B1); PG8_BAR;
            }
        }
        if constexpr (ALIGN_EPI) { if (wr == 0) PG8_BAR; }
        if constexpr (!Epi::AFTER_DRAIN) { E(acc, cur, wr, wc, fr, fq); S.done(cur); }
        if (!has_next) break;
#pragma unroll
        for (int a = 0; a < 2; ++a)
#pragma unroll
            for (int b = 0; b < 2; ++b)
#pragma unroll
                for (int m = 0; m < 4; ++m)
#pragma unroll
                    for (int n = 0; n < 2; ++n) acc[a][b][m][n] = (f32x4){0.f, 0.f, 0.f, 0.f};
        cur = nxt; cA = nA; cB = nB; ++ui;
        if constexpr (ALIGN_EPI) { if (wr == 1) PG8_BAR; }
    }
    PG8_WAIT_V(0);
    if constexpr (!ALIGN_EPI) { if (wr == 0) PG8_BAR; }
    PG8_BAR;
    if constexpr (Epi::AFTER_DRAIN) { E.fused(acc, cur, wr, wc, fr, fq, lds, wid, lane); S.done(cur); }
#undef PG8_SA
#undef PG8_SB
#undef PG8_STAGE
#undef PG8_LDA
#undef PG8_LDB
#undef PG8_MMA
#undef PG8_WAIT_V
#undef PG8_WAIT_L
#undef PG8_BAR
#undef PG8_SCHED
}
}

#ifndef PG8_SP2
#define PG8_SP2 true
#endif
#ifndef PG8_ALIGN
#define PG8_ALIGN true
#endif

#define GAS __attribute__((address_space(1)))
#define LAS __attribute__((address_space(3)))
typedef unsigned short bf16;
typedef unsigned v4u __attribute__((ext_vector_type(4)));
typedef float f32x4 __attribute__((ext_vector_type(4)));
typedef short bf16x8 __attribute__((ext_vector_type(8)));
typedef GAS unsigned gu32;
typedef GAS unsigned long long gu64;
#define RLX_AGENT __ATOMIC_RELAXED, __HIP_MEMORY_SCOPE_AGENT
#define LDS_WAIT() asm volatile("s_waitcnt lgkmcnt(0)" ::: "memory")
#define VM_WAIT() asm volatile("s_waitcnt vmcnt(0)" ::: "memory")
__device__ __forceinline__ unsigned long long rt() { return __builtin_amdgcn_s_memrealtime(); }
__device__ __forceinline__ unsigned f2bf(float f) { unsigned u = __builtin_bit_cast(unsigned, f); return (u + 0x7fffu + ((u >> 16) & 1u)) >> 16; }
__device__ __forceinline__ unsigned pk2(float lo, float hi) { return f2bf(lo) | (f2bf(hi) << 16); }

#define XB_TMO      128
#define XB_XCNT(j)  (256  + 64 * (j))
#define XB_XSUB(j)  (1280 + 64 * (j))
#define XB_XGEN(j)  (2304 + 64 * (j))
#define XB_TOP      3328
#define XB_TOPGEN   3392
#define XCD_BAR_WORDS 3456
#define XB_SPIN_CAP (1u << 18)

__device__ __forceinline__ unsigned xb_ld(unsigned* p)              { return __hip_atomic_load(p, __ATOMIC_RELAXED, __HIP_MEMORY_SCOPE_AGENT); }
__device__ __forceinline__ unsigned xb_add(unsigned* p, unsigned v) { return __hip_atomic_fetch_add(p, v, __ATOMIC_RELAXED, __HIP_MEMORY_SCOPE_AGENT); }
__device__ __forceinline__ unsigned xb_xcc_id() { return (unsigned)__builtin_amdgcn_s_getreg((3 << 11) | 20) & 0xFu; }
#define XB_SPIN(cond, bar) do { unsigned _sp = 0; while (cond) { __builtin_amdgcn_s_sleep(1); \
    if ((++_sp & 255u) == 0u) { if (xb_ld(&(bar)[XB_TMO])) break; if (_sp > XB_SPIN_CAP) { atomicAdd(&(bar)[XB_TMO], 1u); break; } } } } while (0)

struct XcdBarrier {
    unsigned* bar; unsigned x;
    volatile LAS unsigned* st;
};

__device__ __forceinline__ XcdBarrier xcd_barrier_post(unsigned* bar, volatile LAS unsigned* st) {
    XcdBarrier b; b.bar = bar; b.x = xb_xcc_id(); b.st = st;
    if (threadIdx.x == 0) (void)xb_add(&bar[XB_XCNT(b.x)], 1u);
    return b;
}
__device__ __forceinline__ void xcd_barrier_complete(unsigned* bar, unsigned x, unsigned& nloc, unsigned& nx) {
    const unsigned G = gridDim.x * gridDim.y * gridDim.z;
    unsigned sum, cnt, mine, sp = 0u;
    for (;;) {
        sum = 0u; cnt = 0u; mine = 0u;
#pragma unroll
        for (unsigned j = 0; j < 16; ++j) { const unsigned c = xb_ld(&bar[XB_XCNT(j)]); sum += c; cnt += (c > 0u) ? 1u : 0u; mine = (j == x) ? c : mine; }
        if (sum == G) break;
        __builtin_amdgcn_s_sleep(1);
        if ((++sp & 255u) == 0u) { if (xb_ld(&bar[XB_TMO])) break; if (sp > XB_SPIN_CAP) { atomicAdd(&bar[XB_TMO], 1u); break; } }
    }
    nloc = mine > 0u ? mine : 1u; nx = cnt > 0u ? cnt : 1u;
}

__device__ __forceinline__ void xcd_barrier(const XcdBarrier& b) {
    asm volatile("s_waitcnt vmcnt(0)" ::: "memory");
    __syncthreads();
    if (threadIdx.x == 0) {
        unsigned* bar = b.bar;
        __builtin_amdgcn_s_waitcnt(0);
        unsigned nloc = b.st[0], nx = b.st[1];
        if (nloc == 0u) { xcd_barrier_complete(bar, b.x, nloc, nx); b.st[0] = nloc; b.st[1] = nx; }
        const unsigned old = xb_add(&bar[XB_XSUB(b.x)], 1u);
        const unsigned gen = old / nloc;
        if (old + 1u == (gen + 1u) * nloc) {
            __builtin_amdgcn_fence(__ATOMIC_RELEASE, "agent");
            asm volatile("s_waitcnt vmcnt(0)" ::: "memory");
            const unsigned og = xb_add(&bar[XB_TOP], 1u);
            const unsigned tg = og / nx;
            if (og + 1u == (tg + 1u) * nx) xb_add(&bar[XB_TOPGEN], 1u);
            else XB_SPIN(xb_ld(&bar[XB_TOPGEN]) == tg, bar);
            __builtin_amdgcn_fence(__ATOMIC_ACQUIRE, "agent");
            xb_add(&bar[XB_XGEN(b.x)], 1u);
            asm volatile("s_waitcnt vmcnt(0)" ::: "memory");
        } else {
            XB_SPIN(xb_ld(&bar[XB_XGEN(b.x)]) == gen, bar);
            __builtin_amdgcn_fence(__ATOMIC_ACQUIRE, "agent");
            asm volatile("s_waitcnt vmcnt(0)" ::: "memory");
        }
    }
    __syncthreads();
}

#ifndef NLAYERS
#define NLAYERS 2
#endif
#ifndef EN_PRO
#define EN_PRO 1
#endif
#ifndef EN_MIX
#define EN_MIX 1
#endif
#ifndef EN_ATT
#define EN_ATT 1
#endif
#ifndef EN_SITES
#define EN_SITES 255
#endif
constexpr int NWAVES = 8, NTHREADS = 512;
constexpr int BATCH = 16, SEQ = 4096, DM = 1024, CTXL = 256;
constexpr int ML = BATCH * SEQ;
constexpr int MC = BATCH * CTXL;
constexpr int MA = ML + MC;
constexpr int SKV = SEQ + CTXL;
constexpr int INC = 8704;
constexpr int NBIG = 5632;
constexpr int DFF = 2816, NEXP = 8, DFE = 3584;
constexpr int MOE_CH = 174;
constexpr float EPS = 1e-6f;
constexpr float QSCALE = 0.125f * 1.4426950408889634f;

constexpr size_t MiB = 1u << 20;
constexpr size_t WS_CTL = 0, CTL_ZERO_BYTES = 1 * MiB;
constexpr size_t WS_MOD = 1 * MiB;
constexpr size_t WS_ROPE = 2 * MiB;
constexpr size_t WS_LAM = 2 * MiB + 16384;
constexpr size_t WS_AWS = 2 * MiB + 65536;
constexpr size_t WS_ROUTE = 4 * MiB;
constexpr size_t WS_WIN = 8 * MiB;
constexpr size_t WIN_BYTES = 17 * MiB;
constexpr size_t WS_WOUT = 42 * MiB;
constexpr size_t WOUT_BYTES = 6 * MiB;
constexpr size_t WS_WFU = 54 * MiB;
constexpr size_t WS_WFD = 65 * MiB;
constexpr size_t WS_XC = 71 * MiB;
constexpr size_t WS_H = 87 * MiB;
constexpr size_t WS_P0 = 223 * MiB, WS_P1 = 291 * MiB, WS_P2 = 359 * MiB, WS_P3 = 427 * MiB;
constexpr size_t WS_Q = 495 * MiB, WS_K = 631 * MiB, WS_V = 767 * MiB;
constexpr size_t WS_ACT0 = 223 * MiB;
constexpr size_t WS_MWU = 223 * MiB;
constexpr size_t WS_MWD = 335 * MiB;
constexpr size_t WS_HS = 391 * MiB;
constexpr size_t WS_MACT = 651 * MiB;
constexpr size_t WS_END = 1024 * MiB;
static_assert(WS_MACT + (size_t)MOE_CH * 256 * DFE * 2 <= WS_END, "ws map");
static_assert(WS_ACT0 + (size_t)MA * DFF * 2 <= WS_K, "ws map");
constexpr int CW_BAR = 4096;
constexpr int CW_CNT = 8192;

constexpr int LDS_BYTES = 147456;
constexpr int LDSCTL_OFF = LDS_BYTES - 256;

typedef float f32x2 __attribute__((ext_vector_type(2)));
typedef unsigned v2u __attribute__((ext_vector_type(2)));
__device__ __forceinline__ float bf2f(unsigned h) { return __builtin_bit_cast(float, h << 16); }
__device__ __forceinline__ float wave_sum(float v) {
#pragma unroll
    for (int o = 1; o < 64; o <<= 1) v += __shfl_xor(v, o);
    return v;
}
__device__ __forceinline__ float fast_exp2(float x) { return __builtin_amdgcn_exp2f(x); }
__device__ __forceinline__ float fast_rcp(float x) { return __builtin_amdgcn_rcpf(x); }
__device__ __forceinline__ float sigmoid_f(float x) { return fast_rcp(1.f + fast_exp2(-1.4426950408889634f * x)); }
__device__ __forceinline__ float silu_f(float x) { return x * sigmoid_f(x); }
__device__ __forceinline__ float gelu_tanh_f(float x) { const float u = x * (1.f + 0.044715f * x * x); return x * fast_rcp(1.f + fast_exp2(-2.f * 0.7978845608028654f * 1.4426950408889634f * u)); }

__device__ __forceinline__ unsigned char* launder_ptr(unsigned char* p) { asm volatile("" : "+s"(p)); return p; }
struct Args { const float* in[29]; float* out; unsigned char* ws; int ph_lo, ph_hi; };
static_assert(sizeof(Args) == 256, "Args has no holes");
struct PhaseCtl { int lo, hi, ph; };
struct Ctx {
    LAS unsigned char* lds;
    gu32* ctl;
    int tid, lane, wave, vcu, G, gw, NGW;
};

__device__ __forceinline__ void tr_item(const float* W, int ldw, int scol0, bool perm, bf16* WT, int K, int drow0, int k0, LAS float* scr, int lane) {
#pragma unroll 8
    for (int i = 0; i < 32; ++i) { const int kk = 2 * i + (lane >> 5); scr[kk * 33 + (lane & 31)] = W[(size_t)(k0 + kk) * ldw + scol0 + (lane & 31)]; }
    LDS_WAIT(); asm volatile("" ::: "memory");
    const int c = lane & 7;
#pragma unroll
    for (int j = 0; j < 4; ++j) { const int n = (lane >> 3) + 8 * j; const int sn = perm ? ((n >> 1) + 16 * (n & 1)) : n;
        const LAS float* s = scr + (8 * c) * 33 + sn;
        v4u o; o.x = pk2(s[0 * 33], s[1 * 33]); o.y = pk2(s[2 * 33], s[3 * 33]); o.z = pk2(s[4 * 33], s[5 * 33]); o.w = pk2(s[6 * 33], s[7 * 33]);
        *(GAS v4u*)(WT + (size_t)(drow0 + n) * K + k0 + 8 * c) = o; }
    LDS_WAIT(); asm volatile("" ::: "memory");
}
__device__ __forceinline__ int win_src(int d, bool& perm) {
    perm = false;
    if (d < 1024) { perm = true; return 2560 + d; }
    if (d < 2048) { perm = true; return 3584 + (d - 1024); }
    if (d < 3072) return 4608 + (d - 2048);
    if (d < 3584) return d - 3072;
    if (d < 4096) return 512 + (d - 3584);
    if (d < 4608) return 1024 + (d - 4096);
    if (d < 5632) { const int x = d - 4608, j = x >> 8, w = x & 255; return (w < 128 ? 1536 : 2048) + 128 * j + (w & 127); }
    return d;
}
template <int MODE>
__device__ __forceinline__ void tr_matrix(const Ctx& C, const float* W, const float* W2, int ldw, int K, int ndst, bf16* WT) {
    LAS float* scr = (LAS float*)(C.lds + C.wave * 16384);
    const int nblk = ndst / 32, ni = (K / 64) * nblk;
    for (int it = C.gw; it < ni; it += C.NGW) {
        const int kb = it / nblk, db = it % nblk; const float* src = W; int scol0; bool perm = false;
        if (MODE == 0) scol0 = 32 * db;
        else if (MODE == 1) scol0 = win_src(32 * db, perm);
        else { const int j = db >> 3, w = db & 7; if (w >= 4) src = W2; scol0 = 128 * j + 32 * (w & 3); }
        tr_item(src, ldw, scol0, perm, WT, K, 32 * db, 64 * kb, scr, C.lane);
    }
}

__device__ __forceinline__ void mod_phase(const Ctx& C, const float* c, const float* cctx, const float* w_ada, const float* b_ada, float* mod) {
    LAS float* sc = (LAS float*)C.lds;
    LAS float* red = (LAS float*)(C.lds + 17 * 1024 * 4);
    for (int idx = C.tid; idx < 17 * 1024; idx += NTHREADS) { const int b = idx >> 10, k = idx & 1023; const float v = b < 16 ? c[b * 1024 + k] : cctx[k]; sc[idx] = v / (1.f + __expf(-v)); }
    __syncthreads();
    const int cl = C.tid & 31, ks = C.tid >> 5;
    for (int it = blockIdx.x; it < 2 * 192; it += C.G) {
        const int l = it / 192, cb = it % 192, col = cb * 32 + cl;
        float acc[17];
#pragma unroll
        for (int b = 0; b < 17; ++b) acc[b] = 0.f;
        const float* wp = w_ada + ((size_t)l * 1024 + ks * 64) * 6144 + col;
        for (int kk = 0; kk < 64; ++kk) { const float w = wp[(size_t)kk * 6144]; const int k = ks * 64 + kk;
#pragma unroll
            for (int b = 0; b < 17; ++b) acc[b] += sc[b * 1024 + k] * w; }
#pragma unroll
        for (int b = 0; b < 17; ++b) red[(ks * 17 + b) * 32 + cl] = acc[b];
        __syncthreads();
        for (int o = C.tid; o < 17 * 32; o += NTHREADS) { const int b = o >> 5, cc = o & 31; float s = b_ada[l * 6144 + cb * 32 + cc];
#pragma unroll
            for (int q = 0; q < 16; ++q) s += red[(q * 17 + b) * 32 + cc];
            mod[((size_t)l * 17 + b) * 6144 + cb * 32 + cc] = s; }
        __syncthreads();
    }
}
__device__ __forceinline__ void rope_lam_phase(const Ctx& C, const float* c_lambda, float* rope, float* lam) {
    if (blockIdx.x == 0) {
        for (int idx = C.tid; idx < 1024; idx += NTHREADS) {
            const int pos = idx >> 4, i = idx & 15;
            double th = 1.0; for (int q = 0; q < i; ++q) th *= 0.56234132519034908;
            double c1 = 1.0, s1 = th, tc = 1.0, ts = th; const double t2 = th * th;
            for (int n = 1; n <= 12; ++n) { tc *= -t2 / (double)((2 * n - 1) * (2 * n)); ts *= -t2 / (double)((2 * n) * (2 * n + 1)); c1 += tc; s1 += ts; }
            double cc = 1.0, ss = 0.0; for (int q = 0; q < pos; ++q) { const double nc = cc * c1 - ss * s1, ns = ss * c1 + cc * s1; cc = nc; ss = ns; }
            rope[idx * 2] = (float)cc; rope[idx * 2 + 1] = (float)ss;
        }
        if (C.tid < 2) { const int l = C.tid; const float* p = c_lambda + l * 256; float a = 0.f, b = 0.f;
            for (int d = 0; d < 64; ++d) { a += p[d] * p[64 + d]; b += p[128 + d] * p[192 + d]; }
            const float li = l == 0 ? 0.2f : (0.8f - 0.6f * 0.7408182206817179f);
            lam[l] = __expf(a) - __expf(b) + li; }
    }
}

__device__ __forceinline__ void modulate_row(const float* xr, const float* gn, const float* scv, const float* shv, bf16* orow, int lane, f32x4 (&y)[4]) {
    const GAS f32x4* xp = (const GAS f32x4*)xr + lane; f32x4 v[4]; float ss = 0.f;
#pragma unroll
    for (int j = 0; j < 4; ++j) { v[j] = xp[64 * j]; ss += (v[j].x * v[j].x + v[j].y * v[j].y) + (v[j].z * v[j].z + v[j].w * v[j].w); }
    const float rstd = 1.0f / sqrtf(wave_sum(ss) * (1.f / 1024.f) + EPS);
    GAS v2u* o8 = (GAS v2u*)orow + lane;
#pragma unroll
    for (int j = 0; j < 4; ++j) {
        const f32x4 g = ((const GAS f32x4*)gn)[lane + 64 * j], s = ((const GAS f32x4*)scv)[lane + 64 * j], h = ((const GAS f32x4*)shv)[lane + 64 * j];
        y[j] = (v[j] * rstd) * g * (s + 1.0f) + h;
        v2u w; w.x = pg8::cvt_pk_bf16(y[j].x, y[j].y); w.y = pg8::cvt_pk_bf16(y[j].z, y[j].w); o8[64 * j] = w; }
}
__device__ __forceinline__ void modulate_phase(const Ctx& C, const float* xl, const float* xcs, const float* gn, const float* modl, int shidx, int scidx, bf16* H, int nrows) {
    for (int r = C.gw; r < nrows; r += C.NGW) {
        const float* xr = r < ML ? xl + (size_t)r * DM : xcs + (size_t)(r - ML) * DM; const int b = r < ML ? (r >> 12) : 16;
        f32x4 y[4];
        modulate_row(xr, gn, modl + (size_t)b * 6144 + scidx * 1024, modl + (size_t)b * 6144 + shidx * 1024, H + (size_t)r * DM, C.lane, y);
    }
}

using pg8::f32x4; using pg8::u32x4; using pg8::Unit; using pg8::cvt_pk_bf16;
__device__ __forceinline__ u32x4 pack8(const f32x4& a, const f32x4& b) { u32x4 w; w.x = cvt_pk_bf16(a[0], a[1]); w.y = cvt_pk_bf16(a[2], a[3]); w.z = cvt_pk_bf16(b[0], b[1]); w.w = cvt_pk_bf16(b[2], b[3]); return w; }
__device__ __forceinline__ void unpack8(const u32x4& w, f32x4& a, f32x4& b) {
    a[0] = bf2f(w.x & 0xffffu); a[1] = bf2f(w.x >> 16); a[2] = bf2f(w.y & 0xffffu); a[3] = bf2f(w.y >> 16);
    b[0] = bf2f(w.z & 0xffffu); b[1] = bf2f(w.z >> 16); b[2] = bf2f(w.w & 0xffffu); b[3] = bf2f(w.w >> 16); }

struct EpiBig {
    static constexpr bool PERM = true, AFTER_DRAIN = false;
    unsigned char* wsb; const float* rope;
    __device__ __forceinline__ void operator()(const f32x4 (&acc)[2][2][4][2], const Unit& u, int wr, int wc, int fr, int fq) const {
        const int R0 = u.pm * 256, pn = u.pn; const bool isctx = R0 >= ML;
        const int cin = 32 * wc + 8 * fq;
        if (pn < 12) {
            const int kind = pn >> 2;
            bf16* base = (bf16*)(wsb + WS_Q + (size_t)kind * (WS_K - WS_Q));
            long rowadd = 0;
            if (kind != 0) rowadd = isctx ? ((long)((R0 - ML) >> 8) * SKV + SEQ - R0) : ((long)(R0 >> 12) * (SKV - SEQ));
            const bool rot = (kind != 2) && !isctx; const int axis = wc & 1; const float qs = kind == 0 ? QSCALE : 1.f;
#pragma unroll
            for (int ai = 0; ai < 2; ++ai)
#pragma unroll
                for (int m = 0; m < 4; ++m) {
                    const int r = R0 + ai * 128 + wr * 64 + m * 16 + fr;
                    f32x4 t0 = {1.f, 0.f, 1.f, 0.f}, t1 = {1.f, 0.f, 1.f, 0.f};
                    if (rot) { const int t = r & 4095; const int pos = axis == 0 ? (t >> 6) : (t & 63); const GAS f32x4* tp = (const GAS f32x4*)(rope + (pos * 16 + 4 * fq) * 2); t0 = tp[0]; t1 = tp[1]; }
                    bf16* rowp = base + (size_t)((long)r + rowadd) * DM + (pn & 3) * 256 + cin;
#pragma unroll
                    for (int bj = 0; bj < 2; ++bj) {
                        const f32x4 a = acc[ai][bj][m][0], b = acc[ai][bj][m][1]; f32x4 oa, ob;
                        oa[0] = (a[0] * t0[0] - a[1] * t0[1]) * qs; oa[1] = (a[1] * t0[0] + a[0] * t0[1]) * qs; oa[2] = (a[2] * t0[2] - a[3] * t0[3]) * qs; oa[3] = (a[3] * t0[2] + a[2] * t0[3]) * qs;
                        ob[0] = (b[0] * t1[0] - b[1] * t1[1]) * qs; ob[1] = (b[1] * t1[0] + b[0] * t1[1]) * qs; ob[2] = (b[2] * t1[2] - b[3] * t1[3]) * qs; ob[3] = (b[3] * t1[2] + b[2] * t1[3]) * qs;
                        *(GAS u32x4*)(rowp + bj * 128) = pack8(oa, ob); }
                }
        } else if (pn < 18) {
            const int kind = (pn - 12) >> 1;
            bf16* base = (bf16*)(wsb + WS_P0 + (size_t)kind * (WS_P1 - WS_P0)); const int c0 = ((pn - 12) & 1) * 256 + cin;
#pragma unroll
            for (int ai = 0; ai < 2; ++ai)
#pragma unroll
                for (int m = 0; m < 4; ++m) {
                    const int r = R0 + ai * 128 + wr * 64 + m * 16 + fr; bf16* rowp = base + (size_t)r * 512 + c0;
#pragma unroll
                    for (int bj = 0; bj < 2; ++bj) {
                        f32x4 a = acc[ai][bj][m][0], b = acc[ai][bj][m][1];
                        if (kind < 2) {
#pragma unroll
                            for (int q = 0; q < 4; ++q) { a[q] = gelu_tanh_f(a[q]); b[q] = gelu_tanh_f(b[q]); } }
                        *(GAS u32x4*)(rowp + bj * 128) = pack8(a, b); }
                }
        } else {
            const int c0 = (pn - 18) * 128 + cin;
#pragma unroll
            for (int ai = 0; ai < 2; ++ai)
#pragma unroll
                for (int m = 0; m < 4; ++m) {
                    const int r = R0 + ai * 128 + wr * 64 + m * 16 + fr;
                    const f32x4 a = acc[ai][0][m][0] * acc[ai][1][m][0], b = acc[ai][0][m][1] * acc[ai][1][m][1];
                    *(GAS u32x4*)((bf16*)(wsb + WS_P3) + (size_t)r * 512 + c0) = pack8(a, b); }
        }
    }
};

struct EpiGate {
    static constexpr bool PERM = true, AFTER_DRAIN = false;
    unsigned char* wsb; const float* bias;
    __device__ __forceinline__ void operator()(const f32x4 (&acc)[2][2][4][2], const Unit& u, int wr, int wc, int fr, int fq) const {
        const int R0 = u.pm * 256, pn = u.pn, br = pn >> 2, cin = 32 * wc + 8 * fq;
        const size_t boff = br == 0 ? WS_K : (br == 1 ? WS_V : ((pn & 2) ? WS_P3 : WS_P1));
        bf16* base = (bf16*)(wsb + boff); const int ld = br == 2 ? 512 : 1024, c0 = (br == 2 ? (pn & 1) : (pn & 3)) * 256 + cin;
        f32x4 bv[2][2];
#pragma unroll
        for (int bj = 0; bj < 2; ++bj)
#pragma unroll
            for (int n = 0; n < 2; ++n) bv[bj][n] = *(const GAS f32x4*)(bias + pn * 256 + bj * 128 + cin + 4 * n);
#pragma unroll
        for (int ai = 0; ai < 2; ++ai)
#pragma unroll
            for (int m = 0; m < 4; ++m) {
                const int r = R0 + ai * 128 + wr * 64 + m * 16 + fr; bf16* rowp = base + (size_t)r * ld + c0;
#pragma unroll
                for (int bj = 0; bj < 2; ++bj) {
                    f32x4 a = acc[ai][bj][m][0] + bv[bj][0], b = acc[ai][bj][m][1] + bv[bj][1];
#pragma unroll
                    for (int q = 0; q < 4; ++q) { a[q] = sigmoid_f(a[q]); b[q] = sigmoid_f(b[q]); }
                    *(GAS u32x4*)(rowp + bj * 128) = pack8(a, b); }
            }
    }
};

struct EpiMerge {
    static constexpr bool PERM = true, AFTER_DRAIN = false;
    bf16* Y; const bf16* G0; long g1off; int gld; int gsplit_tiles;
    int first;
    __device__ __forceinline__ void operator()(const f32x4 (&acc)[2][2][4][2], const Unit& u, int wr, int wc, int fr, int fq) const {
        const int R0 = u.pm * 256, pn = u.pn, cin = 32 * wc + 8 * fq;
        const bf16* gb = G0 + (pn < gsplit_tiles ? (long)pn * 256 : g1off + (long)(pn - gsplit_tiles) * 256);
#pragma unroll
        for (int ai = 0; ai < 2; ++ai)
#pragma unroll
            for (int m = 0; m < 4; ++m) {
                const int r = R0 + ai * 128 + wr * 64 + m * 16 + fr; bf16* yp = Y + (size_t)r * DM + pn * 256 + cin; const bf16* gp = gb + (size_t)r * gld + cin;
#pragma unroll
                for (int bj = 0; bj < 2; ++bj) {
                    const u32x4 gw = *(const GAS u32x4*)(gp + bj * 128); f32x4 ga, gb2; unpack8(gw, ga, gb2);
                    f32x4 a = acc[ai][bj][m][0] * ga, b = acc[ai][bj][m][1] * gb2;
                    if (!first) { const u32x4 yw = *(const GAS u32x4*)(yp + bj * 128); f32x4 ya, yb; unpack8(yw, ya, yb); a += ya; b += yb; }
                    *(GAS u32x4*)(yp + bj * 128) = pack8(a, b); }
            }
    }
};

struct EpiResid {
    static constexpr bool PERM = false, AFTER_DRAIN = false;
    const float* xb; float* xo; long cbd, cod; const float* modl; int slot;
    __device__ __forceinline__ void operator()(const f32x4 (&acc)[2][2][4][2], const Unit& u, int wr, int wc, int fr, int fq) const {
        const int R0 = u.pm * 256; const bool isctx = R0 >= ML; const int b = isctx ? 16 : (R0 >> 12);
        const float* base = xb + (isctx ? cbd : 0l); float* out = xo + (isctx ? cod : 0l);
        const int col0 = u.pn * 256 + wc * 32 + 4 * fq; const float* gp = modl + (size_t)b * 6144 + slot * 1024 + col0;
        f32x4 gv[2][2];
#pragma unroll
        for (int bj = 0; bj < 2; ++bj)
#pragma unroll
            for (int n = 0; n < 2; ++n) gv[bj][n] = *(const GAS f32x4*)(gp + bj * 128 + n * 16);
#pragma unroll
        for (int ai = 0; ai < 2; ++ai)
#pragma unroll
            for (int m = 0; m < 4; ++m) { const size_t off = (size_t)(R0 + ai * 128 + wr * 64 + m * 16 + fr) * DM + col0;
#pragma unroll
                for (int bj = 0; bj < 2; ++bj)
#pragma unroll
                    for (int n = 0; n < 2; ++n) { const f32x4 bs = *(const GAS f32x4*)(base + off + bj * 128 + n * 16); *(GAS f32x4*)(out + off + bj * 128 + n * 16) = bs + gv[bj][n] * acc[ai][bj][m][n]; }
            }
    }
};

struct EpiSwiGLU {
    static constexpr bool PERM = true, AFTER_DRAIN = false;
    bf16* ACT; int ld, pm0, npe;
    __device__ __forceinline__ void operator()(const f32x4 (&acc)[2][2][4][2], const Unit& u, int wr, int wc, int fr, int fq) const {
        const int R0 = (u.pm - pm0) * 256, jt = u.pn % npe, c0 = jt * 128 + 32 * wc + 8 * fq;
#pragma unroll
        for (int ai = 0; ai < 2; ++ai)
#pragma unroll
            for (int m = 0; m < 4; ++m) {
                const int r = R0 + ai * 128 + wr * 64 + m * 16 + fr; f32x4 a, b;
#pragma unroll
                for (int q = 0; q < 4; ++q) { a[q] = silu_f(acc[ai][0][m][0][q]) * acc[ai][1][m][0][q]; b[q] = silu_f(acc[ai][0][m][1][q]) * acc[ai][1][m][1][q]; }
                *(GAS u32x4*)(ACT + (size_t)r * ld + c0) = pack8(a, b); }
    }
};

struct EpiStoreBf16 {
    static constexpr bool PERM = true, AFTER_DRAIN = false;
    bf16* O; int ld, pm0, npe;
    __device__ __forceinline__ void operator()(const f32x4 (&acc)[2][2][4][2], const Unit& u, int wr, int wc, int fr, int fq) const {
        const int R0 = (pm0 + u.pm) * 256, c0 = (u.pn % npe) * 256 + 32 * wc + 8 * fq;
#pragma unroll
        for (int ai = 0; ai < 2; ++ai)
#pragma unroll
            for (int m = 0; m < 4; ++m) { bf16* rowp = O + (size_t)(R0 + ai * 128 + wr * 64 + m * 16 + fr) * ld + c0;
#pragma unroll
                for (int bj = 0; bj < 2; ++bj) *(GAS u32x4*)(rowp + bj * 128) = pack8(acc[ai][bj][m][0], acc[ai][bj][m][1]); }
    }
};

struct MoeOrder {
    pg8::StaticOrder so; int tile0, npe; bool a_global; const volatile LAS int* offl;
    __device__ __forceinline__ bool next(int i, Unit& u) const {
        Unit v; if (!so.next(i, v)) return false;
        const int gt = tile0 + v.pm, row = gt * 256; int e = 0;
#pragma unroll
        for (int q = 1; q < 8; ++q) e += (offl[q] <= row) ? 1 : 0;
        u.pm = a_global ? gt : v.pm; u.pn = e * npe + v.pn; return true;
    }
    __device__ __forceinline__ void a_ready(const Unit&) const {}
    __device__ __forceinline__ void done(const Unit&) const {}
};

namespace att {
using bf16x8 = __attribute__((ext_vector_type(8))) short;
using s16x4  = __attribute__((ext_vector_type(4))) short;
using f32x16 = __attribute__((ext_vector_type(16))) float;
constexpr int NW = 8, QBLK = 32, KVBLK = 64, LD = 1024;
constexpr int SHM_V = KVBLK * 128 * 2, SHM_K = KVBLK * 128 * 2, SHM_ATTN = 2 * SHM_V + 2 * SHM_K + NW * 64 * 4;
constexpr float THR = 8.f;
#define KSWZ(row, colB) ((row) * 256 + ((colB) ^ (((row) & 7) << 4)))
#define SBAR() __builtin_amdgcn_sched_barrier(0)
__device__ __forceinline__ int crow(int r, int hi) { return (r & 3) + 8 * (r >> 2) + 4 * hi; }
__device__ __forceinline__ unsigned cvtpk(float lo, float hi) { return pg8::cvt_pk_bf16(lo, hi); }

__device__ __forceinline__ void partialSM(f32x16& p0, f32x16& p1, float& m_reg, float& mn, float& alpha) {
  float pmax = p0[0];
#pragma unroll
  for (int r = 1; r < 16; ++r) pmax = fmaxf(pmax, p0[r]);
#pragma unroll
  for (int r = 0; r < 16; ++r) pmax = fmaxf(pmax, p1[r]);
  { auto rr = __builtin_amdgcn_permlane32_swap(__float_as_uint(pmax), __float_as_uint(pmax), false, false);
    pmax = fmaxf(__uint_as_float(rr[0]), __uint_as_float(rr[1])); }
  if (__builtin_expect(__all(pmax - m_reg <= THR), 1)) { mn = m_reg; alpha = 1.f; }
  else { mn = fmaxf(m_reg, pmax); alpha = __builtin_amdgcn_exp2f(m_reg - mn); m_reg = mn; }
#pragma unroll
  for (int r = 0; r < 16; ++r) p0[r] = p0[r] - mn;
#pragma unroll
  for (int r = 0; r < 16; ++r) p1[r] = p1[r] - mn;
#pragma unroll
  for (int r = 0; r < 16; ++r) p0[r] = __builtin_amdgcn_exp2f(p0[r]);
}
__device__ __forceinline__ void finishSM(f32x16& p0, f32x16& p1, float alpha, float& l_reg, bf16x8& pa0, bf16x8& pa1, bf16x8& pa2, bf16x8& pa3) {
#pragma unroll
  for (int r = 0; r < 16; ++r) p1[r] = __builtin_amdgcn_exp2f(p1[r]);
  float ps = 0;
#pragma unroll
  for (int r = 0; r < 16; ++r) ps += p0[r];
#pragma unroll
  for (int r = 0; r < 16; ++r) ps += p1[r];
  { auto rr = __builtin_amdgcn_permlane32_swap(__float_as_uint(ps), __float_as_uint(ps), false, false);
    ps = __uint_as_float(rr[0]) + __uint_as_float(rr[1]); }
  l_reg = l_reg * alpha + ps;
#define PK4(P, BASE, OUT) do { unsigned a0 = cvtpk(P[BASE + 0], P[BASE + 1]), a1 = cvtpk(P[BASE + 2], P[BASE + 3]);   \
    unsigned b0 = cvtpk(P[BASE + 4], P[BASE + 5]), b1 = cvtpk(P[BASE + 6], P[BASE + 7]);                              \
    auto r0 = __builtin_amdgcn_permlane32_swap(a0, b0, false, false); auto r1 = __builtin_amdgcn_permlane32_swap(a1, b1, false, false); \
    u32x4 w = {r0[0], r1[0], r0[1], r1[1]}; OUT = __builtin_bit_cast(bf16x8, w); } while (0)
  PK4(p0, 0, pa0); PK4(p0, 8, pa1); PK4(p1, 0, pa2); PK4(p1, 8, pa3);
#undef PK4
}
__device__ __forceinline__ void qkt(f32x16& p0, f32x16& p1, const LAS char* Ks, const bf16x8* qr, int r32, int hi, int mp) {
  p0 = f32x16{}; p1 = f32x16{};
#pragma unroll
  for (int d0 = 0; d0 < 4; ++d0) { const int cb = (mp * 64 + d0 * 16 + hi * 8) * 2;
    const bf16x8 b0 = *(const LAS bf16x8*)(Ks + KSWZ(r32, cb));
    const bf16x8 b1 = *(const LAS bf16x8*)(Ks + KSWZ(32 + r32, cb));
    p0 = __builtin_amdgcn_mfma_f32_32x32x16_bf16(b0, qr[d0], p0, 0, 0, 0);
    p1 = __builtin_amdgcn_mfma_f32_32x32x16_bf16(b1, qr[d0], p1, 0, 0, 0); }
}
__device__ __forceinline__ int v_st(int k, int c) { const int kk = (k & ~0xC) | ((k & 4) << 1) | ((k & 8) >> 1); return ((kk >> 3) * 4 + (c >> 5)) * 512 + ((kk & 7) * 32 + (c & 31)) * 2; }
__device__ __forceinline__ int v_rd_base(int lane) { return ((lane & 3) << 3) | (((lane >> 2) & 3) << 6) | (((lane >> 4) & 1) << 5) | (((lane >> 5) & 1) << 8); }
constexpr int v_rd_off(int d0, int ks, int half) { return d0 * 512 + ks * 4096 + half * 2048; }
template <int OFF> __device__ __forceinline__ s16x4 tr_read(int vb) {
  s16x4 r; asm volatile("ds_read_b64_tr_b16 %0, %1 offset:%2" : "=&v"(r) : "v"(vb), "i"(OFF) : "memory"); return r;
}
template <int D0> __device__ __forceinline__ void pv_one(f32x16& od, int vb, bf16x8 pa0, bf16x8 pa1, bf16x8 pa2, bf16x8 pa3) {
  const s16x4 l0 = tr_read<v_rd_off(D0, 0, 0)>(vb), h0 = tr_read<v_rd_off(D0, 0, 1)>(vb), l1 = tr_read<v_rd_off(D0, 1, 0)>(vb), h1 = tr_read<v_rd_off(D0, 1, 1)>(vb);
  const s16x4 l2 = tr_read<v_rd_off(D0, 2, 0)>(vb), h2 = tr_read<v_rd_off(D0, 2, 1)>(vb), l3 = tr_read<v_rd_off(D0, 3, 0)>(vb), h3 = tr_read<v_rd_off(D0, 3, 1)>(vb);
  asm volatile("s_waitcnt lgkmcnt(0)" ::: "memory"); SBAR();
#define PK(L, H) (bf16x8){L[0], L[1], L[2], L[3], H[0], H[1], H[2], H[3]}
  od = __builtin_amdgcn_mfma_f32_32x32x16_bf16(pa0, PK(l0, h0), od, 0, 0, 0);
  od = __builtin_amdgcn_mfma_f32_32x32x16_bf16(pa1, PK(l1, h1), od, 0, 0, 0);
  od = __builtin_amdgcn_mfma_f32_32x32x16_bf16(pa2, PK(l2, h2), od, 0, 0, 0);
  od = __builtin_amdgcn_mfma_f32_32x32x16_bf16(pa3, PK(l3, h3), od, 0, 0, 0);
#undef PK
}
__device__ __forceinline__ void pv_d0(f32x16* o, int vb, bf16x8 pa0, bf16x8 pa1, bf16x8 pa2, bf16x8 pa3) {
  pv_one<0>(o[0], vb, pa0, pa1, pa2, pa3); pv_one<1>(o[1], vb, pa0, pa1, pa2, pa3); pv_one<2>(o[2], vb, pa0, pa1, pa2, pa3); pv_one<3>(o[3], vb, pa0, pa1, pa2, pa3);
}

__device__ __forceinline__ void diff_attn_unit(const bf16* __restrict__ Qb, const bf16* __restrict__ Kh, const bf16* __restrict__ Vh, bf16* Ob, int NT,
                                               float lam, const float* __restrict__ subg, float oml, LAS char* lds) {
  const int tid = threadIdx.x, wid = tid >> 6, lane = tid & 63, r32 = lane & 31, hi = lane >> 5, qg = wid >> 1, mp = wid & 1;
  LAS char* V_lds = lds; LAS char* K_lds = lds + 2 * SHM_V;
  LAS float* ws = (LAS float*)(lds + 2 * SHM_V + 2 * SHM_K) + wid * 64; LAS float* li_l = ws; LAS float* al_l = ws + 32;
  float m_reg = -1e30f, l_reg = 0; f32x16 o[4] = {}; bf16x8 qr[4];
  const bf16* Qw = Qb + (long)(qg * QBLK + r32) * LD + mp * 64 + hi * 8;
#pragma unroll
  for (int d0 = 0; d0 < 4; ++d0) qr[d0] = *reinterpret_cast<const bf16x8*>(Qw + d0 * 16);
  const int sr = tid >> 4, sc = (tid & 15) * 8, vst0 = v_st(sr, sc), vst1 = v_st(32 + sr, sc);
  const int vb0 = (int)(unsigned)(uintptr_t)V_lds + v_rd_base(lane);
  struct { bf16x8 vs0, vs1, ks0, ks1; } sr_[2];
#define SLOAD(i, k0) do { sr_[i].vs0 = *reinterpret_cast<const bf16x8*>(&Vh[(long)((k0) + sr) * LD + sc]); sr_[i].vs1 = *reinterpret_cast<const bf16x8*>(&Vh[(long)((k0) + 32 + sr) * LD + sc]); \
    sr_[i].ks0 = *reinterpret_cast<const bf16x8*>(&Kh[(long)((k0) + sr) * LD + sc]); sr_[i].ks1 = *reinterpret_cast<const bf16x8*>(&Kh[(long)((k0) + 32 + sr) * LD + sc]); } while (0)
#define SWRITE(b, i) do { *(LAS bf16x8*)(V_lds + (b) * SHM_V + vst0) = sr_[i].vs0;          \
    *(LAS bf16x8*)(V_lds + (b) * SHM_V + vst1) = sr_[i].vs1; const int kc = sc * 2;               \
    *(LAS bf16x8*)(K_lds + (b) * SHM_K + KSWZ(sr, kc)) = sr_[i].ks0;                       \
    *(LAS bf16x8*)(K_lds + (b) * SHM_K + KSWZ(32 + sr, kc)) = sr_[i].ks1; } while (0)
#define SWAIT() asm volatile("s_waitcnt vmcnt(4)" ::: "memory")
#define RESC(a) do { if (__any((a) < 1.f)) { if (hi == 0) al_l[r32] = (a); asm volatile("s_waitcnt lgkmcnt(0)" ::: "memory"); \
    _Pragma("unroll") for (int d = 0; d < 4; ++d) _Pragma("unroll") for (int r = 0; r < 16; ++r) o[d][r] *= al_l[crow(r, hi)]; } } while (0)
  f32x16 pA0, pA1, pB0, pB1; float mnA, mnB, alA, alB; bf16x8 pa0, pa1, pa2, pa3;
  constexpr int SE = 0, SO = 1;
  SLOAD(SE, 0); asm volatile("s_waitcnt vmcnt(0)" ::: "memory"); SWRITE(0, SE); __syncthreads();
  qkt(pA0, pA1, K_lds, qr, r32, hi, mp); partialSM(pA0, pA1, m_reg, mnA, alA);
  SLOAD(SO, KVBLK); if (2 < NT) SLOAD(SE, 2 * KVBLK);
  SWAIT(); SWRITE(1, SO); __syncthreads();
  for (int j = 1; j + 1 < NT; j += 2) {
    SBAR(); qkt(pB0, pB1, K_lds + SHM_K, qr, r32, hi, mp);
    finishSM(pA0, pA1, alA, l_reg, pa0, pa1, pa2, pa3); SBAR();
    SLOAD(SO, (j + 2) * KVBLK); SBAR();
    pv_d0(o, vb0, pa0, pa1, pa2, pa3); partialSM(pB0, pB1, m_reg, mnB, alB);
    __syncthreads(); SWAIT(); SWRITE(0, SE);
    RESC(alB); __syncthreads();
    SBAR(); qkt(pA0, pA1, K_lds, qr, r32, hi, mp);
    finishSM(pB0, pB1, alB, l_reg, pa0, pa1, pa2, pa3); SBAR();
    if (j + 3 < NT) SLOAD(SE, (j + 3) * KVBLK); SBAR();
    pv_d0(o, vb0 + SHM_V, pa0, pa1, pa2, pa3); partialSM(pA0, pA1, m_reg, mnA, alA);
    __syncthreads(); SWAIT(); SWRITE(1, SO);
    RESC(alA); __syncthreads();
  }
  SBAR(); qkt(pB0, pB1, K_lds + SHM_K, qr, r32, hi, mp);
  finishSM(pA0, pA1, alA, l_reg, pa0, pa1, pa2, pa3); SBAR();
  pv_d0(o, vb0, pa0, pa1, pa2, pa3); partialSM(pB0, pB1, m_reg, mnB, alB);
  __syncthreads(); RESC(alB);
  finishSM(pB0, pB1, alB, l_reg, pa0, pa1, pa2, pa3); SBAR();
  pv_d0(o, vb0 + SHM_V, pa0, pa1, pa2, pa3);
  if (hi == 0) li_l[r32] = l_reg; asm volatile("s_waitcnt lgkmcnt(0)" ::: "memory");
  float rli[16];
#pragma unroll
  for (int r = 0; r < 16; ++r) rli[r] = __builtin_amdgcn_rcpf(li_l[crow(r, hi)]);
  __syncthreads();
  LAS float* X = (LAS float*)lds + qg * 4096;
  if (mp == 1) {
#pragma unroll
    for (int d0 = 0; d0 < 4; ++d0)
#pragma unroll
      for (int r = 0; r < 16; ++r) X[(d0 * 16 + r) * 64 + lane] = o[d0][r] * rli[r] * (-lam);
  }
  __syncthreads();
  if (mp == 0) {
#pragma unroll
    for (int d0 = 0; d0 < 4; ++d0)
#pragma unroll
      for (int r = 0; r < 16; ++r) o[d0][r] = o[d0][r] * rli[r] + X[(d0 * 16 + r) * 64 + lane];
    float g4[4];
#pragma unroll
    for (int d0 = 0; d0 < 4; ++d0) g4[d0] = subg[32 * d0 + r32] * oml;
    bf16* Ow = Ob + (long)(qg * QBLK) * LD;
#pragma unroll
    for (int r = 0; r < 16; ++r) {
      float ss = (o[0][r] * o[0][r] + o[1][r] * o[1][r]) + (o[2][r] * o[2][r] + o[3][r] * o[3][r]);
      ss += __shfl_xor(ss, 1); ss += __shfl_xor(ss, 2); ss += __shfl_xor(ss, 4); ss += __shfl_xor(ss, 8); ss += __shfl_xor(ss, 16);
      const float rs = 1.0f / sqrtf(ss * (1.f / 128.f) + EPS); const int orow = crow(r, hi);
#pragma unroll
      for (int d0 = 0; d0 < 4; ++d0) Ow[(long)orow * LD + d0 * 32 + r32] = (bf16)f2bf(o[d0][r] * rs * g4[d0]);
    }
  }
  __syncthreads();
#undef SLOAD
#undef SWRITE
#undef SWAIT
#undef RESC
}
#undef KSWZ
#undef SBAR
}

constexpr int VT_PITCH = 272;
constexpr int MIX_VT_BYTES = 512 * VT_PITCH;
constexpr int MIX_ST_OFF = MIX_VT_BYTES;
static_assert(MIX_ST_OFF + 1024 <= LDSCTL_OFF, "mixer LDS");
__device__ __forceinline__ void mixer_chunk(const Ctx& C, int ch, bf16* P0, const bf16* P1, bf16* P2, const bf16* P3,
                                            const float* ln_g, const float* ln_b, const bf16* aws  , const float* abs_  , const float* convw  ) {
    const int row0 = ch * 128, tid = C.tid, lane = C.lane, wid = C.wave;
    LAS unsigned char* VT = C.lds; LAS f32x2* ST = (LAS f32x2*)(C.lds + MIX_ST_OFF);
#pragma unroll 2
    for (int i = 0; i < 16; ++i) {
        const int s = wid * 16 + i; const u32x4 w = *(const GAS u32x4*)(P1 + (size_t)(row0 + s) * 512 + lane * 8);
        f32x4 a, b; unpack8(w, a, b);
        const float mean = wave_sum((a[0] + a[1]) + (a[2] + a[3]) + (b[0] + b[1]) + (b[2] + b[3])) * (1.f / 512.f);
        a = a - mean; b = b - mean;
        const float var = wave_sum((a[0] * a[0] + a[1] * a[1]) + (a[2] * a[2] + a[3] * a[3]) + (b[0] * b[0] + b[1] * b[1]) + (b[2] * b[2] + b[3] * b[3])) * (1.f / 512.f);
        if (lane == 0) ST[s] = (f32x2){mean, 1.0f / sqrtf(var + EPS)};
    }
    __syncthreads();
    {
        const int s = tid & 127, q = tid >> 7; const f32x2 st = ST[s]; const bf16* src = P1 + (size_t)(row0 + s) * 512 + q * 128;
#pragma unroll 2
        for (int i = 0; i < 16; ++i) {
            const int c0 = q * 128 + i * 8; const u32x4 w = *(const GAS u32x4*)(src + i * 8); f32x4 a, b; unpack8(w, a, b);
            const f32x4 g0 = *(const GAS f32x4*)(ln_g + c0), g1 = *(const GAS f32x4*)(ln_g + c0 + 4), b0 = *(const GAS f32x4*)(ln_b + c0), b1 = *(const GAS f32x4*)(ln_b + c0 + 4);
            a = (a - st.x) * st.y * g0 + b0; b = (b - st.x) * st.y * g1 + b1;
#pragma unroll
            for (int e = 0; e < 4; ++e) { *(LAS bf16*)(VT + (c0 + e) * VT_PITCH + s * 2) = (bf16)f2bf(a[e]); *(LAS bf16*)(VT + (c0 + 4 + e) * VT_PITCH + s * 2) = (bf16)f2bf(b[e]); }
        }
    }
    __syncthreads();
    {
        const int g = wid, fr = lane & 15, fq = lane >> 4;
        const bf16* wg = aws + (size_t)g * 128 * 128;
#pragma unroll 1
        for (int th = 0; th < 2; ++th) {
            f32x4 acc[4][4];
#pragma unroll
            for (int ti = 0; ti < 4; ++ti)
#pragma unroll
                for (int ei = 0; ei < 4; ++ei) acc[ti][ei] = (f32x4){0.f, 0.f, 0.f, 0.f};
#pragma unroll 1
            for (int kk = 0; kk < 4; ++kk) {
                bf16x8 xf[4], yf[4];
#pragma unroll
                for (int ei = 0; ei < 4; ++ei) xf[ei] = *(const LAS bf16x8*)(VT + (g * 64 + 16 * ei + fr) * VT_PITCH + (32 * kk + 8 * fq) * 2);
#pragma unroll
                for (int ti = 0; ti < 4; ++ti) yf[ti] = *(const GAS bf16x8*)(wg + (size_t)(64 * th + 16 * ti + fr) * 128 + 32 * kk + 8 * fq);
#pragma unroll
                for (int ti = 0; ti < 4; ++ti)
#pragma unroll
                    for (int ei = 0; ei < 4; ++ei) acc[ti][ei] = __builtin_amdgcn_mfma_f32_16x16x32_bf16(xf[ei], yf[ti], acc[ti][ei], 0, 0, 0);
            }
#pragma unroll
            for (int ti = 0; ti < 4; ++ti) {
                const int t = 64 * th + 16 * ti + fr; const float bs = abs_[g * 128 + t];
#pragma unroll
                for (int ei = 0; ei < 4; ++ei) {
                    bf16* p = P0 + (size_t)(row0 + t) * 512 + g * 64 + 16 * ei + 4 * fq; const v2u uw = *(const GAS v2u*)p;
                    const f32x4 a = acc[ti][ei] + bs;
                    v2u ow; ow.x = cvt_pk_bf16(bf2f(uw.x & 0xffffu) * a[0], bf2f(uw.x >> 16) * a[1]); ow.y = cvt_pk_bf16(bf2f(uw.y & 0xffffu) * a[2], bf2f(uw.y >> 16) * a[3]);
                    *(GAS v2u*)p = ow; }
            }
        }
    }
    {
        const int c0 = lane * 8;
        f32x4 w0a = *(const GAS f32x4*)(convw + c0), w0b = *(const GAS f32x4*)(convw + c0 + 4), w1a = *(const GAS f32x4*)(convw + 512 + c0), w1b = *(const GAS f32x4*)(convw + 512 + c0 + 4),
              w2a = *(const GAS f32x4*)(convw + 1024 + c0), w2b = *(const GAS f32x4*)(convw + 1024 + c0 + 4);
#pragma unroll 2
        for (int i = 0; i < 16; ++i) {
            const int r = row0 + wid * 16 + i; const bool isctx = r >= ML; const int tseq = isctx ? ((r - ML) & 255) : (r & 4095), last = isctx ? 255 : 4095;
            const u32x4 zero = {0u, 0u, 0u, 0u};
            const u32x4 zm = tseq > 0 ? *(const GAS u32x4*)(P3 + (size_t)(r - 1) * 512 + c0) : zero;
            const u32x4 zc = *(const GAS u32x4*)(P3 + (size_t)r * 512 + c0);
            const u32x4 zp = tseq < last ? *(const GAS u32x4*)(P3 + (size_t)(r + 1) * 512 + c0) : zero;
            const u32x4 bw = *(const GAS u32x4*)(P2 + (size_t)r * 512 + c0);
            f32x4 ma, mb, ca, cb, pa, pb, ba, bb; unpack8(zm, ma, mb); unpack8(zc, ca, cb); unpack8(zp, pa, pb); unpack8(bw, ba, bb);
            const f32x4 ya = ba * (w0a * ma + w1a * ca + w2a * pa), yb = bb * (w0b * mb + w1b * cb + w2b * pb);
            *(GAS u32x4*)(P2 + (size_t)r * 512 + c0) = pack8(ya, yb);
        }
    }
    __syncthreads();
}

__device__ __forceinline__ void route_phase(const Ctx& C, const float* x, const float* gn, const float* modl, const float* w_router, bf16* H, unsigned* route) {
    LAS float* Wl = (LAS float*)C.lds;
    for (int idx = C.tid; idx < 8192; idx += NTHREADS) { const int k = idx >> 3, e = idx & 7; Wl[((k & 3) + 4 * (k >> 8)) * 512 + ((k >> 2) & 63) * 8 + e] = w_router[idx]; }
    __syncthreads();
    const int RPW = (ML + C.NGW - 1) / C.NGW;
    const int lane = C.lane; const int r0 = C.gw * RPW;
    unsigned long long lc = 0ull;
    unsigned my_e = 0u, my_p = 0u; float my_w1 = 0.f, my_w2 = 0.f;
    for (int it = 0; it < RPW; ++it) {
        const int r = r0 + it; if (r >= ML) break;
        const int b = r >> 12; f32x4 y[4];
        modulate_row(x + (size_t)r * DM, gn, modl + (size_t)b * 6144 + 4 * 1024, modl + (size_t)b * 6144 + 3 * 1024, H + (size_t)r * DM, lane, y);
        float lg[8];
#pragma unroll
        for (int e = 0; e < 8; ++e) lg[e] = 0.f;
#pragma unroll
        for (int j = 0; j < 4; ++j)
#pragma unroll
            for (int i = 0; i < 4; ++i) { const LAS f32x4* wp = (const LAS f32x4*)(Wl + (i + 4 * j) * 512 + lane * 8); const f32x4 wa = wp[0], wb = wp[1]; const float v = y[j][i];
                lg[0] += v * wa[0]; lg[1] += v * wa[1]; lg[2] += v * wa[2]; lg[3] += v * wa[3]; lg[4] += v * wb[0]; lg[5] += v * wb[1]; lg[6] += v * wb[2]; lg[7] += v * wb[3]; }
#pragma unroll
        for (int e = 0; e < 8; ++e) lg[e] = wave_sum(lg[e]);
        int i1 = 0; float v1 = lg[0];
#pragma unroll
        for (int e = 1; e < 8; ++e) if (lg[e] > v1) { v1 = lg[e]; i1 = e; }
        int i2 = -1; float v2 = -3.0e38f;
#pragma unroll
        for (int e = 0; e < 8; ++e) if (e != i1 && lg[e] > v2) { v2 = lg[e]; i2 = e; }
        const float w1 = 1.f / (1.f + __expf(v2 - v1)), w2 = 1.f - w1;
        const unsigned p1 = (unsigned)(lc >> (8 * i1)) & 0xffu; lc += 1ull << (8 * i1);
        const unsigned p2 = (unsigned)(lc >> (8 * i2)) & 0xffu; lc += 1ull << (8 * i2);
        if (lane == it) { my_e = (unsigned)i1 | ((unsigned)i2 << 8); my_p = p1 | (p2 << 8); my_w1 = w1; my_w2 = w2; }
    }
    unsigned base = 0u;
    if (lane < 8) { const unsigned n = (unsigned)(lc >> (8 * lane)) & 0xffu; base = __hip_atomic_fetch_add((unsigned*)(C.ctl + CW_CNT + 64 * lane), n, __ATOMIC_RELAXED, __HIP_MEMORY_SCOPE_AGENT); }
    const unsigned b1 = __shfl(base, (int)(my_e & 0xffu)), b2 = __shfl(base, (int)(my_e >> 8));
    const int r = r0 + lane;
    if (lane < RPW && r < ML) { u32x4 w; w.x = my_e; w.y = __float_as_uint(my_w1); w.z = __float_as_uint(my_w2); w.w = b1 + (my_p & 0xffu); *(GAS u32x4*)(route + (size_t)r * 8) = w; route[(size_t)r * 8 + 4] = b2 + (my_p >> 8); }
}
__device__ __forceinline__ void moe_offsets(const Ctx& C, volatile LAS int* offl) {
    if (C.tid == 0) { int o = 0;
        for (int e = 0; e < 8; ++e) { const int c = (int)__hip_atomic_load((unsigned*)(C.ctl + CW_CNT + 64 * e), __ATOMIC_RELAXED, __HIP_MEMORY_SCOPE_AGENT); offl[e] = o; offl[16 + e] = c; o += (c + 255) & ~255; }
        offl[8] = o; }
    __syncthreads();
}
__device__ __forceinline__ void gather_phase(const Ctx& C, const bf16* H, bf16* HS, unsigned* route, const volatile LAS int* offl) {
    const int lane = C.lane;
    for (int t = C.gw; t < ML; t += C.NGW) {
        const u32x4 w = *(const GAS u32x4*)(route + (size_t)t * 8); const unsigned p2 = route[(size_t)t * 8 + 4];
        const int e1 = w.x & 0xff, e2 = (w.x >> 8) & 0xff; const int s1 = offl[e1] + (int)w.w, s2 = offl[e2] + (int)p2;
        const GAS u32x4* src = (const GAS u32x4*)(H + (size_t)t * DM) + lane; const u32x4 a = src[0], b = src[64];
        GAS u32x4* d1 = (GAS u32x4*)(HS + (size_t)s1 * DM) + lane; GAS u32x4* d2 = (GAS u32x4*)(HS + (size_t)s2 * DM) + lane;
        d1[0] = a; d1[64] = b; d2[0] = a; d2[64] = b;
        if (lane == 0) { route[(size_t)t * 8 + 5] = (unsigned)s1; route[(size_t)t * 8 + 6] = (unsigned)s2; }
    }
    for (int v = C.gw; v < 8 * 256; v += C.NGW) { const int e = v >> 8, i = v & 255; const int row = offl[e] + offl[16 + e] + i;
        if (row < offl[e + 1]) { GAS u32x4* d = (GAS u32x4*)(HS + (size_t)row * DM) + lane; const u32x4 z = {0u, 0u, 0u, 0u}; d[0] = z; d[64] = z; } }
}
__device__ __forceinline__ void final_phase(const Ctx& C, float* xo, const bf16* HS, const unsigned* route, const float* modl, const float* fg) {
    const int lane = C.lane;
    for (int t = C.gw; t < ML; t += C.NGW) {
        const u32x4 w = *(const GAS u32x4*)(route + (size_t)t * 8); const unsigned s1 = route[(size_t)t * 8 + 5], s2 = route[(size_t)t * 8 + 6];
        const float w1 = __uint_as_float(w.y), w2 = __uint_as_float(w.z); const int b = t >> 12;
        const float* g2 = modl + (size_t)b * 6144 + 5 * 1024;
        f32x4 v[4]; float ss = 0.f;
#pragma unroll
        for (int h = 0; h < 2; ++h) {
            const int c0 = h * 512 + lane * 8;
            const u32x4 oa = *(const GAS u32x4*)(HS + (size_t)s1 * DM + c0), ob = *(const GAS u32x4*)(HS + (size_t)s2 * DM + c0);
            f32x4 a0, a1, b0, b1; unpack8(oa, a0, a1); unpack8(ob, b0, b1);
            const f32x4 x0 = *(const GAS f32x4*)(xo + (size_t)t * DM + c0), x1 = *(const GAS f32x4*)(xo + (size_t)t * DM + c0 + 4);
            const f32x4 g0 = *(const GAS f32x4*)(g2 + c0), g1 = *(const GAS f32x4*)(g2 + c0 + 4);
            v[2 * h] = x0 + g0 * (a0 * w1 + b0 * w2); v[2 * h + 1] = x1 + g1 * (a1 * w1 + b1 * w2);
        }
#pragma unroll
        for (int j = 0; j < 4; ++j) ss += (v[j].x * v[j].x + v[j].y * v[j].y) + (v[j].z * v[j].z + v[j].w * v[j].w);
        const float rstd = 1.0f / sqrtf(wave_sum(ss) * (1.f / 1024.f) + EPS);
#pragma unroll
        for (int h = 0; h < 2; ++h) { const int c0 = h * 512 + lane * 8;
            const f32x4 f0 = *(const GAS f32x4*)(fg + c0), f1 = *(const GAS f32x4*)(fg + c0 + 4);
            *(GAS f32x4*)(xo + (size_t)t * DM + c0) = v[2 * h] * rstd * f0; *(GAS f32x4*)(xo + (size_t)t * DM + c0 + 4) = v[2 * h + 1] * rstd * f1; }
    }
}

#ifdef PROBE
constexpr int PR_BASE = 12288;
__device__ __forceinline__ unsigned hsh(unsigned x) { x ^= x >> 16; x *= 0x7feb352du; x ^= x >> 15; x *= 0x846ca68bu; x ^= x >> 16; return x; }
__device__ __forceinline__ float bfr(float f) { return bf2f(f2bf(f)); }
__device__ __forceinline__ float wdot(const bf16* a, const float* W, int ldw, int col, int K, int lane) {
    float s = 0.f; for (int k = lane; k < K; k += 64) s += bf2f(a[k]) * bfr(W[(size_t)k * ldw + col]); return wave_sum(s);
}
struct Probe {
    gu32* ctl; int tid, lane, wave; LAS float* sh;
    __device__ __forceinline__ void rec(int id, float got, float ref, float tol = 0.03f) const {
        const float err = fabsf(got - ref) / (fabsf(ref) + 0.05f);
        if (!(err <= tol)) { unsigned expect = 0u; if (__hip_atomic_compare_exchange_strong((unsigned*)(ctl + PR_BASE), &expect, (unsigned)id, __ATOMIC_RELAXED, __ATOMIC_RELAXED, __HIP_MEMORY_SCOPE_AGENT)) __hip_atomic_store((unsigned*)(ctl + PR_BASE + 1), __float_as_uint(err > 1e6f ? 1e6f : err), __ATOMIC_RELAXED, __HIP_MEMORY_SCOPE_AGENT); }
        else atomicMax((unsigned*)(ctl + PR_BASE + 2), __float_as_uint(err));
    }
};
#define RAWP(r, col) wdot(Hb + (size_t)(r) * DM, win, INC, (col), 1024, P.lane)

template <int L>
__device__ __forceinline__ void probe_after_mod1(const Probe& P, const Args& args, unsigned char* ws) {
    const float* mod = (const float*)(ws + WS_MOD) + (size_t)L * 17 * 6144; const bf16* Hb = (const bf16*)(ws + WS_H);
    for (int sidx = P.wave; sidx < 48; sidx += 8) {
        const unsigned hh = hsh(sidx * 977u + 13u + L * 7919u); const int b = hh % 17, j = (hh >> 8) % 6144;
        float s = 0.f; for (int k = P.lane; k < 1024; k += 64) { const float v = b < 16 ? args.in[1][b * 1024 + k] : args.in[3][k]; s += v / (1.f + __expf(-v)) * args.in[4][((size_t)L * 1024 + k) * 6144 + j]; }
        s = wave_sum(s) + args.in[5][L * 6144 + j];
        if (P.lane == 0) P.rec(1 + 20 * L, mod[(size_t)b * 6144 + j], s, 0.002f);
    }
    for (int sidx = P.wave; sidx < 64; sidx += 8) {
        const unsigned hh = hsh(sidx * 31337u + 5u + L); int r = hh % MA; if (sidx < 8) r = ML + (hh % MC); const int c = (hh >> 10) & 1023; const int b = r < ML ? (r >> 12) : 16;
        const float* xr = r < ML ? (L == 0 ? args.in[0] : (const float*)args.out) + (size_t)r * DM : (L == 0 ? args.in[2] : (const float*)(ws + WS_XC)) + (size_t)(r - ML) * DM;
        float ss = 0.f; for (int k = P.lane; k < 1024; k += 64) ss += xr[k] * xr[k]; ss = wave_sum(ss);
        const float ref = xr[c] * (1.f / sqrtf(ss / 1024.f + EPS)) * args.in[6][L * 1024 + c] * (1.f + mod[(size_t)b * 6144 + 1024 + c]) + mod[(size_t)b * 6144 + c];
        if (P.lane == 0) P.rec(2 + 20 * L, bf2f(Hb[(size_t)r * DM + c]), ref, 0.01f);
    }
}
template <int L>
__device__ __forceinline__ void probe_after_big(const Probe& P, const Args& args, unsigned char* ws) {
    const bf16* Hb = (const bf16*)(ws + WS_H); const float* win = args.in[8] + (size_t)L * 1024 * INC;
    for (int sidx = P.wave; sidx < 96; sidx += 8) {
        const unsigned hh = hsh(sidx * 7001u + 77u + L * 3u); int r = hh % ML; if ((sidx & 3) == 3) r = ML + (hh % MC);
        const bool isctx = r >= ML; const int b = isctx ? (r - ML) / CTXL : (r >> 12); const int t = isctx ? 0 : (r & 4095);
        const long krow = isctx ? (long)b * SKV + SEQ + (r - ML) % CTXL : (long)b * SKV + t;
        const int h = (hh >> 17) & 7, m = (hh >> 20) & 1, d = (hh >> 21) & 63;
        for (int qk = 0; qk < 2; ++qk) {
            const int a = d >> 5, wi = d & 31, i = wi & 15, half = wi >> 4;
            const int cbase = (qk == 0 ? 2560 : 3584) + h * 128 + m * 64 + 32 * a;
            const float x0 = RAWP(r, cbase + i), x1 = RAWP(r, cbase + 16 + i);
            float cs = 1.f, sn = 0.f;
            if (!isctx) { const float pos = (float)(a == 0 ? (t >> 6) : (t & 63)); const float inv = exp2f(-(float)i * (13.287712379549449f / 16.f)); const float ang = pos * inv; cs = cosf(ang); sn = sinf(ang); }
            float ref = half == 0 ? x0 * cs - x1 * sn : x1 * cs + x0 * sn; if (qk == 0) ref *= QSCALE;
            const int p = 32 * a + 2 * i + half;
            const bf16* buf = (const bf16*)(ws + (qk == 0 ? WS_Q : WS_K)); const long row = qk == 0 ? (long)r : krow;
            if (P.lane == 0) P.rec(3 + qk + 20 * L, bf2f(buf[(size_t)row * DM + h * 128 + m * 64 + p]), ref, 0.03f);
        }
        const int e = (hh >> 20) & 127;
        { const float ref = RAWP(r, 4608 + h * 128 + e); if (P.lane == 0) P.rec(5 + 20 * L, bf2f(((const bf16*)(ws + WS_V))[(size_t)krow * DM + h * 128 + e]), ref, 0.03f); }
        const int c = (hh >> 9) & 511;
        { const float ref = gelu_tanh_f(RAWP(r, c)); if (P.lane == 0) P.rec(6 + 20 * L, bf2f(((const bf16*)(ws + WS_P0))[(size_t)r * 512 + c]), ref, 0.03f); }
        { const float ref = gelu_tanh_f(RAWP(r, 512 + c)); if (P.lane == 0) P.rec(7 + 20 * L, bf2f(((const bf16*)(ws + WS_P1))[(size_t)r * 512 + c]), ref, 0.03f); }
        { const float ref = RAWP(r, 1024 + c); if (P.lane == 0) P.rec(8 + 20 * L, bf2f(((const bf16*)(ws + WS_P2))[(size_t)r * 512 + c]), ref, 0.03f); }
        { const float ref = RAWP(r, 1536 + c) * RAWP(r, 2048 + c); if (P.lane == 0) P.rec(9 + 20 * L, bf2f(((const bf16*)(ws + WS_P3))[(size_t)r * 512 + c]), ref, 0.04f); }
    }
}
template <int L>
__device__ __forceinline__ void probe_after_mix(const Probe& P, const Args& args, unsigned char* ws) {
    const bf16* Hb = (const bf16*)(ws + WS_H); const float* win = args.in[8] + (size_t)L * 1024 * INC;
    const bf16* P1 = (const bf16*)(ws + WS_P1); const bf16* P3 = (const bf16*)(ws + WS_P3);
#if EN_MIX
    for (int sidx = 0; sidx < 6; ++sidx) {
        const unsigned hh = hsh(sidx * 1237u + 3u + L); int r = hh % (L == 0 ? MA : ML); if (sidx == 5 && L == 0) r = ML + (hh % MC);
        const int c = (hh >> 12) & 511, g = c >> 6, row0 = r & ~127, tt = r & 127;
        __syncthreads();
        if (P.tid < 128) { const bf16* vr = P1 + (size_t)(row0 + P.tid) * 512; float s = 0.f; for (int k = 0; k < 512; ++k) s += bf2f(vr[k]); const float mean = s / 512.f; float q = 0.f; for (int k = 0; k < 512; ++k) { const float dlt = bf2f(vr[k]) - mean; q += dlt * dlt; }
            const float ln = (bf2f(vr[c]) - mean) * (1.f / sqrtf(q / 512.f + EPS)) * args.in[10][L * 512 + c] + args.in[11][L * 512 + c];
            P.sh[P.tid] = args.in[12][(((size_t)L * 8 + g) * 128 + tt) * 128 + P.tid] * ln; }
        __syncthreads();
        if (P.wave == 0) { float s = P.sh[P.lane] + P.sh[64 + P.lane]; s = wave_sum(s) + args.in[13][(L * 8 + g) * 128 + tt];
            const float gu = gelu_tanh_f(RAWP(r, c)); if (P.lane == 0) P.rec(10 + 20 * L, bf2f(((const bf16*)(ws + WS_P0))[(size_t)r * 512 + c]), bfr(gu) * s, 0.04f); }
    }
    for (int sidx = P.wave; sidx < 64; sidx += 8) {
        const unsigned hh = hsh(sidx * 4447u + 9u + L); int r = hh % (L == 0 ? MA : ML); if (sidx < 8) r = (sidx & 1) ? ((hh % BATCH) * SEQ + (sidx & 2 ? 0 : SEQ - 1)) : r; if (sidx >= 8 && sidx < 12 && L == 0) r = ML + (hh % BATCH) * CTXL + (sidx & 1 ? 0 : CTXL - 1);
        const int c = (hh >> 11) & 511; const bool isctx = r >= ML; const int tseq = isctx ? ((r - ML) & 255) : (r & 4095), last = isctx ? 255 : 4095;
        const float zm = tseq > 0 ? bf2f(P3[(size_t)(r - 1) * 512 + c]) : 0.f, zc = bf2f(P3[(size_t)r * 512 + c]), zp = tseq < last ? bf2f(P3[(size_t)(r + 1) * 512 + c]) : 0.f;
        const float bg = bfr(RAWP(r, 1024 + c)); const float* cw = args.in[14] + L * 1536;
        const float ref = bg * (cw[c] * zm + cw[512 + c] * zc + cw[1024 + c] * zp);
        if (P.lane == 0) P.rec(11 + 20 * L, bf2f(((const bf16*)(ws + WS_P2))[(size_t)r * 512 + c]), ref, 0.04f);
    }
#endif
#if EN_ATT
    LAS float* qv = P.sh;
    LAS float* s0 = P.sh + 128;
    LAS float* s1 = P.sh + 128 + 4352;
    LAS float* red = P.sh + 128 + 2 * 4352;
    LAS float* ov = red + 64;
    const float lam = ((const float*)(ws + WS_LAM))[L]; const float oml = L == 0 ? 0.8f : (1.f - (0.8f - 0.6f * 0.7408182206817179f));
    for (int sidx = 0; sidx < (L == 0 ? 5 : 3); ++sidx) {
        const unsigned hh = hsh(sidx * 9173u + 21u + L); const bool isctx = (L == 0 && sidx >= 3); const int b = hh % BATCH, h = (hh >> 8) & 7;
        const int r = isctx ? ML + b * CTXL + ((hh >> 12) % CTXL) : b * SEQ + ((hh >> 12) & 4095); const int t = r & 4095;
        const int nk = isctx ? CTXL : SKV; const long k0 = isctx ? (long)b * SKV + SEQ : (long)b * SKV;
        __syncthreads();
        for (int q = P.wave; q < 128; q += 8) {
            const int m = q >> 6, p = q & 63, a = p >> 5, i = (p & 31) >> 1, half = p & 1; const int cbase = 2560 + h * 128 + m * 64 + 32 * a;
            const float x0 = RAWP(r, cbase + i), x1 = RAWP(r, cbase + 16 + i); float cs = 1.f, sn = 0.f;
            if (!isctx) { const float pos = (float)(a == 0 ? (t >> 6) : (t & 63)); const float inv = exp2f(-(float)i * (13.287712379549449f / 16.f)); cs = cosf(pos * inv); sn = sinf(pos * inv); }
            if (P.lane == 0) qv[q] = bfr((half == 0 ? x0 * cs - x1 * sn : x1 * cs + x0 * sn) * QSCALE);
        }
        __syncthreads();
        const bf16* Kb = (const bf16*)(ws + WS_K); const bf16* Vb = (const bf16*)(ws + WS_V);
        for (int k = P.tid; k < nk; k += NTHREADS) { const bf16* kr = Kb + (size_t)(k0 + k) * DM + h * 128; float a0 = 0.f, a1 = 0.f; for (int dd = 0; dd < 64; ++dd) { a0 += qv[dd] * bf2f(kr[dd]); a1 += qv[64 + dd] * bf2f(kr[64 + dd]); } s0[k] = a0; s1[k] = a1; }
        __syncthreads();
        float m0 = -1e30f, m1 = -1e30f; for (int k = P.tid; k < nk; k += NTHREADS) { m0 = fmaxf(m0, s0[k]); m1 = fmaxf(m1, s1[k]); }
        for (int o = 1; o < 64; o <<= 1) { m0 = fmaxf(m0, __shfl_xor(m0, o)); m1 = fmaxf(m1, __shfl_xor(m1, o)); }
        if (P.lane == 0) { red[P.wave] = m0; red[8 + P.wave] = m1; } __syncthreads();
        m0 = red[0]; m1 = red[8]; for (int w = 1; w < 8; ++w) { m0 = fmaxf(m0, red[w]); m1 = fmaxf(m1, red[8 + w]); } __syncthreads();
        float l0 = 0.f, l1 = 0.f; for (int k = P.tid; k < nk; k += NTHREADS) { const float e0 = exp2f(s0[k] - m0), e1 = exp2f(s1[k] - m1); s0[k] = e0; s1[k] = e1; l0 += e0; l1 += e1; }
        l0 = wave_sum(l0); l1 = wave_sum(l1); if (P.lane == 0) { red[16 + P.wave] = l0; red[24 + P.wave] = l1; } __syncthreads();
        l0 = 0.f; l1 = 0.f; for (int w = 0; w < 8; ++w) { l0 += red[16 + w]; l1 += red[24 + w]; }
        if (P.tid < 128) { float acc = 0.f; for (int k = 0; k < nk; ++k) acc += (s0[k] / l0 - lam * s1[k] / l1) * bf2f(Vb[(size_t)(k0 + k) * DM + h * 128 + P.tid]); ov[P.tid] = acc; }
        __syncthreads();
        if (P.tid < 128) { float ss = 0.f; for (int e = 0; e < 128; ++e) ss += ov[e] * ov[e]; const float ref = ov[P.tid] * (1.f / sqrtf(ss / 128.f + EPS)) * args.in[16][L * 128 + P.tid] * oml;
            if ((P.tid & 15) == (sidx & 15) || P.tid == 77) P.rec((isctx ? 13 : 12) + 20 * L, bf2f(((const bf16*)(ws + WS_Q))[(size_t)r * DM + h * 128 + P.tid]), ref, 0.06f); }
    }
#endif
    __syncthreads();
}
template <int L>
__device__ __forceinline__ void probe_after_gate(const Probe& P, const Args& args, unsigned char* ws) {
    const bf16* Hb = (const bf16*)(ws + WS_H); const float* win = args.in[8] + (size_t)L * 1024 * INC;
    const bf16* WINb = (const bf16*)(ws + WS_WIN + L * WIN_BYTES);
    if (P.tid < 400) P.sh[16 + P.tid] = 0.f;
    __syncthreads();
    for (int sidx = P.wave; sidx < 96; sidx += 8) {
        const unsigned hh = hsh(sidx * 3301u + 11u + L); const int row = 5632 + (sidx % 3) * 1024 + ((hh >> 4) & 1023), k = (hh >> 16) & 1023;
        if (P.lane == 0) P.rec(13 + 20 * L, bf2f(WINb[(size_t)row * 1024 + k]), bfr(win[(size_t)k * INC + row]), 0.001f);
    }
    __syncthreads();
    for (int br = 0; br < 3; ++br) {
        for (int sidx = P.wave; sidx < 64; sidx += 8) {
            const unsigned hh = hsh(sidx * 5501u + 1u + L + br * 77u); const int r = hh % (L == 0 ? MA : ML), n = (hh >> 12) & 1023;
            const float ref = sigmoid_f(RAWP(r, 5632 + br * 1024 + n) + args.in[9][L * 3072 + br * 1024 + n]);
            const bf16* g = br == 0 ? (const bf16*)(ws + WS_K) + (size_t)r * DM + n : (br == 1 ? (const bf16*)(ws + WS_V) + (size_t)r * DM + n : (const bf16*)(ws + (n < 512 ? WS_P1 : WS_P3)) + (size_t)r * 512 + (n & 511));
            if (P.lane == 0) {
                const float got = bf2f(*g);
                if (fabsf(got - ref) / (fabsf(ref) + 0.05f) > 0.03f) { P.sh[16] = 1.f; const int sl = P.wave * 8 + (sidx >> 3); P.sh[128 + 2 * sl] = __uint_as_float((unsigned)((uintptr_t)g & 0xffffffffu)); P.sh[129 + 2 * sl] = __uint_as_float((unsigned)((uintptr_t)g >> 32)); P.sh[300 + sl] = ref; }
                else P.rec(14 + br + 20 * L, got, ref, 0.03f);
            }
        }
        __syncthreads();
        if (P.sh[16] != 0.f) {
            const GAS u32x4* tp = (const GAS u32x4*)args.in[25] + P.tid; u32x4 acc_ = {0u, 0u, 0u, 0u};
            for (int q_ = 0; q_ < 3072; ++q_) { const u32x4 v_ = tp[(size_t)q_ * 512]; acc_.x ^= v_.x; acc_.y ^= v_.y; acc_.z ^= v_.z; acc_.w ^= v_.w; }
            if ((acc_.x ^ acc_.y ^ acc_.z ^ acc_.w) == 0x12345677u) P.sh[100] = 1.f;
            __syncthreads();
            if (P.tid == 0) { for (int q = 0; q < 64; ++q) { const unsigned lo_ = __float_as_uint(P.sh[128 + 2 * q]), hi_ = __float_as_uint(P.sh[129 + 2 * q]); if (lo_ == 0u && hi_ == 0u) continue;
                const bf16* gq = (const bf16*)(((uintptr_t)hi_ << 32) | lo_); const unsigned* gw = (const unsigned*)((uintptr_t)gq & ~(uintptr_t)3); const int sh = ((uintptr_t)gq & 2) ? 16 : 0;
                const float g1 = bf2f((__hip_atomic_load(gw, __ATOMIC_RELAXED, __HIP_MEMORY_SCOPE_AGENT) >> sh) & 0xffffu); const float ref = P.sh[300 + q];
                const bool ok1 = fabsf(g1 - ref) / (fabsf(ref) + 0.05f) <= 0.03f; if (!ok1 && br == 0) {
                    const size_t eo = (size_t)(gq - (const bf16*)(ws + WS_K)); const int kr = (int)(eo >> 10), nn = (int)(eo & 1023); const int bb = kr / SKV, key = kr % SKV; const bool cx = key >= SEQ;
                    const int tok = cx ? ML + bb * CTXL + (key - SEQ) : bb * SEQ + key; const int hh2 = nn >> 7, mm = (nn >> 6) & 1, pp = nn & 63, aa = pp >> 5, ii = (pp & 31) >> 1, hf = pp & 1;
                    const int cb2 = 3584 + hh2 * 128 + mm * 64 + 32 * aa; float x0 = 0.f, x1 = 0.f;
                    for (int k = 0; k < 1024; ++k) { const float hv = bf2f(Hb[(size_t)tok * DM + k]); x0 += hv * bfr(win[(size_t)k * INC + cb2 + ii]); x1 += hv * bfr(win[(size_t)k * INC + cb2 + 16 + ii]); }
                    float cs = 1.f, sn = 0.f; if (!cx) { const float pos = (float)(aa == 0 ? (key >> 6) : (key & 63)); const float inv = exp2f(-(float)ii * (13.287712379549449f / 16.f)); cs = cosf(pos * inv); sn = sinf(pos * inv); }
                    const float kold = hf == 0 ? x0 * cs - x1 * sn : x1 * cs + x0 * sn;
                    if (fabsf(kold - g1) <= 0.03f * (fabsf(kold) + 0.05f)) { unsigned e9 = 0u; __hip_atomic_compare_exchange_strong((unsigned*)(P.ctl + PR_BASE + 6), &e9, 1u, __ATOMIC_RELAXED, __ATOMIC_RELAXED, __HIP_MEMORY_SCOPE_AGENT); }
                }
                if (!ok1) { unsigned expect = 0u; if (__hip_atomic_compare_exchange_strong((unsigned*)(P.ctl + PR_BASE + 3), &expect, __float_as_uint(g1) | 1u, __ATOMIC_RELAXED, __ATOMIC_RELAXED, __HIP_MEMORY_SCOPE_AGENT)) { __hip_atomic_store((unsigned*)(P.ctl + PR_BASE + 4), (unsigned)br + 1u, __ATOMIC_RELAXED, __HIP_MEMORY_SCOPE_AGENT); __hip_atomic_store((unsigned*)(P.ctl + PR_BASE + 5), __float_as_uint(ref), __ATOMIC_RELAXED, __HIP_MEMORY_SCOPE_AGENT); {
                        const size_t eo2 = (size_t)(gq - (const bf16*)(ws + WS_K)); const bf16* rb = (const bf16*)(ws + WS_K) + (eo2 & ~(size_t)63); int cr = 0, cc = 0;
                        for (int q2 = 0; q2 < 64; ++q2) { const float v2 = bf2f(rb[q2]); if (!(v2 >= 0.f && v2 <= 1.f)) ++cr; }
                        const size_t rr2 = (eo2 >> 10) & ~(size_t)63, nn2 = eo2 & 1023;
                        for (int q2 = 0; q2 < 64; ++q2) { const float v2 = bf2f(((const bf16*)(ws + WS_K))[(rr2 + q2) * 1024 + nn2]); if (!(v2 >= 0.f && v2 <= 1.f)) ++cc; }
                        int c16 = 0, c8 = 0; const size_t r0b = eo2 >> 10;
                        for (int q2 = 0; q2 < 64; ++q2) { const float v2 = bf2f(((const bf16*)(ws + WS_K))[(rr2 + q2) * 1024 + nn2]); const bool bad = !(v2 >= 0.f && v2 <= 1.f); if (bad && ((rr2 + q2) & 15) == (r0b & 15)) ++c16; if (bad && ((rr2 + q2) >> 3) == (r0b >> 3)) ++c8; }
                        unsigned m8 = 0u, g8 = 0u; for (int q2 = 0; q2 < 64; ++q2) { const float v2 = bf2f(((const bf16*)(ws + WS_K))[(rr2 + q2) * 1024 + nn2]); const bool bad = !(v2 >= 0.f && v2 <= 1.f); if (bad && ((rr2 + q2) >> 3) == (r0b >> 3)) m8 |= 1u << ((rr2 + q2) & 7); if (bad) g8 |= 1u << (q2 >> 3); }
                        __hip_atomic_store((unsigned*)(P.ctl + PR_BASE + 10), m8 | (g8 << 8), __ATOMIC_RELAXED, __HIP_MEMORY_SCOPE_AGENT);
                        __hip_atomic_store((unsigned*)(P.ctl + PR_BASE + 9), (unsigned)(c16 | (c8 << 8)), __ATOMIC_RELAXED, __HIP_MEMORY_SCOPE_AGENT);
                        __hip_atomic_store((unsigned*)(P.ctl + PR_BASE + 8), (unsigned)(cr | (cc << 8)), __ATOMIC_RELAXED, __HIP_MEMORY_SCOPE_AGENT); }
                    __hip_atomic_store((unsigned*)(P.ctl + PR_BASE + 7), (unsigned)(gq - (const bf16*)(ws + (br == 0 ? WS_K : (br == 1 ? WS_V : WS_P1)))), __ATOMIC_RELAXED, __HIP_MEMORY_SCOPE_AGENT); } } } }
        }
        __syncthreads();
    }
}
template <int L>
__device__ __forceinline__ void probe_after_wo(const Probe& P, const Args& args, unsigned char* ws) {
    const bf16* Hb = (const bf16*)(ws + WS_H); const float* win = args.in[8] + (size_t)L * 1024 * INC;
    const bf16* Y = (const bf16*)(ws + WS_K);
    for (int sidx = P.wave; sidx < 64; sidx += 8) {
        const unsigned hh = hsh(sidx * 811u + 17u + L); int r = hh % (L == 0 ? MA : ML); if (L == 0 && sidx < 8) r = ML + hh % MC; const int n = (hh >> 12) & 1023;
        const float ga = sigmoid_f(RAWP(r, 5632 + n) + args.in[9][L * 3072 + n]), gb = sigmoid_f(RAWP(r, 5632 + 1024 + n) + args.in[9][L * 3072 + 1024 + n]), gc = sigmoid_f(RAWP(r, 5632 + 2048 + n) + args.in[9][L * 3072 + 2048 + n]);
        const float pa = wdot((const bf16*)(ws + WS_P0) + (size_t)r * 512, args.in[17] + (size_t)L * 512 * 1024, 1024, n, 512, P.lane);
        const float pb = wdot((const bf16*)(ws + WS_P2) + (size_t)r * 512, args.in[18] + (size_t)L * 512 * 1024, 1024, n, 512, P.lane);
        const float pc = wdot((const bf16*)(ws + WS_Q) + (size_t)r * DM, args.in[19] + (size_t)L * 1024 * 1024, 1024, n, 1024, P.lane);
        if (P.lane == 0) P.rec(17 + 20 * L, bf2f(Y[(size_t)r * DM + n]), ga * pa + gb * pb + gc * pc, 0.05f);
        const float o = wdot(Y + (size_t)r * DM, args.in[20] + (size_t)L * 1024 * 1024, 1024, n, 1024, P.lane);
        const int b = r < ML ? (r >> 12) : 16; const float g1 = ((const float*)(ws + WS_MOD))[((size_t)L * 17 + b) * 6144 + 2048 + n];
        if (L == 0) { const float x0 = r < ML ? args.in[0][(size_t)r * DM + n] : args.in[2][(size_t)(r - ML) * DM + n];
            const float got = r < ML ? args.out[(size_t)r * DM + n] : ((const float*)(ws + WS_XC))[(size_t)(r - ML) * DM + n];
            if (P.lane == 0) P.rec(18, got - x0, g1 * o, 0.03f); }
    }
}
__device__ __forceinline__ void probe_after_ffn0(const Probe& P, const Args& args, unsigned char* ws) {
    const bf16* Hb = (const bf16*)(ws + WS_H); const bf16* ACT = (const bf16*)(ws + WS_ACT0);
    for (int sidx = P.wave; sidx < 64; sidx += 8) {
        const unsigned hh = hsh(sidx * 60013u + 5u); int r = hh % MA; if (sidx < 8) r = ML + hh % MC; const int j = (hh >> 10) % DFF;
        const float gt = wdot(Hb + (size_t)r * DM, args.in[21], DFF, j, 1024, P.lane), up = wdot(Hb + (size_t)r * DM, args.in[22], DFF, j, 1024, P.lane);
        if (P.lane == 0) P.rec(19, bf2f(ACT[(size_t)r * DFF + j]), silu_f(gt) * up, 0.04f);
    }
}
#undef RAWP
#endif


#define WSB() unsigned char* ws = launder_ptr(args.ws)
#define W_MOD ((float*)(ws + WS_MOD))
#define W_ROPE ((float*)(ws + WS_ROPE))
#define W_LAM ((float*)(ws + WS_LAM))
#define W_AWS ((bf16*)(ws + WS_AWS))
#define W_ROUTE ((unsigned*)(ws + WS_ROUTE))
#define W_XC ((float*)(ws + WS_XC))
#define W_H ((bf16*)(ws + WS_H))
#define W_P0 ((bf16*)(ws + WS_P0))
#define W_P1 ((bf16*)(ws + WS_P1))
#define W_P2 ((bf16*)(ws + WS_P2))
#define W_P3 ((bf16*)(ws + WS_P3))
#define W_Q ((bf16*)(ws + WS_Q))
#define W_K ((bf16*)(ws + WS_K))
#define W_V ((bf16*)(ws + WS_V))
#define W_MODL (W_MOD + (size_t)L * 17 * 6144)
#define W_WIN ((const bf16*)(ws + WS_WIN + L * WIN_BYTES))
#define W_WOUT ((const bf16*)(ws + WS_WOUT + L * WOUT_BYTES))
#define PH_ON (P.lo <= P.ph && P.ph < P.hi)
#define SEAM() do { if (P.lo <= P.ph && P.ph + 1 < P.hi) xcd_barrier(bar); ++P.ph; } while (0)
#define ELEM_DELTA(a, b) ((long)(((intptr_t)(a) - (intptr_t)(b)) / 4))

#ifdef PROBE
#define PROBE_HOOK(FN) do { if (P.lo < P.ph && P.ph <= P.hi) { if (blockIdx.x == 0) { WSB(); const Probe PR{C.ctl, C.tid, C.lane, C.wave, (LAS float*)C.lds}; FN(PR, args, ws); } xcd_barrier(bar); } } while (0)
#else
#define PROBE_HOOK(FN) do { } while (0)
#endif

template <int L, int BR>
__device__ __forceinline__ void merge_phase(const Ctx& C, const Args& args, const XcdBarrier& bar, PhaseCtl& P) {
    constexpr int mrows = L == 0 ? MA : ML;
    if (PH_ON) { WSB();
#if (EN_SITES >> 2) & 1
        constexpr size_t aoff = BR == 0 ? WS_P0 : (BR == 1 ? WS_P2 : WS_Q), goff = BR == 0 ? WS_K : (BR == 1 ? WS_V : WS_P1);
        constexpr int K = BR == 2 ? 1024 : 512;
        const bf16* Bt = W_WOUT + (BR == 0 ? 0 : (BR == 1 ? 512 * 1024 : 1024 * 1024));
        pg8::Gemm g{(const bf16*)(ws + aoff), Bt, mrows, 1024, K}; pg8::StaticOrder S; S.init(mrows, 1024, C.G, (int)blockIdx.x);
        EpiMerge E{W_K, (const bf16*)(ws + goff), (long)((WS_P3 - WS_P1) / 2), BR == 2 ? 512 : 1024, BR == 2 ? 2 : 4, BR == 0 ? 1 : 0};
        pg8::gemm_phase<EpiMerge, pg8::StaticOrder, PG8_ALIGN, PG8_SP2>(C.lds, g, S, E);
#endif
    }
    SEAM();
}

template <int L>
__device__ __forceinline__ void layer_body(const Ctx& C, const Args& args, const XcdBarrier& bar, PhaseCtl& P, volatile LAS int* offl) {
    constexpr int mrows = L == 0 ? MA : ML;
    if (PH_ON) { WSB(); modulate_phase(C, L == 0 ? args.in[0] : (const float*)args.out, L == 0 ? args.in[2] : (const float*)W_XC, args.in[6] + L * 1024, W_MODL, 0, 1, W_H, MA); }
    SEAM();
    PROBE_HOOK(probe_after_mod1<L>);
    if (PH_ON) { WSB();
#if (EN_SITES >> 0) & 1
        pg8::Gemm g{W_H, W_WIN, MA, NBIG, 1024}; pg8::StaticOrder S; S.init(MA, NBIG, C.G, (int)blockIdx.x);
        EpiBig E{ws, W_ROPE};
        pg8::gemm_phase<EpiBig, pg8::StaticOrder, PG8_ALIGN, PG8_SP2>(C.lds, g, S, E);
#endif
    }
    SEAM();
    PROBE_HOOK(probe_after_big<L>);
    if (PH_ON) { WSB();
#ifdef PROBE_FILL2
        { GAS u32x4* kf = (GAS u32x4*)(ws + WS_K); const u32x4 pat = {0x46404640u, 0x46404640u, 0x46404640u, 0x46404640u};
          for (size_t i = (size_t)C.gw * 64 + C.lane; i < (size_t)MA * DM * 2 / 16; i += (size_t)C.NGW * 64) kf[i] = pat; }
#endif
#if EN_MIX
        for (int ch = C.vcu; ch < mrows / 128; ch += C.G)
            mixer_chunk(C, ch, W_P0, W_P1, W_P2, W_P3, args.in[10] + L * 512, args.in[11] + L * 512, W_AWS + (size_t)L * 8 * 128 * 128, args.in[13] + L * 8 * 128, args.in[14] + L * 3 * 512);
#endif
#if EN_ATT
        const float lam = W_LAM[L]; constexpr float oml = L == 0 ? 0.8f : (1.f - (0.8f - 0.6f * 0.7408182206817179f)); const float* subg = args.in[16] + L * 128;
        for (int u = C.vcu; u < BATCH * 8 * 32; u += C.G) {
            const int bh = u >> 5, qb = u & 31, b = bh >> 3, h = bh & 7;
            bf16* qp = W_Q + ((size_t)b * SEQ + qb * 128) * DM + h * 128;
            att::diff_attn_unit(qp, W_K + (size_t)b * SKV * DM + h * 128, W_V + (size_t)b * SKV * DM + h * 128, qp, SKV / 64, lam, subg, oml, (LAS char*)C.lds);
        }
        if (L == 0) {
            for (int u = C.vcu; u < BATCH * 8 * 2; u += C.G) {
                const int b = u >> 4, h = (u >> 1) & 7, qb = u & 1;
                bf16* qp = W_Q + ((size_t)ML + b * CTXL + qb * 128) * DM + h * 128;
                att::diff_attn_unit(qp, W_K + ((size_t)b * SKV + SEQ) * DM + h * 128, W_V + ((size_t)b * SKV + SEQ) * DM + h * 128, qp, CTXL / 64, lam, subg, oml, (LAS char*)C.lds);
            }
        }
#endif
    }
    SEAM();
    PROBE_HOOK(probe_after_mix<L>);
    if (PH_ON) { WSB();
#if (EN_SITES >> 1) & 1
        pg8::Gemm g{W_H, W_WIN + (size_t)NBIG * 1024, mrows, 3072, 1024}; pg8::StaticOrder S; S.init(mrows, 3072, C.G, (int)blockIdx.x);
        EpiGate E{ws, args.in[9] + L * 3072};
        pg8::gemm_phase<EpiGate, pg8::StaticOrder, PG8_ALIGN, PG8_SP2>(C.lds, g, S, E);
#endif
    }
    SEAM();
    PROBE_HOOK(probe_after_gate<L>);
#ifdef PROBE_SCAN
    if (L == 0) { WSB(); unsigned cntk = 0u, cntv = 0u;
        const GAS u32x4* kp = (const GAS u32x4*)(ws + WS_K); const GAS u32x4* vp = (const GAS u32x4*)(ws + WS_V);
        for (size_t i = (size_t)C.gw * 64 + C.lane; i < (size_t)MA * DM * 2 / 16; i += (size_t)C.NGW * 64) {
            const u32x4 a = kp[i], b = vp[i]; f32x4 x0, x1; unpack8(a, x0, x1);
            for (int q = 0; q < 4; ++q) { if (!(x0[q] >= 0.f && x0[q] <= 1.f)) ++cntk; if (!(x1[q] >= 0.f && x1[q] <= 1.f)) ++cntk; }
            unpack8(b, x0, x1);
            for (int q = 0; q < 4; ++q) { if (!(x0[q] >= 0.f && x0[q] <= 1.f)) ++cntv; if (!(x1[q] >= 0.f && x1[q] <= 1.f)) ++cntv; } }
        if (cntk) atomicAdd((unsigned*)(C.ctl + PR_BASE + 12), cntk); if (cntv) atomicAdd((unsigned*)(C.ctl + PR_BASE + 13), cntv);
        xcd_barrier(bar); }
#endif
    merge_phase<L, 0>(C, args, bar, P);
    merge_phase<L, 1>(C, args, bar, P);
    merge_phase<L, 2>(C, args, bar, P);
    if (PH_ON) { WSB();
#if (EN_SITES >> 3) & 1
        pg8::Gemm g{W_K, W_WOUT + 2 * 1024 * 1024, mrows, 1024, 1024}; pg8::StaticOrder S; S.init(mrows, 1024, C.G, (int)blockIdx.x);
        const float* xb = L == 0 ? args.in[0] : (const float*)args.out; const float* cb = L == 0 ? args.in[2] : (const float*)W_XC;
        EpiResid E{xb, args.out, ELEM_DELTA(cb, xb) - (long)ML * DM, ELEM_DELTA(W_XC, args.out) - (long)ML * DM, W_MODL, 2};
        pg8::gemm_phase<EpiResid, pg8::StaticOrder, PG8_ALIGN, PG8_SP2>(C.lds, g, S, E);
#endif
    }
    SEAM();
    PROBE_HOOK(probe_after_wo<L>);
    if (L == 0) {
        if (PH_ON) { WSB(); modulate_phase(C, args.out, W_XC, args.in[7], W_MODL, 3, 4, W_H, MA); }
        SEAM();
        if (PH_ON) { WSB();
#if (EN_SITES >> 4) & 1
            pg8::Gemm g{W_H, (const bf16*)(ws + WS_WFU), MA, 2 * DFF, 1024}; pg8::StaticOrder S; S.init(MA, 2 * DFF, C.G, (int)blockIdx.x);
            EpiSwiGLU E{(bf16*)(ws + WS_ACT0), DFF, 0, 22};
            pg8::gemm_phase<EpiSwiGLU, pg8::StaticOrder, PG8_ALIGN, PG8_SP2>(C.lds, g, S, E);
#endif
        }
        SEAM();
        PROBE_HOOK(probe_after_ffn0);
        if (PH_ON) { WSB();
#if (EN_SITES >> 5) & 1
            pg8::Gemm g{(const bf16*)(ws + WS_ACT0), (const bf16*)(ws + WS_WFD), MA, 1024, DFF}; pg8::StaticOrder S; S.init(MA, 1024, C.G, (int)blockIdx.x);
            const long cd = ELEM_DELTA(W_XC, args.out) - (long)ML * DM;
            EpiResid E{args.out, args.out, cd, cd, W_MODL, 5};
            pg8::gemm_phase<EpiResid, pg8::StaticOrder, PG8_ALIGN, PG8_SP2>(C.lds, g, S, E);
#endif
        }
        SEAM();
    } else {
        if (PH_ON) { WSB();
            route_phase(C, args.out, args.in[7] + 1024, W_MODL, args.in[24], W_H, W_ROUTE);
            __syncthreads();
            for (int e = 0; e < NEXP; ++e) {
                tr_matrix<2>(C, args.in[25] + (size_t)e * 1024 * DFE, args.in[26] + (size_t)e * 1024 * DFE, DFE, 1024, 2 * DFE, (bf16*)(ws + WS_MWU) + (size_t)e * 2 * DFE * 1024);
                tr_matrix<0>(C, args.in[27] + (size_t)e * DFE * 1024, nullptr, 1024, DFE, 1024, (bf16*)(ws + WS_MWD) + (size_t)e * 1024 * DFE);
            }
        }
        SEAM();
        if (P.lo < P.ph + 8 && P.ph < P.hi) moe_offsets(C, offl);
        if (PH_ON) { WSB(); gather_phase(C, W_H, (bf16*)(ws + WS_HS), W_ROUTE, offl); }
        SEAM();
        for (int ck = 0; ck < 3; ++ck) {
            const int ntall = offl[8] >> 8; int nt = ntall - ck * MOE_CH; nt = nt < 0 ? 0 : (nt > MOE_CH ? MOE_CH : nt);
            if (PH_ON) { WSB();
#if (EN_SITES >> 6) & 1
                pg8::Gemm g{(const bf16*)(ws + WS_HS), (const bf16*)(ws + WS_MWU), nt * 256, 2 * DFE, 1024};
                MoeOrder S; S.so.init(nt * 256, 2 * DFE, C.G, (int)blockIdx.x); S.tile0 = ck * MOE_CH; S.npe = 28; S.a_global = true; S.offl = offl;
                EpiSwiGLU E{(bf16*)(ws + WS_MACT), DFE, ck * MOE_CH, 28};
                pg8::gemm_phase<EpiSwiGLU, MoeOrder, PG8_ALIGN, PG8_SP2>(C.lds, g, S, E);
#endif
            }
            SEAM();
            if (PH_ON) { WSB();
#if (EN_SITES >> 7) & 1
                pg8::Gemm g{(const bf16*)(ws + WS_MACT), (const bf16*)(ws + WS_MWD), nt * 256, 1024, DFE};
                MoeOrder S; S.so.init(nt * 256, 1024, C.G, (int)blockIdx.x); S.tile0 = ck * MOE_CH; S.npe = 4; S.a_global = false; S.offl = offl;
                EpiStoreBf16 E{(bf16*)(ws + WS_HS), 1024, ck * MOE_CH, 4};
                pg8::gemm_phase<EpiStoreBf16, MoeOrder, PG8_ALIGN, PG8_SP2>(C.lds, g, S, E);
#endif
            }
            SEAM();
        }
        if (PH_ON) { WSB(); final_phase(C, args.out, (const bf16*)(ws + WS_HS), W_ROUTE, W_MODL, args.in[28]); }
        SEAM();
    }
}

__global__ void __launch_bounds__(NTHREADS, 2) fwd_kernel(Args args) {
    extern __shared__ __attribute__((aligned(16))) unsigned char lds_raw[];
    Ctx C;
    C.lds = (LAS unsigned char*)lds_raw; C.ctl = (gu32*)(args.ws + WS_CTL);
    C.tid = threadIdx.x; C.lane = C.tid & 63; C.wave = __builtin_amdgcn_readfirstlane(C.tid >> 6);
    C.G = gridDim.x; { const int bx = blockIdx.x; C.vcu = (C.G % 8 == 0) ? (bx % 8) * (C.G / 8) + bx / 8 : bx; }
    C.gw = C.vcu * NWAVES + C.wave; C.NGW = C.G * NWAVES;
    volatile LAS unsigned* MISC = (volatile LAS unsigned*)(C.lds + LDSCTL_OFF);
    volatile LAS int* offl = (volatile LAS int*)(C.lds + LDSCTL_OFF + 64);
    if (C.tid < 64) MISC[C.tid] = 0u;
    __syncthreads();
    const XcdBarrier bar = xcd_barrier_post((unsigned*)(C.ctl + CW_BAR), MISC);
    PhaseCtl P{args.ph_lo, args.ph_hi, 0};

#if EN_PRO
    if (PH_ON) { WSB();
        for (int l = 0; l < 2; ++l) {
            tr_matrix<1>(C, args.in[8] + (size_t)l * 1024 * INC, nullptr, INC, 1024, INC, (bf16*)(ws + WS_WIN + l * WIN_BYTES));
            bf16* wo = (bf16*)(ws + WS_WOUT + l * WOUT_BYTES);
            tr_matrix<0>(C, args.in[17] + (size_t)l * 512 * 1024, nullptr, 1024, 512, 1024, wo);
            tr_matrix<0>(C, args.in[18] + (size_t)l * 512 * 1024, nullptr, 1024, 512, 1024, wo + 512 * 1024);
            tr_matrix<0>(C, args.in[19] + (size_t)l * 1024 * 1024, nullptr, 1024, 1024, 1024, wo + 1024 * 1024);
            tr_matrix<0>(C, args.in[20] + (size_t)l * 1024 * 1024, nullptr, 1024, 1024, 1024, wo + 2 * 1024 * 1024);
        }
        tr_matrix<2>(C, args.in[21], args.in[22], DFF, 1024, 2 * DFF, (bf16*)(ws + WS_WFU));
        tr_matrix<0>(C, args.in[23], nullptr, 1024, DFF, 1024, (bf16*)(ws + WS_WFD));
        for (int i = C.gw * 64 + C.lane; i < 2 * 8 * 128 * 128; i += C.NGW * 64) W_AWS[i] = (bf16)f2bf(args.in[12][i]);
        __syncthreads();
        mod_phase(C, args.in[1], args.in[3], args.in[4], args.in[5], W_MOD);
        rope_lam_phase(C, args.in[15], W_ROPE, W_LAM);
#ifdef PROBE_FILL
        { GAS u32x4* kf = (GAS u32x4*)(ws + WS_K); const u32x4 pat = {0x46404640u, 0x46404640u, 0x46404640u, 0x46404640u};
          for (size_t i = (size_t)C.gw * 64 + C.lane; i < (size_t)MA * DM * 2 / 16; i += (size_t)C.NGW * 64) kf[i] = pat; }
#endif
    }
#endif
    SEAM();
    layer_body<0>(C, args, bar, P, offl);
#if NLAYERS > 1
    layer_body<1>(C, args, bar, P, offl);
#endif
#ifdef PROBE
    {
        xcd_barrier(bar);
        const unsigned id = __hip_atomic_load((unsigned*)(C.ctl + PR_BASE), __ATOMIC_RELAXED, __HIP_MEMORY_SCOPE_AGENT);
        const float e1 = __uint_as_float(__hip_atomic_load((unsigned*)(C.ctl + PR_BASE + 1), __ATOMIC_RELAXED, __HIP_MEMORY_SCOPE_AGENT)), e2 = __uint_as_float(__hip_atomic_load((unsigned*)(C.ctl + PR_BASE + 2), __ATOMIC_RELAXED, __HIP_MEMORY_SCOPE_AGENT));
        const float err = id ? e1 : e2; float code = err < 0.05f ? 1000.f * err : 50.f + 100.f * (err > 4.5f ? 4.5f : err); const float bv = 8.f * sqrtf(code);
        const unsigned sv = __hip_atomic_load((unsigned*)(C.ctl + PR_BASE + 3), __ATOMIC_RELAXED, __HIP_MEMORY_SCOPE_AGENT), sb = __hip_atomic_load((unsigned*)(C.ctl + PR_BASE + 4), __ATOMIC_RELAXED, __HIP_MEMORY_SCOPE_AGENT);
        float a0 = 100.f * (float)id, bvv = bv;
        const unsigned eoff = __hip_atomic_load((unsigned*)(C.ctl + PR_BASE + 7), __ATOMIC_RELAXED, __HIP_MEMORY_SCOPE_AGENT);
#ifndef PROBE_SEL
#define PROBE_SEL 0
#endif
        if (PROBE_SEL == 8 && false) {} else if (sv && PROBE_SEL == 1) { const unsigned rr = eoff >> 10, nn = eoff & 1023u; a0 = 100.f * (float)(nn >> 4); bvv = 8.f * sqrtf((float)(rr >> 10)); }
        else if (sv && PROBE_SEL == 2) { const unsigned rr = eoff >> 10, nn = eoff & 1023u; a0 = 100.f * (float)(nn & 15u) + 50.f; bvv = 8.f * sqrtf((float)((rr >> 4) & 63u)); }
        else if (sv && PROBE_SEL == 4) { const unsigned cw = __hip_atomic_load((unsigned*)(C.ctl + PR_BASE + 8), __ATOMIC_RELAXED, __HIP_MEMORY_SCOPE_AGENT); a0 = 100.f * (float)(cw & 0xffu) + 50.f; bvv = 8.f * sqrtf((float)(cw >> 8)); }
        else if (sv && PROBE_SEL == 5) { const unsigned cw = __hip_atomic_load((unsigned*)(C.ctl + PR_BASE + 9), __ATOMIC_RELAXED, __HIP_MEMORY_SCOPE_AGENT); a0 = 100.f * (float)(cw & 0xffu) + 50.f; bvv = 8.f * sqrtf((float)(cw >> 8)); }
        else if (sv && PROBE_SEL == 6) { const unsigned cw = __hip_atomic_load((unsigned*)(C.ctl + PR_BASE + 10), __ATOMIC_RELAXED, __HIP_MEMORY_SCOPE_AGENT); a0 = 100.f * (float)((cw >> 4) & 15u) + 50.f; bvv = 8.f * sqrtf((float)(cw & 15u)); }
        else if (sv && PROBE_SEL == 7) { const unsigned cw = __hip_atomic_load((unsigned*)(C.ctl + PR_BASE + 10), __ATOMIC_RELAXED, __HIP_MEMORY_SCOPE_AGENT) >> 8; a0 = 100.f * (float)((cw >> 4) & 15u) + 50.f; bvv = 8.f * sqrtf((float)(cw & 15u)); }
        else if (PROBE_SEL == 8) { const unsigned ck = __hip_atomic_load((unsigned*)(C.ctl + PR_BASE + 12), __ATOMIC_RELAXED, __HIP_MEMORY_SCOPE_AGENT), cv = __hip_atomic_load((unsigned*)(C.ctl + PR_BASE + 13), __ATOMIC_RELAXED, __HIP_MEMORY_SCOPE_AGENT);
            a0 = 100.f * (float)ck; bvv = 8.f * sqrtf((float)cv); }
        else if (sv && PROBE_SEL == 3) { const unsigned rr = eoff >> 10; a0 = 100.f * (float)(rr & 15u) + 50.f; bvv = 0.f; }
        else if (sv) { const float val = __uint_as_float(sv); a0 = 1000.f * fabsf(val); const unsigned ko = __hip_atomic_load((unsigned*)(C.ctl + PR_BASE + 6), __ATOMIC_RELAXED, __HIP_MEMORY_SCOPE_AGENT); bvv = 8.f * sqrtf(10.f * (float)sb + (val < 0.f ? 5.f : 0.f) + (ko ? 100.f : 0.f)); }
        for (size_t i = (size_t)C.gw * 64 + C.lane; i < (size_t)ML * DM; i += (size_t)C.NGW * 64) args.out[i] = i == 0 ? a0 : ((i >= 1024 && i < 1024 + (1u << 20)) ? bvv : 0.f);
    }
#endif
}
#undef PH_ON
#undef SEAM
#undef WSB

extern "C" void kernel_launch(void* const* d_in, const int* in_sizes, int n_in, void* d_out, int out_size, void* d_ws, size_t ws_size, hipStream_t stream) {
    static int grid = 0;
    if (grid == 0) {
        if (n_in != 29 || in_sizes[0] != ML * DM || out_size != ML * DM || ws_size < WS_END) {
            fprintf(stderr, "kernel_launch: shape mismatch: n_in %d in0 %d out %d ws %zu (need %zu); nothing launched\n", n_in, n_in > 0 ? in_sizes[0] : -1, out_size, ws_size, (size_t)WS_END); grid = -1; return; }
        int dev = 0, cus = 0, per_cu = 0;
        if (hipGetDevice(&dev) != hipSuccess || hipDeviceGetAttribute(&cus, hipDeviceAttributeMultiprocessorCount, dev) != hipSuccess) { fprintf(stderr, "kernel_launch: device query failed\n"); grid = -1; return; }
        if (hipFuncSetAttribute((const void*)fwd_kernel, hipFuncAttributeMaxDynamicSharedMemorySize, LDS_BYTES) != hipSuccess) { fprintf(stderr, "kernel_launch: hipFuncSetAttribute failed\n"); grid = -1; return; }
        if (hipOccupancyMaxActiveBlocksPerMultiprocessor(&per_cu, (const void*)fwd_kernel, NTHREADS, LDS_BYTES) != hipSuccess || per_cu < 1)
            fprintf(stderr, "kernel_launch: note: occupancy query reports %d workgroups per CU\n", per_cu);
        (void)hipGetLastError();
        grid = cus;
    }
    if (grid < 0) return;
    if (hipMemsetAsync((char*)d_ws + WS_CTL, 0, CTL_ZERO_BYTES, stream) != hipSuccess) { fprintf(stderr, "kernel_launch: memset failed\n"); return; }
    Args a{};
    for (int i = 0; i < 29; ++i) a.in[i] = (const float*)d_in[i];
    a.out = (float*)d_out; a.ws = (unsigned char*)d_ws; a.ph_lo = 0; a.ph_hi = 1000;
    hipLaunchKernelGGL(fwd_kernel, dim3(grid), dim3(NTHREADS), LDS_BYTES, stream, a);
    const hipError_t le = hipPeekAtLastError();
    if (le != hipSuccess) fprintf(stderr, "kernel_launch: launch failed: %s\n", hipGetErrorName(le));
}
```

```cpp
#include <hip/hip_runtime.h>
#include <cstdio>
#include <cstdint>
namespace pg8 {
#define PG8_LAS __attribute__((address_space(3)))
typedef unsigned short bf16_t;
typedef short bf16x8 __attribute__((ext_vector_type(8)));
typedef float f32x4 __attribute__((ext_vector_type(4)));
typedef unsigned u32x4 __attribute__((ext_vector_type(4)));
constexpr int BM = 256, BK = 64, HALF = 128, HTB = HALF * BK * 2  , STAGE_BYTES = 8 * HTB, NXCD = 8, WGM = 8;

__host__ __device__ __forceinline__ int lds_byte(int r, int c) { const int st = (r >> 4) * 2 + (c >> 5), rr = r & 15, cc = c & 31, ob = rr * 64 + cc * 2; return st * 1024 + (ob ^ (((ob >> 9) & 1) << 5)); }
__host__ __device__ __forceinline__ void stage_rc(int b, int& R, int& C) { const int st = b / 1024, sb = b % 1024, swz = sb ^ (((sb >> 9) & 1) << 5); R = (st >> 1) * 16 + swz / 64; C = (st & 1) * 32 + (swz % 64) / 2; }
__host__ __device__ __forceinline__ int perm32(int rho) { const int n = rho >> 4, i = rho & 15; return 8 * (i >> 2) + 4 * n + (i & 3); }

struct Unit { int pm, pn; };
struct Gemm { const bf16_t* A; const bf16_t* Bt; int M, N, K; };

struct StaticOrder {
    int nM, nN, nwg, G, c;
    __host__ __device__ void init(int M, int N, int G_, int c_) { nM = M / BM; nN = N / BM; nwg = nM * nN; G = G_; c = c_; }
    __host__ __device__ bool next(int i, Unit& u) const {
        const long L = (long)i * G + c; if (L >= nwg) return false;
        int wgid = (int)L; { const int q = nwg / NXCD, r = nwg % NXCD, xcd = wgid % NXCD, off = wgid / NXCD; wgid = (xcd < r ? xcd * (q + 1) : r * (q + 1) + (xcd - r) * q) + off; }
        const int nig = WGM * nN, gid = wgid / nig, fm = gid * WGM, gsz = (nM - fm) < WGM ? (nM - fm) : WGM;
        u.pm = fm + ((wgid % nig) % gsz); u.pn = (wgid % nig) / gsz; return true;
    }
    __device__ __forceinline__ void a_ready(const Unit&) const {}
    __device__ __forceinline__ void done(const Unit&) const {}
};

typedef float cvt_f32x2 __attribute__((ext_vector_type(2))); typedef __bf16 cvt_bf16x2 __attribute__((ext_vector_type(2)));
__device__ __forceinline__ unsigned cvt_pk_bf16(float lo, float hi) { const cvt_f32x2 v = {lo, hi}; const cvt_bf16x2 b = __builtin_convertvector(v, cvt_bf16x2); return __builtin_bit_cast(unsigned, b); }
typedef float f32x2 __attribute__((ext_vector_type(2)));
__device__ __forceinline__ f32x2 gelu_pk(f32x2 v) {
    const f32x2 av = __builtin_elementwise_abs(v), d = av * 0.2316418882f + 1.0f;
    f32x2 t; t.x = __builtin_amdgcn_rcpf(d.x); t.y = __builtin_amdgcn_rcpf(d.y);
    f32x2 q = t * 0.5307027145f + (-0.7265760135f); q = q * t + 0.7107068705f; q = q * t + (-0.142248368f); q = q * t + 0.127414796f; q = q * t;
    const f32x2 s = (v * v) * (-0.72134752044f);
    f32x2 e; e.x = __builtin_amdgcn_exp2f(s.x); e.y = __builtin_amdgcn_exp2f(s.y);
    const f32x2 m = v * (q * e), r = v - m;
    f32x2 o; o.x = v.x < 0.f ? m.x : r.x; o.y = v.y < 0.f ? m.y : r.y; return o;
}


template <class Epi, class Sched, bool ALIGN_EPI = false, bool SP2 = false>
__device__ __forceinline__ void gemm_phase(PG8_LAS unsigned char* lds, const Gemm g, const Sched& S, const Epi& E) {
    const int tid = threadIdx.x, wid = __builtin_amdgcn_readfirstlane(tid >> 6), lane = tid & 63, wr = wid >> 2, wc = wid & 3, fr = lane & 15, fq = lane >> 4;
    const int K = g.K, nt = K / BK;
    unsigned voffA[2], voffB[2];
#pragma unroll
    for (int i = 0; i < 2; ++i) { int R, C; stage_rc(tid * 16 + i * 8192, R, C); const int Rb = Epi::PERM ? ((R & ~31) + perm32(R & 31)) : R;
        voffA[i] = (unsigned)(R * K + C) * 2u; voffB[i] = (unsigned)(Rb * K + C) * 2u; }
    const size_t kstep = (size_t)(BK * 2);
#ifndef PG8_KROT
#define PG8_KROT 0
#endif
    static_assert(SP2 || !PG8_KROT, "the K-slice rotation is written for the SP2 loop only");
    const int krot = PG8_KROT ? (int)((blockIdx.x >> 3) % (unsigned)(K / BK)) : 0;
#define PG8_KO(j) ((size_t)(((j) + krot) >= nt ? ((j) + krot) - nt : ((j) + krot)) * kstep)
    const size_t hstep = (size_t)HALF * K * 2;
    const size_t tstep = 2 * hstep;
    const unsigned ldsw = (unsigned)wid * 1024u;
    const int aoff = lds_byte(wr * 64 + fr, fq * 8), boff = lds_byte(wc * 32 + fr, fq * 8);
#define PG8_SA(b, h) (((b) * 2 + (h)) * HTB)
#define PG8_SB(b, h) ((4 + (b) * 2 + (h)) * HTB)
#define PG8_STAGE(bufoff, gbase, voff) do { _Pragma("unroll") for (int _i = 0; _i < 2; ++_i) \
        __builtin_amdgcn_global_load_lds((const unsigned*)((const char*)(gbase) + (voff)[_i]), (PG8_LAS unsigned*)(lds + (bufoff) + ldsw + _i * 8192), 16, 0, 0); } while (0)
#define PG8_LDA(dst, b, h) do { _Pragma("unroll") for (int m = 0; m < 4; ++m) _Pragma("unroll") for (int k = 0; k < 2; ++k) dst[m][k] = *(const PG8_LAS bf16x8*)(lds + PG8_SA(b, h) + aoff + m * 2048 + k * 1024); } while (0)
#define PG8_LDB(dst, b, h) do { _Pragma("unroll") for (int n = 0; n < 2; ++n) _Pragma("unroll") for (int k = 0; k < 2; ++k) dst[n][k] = *(const PG8_LAS bf16x8*)(lds + PG8_SB(b, h) + boff + n * 2048 + k * 1024); } while (0)
#define PG8_MMA(ai, bj, At, Bt) do { __builtin_amdgcn_s_setprio(1); _Pragma("unroll") for (int m = 0; m < 4; ++m) _Pragma("unroll") for (int n = 0; n < 2; ++n) _Pragma("unroll") for (int k = 0; k < 2; ++k) \
        acc[ai][bj][m][n] = __builtin_amdgcn_mfma_f32_16x16x32_bf16(Bt[n][k], At[m][k], acc[ai][bj][m][n], 0, 0, 0); __builtin_amdgcn_s_setprio(0); } while (0)
#define PG8_WAIT_V(n) asm volatile("s_waitcnt vmcnt(" #n ")" ::: "memory")
#define PG8_WAIT_L(n) asm volatile("s_waitcnt lgkmcnt(" #n ")" ::: "memory")
#define PG8_BAR __builtin_amdgcn_s_barrier()
#define PG8_SCHED __builtin_amdgcn_sched_barrier(0)
    Unit cur, nxt; int ui = 0;
    if (!S.next(0, cur)) return;
    f32x4 acc[2][2][4][2];
#pragma unroll
    for (int a = 0; a < 2; ++a)
#pragma unroll
        for (int b = 0; b < 2; ++b)
#pragma unroll
            for (int m = 0; m < 4; ++m)
#pragma unroll
                for (int n = 0; n < 2; ++n) acc[a][b][m][n] = (f32x4){0.f, 0.f, 0.f, 0.f};
    bf16x8 At[4][2], B0[2][2], B1[2][2];
    const char* cA = (const char*)g.A + (size_t)cur.pm * tstep; const char* cB = (const char*)g.Bt + (size_t)cur.pn * tstep;
    S.a_ready(cur);
    if constexpr (SP2) {
        PG8_STAGE(PG8_SB(0, 0), cB + PG8_KO(0), voffB); PG8_STAGE(PG8_SB(0, 1), cB + hstep + PG8_KO(0), voffB); PG8_STAGE(PG8_SA(0, 0), cA + PG8_KO(0), voffA); PG8_STAGE(PG8_SA(0, 1), cA + hstep + PG8_KO(0), voffA);
        if (wr == 1) PG8_BAR;
        PG8_WAIT_V(2); PG8_BAR;
        PG8_STAGE(PG8_SB(1, 0), cB + PG8_KO(1), voffB); PG8_STAGE(PG8_SA(1, 0), cA + PG8_KO(1), voffA); PG8_STAGE(PG8_SB(1, 1), cB + hstep + PG8_KO(1), voffB);
        PG8_WAIT_V(6); PG8_BAR;
    } else {
        PG8_STAGE(PG8_SB(0, 0), cB, voffB); PG8_STAGE(PG8_SA(0, 0), cA, voffA); PG8_STAGE(PG8_SB(0, 1), cB + hstep, voffB); PG8_STAGE(PG8_SA(0, 1), cA + hstep, voffA);
        if (wr == 1) PG8_BAR;
        PG8_WAIT_V(4); PG8_BAR;
        PG8_STAGE(PG8_SB(1, 0), cB + kstep, voffB); PG8_STAGE(PG8_SA(1, 0), cA + kstep, voffA); PG8_STAGE(PG8_SB(1, 1), cB + hstep + kstep, voffB);
        PG8_WAIT_V(6); PG8_BAR;
    }
    for (;;) {
        const bool has_next = S.next(ui + 1, nxt);
        const char* nA = has_next ? (const char*)g.A + (size_t)nxt.pm * tstep : cA; const char* nB = has_next ? (const char*)g.Bt + (size_t)nxt.pn * tstep : cB;
        for (int t = 0; t < nt; t += 2) {
            const bool last = (t == nt - 2);
            const char* a1 = cA + PG8_KO(t + 1);
            const char* a2 = last ? nA + PG8_KO(0) : cA + PG8_KO(t + 2); const char* b2 = last ? nB + PG8_KO(0) : cB + PG8_KO(t + 2);
            const char* a3 = last ? nA + PG8_KO(1) : cA + PG8_KO(t + 3); const char* b3 = last ? nB + PG8_KO(1) : cB + PG8_KO(t + 3);
            if (last && has_next) S.a_ready(nxt);
            if constexpr (SP2) {
            PG8_LDB(B0, 0, 0); PG8_LDB(B1, 0, 1); PG8_SCHED; PG8_LDA(At, 0, 0); PG8_STAGE(PG8_SA(1, 1), a1 + hstep, voffA);
            PG8_WAIT_V(8); PG8_WAIT_L(0); PG8_BAR; PG8_MMA(0, 0, At, B0); PG8_MMA(0, 1, At, B1); PG8_BAR; PG8_SCHED;
            PG8_LDA(At, 0, 1); PG8_STAGE(PG8_SB(0, 0), b2, voffB); PG8_STAGE(PG8_SB(0, 1), b2 + hstep, voffB); PG8_STAGE(PG8_SA(0, 0), a2, voffA);
            PG8_WAIT_V(8); PG8_WAIT_L(0); PG8_BAR; PG8_MMA(1, 0, At, B0); PG8_MMA(1, 1, At, B1); PG8_BAR; PG8_SCHED;
            PG8_LDB(B0, 1, 0); PG8_LDB(B1, 1, 1); PG8_SCHED; PG8_LDA(At, 1, 0); PG8_STAGE(PG8_SA(0, 1), a2 + hstep, voffA);
            PG8_WAIT_V(8); PG8_WAIT_L(0); PG8_BAR; PG8_MMA(0, 0, At, B0); PG8_MMA(0, 1, At, B1); PG8_BAR; PG8_SCHED;
            PG8_LDA(At, 1, 1); PG8_STAGE(PG8_SB(1, 0), b3, voffB); PG8_STAGE(PG8_SB(1, 1), b3 + hstep, voffB); PG8_STAGE(PG8_SA(1, 0), a3, voffA);
            PG8_WAIT_V(8); PG8_WAIT_L(0); PG8_BAR; PG8_MMA(1, 0, At, B0); PG8_MMA(1, 1, At, B1); PG8_BAR; PG8_SCHED;
            } else {
            PG8_LDB(B0, 0, 0); PG8_SCHED; PG8_LDA(At, 0, 0); PG8_STAGE(PG8_SA(1, 1), a1 + hstep, voffA);
            PG8_WAIT_L(8); PG8_BAR; PG8_WAIT_L(0); PG8_MMA(0, 0, At, B0); PG8_BAR; PG8_SCHED;
            PG8_LDB(B1, 0, 1); PG8_STAGE(PG8_SB(0, 0), b2, voffB);
            PG8_BAR; PG8_WAIT_L(0); PG8_MMA(0, 1, At, B1); PG8_BAR;
            PG8_LDA(At, 0, 1); PG8_STAGE(PG8_SA(0, 0), a2, voffA);
            PG8_BAR; PG8_WAIT_L(0); PG8_MMA(1, 0, At, B0); PG8_BAR; PG8_SCHED;
            PG8_STAGE(PG8_SB(0, 1), b2 + hstep, voffB);
            PG8_WAIT_V(6); PG8_BAR; PG8_MMA(1, 1, At, B1); PG8_BAR;
            PG8_LDB(B0, 1, 0); PG8_SCHED; PG8_LDA(At, 1, 0); PG8_STAGE(PG8_SA(0, 1), a2 + hstep, voffA);
            PG8_WAIT_L(8); PG8_BAR; PG8_WAIT_L(0); PG8_MMA(0, 0, At, B0); PG8_BAR; PG8_SCHED;
            PG8_LDB(B1, 1, 1); PG8_STAGE(PG8_SB(1, 0), b3, voffB);
            PG8_BAR; PG8_WAIT_L(0); PG8_MMA(0, 1, At, B1); PG8_BAR;
            PG8_LDA(At, 1, 1); PG8_STAGE(PG8_SA(1, 0), a3, voffA);
            PG8_BAR; PG8_WAIT_L(0); PG8_MMA(1, 0, At, B0); PG8_BAR; PG8_SCHED;
            PG8_STAGE(PG8_SB(1, 1), b3 + hstep, voffB);
            PG8_WAIT_V(6); PG8_BAR; PG8_MMA(1, 1, At, B1); PG8_BAR;
            }
        }
        if constexpr (ALIGN_EPI) { if (wr == 0) PG8_BAR; }
        if constexpr (!Epi::AFTER_DRAIN) { E(acc, cur, wr, wc, fr, fq); S.done(cur); }
        if (!has_next) break;
#pragma unroll
        for (int a = 0; a < 2; ++a)
#pragma unroll
            for (int b = 0; b < 2; ++b)
#pragma unroll
                for (int m = 0; m < 4; ++m)
#pragma unroll
                    for (int n = 0; n < 2; ++n) acc[a][b][m][n] = (f32x4){0.f, 0.f, 0.f, 0.f};
        cur = nxt; cA = nA; cB = nB; ++ui;
        if constexpr (ALIGN_EPI) { if (wr == 1) PG8_BAR; }
    }
    PG8_WAIT_V(0);
    if constexpr (!ALIGN_EPI) { if (wr == 0) PG8_BAR; }
    PG8_BAR;
    if constexpr (Epi::AFTER_DRAIN) { E.fused(acc, cur, wr, wc, fr, fq, lds, wid, lane); S.done(cur); }
#undef PG8_SA
#undef PG8_SB
#undef PG8_STAGE
#undef PG8_LDA
#undef PG8_LDB
#undef PG8_MMA
#undef PG8_WAIT_V
#undef PG8_WAIT_L
#undef PG8_BAR
#undef PG8_SCHED
#undef PG8_KO
}
}

#ifndef PG8_SP2
#define PG8_SP2 true
#endif
#ifndef PG8_ALIGN
#define PG8_ALIGN true
#endif

#define GAS __attribute__((address_space(1)))
#define LAS __attribute__((address_space(3)))
typedef unsigned short bf16;
typedef unsigned v4u __attribute__((ext_vector_type(4)));
typedef float f32x4 __attribute__((ext_vector_type(4)));
typedef short bf16x8 __attribute__((ext_vector_type(8)));
typedef GAS unsigned gu32;
typedef GAS unsigned long long gu64;
#define RLX_AGENT __ATOMIC_RELAXED, __HIP_MEMORY_SCOPE_AGENT
#define LDS_WAIT() asm volatile("s_waitcnt lgkmcnt(0)" ::: "memory")
#define VM_WAIT() asm volatile("s_waitcnt vmcnt(0)" ::: "memory")
__device__ __forceinline__ unsigned long long rt() { return __builtin_amdgcn_s_memrealtime(); }
__device__ __forceinline__ unsigned f2bf(float f) { unsigned u = __builtin_bit_cast(unsigned, f); return (u + 0x7fffu + ((u >> 16) & 1u)) >> 16; }
__device__ __forceinline__ unsigned pk2(float lo, float hi) { return f2bf(lo) | (f2bf(hi) << 16); }

#define XB_TMO      128
#define XB_XCNT(j)  (256  + 64 * (j))
#define XB_XSUB(j)  (1280 + 64 * (j))
#define XB_XGEN(j)  (2304 + 64 * (j))
#define XB_TOP      3328
#define XB_TOPGEN   3392
#define XCD_BAR_WORDS 3456
#define XB_SPIN_CAP (1u << 18)

__device__ __forceinline__ unsigned xb_ld(unsigned* p)              { return __hip_atomic_load(p, __ATOMIC_RELAXED, __HIP_MEMORY_SCOPE_AGENT); }
__device__ __forceinline__ unsigned xb_add(unsigned* p, unsigned v) { return __hip_atomic_fetch_add(p, v, __ATOMIC_RELAXED, __HIP_MEMORY_SCOPE_AGENT); }
__device__ __forceinline__ unsigned xb_xcc_id() { return (unsigned)__builtin_amdgcn_s_getreg((3 << 11) | 20) & 0xFu; }
#define XB_SPIN(cond, bar) do { unsigned _sp = 0; while (cond) { __builtin_amdgcn_s_sleep(1); \
    if ((++_sp & 255u) == 0u) { if (xb_ld(&(bar)[XB_TMO])) break; if (_sp > XB_SPIN_CAP) { atomicAdd(&(bar)[XB_TMO], 1u); break; } } } } while (0)

struct XcdBarrier {
    unsigned* bar; unsigned x;
    volatile LAS unsigned* st;
};

__device__ __forceinline__ XcdBarrier xcd_barrier_post(unsigned* bar, volatile LAS unsigned* st) {
    XcdBarrier b; b.bar = bar; b.x = xb_xcc_id(); b.st = st;
    if (threadIdx.x == 0) (void)xb_add(&bar[XB_XCNT(b.x)], 1u);
    return b;
}
__device__ __forceinline__ void xcd_barrier_complete(unsigned* bar, unsigned x, unsigned& nloc, unsigned& nx) {
    const unsigned G = gridDim.x * gridDim.y * gridDim.z;
    unsigned sum, cnt, mine, sp = 0u;
    for (;;) {
        sum = 0u; cnt = 0u; mine = 0u;
#pragma unroll
        for (unsigned j = 0; j < 16; ++j) { const unsigned c = xb_ld(&bar[XB_XCNT(j)]); sum += c; cnt += (c > 0u) ? 1u : 0u; mine = (j == x) ? c : mine; }
        if (sum == G) break;
        __builtin_amdgcn_s_sleep(1);
        if ((++sp & 255u) == 0u) { if (xb_ld(&bar[XB_TMO])) break; if (sp > XB_SPIN_CAP) { atomicAdd(&bar[XB_TMO], 1u); break; } }
    }
    nloc = mine > 0u ? mine : 1u; nx = cnt > 0u ? cnt : 1u;
}

__device__ __forceinline__ void xcd_barrier(const XcdBarrier& b) {
    asm volatile("s_waitcnt vmcnt(0)" ::: "memory");
    __syncthreads();
    if (threadIdx.x == 0) {
        unsigned* bar = b.bar;
        __builtin_amdgcn_s_waitcnt(0);
        unsigned nloc = b.st[0], nx = b.st[1];
        if (nloc == 0u) { xcd_barrier_complete(bar, b.x, nloc, nx); b.st[0] = nloc; b.st[1] = nx; }
        const unsigned old = xb_add(&bar[XB_XSUB(b.x)], 1u);
        const unsigned gen = old / nloc;
        if (old + 1u == (gen + 1u) * nloc) {
            __builtin_amdgcn_fence(__ATOMIC_RELEASE, "agent");
            asm volatile("s_waitcnt vmcnt(0)" ::: "memory");
            const unsigned og = xb_add(&bar[XB_TOP], 1u);
            const unsigned tg = og / nx;
            if (og + 1u == (tg + 1u) * nx) xb_add(&bar[XB_TOPGEN], 1u);
            else XB_SPIN(xb_ld(&bar[XB_TOPGEN]) == tg, bar);
            __builtin_amdgcn_fence(__ATOMIC_ACQUIRE, "agent");
            xb_add(&bar[XB_XGEN(b.x)], 1u);
            asm volatile("s_waitcnt vmcnt(0)" ::: "memory");
        } else {
            XB_SPIN(xb_ld(&bar[XB_XGEN(b.x)]) == gen, bar);
            __builtin_amdgcn_fence(__ATOMIC_ACQUIRE, "agent");
            asm volatile("s_waitcnt vmcnt(0)" ::: "memory");
        }
    }
    __syncthreads();
}

#ifndef NLAYERS
#define NLAYERS 2
#endif
#ifndef EN_PRO
#define EN_PRO 1
#endif
#ifndef EN_MIX
#define EN_MIX 1
#endif
#ifndef EN_ATT
#define EN_ATT 1
#endif
#ifndef EN_SITES
#define EN_SITES 255
#endif
constexpr int NWAVES = 8, NTHREADS = 512;
constexpr int BATCH = 16, SEQ = 4096, DM = 1024, CTXL = 256;
constexpr int ML = BATCH * SEQ;
constexpr int MC = BATCH * CTXL;
constexpr int MA = ML + MC;
constexpr int SKV = SEQ + CTXL;
constexpr int INC = 8704;
constexpr int NBIG = 5632;
constexpr int DFF = 2816, NEXP = 8, DFE = 3584;
constexpr int MOE_CH = 192;
constexpr float EPS = 1e-6f;
constexpr float QSCALE = 0.125f * 1.4426950408889634f;

constexpr size_t MiB = 1u << 20;
constexpr size_t WS_CTL = 0, CTL_ZERO_BYTES = 1 * MiB;
constexpr size_t WS_MOD = 1 * MiB;
constexpr size_t WS_ROPE = 2 * MiB;
constexpr size_t WS_LAM = 2 * MiB + 16384;
constexpr size_t WS_AWS = 2 * MiB + 65536;
constexpr size_t WS_ROUTE = 4 * MiB;
constexpr size_t WS_WIN = 8 * MiB;
constexpr size_t WIN_BYTES = 17 * MiB;
constexpr size_t WS_WOUT = 42 * MiB;
constexpr size_t WOUT_BYTES = 6 * MiB;
constexpr size_t WS_WFU = 54 * MiB;
constexpr size_t WS_WFD = 65 * MiB;
constexpr size_t WS_XC = 71 * MiB;
constexpr size_t WS_H = 87 * MiB;
constexpr size_t WS_P0 = 223 * MiB, WS_P1 = 291 * MiB, WS_P2 = 359 * MiB, WS_P3 = 427 * MiB;
constexpr size_t WS_Q = 495 * MiB, WS_K = 631 * MiB, WS_V = 767 * MiB;
constexpr size_t WS_ACT0 = 223 * MiB;
constexpr size_t WS_MWU = 223 * MiB;
constexpr size_t WS_MWD = 335 * MiB;
constexpr size_t WS_HS = 391 * MiB;
constexpr size_t WS_MACT = 651 * MiB;
constexpr size_t WS_END = 1024 * MiB;
static_assert(WS_MACT + (size_t)MOE_CH * 256 * DFE * 2 <= WS_END, "ws map");
static_assert(WS_ACT0 + (size_t)MA * DFF * 2 <= WS_K, "ws map");
constexpr int CW_BAR = 4096;
constexpr int CW_CNT = 8192;

constexpr int LDS_BYTES = 147456;
constexpr int LDSCTL_OFF = LDS_BYTES - 256;

typedef float f32x2 __attribute__((ext_vector_type(2)));
typedef unsigned v2u __attribute__((ext_vector_type(2)));
__device__ __forceinline__ float bf2f(unsigned h) { return __builtin_bit_cast(float, h << 16); }
__device__ __forceinline__ float dpp_add(float v, int ctrl_sel) {
    const int x = __builtin_bit_cast(int, v); int y;
    if (ctrl_sel == 0) y = __builtin_amdgcn_update_dpp(0, x, 0xB1, 0xf, 0xf, false);
    else if (ctrl_sel == 1) y = __builtin_amdgcn_update_dpp(0, x, 0x4E, 0xf, 0xf, false);
    else if (ctrl_sel == 2) y = __builtin_amdgcn_update_dpp(0, x, 0x141, 0xf, 0xf, false);
    else y = __builtin_amdgcn_update_dpp(0, x, 0x140, 0xf, 0xf, false);
    return v + __builtin_bit_cast(float, y);
}
__device__ __forceinline__ float wave_sum(float v) {
    v = dpp_add(v, 0); v = dpp_add(v, 1); v = dpp_add(v, 2); v = dpp_add(v, 3);
    const int x = __builtin_bit_cast(int, v);
    const float s0 = __builtin_bit_cast(float, __builtin_amdgcn_readlane(x, 0)), s1 = __builtin_bit_cast(float, __builtin_amdgcn_readlane(x, 16)),
                s2 = __builtin_bit_cast(float, __builtin_amdgcn_readlane(x, 32)), s3 = __builtin_bit_cast(float, __builtin_amdgcn_readlane(x, 48));
    return (s0 + s1) + (s2 + s3);
}
__device__ __forceinline__ float fast_exp2(float x) { return __builtin_amdgcn_exp2f(x); }
__device__ __forceinline__ float fast_rcp(float x) { return __builtin_amdgcn_rcpf(x); }
__device__ __forceinline__ float sigmoid_f(float x) { return fast_rcp(1.f + fast_exp2(-1.4426950408889634f * x)); }
__device__ __forceinline__ float silu_f(float x) { return x * sigmoid_f(x); }
__device__ __forceinline__ float gelu_tanh_f(float x) { const float u = x * (1.f + 0.044715f * x * x); return x * fast_rcp(1.f + fast_exp2(-2.f * 0.7978845608028654f * 1.4426950408889634f * u)); }

__device__ __forceinline__ unsigned char* launder_ptr(unsigned char* p) { asm volatile("" : "+s"(p)); return p; }
struct Args { const float* in[29]; float* out; unsigned char* ws; int ph_lo, ph_hi; };
static_assert(sizeof(Args) == 256, "Args has no holes");
struct PhaseCtl { int lo, hi, ph; };
struct Ctx {
    LAS unsigned char* lds;
    gu32* ctl;
    int tid, lane, wave, vcu, G, gw, NGW;
};

__device__ __forceinline__ void tr_item(const float* W, int ldw, int scol0, bool perm, bf16* WT, int K, int drow0, int k0, LAS float* scr, int lane) {
#pragma unroll 8
    for (int i = 0; i < 32; ++i) { const int kk = 2 * i + (lane >> 5); scr[kk * 33 + (lane & 31)] = W[(size_t)(k0 + kk) * ldw + scol0 + (lane & 31)]; }
    LDS_WAIT(); asm volatile("" ::: "memory");
    const int c = lane & 7;
#pragma unroll
    for (int j = 0; j < 4; ++j) { const int n = (lane >> 3) + 8 * j; const int sn = perm ? ((n >> 1) + 16 * (n & 1)) : n;
        const LAS float* s = scr + (8 * c) * 33 + sn;
        v4u o; o.x = pk2(s[0 * 33], s[1 * 33]); o.y = pk2(s[2 * 33], s[3 * 33]); o.z = pk2(s[4 * 33], s[5 * 33]); o.w = pk2(s[6 * 33], s[7 * 33]);
        *(GAS v4u*)(WT + (size_t)(drow0 + n) * K + k0 + 8 * c) = o; }
    LDS_WAIT(); asm volatile("" ::: "memory");
}
__device__ __forceinline__ int win_src(int d, bool& perm) {
    perm = false;
    if (d < 1024) { perm = true; return 2560 + d; }
    if (d < 2048) { perm = true; return 3584 + (d - 1024); }
    if (d < 3072) return 4608 + (d - 2048);
    if (d < 3584) return d - 3072;
    if (d < 4096) return 512 + (d - 3584);
    if (d < 4608) return 1024 + (d - 4096);
    if (d < 5632) { const int x = d - 4608, j = x >> 8, w = x & 255; return (w < 128 ? 1536 : 2048) + 128 * j + (w & 127); }
    return d;
}
template <int MODE>
__device__ __forceinline__ void tr_matrix(const Ctx& C, const float* W, const float* W2, int ldw, int K, int ndst, bf16* WT) {
    LAS float* scr = (LAS float*)(C.lds + C.wave * 16384);
    const int nblk = ndst / 32, ni = (K / 64) * nblk;
    for (int it = C.gw; it < ni; it += C.NGW) {
        const int kb = it / nblk, db = it % nblk; const float* src = W; int scol0; bool perm = false;
        if (MODE == 0) scol0 = 32 * db;
        else if (MODE == 1) scol0 = win_src(32 * db, perm);
        else { const int j = db >> 3, w = db & 7; if (w >= 4) src = W2; scol0 = 128 * j + 32 * (w & 3); }
        tr_item(src, ldw, scol0, perm, WT, K, 32 * db, 64 * kb, scr, C.lane);
    }
}

__device__ __forceinline__ void mod_phase(const Ctx& C, const float* c, const float* cctx, const float* w_ada, const float* b_ada, float* mod) {
    LAS float* sc = (LAS float*)C.lds;
    LAS float* red = (LAS float*)(C.lds + 17 * 1024 * 4);
    for (int idx = C.tid; idx < 17 * 1024; idx += NTHREADS) { const int b = idx >> 10, k = idx & 1023; const float v = b < 16 ? c[b * 1024 + k] : cctx[k]; sc[idx] = v / (1.f + __expf(-v)); }
    __syncthreads();
    const int cl = C.tid & 31, ks = C.tid >> 5;
    for (int it = blockIdx.x; it < 2 * 192; it += C.G) {
        const int l = it / 192, cb = it % 192, col = cb * 32 + cl;
        float acc[17];
#pragma unroll
        for (int b = 0; b < 17; ++b) acc[b] = 0.f;
        const float* wp = w_ada + ((size_t)l * 1024 + ks * 64) * 6144 + col;
        for (int kk = 0; kk < 64; ++kk) { const float w = wp[(size_t)kk * 6144]; const int k = ks * 64 + kk;
#pragma unroll
            for (int b = 0; b < 17; ++b) acc[b] += sc[b * 1024 + k] * w; }
#pragma unroll
        for (int b = 0; b < 17; ++b) red[(ks * 17 + b) * 32 + cl] = acc[b];
        __syncthreads();
        for (int o = C.tid; o < 17 * 32; o += NTHREADS) { const int b = o >> 5, cc = o & 31; float s = b_ada[l * 6144 + cb * 32 + cc];
#pragma unroll
            for (int q = 0; q < 16; ++q) s += red[(q * 17 + b) * 32 + cc];
            mod[((size_t)l * 17 + b) * 6144 + cb * 32 + cc] = s; }
        __syncthreads();
    }
}
__device__ __forceinline__ void rope_lam_phase(const Ctx& C, const float* c_lambda, float* rope, float* lam) {
    if (blockIdx.x == 0) {
        for (int idx = C.tid; idx < 1024; idx += NTHREADS) {
            const int pos = idx >> 4, i = idx & 15;
            double th = 1.0; for (int q = 0; q < i; ++q) th *= 0.56234132519034908;
            double c1 = 1.0, s1 = th, tc = 1.0, ts = th; const double t2 = th * th;
            for (int n = 1; n <= 12; ++n) { tc *= -t2 / (double)((2 * n - 1) * (2 * n)); ts *= -t2 / (double)((2 * n) * (2 * n + 1)); c1 += tc; s1 += ts; }
            double cc = 1.0, ss = 0.0; for (int q = 0; q < pos; ++q) { const double nc = cc * c1 - ss * s1, ns = ss * c1 + cc * s1; cc = nc; ss = ns; }
            rope[idx * 2] = (float)cc; rope[idx * 2 + 1] = (float)ss;
        }
        if (C.tid < 2) { const int l = C.tid; const float* p = c_lambda + l * 256; float a = 0.f, b = 0.f;
            for (int d = 0; d < 64; ++d) { a += p[d] * p[64 + d]; b += p[128 + d] * p[192 + d]; }
            const float li = l == 0 ? 0.2f : (0.8f - 0.6f * 0.7408182206817179f);
            lam[l] = __expf(a) - __expf(b) + li; }
    }
}

__device__ __forceinline__ void modulate_row(const float* xr, const float* gn, const float* scv, const float* shv, bf16* orow, int lane, f32x4 (&y)[4]) {
    const GAS f32x4* xp = (const GAS f32x4*)xr + lane; f32x4 v[4]; float ss = 0.f;
#pragma unroll
    for (int j = 0; j < 4; ++j) { v[j] = xp[64 * j]; ss += (v[j].x * v[j].x + v[j].y * v[j].y) + (v[j].z * v[j].z + v[j].w * v[j].w); }
    const float rstd = 1.0f / sqrtf(wave_sum(ss) * (1.f / 1024.f) + EPS);
    GAS v2u* o8 = (GAS v2u*)orow + lane;
#pragma unroll
    for (int j = 0; j < 4; ++j) {
        const f32x4 g = ((const GAS f32x4*)gn)[lane + 64 * j], s = ((const GAS f32x4*)scv)[lane + 64 * j], h = ((const GAS f32x4*)shv)[lane + 64 * j];
        y[j] = (v[j] * rstd) * g * (s + 1.0f) + h;
        v2u w; w.x = pg8::cvt_pk_bf16(y[j].x, y[j].y); w.y = pg8::cvt_pk_bf16(y[j].z, y[j].w); o8[64 * j] = w; }
}
__device__ __forceinline__ void modulate_phase(const Ctx& C, const float* xl, const float* xcs, const float* gn, const float* modl, int shidx, int scidx, bf16* H, int nrows) {
    const int lane = C.lane;
    for (int r0 = C.gw; r0 < nrows; r0 += 2 * C.NGW) {
        const int r1 = r0 + C.NGW; const bool has1 = r1 < nrows; const int r1c = has1 ? r1 : r0;
        const float* xr0 = r0 < ML ? xl + (size_t)r0 * DM : xcs + (size_t)(r0 - ML) * DM; const int b0 = r0 < ML ? (r0 >> 12) : 16;
        const float* xr1 = r1c < ML ? xl + (size_t)r1c * DM : xcs + (size_t)(r1c - ML) * DM; const int b1 = r1c < ML ? (r1c >> 12) : 16;
        const GAS f32x4* p0 = (const GAS f32x4*)xr0 + lane; const GAS f32x4* p1 = (const GAS f32x4*)xr1 + lane;
        f32x4 v0[4], v1[4]; float s0 = 0.f, s1 = 0.f;
#pragma unroll
        for (int j = 0; j < 4; ++j) { v0[j] = p0[64 * j]; v1[j] = p1[64 * j]; }
#pragma unroll
        for (int j = 0; j < 4; ++j) { s0 += (v0[j].x * v0[j].x + v0[j].y * v0[j].y) + (v0[j].z * v0[j].z + v0[j].w * v0[j].w); s1 += (v1[j].x * v1[j].x + v1[j].y * v1[j].y) + (v1[j].z * v1[j].z + v1[j].w * v1[j].w); }
        const float rs0 = 1.0f / sqrtf(wave_sum(s0) * (1.f / 1024.f) + EPS), rs1 = 1.0f / sqrtf(wave_sum(s1) * (1.f / 1024.f) + EPS);
        const float* m0 = modl + (size_t)b0 * 6144; const float* m1 = modl + (size_t)b1 * 6144;
        GAS v2u* o0 = (GAS v2u*)(H + (size_t)r0 * DM) + lane; GAS v2u* o1 = (GAS v2u*)(H + (size_t)r1c * DM) + lane;
#pragma unroll
        for (int j = 0; j < 4; ++j) {
            const f32x4 g = ((const GAS f32x4*)gn)[lane + 64 * j];
            const f32x4 sa = ((const GAS f32x4*)(m0 + scidx * 1024))[lane + 64 * j], ha = ((const GAS f32x4*)(m0 + shidx * 1024))[lane + 64 * j];
            const f32x4 ya = (v0[j] * rs0) * g * (sa + 1.0f) + ha;
            v2u w; w.x = pg8::cvt_pk_bf16(ya.x, ya.y); w.y = pg8::cvt_pk_bf16(ya.z, ya.w); o0[64 * j] = w;
            if (has1) { const f32x4 sb = ((const GAS f32x4*)(m1 + scidx * 1024))[lane + 64 * j], hb = ((const GAS f32x4*)(m1 + shidx * 1024))[lane + 64 * j];
                const f32x4 yb = (v1[j] * rs1) * g * (sb + 1.0f) + hb;
                v2u w2; w2.x = pg8::cvt_pk_bf16(yb.x, yb.y); w2.y = pg8::cvt_pk_bf16(yb.z, yb.w); o1[64 * j] = w2; }
        }
    }
}

using pg8::f32x4; using pg8::u32x4; using pg8::Unit; using pg8::cvt_pk_bf16;
__device__ __forceinline__ u32x4 pack8(const f32x4& a, const f32x4& b) { u32x4 w; w.x = cvt_pk_bf16(a[0], a[1]); w.y = cvt_pk_bf16(a[2], a[3]); w.z = cvt_pk_bf16(b[0], b[1]); w.w = cvt_pk_bf16(b[2], b[3]); return w; }
__device__ __forceinline__ void unpack8(const u32x4& w, f32x4& a, f32x4& b) {
    a[0] = bf2f(w.x & 0xffffu); a[1] = bf2f(w.x >> 16); a[2] = bf2f(w.y & 0xffffu); a[3] = bf2f(w.y >> 16);
    b[0] = bf2f(w.z & 0xffffu); b[1] = bf2f(w.z >> 16); b[2] = bf2f(w.w & 0xffffu); b[3] = bf2f(w.w >> 16); }

#ifndef NT_BIG
#define NT_BIG 0
#endif
#if NT_BIG
#define ST16(p, v) __builtin_nontemporal_store((v), (p))
#else
#define ST16(p, v) (*(p) = (v))
#endif
struct EpiBig {
    static constexpr bool PERM = true, AFTER_DRAIN = false;
    unsigned char* wsb; const LAS float* rope;
    __device__ __forceinline__ void operator()(const f32x4 (&acc)[2][2][4][2], const Unit& u, int wr, int wc, int fr, int fq) const {
        const int R0 = u.pm * 256, pn = u.pn; const bool isctx = R0 >= ML;
        const int cin = 32 * wc + 8 * fq;
        if (pn < 12) {
            const int kind = pn >> 2;
            bf16* base = (bf16*)(wsb + WS_Q + (size_t)kind * (WS_K - WS_Q));
            long rowadd = 0;
            if (kind != 0) rowadd = isctx ? ((long)((R0 - ML) >> 8) * SKV + SEQ - R0) : ((long)(R0 >> 12) * (SKV - SEQ));
            const bool rot = (kind != 2) && !isctx; const int axis = wc & 1; const float qs = kind == 0 ? QSCALE : 1.f;
#pragma unroll
            for (int ai = 0; ai < 2; ++ai)
#pragma unroll
                for (int m = 0; m < 4; ++m) {
                    const int r = R0 + ai * 128 + wr * 64 + m * 16 + fr;
                    f32x4 t0 = {1.f, 0.f, 1.f, 0.f}, t1 = {1.f, 0.f, 1.f, 0.f};
                    if (rot) { const int t = r & 4095; const int pos = axis == 0 ? (t >> 6) : (t & 63); const LAS f32x4* tp = (const LAS f32x4*)(rope + (pos * 16 + 4 * fq) * 2); t0 = tp[0]; t1 = tp[1]; }
                    bf16* rowp = base + (size_t)((long)r + rowadd) * DM + (pn & 3) * 256 + cin;
#pragma unroll
                    for (int bj = 0; bj < 2; ++bj) {
                        const f32x4 a = acc[ai][bj][m][0], b = acc[ai][bj][m][1]; f32x4 oa, ob;
                        oa[0] = (a[0] * t0[0] - a[1] * t0[1]) * qs; oa[1] = (a[1] * t0[0] + a[0] * t0[1]) * qs; oa[2] = (a[2] * t0[2] - a[3] * t0[3]) * qs; oa[3] = (a[3] * t0[2] + a[2] * t0[3]) * qs;
                        ob[0] = (b[0] * t1[0] - b[1] * t1[1]) * qs; ob[1] = (b[1] * t1[0] + b[0] * t1[1]) * qs; ob[2] = (b[2] * t1[2] - b[3] * t1[3]) * qs; ob[3] = (b[3] * t1[2] + b[2] * t1[3]) * qs;
                        ST16((GAS u32x4*)(rowp + bj * 128), pack8(oa, ob)); }
                }
        } else if (pn < 18) {
            const int kind = (pn - 12) >> 1;
            bf16* base = (bf16*)(wsb + WS_P0 + (size_t)kind * (WS_P1 - WS_P0)); const int c0 = ((pn - 12) & 1) * 256 + cin;
#pragma unroll
            for (int ai = 0; ai < 2; ++ai)
#pragma unroll
                for (int m = 0; m < 4; ++m) {
                    const int r = R0 + ai * 128 + wr * 64 + m * 16 + fr; bf16* rowp = base + (size_t)r * 512 + c0;
#pragma unroll
                    for (int bj = 0; bj < 2; ++bj) {
                        f32x4 a = acc[ai][bj][m][0], b = acc[ai][bj][m][1];
                        if (kind < 2) {
#pragma unroll
                            for (int q = 0; q < 4; ++q) { a[q] = gelu_tanh_f(a[q]); b[q] = gelu_tanh_f(b[q]); } }
                        ST16((GAS u32x4*)(rowp + bj * 128), pack8(a, b)); }
                }
        } else {
            const int c0 = (pn - 18) * 128 + cin;
#pragma unroll
            for (int ai = 0; ai < 2; ++ai)
#pragma unroll
                for (int m = 0; m < 4; ++m) {
                    const int r = R0 + ai * 128 + wr * 64 + m * 16 + fr;
                    const f32x4 a = acc[ai][0][m][0] * acc[ai][1][m][0], b = acc[ai][0][m][1] * acc[ai][1][m][1];
                    ST16((GAS u32x4*)((bf16*)(wsb + WS_P3) + (size_t)r * 512 + c0), pack8(a, b)); }
        }
    }
};

struct EpiGate {
    static constexpr bool PERM = true, AFTER_DRAIN = false;
    unsigned char* wsb; const LAS float* bias;
    __device__ __forceinline__ void operator()(const f32x4 (&acc)[2][2][4][2], const Unit& u, int wr, int wc, int fr, int fq) const {
        const int R0 = u.pm * 256, pn = u.pn, br = pn >> 2, cin = 32 * wc + 8 * fq;
        const size_t boff = br == 0 ? WS_K : (br == 1 ? WS_V : ((pn & 2) ? WS_P3 : WS_P1));
        bf16* base = (bf16*)(wsb + boff); const int ld = br == 2 ? 512 : 1024, c0 = (br == 2 ? (pn & 1) : (pn & 3)) * 256 + cin;
        f32x4 bv[2][2];
#pragma unroll
        for (int bj = 0; bj < 2; ++bj)
#pragma unroll
            for (int n = 0; n < 2; ++n) bv[bj][n] = *(const LAS f32x4*)(bias + pn * 256 + bj * 128 + cin + 4 * n);
#pragma unroll
        for (int ai = 0; ai < 2; ++ai)
#pragma unroll
            for (int m = 0; m < 4; ++m) {
                const int r = R0 + ai * 128 + wr * 64 + m * 16 + fr; bf16* rowp = base + (size_t)r * ld + c0;
#pragma unroll
                for (int bj = 0; bj < 2; ++bj) {
                    f32x4 a = acc[ai][bj][m][0] + bv[bj][0], b = acc[ai][bj][m][1] + bv[bj][1];
#pragma unroll
                    for (int q = 0; q < 4; ++q) { a[q] = sigmoid_f(a[q]); b[q] = sigmoid_f(b[q]); }
                    ST16((GAS u32x4*)(rowp + bj * 128), pack8(a, b)); }
            }
    }
};

struct EpiMerge {
    static constexpr bool PERM = true, AFTER_DRAIN = false;
    bf16* Y; const bf16* G0; long g1off; int gld; int gsplit_tiles;
    int first; int dry;
    __device__ __forceinline__ void operator()(const f32x4 (&acc)[2][2][4][2], const Unit& u, int wr, int wc, int fr, int fq) const {
        const int R0 = u.pm * 256, pn = u.pn, cin = 32 * wc + 8 * fq;
        const bf16* gb = G0 + (pn < gsplit_tiles ? (long)pn * 256 : g1off + (long)(pn - gsplit_tiles) * 256);
#pragma unroll
        for (int ai = 0; ai < 2; ++ai)
#pragma unroll
            for (int m = 0; m < 4; ++m) {
                const int r = R0 + ai * 128 + wr * 64 + m * 16 + fr; bf16* yp = Y + (size_t)r * DM + pn * 256 + cin; const bf16* gp = gb + (size_t)r * gld + cin;
#pragma unroll
                for (int bj = 0; bj < 2; ++bj) {
                    const u32x4 gw = *(const GAS u32x4*)(gp + bj * 128); f32x4 ga, gb2; unpack8(gw, ga, gb2);
                    f32x4 a = acc[ai][bj][m][0] * ga, b = acc[ai][bj][m][1] * gb2;
                    if (!first) { const u32x4 yw = *(const GAS u32x4*)(yp + bj * 128); f32x4 ya, yb; unpack8(yw, ya, yb); a += ya; b += yb; }
                    if (!dry) *(GAS u32x4*)(yp + bj * 128) = pack8(a, b); }
            }
    }
};

struct EpiResid {
    static constexpr bool PERM = false, AFTER_DRAIN = false;
    const float* xb; float* xo; long cbd, cod; const float* modl; int slot; int dry;
    __device__ __forceinline__ void operator()(const f32x4 (&acc)[2][2][4][2], const Unit& u, int wr, int wc, int fr, int fq) const {
        const int R0 = u.pm * 256; const bool isctx = R0 >= ML; const int b = isctx ? 16 : (R0 >> 12);
        const float* base = xb + (isctx ? cbd : 0l); float* out = xo + (isctx ? cod : 0l);
        const int col0 = u.pn * 256 + wc * 32 + 4 * fq; const float* gp = modl + (size_t)b * 6144 + slot * 1024 + col0;
        f32x4 gv[2][2];
#pragma unroll
        for (int bj = 0; bj < 2; ++bj)
#pragma unroll
            for (int n = 0; n < 2; ++n) gv[bj][n] = *(const GAS f32x4*)(gp + bj * 128 + n * 16);
#pragma unroll
        for (int ai = 0; ai < 2; ++ai)
#pragma unroll
            for (int m = 0; m < 4; ++m) { const size_t off = (size_t)(R0 + ai * 128 + wr * 64 + m * 16 + fr) * DM + col0;
#pragma unroll
                for (int bj = 0; bj < 2; ++bj)
#pragma unroll
                    for (int n = 0; n < 2; ++n) { const f32x4 bs = *(const GAS f32x4*)(base + off + bj * 128 + n * 16); if (!dry) *(GAS f32x4*)(out + off + bj * 128 + n * 16) = bs + gv[bj][n] * acc[ai][bj][m][n]; }
            }
    }
};

struct EpiSwiGLU {
    static constexpr bool PERM = true, AFTER_DRAIN = false;
    bf16* ACT; int ld, pm0, npe;
    __device__ __forceinline__ void operator()(const f32x4 (&acc)[2][2][4][2], const Unit& u, int wr, int wc, int fr, int fq) const {
        const int R0 = (u.pm - pm0) * 256, jt = u.pn % npe, c0 = jt * 128 + 32 * wc + 8 * fq;
#pragma unroll
        for (int ai = 0; ai < 2; ++ai)
#pragma unroll
            for (int m = 0; m < 4; ++m) {
                const int r = R0 + ai * 128 + wr * 64 + m * 16 + fr; f32x4 a, b;
#pragma unroll
                for (int q = 0; q < 4; ++q) { a[q] = silu_f(acc[ai][0][m][0][q]) * acc[ai][1][m][0][q]; b[q] = silu_f(acc[ai][0][m][1][q]) * acc[ai][1][m][1][q]; }
#ifdef NT_ACT
                __builtin_nontemporal_store(pack8(a, b), (GAS u32x4*)(ACT + (size_t)r * ld + c0)); }
#else
                *(GAS u32x4*)(ACT + (size_t)r * ld + c0) = pack8(a, b); }
#endif
    }
};

struct EpiStoreBf16 {
    static constexpr bool PERM = true, AFTER_DRAIN = false;
    bf16* O; int ld, pm0, npe;
    __device__ __forceinline__ void operator()(const f32x4 (&acc)[2][2][4][2], const Unit& u, int wr, int wc, int fr, int fq) const {
        const int R0 = (pm0 + u.pm) * 256, c0 = (u.pn % npe) * 256 + 32 * wc + 8 * fq;
#pragma unroll
        for (int ai = 0; ai < 2; ++ai)
#pragma unroll
            for (int m = 0; m < 4; ++m) { bf16* rowp = O + (size_t)(R0 + ai * 128 + wr * 64 + m * 16 + fr) * ld + c0;
#pragma unroll
#ifdef NT_PAIR
                for (int bj = 0; bj < 2; ++bj) __builtin_nontemporal_store(pack8(acc[ai][bj][m][0], acc[ai][bj][m][1]), (GAS u32x4*)(rowp + bj * 128)); }
#else
                for (int bj = 0; bj < 2; ++bj) *(GAS u32x4*)(rowp + bj * 128) = pack8(acc[ai][bj][m][0], acc[ai][bj][m][1]); }
#endif
    }
};

struct MoeOrder {
    pg8::StaticOrder so; int tile0, npe; bool a_global; const volatile LAS int* offl;
    __device__ __forceinline__ bool next(int i, Unit& u) const {
        Unit v; if (!so.next(i, v)) return false;
        const int gt = tile0 + v.pm, row = gt * 256; int e = 0;
#pragma unroll
        for (int q = 1; q < 8; ++q) e += (offl[q] <= row) ? 1 : 0;
        u.pm = a_global ? gt : v.pm; u.pn = e * npe + v.pn; return true;
    }
    __device__ __forceinline__ void a_ready(const Unit&) const {}
    __device__ __forceinline__ void done(const Unit&) const {}
};

struct GateOrder {
    pg8::StaticOrder so;
    __device__ __forceinline__ bool next(int i, Unit& u) const { Unit v; if (!so.next(i / 3, v)) return false; u.pm = v.pm; u.pn = v.pn + 4 * (i % 3); return true; }
    __device__ __forceinline__ void a_ready(const Unit&) const {}
    __device__ __forceinline__ void done(const Unit&) const {}
};

struct BigOrderL1 {
    pg8::StaticOrder so; int G, c;
    __device__ __forceinline__ bool next(int i, Unit& u) const {
        const int L = i * G + c, nlat = (ML / 256) * (NBIG / 256);
        if (L < nlat) return so.next(i, u);
        const int k = L - nlat; if (k >= (MC / 256) * 8) return false;
        u.pm = ML / 256 + (k >> 3); u.pn = 4 + (k & 7); return true;
    }
    __device__ __forceinline__ void a_ready(const Unit&) const {}
    __device__ __forceinline__ void done(const Unit&) const {}
};


namespace att {
using bf16x8 = __attribute__((ext_vector_type(8))) short;
using s16x4  = __attribute__((ext_vector_type(4))) short;
using f32x16 = __attribute__((ext_vector_type(16))) float;
constexpr int NW = 8, QBLK = 32, KVBLK = 64, LD = 1024;
constexpr int SHM_V = KVBLK * 128 * 2, SHM_K = KVBLK * 128 * 2, SHM_ATTN = 2 * SHM_V + 2 * SHM_K + NW * 64 * 4;
#define KSWZ(row, colB) ((row) * 256 + ((colB) ^ (((row) & 7) << 4)))
#define SBAR() __builtin_amdgcn_sched_barrier(0)
__device__ __forceinline__ int crow(int r, int hi) { return (r & 3) + 8 * (r >> 2) + 4 * hi; }
__device__ __forceinline__ unsigned cvtpk(float lo, float hi) { return pg8::cvt_pk_bf16(lo, hi); }

__device__ __forceinline__ void partialSM(f32x16& p0) {
#pragma unroll
  for (int r = 0; r < 16; ++r) p0[r] = __builtin_amdgcn_exp2f(p0[r]);
}
__device__ __forceinline__ void finishSM(f32x16& p0, f32x16& p1, float& l_reg, bf16x8& pa0, bf16x8& pa1, bf16x8& pa2, bf16x8& pa3) {
#pragma unroll
  for (int r = 0; r < 16; ++r) p1[r] = __builtin_amdgcn_exp2f(p1[r]);
  float ps = 0;
#pragma unroll
  for (int r = 0; r < 16; ++r) ps += p0[r];
#pragma unroll
  for (int r = 0; r < 16; ++r) ps += p1[r];
  l_reg += ps;
#define PK4(P, BASE, OUT) do { unsigned a0 = cvtpk(P[BASE + 0], P[BASE + 1]), a1 = cvtpk(P[BASE + 2], P[BASE + 3]);   \
    unsigned b0 = cvtpk(P[BASE + 4], P[BASE + 5]), b1 = cvtpk(P[BASE + 6], P[BASE + 7]);                              \
    auto r0 = __builtin_amdgcn_permlane32_swap(a0, b0, false, false); auto r1 = __builtin_amdgcn_permlane32_swap(a1, b1, false, false); \
    u32x4 w = {r0[0], r1[0], r0[1], r1[1]}; OUT = __builtin_bit_cast(bf16x8, w); } while (0)
  PK4(p0, 0, pa0); PK4(p0, 8, pa1); PK4(p1, 0, pa2); PK4(p1, 8, pa3);
#undef PK4
}
__device__ __forceinline__ void qkt(f32x16& p0, f32x16& p1, const LAS char* Ks, const bf16x8* qr, int r32, int hi, int mp) {
  p0 = f32x16{}; p1 = f32x16{};
#ifdef ATT_PRIO
  __builtin_amdgcn_s_setprio(1);
#endif
#pragma unroll
  for (int d0 = 0; d0 < 4; ++d0) { const int cb = (mp * 64 + d0 * 16 + hi * 8) * 2;
    const bf16x8 b0 = *(const LAS bf16x8*)(Ks + KSWZ(r32, cb));
    const bf16x8 b1 = *(const LAS bf16x8*)(Ks + KSWZ(32 + r32, cb));
    p0 = __builtin_amdgcn_mfma_f32_32x32x16_bf16(b0, qr[d0], p0, 0, 0, 0);
    p1 = __builtin_amdgcn_mfma_f32_32x32x16_bf16(b1, qr[d0], p1, 0, 0, 0); }
#ifdef ATT_PRIO
  __builtin_amdgcn_s_setprio(0);
#endif
}
__device__ __forceinline__ int v_st(int k, int c) { const int kk = (k & ~0xC) | ((k & 4) << 1) | ((k & 8) >> 1); return ((kk >> 3) * 4 + (c >> 5)) * 512 + ((kk & 7) * 32 + (c & 31)) * 2; }
__device__ __forceinline__ int v_rd_base(int lane) { return ((lane & 3) << 3) | (((lane >> 2) & 3) << 6) | (((lane >> 4) & 1) << 5) | (((lane >> 5) & 1) << 8); }
constexpr int v_rd_off(int d0, int ks, int half) { return d0 * 512 + ks * 4096 + half * 2048; }
template <int OFF> __device__ __forceinline__ s16x4 tr_read(int vb) {
  s16x4 r; asm volatile("ds_read_b64_tr_b16 %0, %1 offset:%2" : "=&v"(r) : "v"(vb), "i"(OFF) : "memory"); return r;
}
template <int D0> __device__ __forceinline__ void pv_one(f32x16& od, int vb, bf16x8 pa0, bf16x8 pa1, bf16x8 pa2, bf16x8 pa3) {
  const s16x4 l0 = tr_read<v_rd_off(D0, 0, 0)>(vb), h0 = tr_read<v_rd_off(D0, 0, 1)>(vb), l1 = tr_read<v_rd_off(D0, 1, 0)>(vb), h1 = tr_read<v_rd_off(D0, 1, 1)>(vb);
  const s16x4 l2 = tr_read<v_rd_off(D0, 2, 0)>(vb), h2 = tr_read<v_rd_off(D0, 2, 1)>(vb), l3 = tr_read<v_rd_off(D0, 3, 0)>(vb), h3 = tr_read<v_rd_off(D0, 3, 1)>(vb);
  asm volatile("s_waitcnt lgkmcnt(0)" ::: "memory"); SBAR();
#define PK(L, H) (bf16x8){L[0], L[1], L[2], L[3], H[0], H[1], H[2], H[3]}
  od = __builtin_amdgcn_mfma_f32_32x32x16_bf16(pa0, PK(l0, h0), od, 0, 0, 0);
  od = __builtin_amdgcn_mfma_f32_32x32x16_bf16(pa1, PK(l1, h1), od, 0, 0, 0);
  od = __builtin_amdgcn_mfma_f32_32x32x16_bf16(pa2, PK(l2, h2), od, 0, 0, 0);
  od = __builtin_amdgcn_mfma_f32_32x32x16_bf16(pa3, PK(l3, h3), od, 0, 0, 0);
#undef PK
}
__device__ __forceinline__ void pv_d0(f32x16* o, int vb, bf16x8 pa0, bf16x8 pa1, bf16x8 pa2, bf16x8 pa3) {
  pv_one<0>(o[0], vb, pa0, pa1, pa2, pa3); pv_one<1>(o[1], vb, pa0, pa1, pa2, pa3); pv_one<2>(o[2], vb, pa0, pa1, pa2, pa3); pv_one<3>(o[3], vb, pa0, pa1, pa2, pa3);
}

struct VFrag { s16x4 l0, h0, l1, h1, l2, h2, l3, h3; };
template <int D0> __device__ __forceinline__ void v_load(VFrag& f, int vb) {
  f.l0 = tr_read<v_rd_off(D0, 0, 0)>(vb); f.h0 = tr_read<v_rd_off(D0, 0, 1)>(vb); f.l1 = tr_read<v_rd_off(D0, 1, 0)>(vb); f.h1 = tr_read<v_rd_off(D0, 1, 1)>(vb);
  f.l2 = tr_read<v_rd_off(D0, 2, 0)>(vb); f.h2 = tr_read<v_rd_off(D0, 2, 1)>(vb); f.l3 = tr_read<v_rd_off(D0, 3, 0)>(vb); f.h3 = tr_read<v_rd_off(D0, 3, 1)>(vb);
}
__device__ __forceinline__ void pv_mma(f32x16& od, const VFrag& f, bf16x8 pa0, bf16x8 pa1, bf16x8 pa2, bf16x8 pa3) {
#define PK(L, H) (bf16x8){L[0], L[1], L[2], L[3], H[0], H[1], H[2], H[3]}
#ifdef ATT_PRIO
  __builtin_amdgcn_s_setprio(1);
#endif
  od = __builtin_amdgcn_mfma_f32_32x32x16_bf16(pa0, PK(f.l0, f.h0), od, 0, 0, 0);
  od = __builtin_amdgcn_mfma_f32_32x32x16_bf16(pa1, PK(f.l1, f.h1), od, 0, 0, 0);
  od = __builtin_amdgcn_mfma_f32_32x32x16_bf16(pa2, PK(f.l2, f.h2), od, 0, 0, 0);
  od = __builtin_amdgcn_mfma_f32_32x32x16_bf16(pa3, PK(f.l3, f.h3), od, 0, 0, 0);
#ifdef ATT_PRIO
  __builtin_amdgcn_s_setprio(0);
#endif
#undef PK
}
#define LWAIT(n) do { asm volatile("s_waitcnt lgkmcnt(" #n ")" ::: "memory"); SBAR(); } while (0)
__device__ __forceinline__ void pv_pipe(f32x16* o, int vb, VFrag& f0, bf16x8 pa0, bf16x8 pa1, bf16x8 pa2, bf16x8 pa3) {
  VFrag f1;
  v_load<1>(f1, vb); LWAIT(8); pv_mma(o[0], f0, pa0, pa1, pa2, pa3); SBAR();
  v_load<2>(f0, vb); LWAIT(8); pv_mma(o[1], f1, pa0, pa1, pa2, pa3); SBAR();
  v_load<3>(f1, vb); LWAIT(8); pv_mma(o[2], f0, pa0, pa1, pa2, pa3); SBAR();
  LWAIT(0); pv_mma(o[3], f1, pa0, pa1, pa2, pa3);
}

#ifndef ATT_VPIPE
#define ATT_VPIPE 1
#endif
#if ATT_VPIPE
#define ATT_STEP_BODY(b) qkt(p0, p1, K_lds + (b) * SHM_K, qr, r32, hi, mp); SBAR(); VFrag vf0; v_load<0>(vf0, vb0 + (b) * SHM_V); SBAR(); \
    partialSM(p0); finishSM(p0, p1, l_reg, pa0, pa1, pa2, pa3); SBAR(); pv_pipe(o, vb0 + (b) * SHM_V, vf0, pa0, pa1, pa2, pa3); SBAR();
#else
#define ATT_STEP_BODY(b) qkt(p0, p1, K_lds + (b) * SHM_K, qr, r32, hi, mp); partialSM(p0); finishSM(p0, p1, l_reg, pa0, pa1, pa2, pa3); SBAR(); pv_d0(o, vb0 + (b) * SHM_V, pa0, pa1, pa2, pa3); SBAR();
#endif
__device__ __forceinline__ void diff_attn_unit(const bf16* Qb_, const bf16* Kh_, const bf16* Vh_, bf16* Ob_, int NT,
                                               float lam, const float* subg_, float oml, LAS char* lds, bool dostore = true, int rot = 0) {
  const GAS bf16* Qb = (const GAS bf16*)Qb_; const GAS bf16* Kh = (const GAS bf16*)Kh_; const GAS bf16* Vh = (const GAS bf16*)Vh_; GAS bf16* Ob = (GAS bf16*)Ob_; const GAS float* subg = (const GAS float*)subg_;
  const int tid = threadIdx.x, wid = tid >> 6, lane = tid & 63, r32 = lane & 31, hi = lane >> 5, qg = wid >> 1, mp = wid & 1;
  LAS char* V_lds = lds; LAS char* K_lds = lds + 2 * SHM_V;
  LAS float* ws = (LAS float*)(lds + 2 * SHM_V + 2 * SHM_K) + wid * 64; LAS float* li_l = ws; LAS float* al_l = ws + 32;
  float l_reg = 0; f32x16 o[4] = {}; bf16x8 qr[4];
  const GAS bf16* Qw = Qb + (long)(qg * QBLK + r32) * LD + mp * 64 + hi * 8;
#pragma unroll
  for (int d0 = 0; d0 < 4; ++d0) qr[d0] = *(const GAS bf16x8*)(Qw + d0 * 16);
  const int vb0 = (int)(unsigned)(uintptr_t)V_lds + v_rd_base(lane);
  int offK[2], offV[2];
#pragma unroll
  for (int i = 0; i < 2; ++i) { const int c = wid * 2 + i;
    { const int row = 4 * c + (lane >> 4), p = (lane & 15) ^ (row & 7); offK[i] = row * LD + p * 8; }
    { const int st = 2 * c + (lane >> 5), li = lane & 31, kk = (st >> 2) * 8 + (li >> 2), col = (st & 3) * 32 + (li & 3) * 8, k = (kk & ~0xC) | ((kk & 8) >> 1) | ((kk & 4) << 1); offV[i] = k * LD + col; } }
#define DMA_TILE(b, k0) do { _Pragma("unroll") for (int i_ = 0; i_ < 2; ++i_) {                                                                              \
      __builtin_amdgcn_global_load_lds((const GAS unsigned*)(Kh + (long)(k0) * LD + offK[i_]), (LAS unsigned*)(K_lds + (b) * SHM_K + (wid * 2 + i_) * 1024), 16, 0, 0);  \
      __builtin_amdgcn_global_load_lds((const GAS unsigned*)(Vh + (long)(k0) * LD + offV[i_]), (LAS unsigned*)(V_lds + (b) * SHM_V + (wid * 2 + i_) * 1024), 16, 0, 0); } } while (0)
#define TILE_STEP(b, t) do { f32x16 p0, p1; bf16x8 pa0, pa1, pa2, pa3; SBAR();                                   \
    ATT_STEP_BODY(b)                                                                                              \
    asm volatile("s_waitcnt vmcnt(0)" ::: "memory"); __syncthreads();                                            \
    if ((t) + 2 < NT) DMA_TILE(b, KT((t) + 2) * KVBLK); } while (0)
#define KT(t_) (((t_) + rot) >= NT ? ((t_) + rot) - NT : ((t_) + rot))
  DMA_TILE(0, KT(0) * KVBLK); DMA_TILE(1, KT(1) * KVBLK); asm volatile("s_waitcnt vmcnt(0)" ::: "memory"); __syncthreads();
  for (int t = 0; t < NT; t += 2) { TILE_STEP(0, t); TILE_STEP(1, t + 1); }
#undef TILE_STEP
#undef DMA_TILE
#undef KT
  int lane_e = lane;
#if 1
  asm volatile("" : "+v"(lane_e));
#endif
  { auto rr = __builtin_amdgcn_permlane32_swap(__float_as_uint(l_reg), __float_as_uint(l_reg), false, false); l_reg = __uint_as_float(rr[0]) + __uint_as_float(rr[1]); }
  if (hi == 0) li_l[r32] = l_reg; asm volatile("s_waitcnt lgkmcnt(0)" ::: "memory");
  const int r32e = lane_e & 31, hie = lane_e >> 5;
  float rli[16];
#pragma unroll
  for (int r = 0; r < 16; ++r) rli[r] = __builtin_amdgcn_rcpf(li_l[crow(r, hie)]);
  __syncthreads();
  LAS float* X = (LAS float*)lds + qg * 4096;
  if (mp == 1) {
#pragma unroll
    for (int d0 = 0; d0 < 4; ++d0)
#pragma unroll
      for (int r = 0; r < 16; ++r) X[(d0 * 16 + r) * 64 + lane_e] = o[d0][r] * rli[r] * (-lam);
  }
  __syncthreads();
  if (mp == 0) {
#pragma unroll
    for (int d0 = 0; d0 < 4; ++d0) {
#pragma unroll
      for (int r = 0; r < 16; ++r) o[d0][r] = o[d0][r] * rli[r] + X[(d0 * 16 + r) * 64 + lane_e];
      asm volatile("" ::: "memory");
    }
    float g4[4];
#pragma unroll
    for (int d0 = 0; d0 < 4; ++d0) g4[d0] = subg[32 * d0 + r32e] * oml;
    GAS bf16* Ow = Ob + (long)(qg * QBLK) * LD;
#pragma unroll
    for (int r = 0; r < 16; ++r) {
      float ss = (o[0][r] * o[0][r] + o[1][r] * o[1][r]) + (o[2][r] * o[2][r] + o[3][r] * o[3][r]);
      ss += __shfl_xor(ss, 1); ss += __shfl_xor(ss, 2); ss += __shfl_xor(ss, 4); ss += __shfl_xor(ss, 8); ss += __shfl_xor(ss, 16);
      const float rs = 1.0f / sqrtf(ss * (1.f / 128.f) + EPS); const int orow = crow(r, hie);
#pragma unroll
      for (int d0 = 0; d0 < 4; ++d0) if (dostore) Ow[(long)orow * LD + d0 * 32 + r32e] = (bf16)f2bf(o[d0][r] * rs * g4[d0]);
    }
  }
  __syncthreads();
}

template <bool CTX>
__device__ __forceinline__ void diff_attn_units(const bf16* Q_, const bf16* K_, const bf16* V_, int first, int count, int stride,
                                                float lam, const float* subg_, float oml, LAS char* lds) {
  constexpr int NT = CTX ? CTXL / 64 : SKV / 64;
  if (first >= count) return;
  const GAS bf16* Qg = (const GAS bf16*)Q_; const GAS bf16* Kg = (const GAS bf16*)K_; const GAS bf16* Vg = (const GAS bf16*)V_; const GAS float* subg = (const GAS float*)subg_;
  const int tid = threadIdx.x, wid = tid >> 6, lane = tid & 63, r32 = lane & 31, hi = lane >> 5, qg = wid >> 1, mp = wid & 1;
  LAS char* V_lds = lds; LAS char* K_lds = lds + 2 * SHM_V;
  LAS float* ws = (LAS float*)(lds + 2 * SHM_V + 2 * SHM_K) + wid * 64; LAS float* li_l = ws;
  LAS float* X = (LAS float*)(lds + SHM_ATTN) + qg * 4096;
  const int vb0 = (int)(unsigned)(uintptr_t)V_lds + v_rd_base(lane);
  int offK[2], offV[2];
#pragma unroll
  for (int i = 0; i < 2; ++i) { const int c = wid * 2 + i;
    { const int row = 4 * c + (lane >> 4), p = (lane & 15) ^ (row & 7); offK[i] = row * LD + p * 8; }
    { const int st = 2 * c + (lane >> 5), li = lane & 31, kk = (st >> 2) * 8 + (li >> 2), col = (st & 3) * 32 + (li & 3) * 8, k = (kk & ~0xC) | ((kk & 8) >> 1) | ((kk & 4) << 1); offV[i] = k * LD + col; } }
#define UNIT_Q(u_) (CTX ? ((size_t)ML + ((u_) >> 4) * CTXL + ((u_) & 1) * 128) * DM + (((u_) >> 1) & 7) * 128 : ((size_t)((u_) >> 8) * SEQ + ((u_) & 31) * 128) * DM + (((u_) >> 5) & 7) * 128)
#define UNIT_K(u_) (CTX ? ((size_t)((u_) >> 4) * SKV + SEQ) * DM + (((u_) >> 1) & 7) * 128 : (size_t)((u_) >> 8) * SKV * DM + (((u_) >> 5) & 7) * 128)
#define UNIT_ROT(u_) (CTX ? 0 : ((u_) & 31) * 2)
#define DMA_TILE(b, k0) do { _Pragma("unroll") for (int i_ = 0; i_ < 2; ++i_) {                                                                              \
      __builtin_amdgcn_global_load_lds((const GAS unsigned*)(Kh + (long)(k0) * LD + offK[i_]), (LAS unsigned*)(K_lds + (b) * SHM_K + (wid * 2 + i_) * 1024), 16, 0, 0);  \
      __builtin_amdgcn_global_load_lds((const GAS unsigned*)(Vh + (long)(k0) * LD + offV[i_]), (LAS unsigned*)(V_lds + (b) * SHM_V + (wid * 2 + i_) * 1024), 16, 0, 0); } } while (0)
#define KT(t_) (((t_) + rot) >= NT ? ((t_) + rot) - NT : ((t_) + rot))
#define TILE_STEP(b, t) do { f32x16 p0, p1; bf16x8 pa0, pa1, pa2, pa3; SBAR();                                   \
    ATT_STEP_BODY(b)                                                                                              \
    asm volatile("s_waitcnt vmcnt(0)" ::: "memory"); __syncthreads();                                            \
    if ((t) + 2 < NT) DMA_TILE(b, KT((t) + 2) * KVBLK); } while (0)
  int u = first; int rot = UNIT_ROT(u);
  const GAS bf16* Kh = Kg + UNIT_K(u); const GAS bf16* Vh = Vg + UNIT_K(u); size_t qoff = UNIT_Q(u);
  bf16x8 qr[4];
  { const GAS bf16* Qw = Qg + qoff + (long)(qg * QBLK + r32) * LD + mp * 64 + hi * 8;
#pragma unroll
    for (int d0 = 0; d0 < 4; ++d0) qr[d0] = *(const GAS bf16x8*)(Qw + d0 * 16); }
  DMA_TILE(0, KT(0) * KVBLK); DMA_TILE(1, KT(1) * KVBLK); asm volatile("s_waitcnt vmcnt(0)" ::: "memory"); __syncthreads();
  for (;;) {
    float l_reg = 0; f32x16 o[4] = {};
    for (int t = 0; t < NT; t += 2) { TILE_STEP(0, t); TILE_STEP(1, t + 1); }
    GAS bf16* Ob = (GAS bf16*)Qg + qoff;
    const int un = u + stride; const bool has_next = un < count;
    if (has_next) {
      rot = UNIT_ROT(un); Kh = Kg + UNIT_K(un); Vh = Vg + UNIT_K(un); qoff = UNIT_Q(un);
      const GAS bf16* Qw = Qg + qoff + (long)(qg * QBLK + r32) * LD + mp * 64 + hi * 8;
#pragma unroll
      for (int d0 = 0; d0 < 4; ++d0) qr[d0] = *(const GAS bf16x8*)(Qw + d0 * 16);
      DMA_TILE(0, KT(0) * KVBLK); DMA_TILE(1, KT(1) * KVBLK);
    }
    int lane_e = lane; asm volatile("" : "+v"(lane_e));
    { auto rr = __builtin_amdgcn_permlane32_swap(__float_as_uint(l_reg), __float_as_uint(l_reg), false, false); l_reg = __uint_as_float(rr[0]) + __uint_as_float(rr[1]); }
    if (hi == 0) li_l[r32] = l_reg; asm volatile("s_waitcnt lgkmcnt(0)" ::: "memory");
    const int r32e = lane_e & 31, hie = lane_e >> 5;
    float rli[16];
#pragma unroll
    for (int r = 0; r < 16; ++r) rli[r] = __builtin_amdgcn_rcpf(li_l[crow(r, hie)]);
    if (mp == 1) {
#pragma unroll
      for (int d0 = 0; d0 < 4; ++d0)
#pragma unroll
        for (int r = 0; r < 16; ++r) X[(d0 * 16 + r) * 64 + lane_e] = o[d0][r] * rli[r] * (-lam);
    }
    asm volatile("s_waitcnt lgkmcnt(0)" ::: "memory"); __builtin_amdgcn_s_barrier(); asm volatile("" ::: "memory");
    if (mp == 0) {
#pragma unroll
      for (int d0 = 0; d0 < 4; ++d0) {
#pragma unroll
        for (int r = 0; r < 16; ++r) o[d0][r] = o[d0][r] * rli[r] + X[(d0 * 16 + r) * 64 + lane_e];
        asm volatile("" ::: "memory");
      }
      float g4[4];
#pragma unroll
      for (int d0 = 0; d0 < 4; ++d0) g4[d0] = subg[32 * d0 + r32e] * oml;
      GAS bf16* Ow = Ob + (long)(qg * QBLK) * LD;
#pragma unroll
      for (int r = 0; r < 16; ++r) {
        float ss = (o[0][r] * o[0][r] + o[1][r] * o[1][r]) + (o[2][r] * o[2][r] + o[3][r] * o[3][r]);
        ss += __shfl_xor(ss, 1); ss += __shfl_xor(ss, 2); ss += __shfl_xor(ss, 4); ss += __shfl_xor(ss, 8); ss += __shfl_xor(ss, 16);
        const float rs = 1.0f / sqrtf(ss * (1.f / 128.f) + EPS); const int orow = crow(r, hie);
#pragma unroll
        for (int d0 = 0; d0 < 4; ++d0) Ow[(long)orow * LD + d0 * 32 + r32e] = (bf16)f2bf(o[d0][r] * rs * g4[d0]);
      }
    }
    asm volatile("s_waitcnt vmcnt(0) lgkmcnt(0)" ::: "memory"); __syncthreads();
    if (!has_next) break;
    u = un;
  }
#undef TILE_STEP
#undef DMA_TILE
#undef KT
#undef UNIT_Q
#undef UNIT_K
#undef UNIT_ROT
}
#undef KSWZ
#undef SBAR
}

constexpr int VT_PITCH = 272;
constexpr int MIX_VT_BYTES = 512 * VT_PITCH;
constexpr int MIX_ST_OFF = MIX_VT_BYTES;
static_assert(MIX_ST_OFF + 1024 <= LDSCTL_OFF, "mixer LDS");
__device__ __forceinline__ void mixer_chunk(const Ctx& C, int ch, bf16* P0, const bf16* P1, bf16* P2, const bf16* P3,
                                            const float* ln_g, const float* ln_b, const bf16* aws  , const float* abs_  , const float* convw  , bool dostore = true) {
    const int row0 = ch * 128, tid = C.tid, lane = C.lane, wid = C.wave;
    LAS unsigned char* VT = C.lds; LAS f32x2* ST = (LAS f32x2*)(C.lds + MIX_ST_OFF);
#pragma unroll 2
    for (int i = 0; i < 16; ++i) {
        const int s = wid * 16 + i; const u32x4 w = *(const GAS u32x4*)(P1 + (size_t)(row0 + s) * 512 + lane * 8);
        f32x4 a, b; unpack8(w, a, b);
        const float mean = wave_sum((a[0] + a[1]) + (a[2] + a[3]) + (b[0] + b[1]) + (b[2] + b[3])) * (1.f / 512.f);
        a = a - mean; b = b - mean;
        const float var = wave_sum((a[0] * a[0] + a[1] * a[1]) + (a[2] * a[2] + a[3] * a[3]) + (b[0] * b[0] + b[1] * b[1]) + (b[2] * b[2] + b[3] * b[3])) * (1.f / 512.f);
        if (lane == 0) ST[s] = (f32x2){mean, 1.0f / sqrtf(var + EPS)};
    }
    __syncthreads();
    {
        const int s = tid & 127, q = tid >> 7; const f32x2 st = ST[s]; const bf16* src = P1 + (size_t)(row0 + s) * 512 + q * 128;
#pragma unroll 2
        for (int i = 0; i < 16; ++i) {
            const int c0 = q * 128 + i * 8; const u32x4 w = *(const GAS u32x4*)(src + i * 8); f32x4 a, b; unpack8(w, a, b);
            const f32x4 g0 = *(const GAS f32x4*)(ln_g + c0), g1 = *(const GAS f32x4*)(ln_g + c0 + 4), b0 = *(const GAS f32x4*)(ln_b + c0), b1 = *(const GAS f32x4*)(ln_b + c0 + 4);
            a = (a - st.x) * st.y * g0 + b0; b = (b - st.x) * st.y * g1 + b1;
#pragma unroll
            for (int e = 0; e < 4; ++e) { *(LAS bf16*)(VT + (c0 + e) * VT_PITCH + s * 2) = (bf16)f2bf(a[e]); *(LAS bf16*)(VT + (c0 + 4 + e) * VT_PITCH + s * 2) = (bf16)f2bf(b[e]); }
        }
    }
    __syncthreads();
    {
        const int g = wid, fr = lane & 15, fq = lane >> 4;
        const bf16* wg = aws + (size_t)g * 128 * 128;
#pragma unroll 1
        for (int th = 0; th < 2; ++th) {
            f32x4 acc[4][4];
#pragma unroll
            for (int ti = 0; ti < 4; ++ti)
#pragma unroll
                for (int ei = 0; ei < 4; ++ei) acc[ti][ei] = (f32x4){0.f, 0.f, 0.f, 0.f};
#pragma unroll 1
            for (int kk = 0; kk < 4; ++kk) {
                bf16x8 xf[4], yf[4];
#pragma unroll
                for (int ei = 0; ei < 4; ++ei) xf[ei] = *(const LAS bf16x8*)(VT + (g * 64 + 16 * ei + fr) * VT_PITCH + (32 * kk + 8 * fq) * 2);
#pragma unroll
                for (int ti = 0; ti < 4; ++ti) yf[ti] = *(const GAS bf16x8*)(wg + (size_t)(64 * th + 16 * ti + fr) * 128 + 32 * kk + 8 * fq);
#pragma unroll
                for (int ti = 0; ti < 4; ++ti)
#pragma unroll
                    for (int ei = 0; ei < 4; ++ei) acc[ti][ei] = __builtin_amdgcn_mfma_f32_16x16x32_bf16(xf[ei], yf[ti], acc[ti][ei], 0, 0, 0);
            }
#pragma unroll
            for (int ti = 0; ti < 4; ++ti) {
                const int t = 64 * th + 16 * ti + fr; const float bs = abs_[g * 128 + t];
#pragma unroll
                for (int ei = 0; ei < 4; ++ei) {
                    bf16* p = P0 + (size_t)(row0 + t) * 512 + g * 64 + 16 * ei + 4 * fq; const v2u uw = *(const GAS v2u*)p;
                    const f32x4 a = acc[ti][ei] + bs;
                    v2u ow; ow.x = cvt_pk_bf16(bf2f(uw.x & 0xffffu) * a[0], bf2f(uw.x >> 16) * a[1]); ow.y = cvt_pk_bf16(bf2f(uw.y & 0xffffu) * a[2], bf2f(uw.y >> 16) * a[3]);
                    if (dostore) *(GAS v2u*)p = ow; }
            }
        }
    }
    {
        const int c0 = lane * 8;
        f32x4 w0a = *(const GAS f32x4*)(convw + c0), w0b = *(const GAS f32x4*)(convw + c0 + 4), w1a = *(const GAS f32x4*)(convw + 512 + c0), w1b = *(const GAS f32x4*)(convw + 512 + c0 + 4),
              w2a = *(const GAS f32x4*)(convw + 1024 + c0), w2b = *(const GAS f32x4*)(convw + 1024 + c0 + 4);
#pragma unroll 2
        for (int i = 0; i < 16; ++i) {
            const int r = row0 + wid * 16 + i; const bool isctx = r >= ML; const int tseq = isctx ? ((r - ML) & 255) : (r & 4095), last = isctx ? 255 : 4095;
            const u32x4 zero = {0u, 0u, 0u, 0u};
            const u32x4 zm = tseq > 0 ? *(const GAS u32x4*)(P3 + (size_t)(r - 1) * 512 + c0) : zero;
            const u32x4 zc = *(const GAS u32x4*)(P3 + (size_t)r * 512 + c0);
            const u32x4 zp = tseq < last ? *(const GAS u32x4*)(P3 + (size_t)(r + 1) * 512 + c0) : zero;
            const u32x4 bw = *(const GAS u32x4*)(P2 + (size_t)r * 512 + c0);
            f32x4 ma, mb, ca, cb, pa, pb, ba, bb; unpack8(zm, ma, mb); unpack8(zc, ca, cb); unpack8(zp, pa, pb); unpack8(bw, ba, bb);
            const f32x4 ya = ba * (w0a * ma + w1a * ca + w2a * pa), yb = bb * (w0b * mb + w1b * cb + w2b * pb);
            if (dostore) *(GAS u32x4*)(P2 + (size_t)r * 512 + c0) = pack8(ya, yb);
        }
    }
    __syncthreads();
}

__device__ __forceinline__ void route_phase(const Ctx& C, const float* x, const float* gn, const float* modl, const float* w_router, bf16* H, unsigned* route, bool dry = false) {
    LAS float* Wl = (LAS float*)C.lds;
    for (int idx = C.tid; idx < 8192; idx += NTHREADS) { const int k = idx >> 3, e = idx & 7; Wl[((k & 3) + 4 * (k >> 8)) * 512 + ((k >> 2) & 63) * 8 + e] = w_router[idx]; }
    __syncthreads();
    const int RPW = (ML + C.NGW - 1) / C.NGW;
    const int lane = C.lane; const int r0 = C.gw * RPW;
    unsigned long long lc = 0ull;
    unsigned my_e = 0u, my_p = 0u; float my_w1 = 0.f, my_w2 = 0.f;
    for (int it = 0; it < RPW; ++it) {
        const int r = r0 + it; if (r >= ML) break;
        const int b = r >> 12; f32x4 y[4];
        modulate_row(x + (size_t)r * DM, gn, modl + (size_t)b * 6144 + 4 * 1024, modl + (size_t)b * 6144 + 3 * 1024, H + (size_t)r * DM, lane, y);
        float lg[8];
#pragma unroll
        for (int e = 0; e < 8; ++e) lg[e] = 0.f;
#pragma unroll
        for (int j = 0; j < 4; ++j)
#pragma unroll
            for (int i = 0; i < 4; ++i) { const LAS f32x4* wp = (const LAS f32x4*)(Wl + (i + 4 * j) * 512 + lane * 8); const f32x4 wa = wp[0], wb = wp[1]; const float v = y[j][i];
                lg[0] += v * wa[0]; lg[1] += v * wa[1]; lg[2] += v * wa[2]; lg[3] += v * wa[3]; lg[4] += v * wb[0]; lg[5] += v * wb[1]; lg[6] += v * wb[2]; lg[7] += v * wb[3]; }
#pragma unroll
        for (int e = 0; e < 8; ++e) lg[e] = wave_sum(lg[e]);
        int i1 = 0; float v1 = lg[0];
#pragma unroll
        for (int e = 1; e < 8; ++e) if (lg[e] > v1) { v1 = lg[e]; i1 = e; }
        int i2 = -1; float v2 = -3.0e38f;
#pragma unroll
        for (int e = 0; e < 8; ++e) if (e != i1 && lg[e] > v2) { v2 = lg[e]; i2 = e; }
        const float w1 = 1.f / (1.f + __expf(v2 - v1)), w2 = 1.f - w1;
        const unsigned p1 = (unsigned)(lc >> (8 * i1)) & 0xffu; lc += 1ull << (8 * i1);
        const unsigned p2 = (unsigned)(lc >> (8 * i2)) & 0xffu; lc += 1ull << (8 * i2);
        if (lane == it) { my_e = (unsigned)i1 | ((unsigned)i2 << 8); my_p = p1 | (p2 << 8); my_w1 = w1; my_w2 = w2; }
    }
    unsigned base = 0u;
    if (lane < 8 && !dry) { const unsigned n = (unsigned)(lc >> (8 * lane)) & 0xffu; base = __hip_atomic_fetch_add((unsigned*)(C.ctl + CW_CNT + 64 * lane), n, __ATOMIC_RELAXED, __HIP_MEMORY_SCOPE_AGENT); }
    const unsigned b1 = __shfl(base, (int)(my_e & 0xffu)), b2 = __shfl(base, (int)(my_e >> 8));
    const int r = r0 + lane;
    if (lane < RPW && r < ML && !dry) { u32x4 w; w.x = my_e; w.y = __float_as_uint(my_w1); w.z = __float_as_uint(my_w2); w.w = b1 + (my_p & 0xffu); *(GAS u32x4*)(route + (size_t)r * 8) = w; route[(size_t)r * 8 + 4] = b2 + (my_p >> 8); }
}
__device__ __forceinline__ void moe_offsets(const Ctx& C, volatile LAS int* offl) {
    if (C.tid == 0) { int o = 0;
        for (int e = 0; e < 8; ++e) { const int c = (int)__hip_atomic_load((unsigned*)(C.ctl + CW_CNT + 64 * e), __ATOMIC_RELAXED, __HIP_MEMORY_SCOPE_AGENT); offl[e] = o; offl[16 + e] = c; o += (c + 255) & ~255; }
        offl[8] = o; }
    __syncthreads();
}
__device__ __forceinline__ void gather_phase(const Ctx& C, const bf16* H, bf16* HS, unsigned* route, const volatile LAS int* offl) {
    const int lane = C.lane;
    for (int t = C.gw; t < ML; t += C.NGW) {
        const u32x4 w = *(const GAS u32x4*)(route + (size_t)t * 8); const unsigned p2 = route[(size_t)t * 8 + 4];
        const int e1 = w.x & 0xff, e2 = (w.x >> 8) & 0xff; const int s1 = offl[e1] + (int)w.w, s2 = offl[e2] + (int)p2;
        const GAS u32x4* src = (const GAS u32x4*)(H + (size_t)t * DM) + lane; const u32x4 a = src[0], b = src[64];
        GAS u32x4* d1 = (GAS u32x4*)(HS + (size_t)s1 * DM) + lane; GAS u32x4* d2 = (GAS u32x4*)(HS + (size_t)s2 * DM) + lane;
        d1[0] = a; d1[64] = b; d2[0] = a; d2[64] = b;
        if (lane == 0) { route[(size_t)t * 8 + 5] = (unsigned)s1; route[(size_t)t * 8 + 6] = (unsigned)s2; }
    }
    for (int v = C.gw; v < 8 * 256; v += C.NGW) { const int e = v >> 8, i = v & 255; const int row = offl[e] + offl[16 + e] + i;
        if (row < offl[e + 1]) { GAS u32x4* d = (GAS u32x4*)(HS + (size_t)row * DM) + lane; const u32x4 z = {0u, 0u, 0u, 0u}; d[0] = z; d[64] = z; } }
}
__device__ __forceinline__ void final_phase(const Ctx& C, float* xo, const bf16* HS, const unsigned* route, const float* modl, const float* fg, bool dry = false) {
    const int lane = C.lane;
    for (int t = C.gw; t < ML; t += C.NGW) {
        const u32x4 w = *(const GAS u32x4*)(route + (size_t)t * 8); const unsigned s1 = route[(size_t)t * 8 + 5], s2 = route[(size_t)t * 8 + 6];
        const float w1 = __uint_as_float(w.y), w2 = __uint_as_float(w.z); const int b = t >> 12;
        const float* g2 = modl + (size_t)b * 6144 + 5 * 1024;
        f32x4 v[4]; float ss = 0.f;
#pragma unroll
        for (int h = 0; h < 2; ++h) {
            const int c0 = h * 512 + lane * 8;
            const u32x4 oa = *(const GAS u32x4*)(HS + (size_t)s1 * DM + c0), ob = *(const GAS u32x4*)(HS + (size_t)s2 * DM + c0);
            f32x4 a0, a1, b0, b1; unpack8(oa, a0, a1); unpack8(ob, b0, b1);
            const f32x4 x0 = *(const GAS f32x4*)(xo + (size_t)t * DM + c0), x1 = *(const GAS f32x4*)(xo + (size_t)t * DM + c0 + 4);
            const f32x4 g0 = *(const GAS f32x4*)(g2 + c0), g1 = *(const GAS f32x4*)(g2 + c0 + 4);
            v[2 * h] = x0 + g0 * (a0 * w1 + b0 * w2); v[2 * h + 1] = x1 + g1 * (a1 * w1 + b1 * w2);
        }
#pragma unroll
        for (int j = 0; j < 4; ++j) ss += (v[j].x * v[j].x + v[j].y * v[j].y) + (v[j].z * v[j].z + v[j].w * v[j].w);
        const float rstd = 1.0f / sqrtf(wave_sum(ss) * (1.f / 1024.f) + EPS);
#pragma unroll
        for (int h = 0; h < 2; ++h) { const int c0 = h * 512 + lane * 8;
            const f32x4 f0 = *(const GAS f32x4*)(fg + c0), f1 = *(const GAS f32x4*)(fg + c0 + 4);
            if (!dry) { *(GAS f32x4*)(xo + (size_t)t * DM + c0) = v[2 * h] * rstd * f0; *(GAS f32x4*)(xo + (size_t)t * DM + c0 + 4) = v[2 * h + 1] * rstd * f1; } }
    }
}

#ifdef PROBE
constexpr int PR_BASE = 12288;
__device__ __forceinline__ unsigned hsh(unsigned x) { x ^= x >> 16; x *= 0x7feb352du; x ^= x >> 15; x *= 0x846ca68bu; x ^= x >> 16; return x; }
__device__ __forceinline__ float bfr(float f) { return bf2f(f2bf(f)); }
__device__ __forceinline__ float wdot(const bf16* a, const float* W, int ldw, int col, int K, int lane) {
    float s = 0.f; for (int k = lane; k < K; k += 64) s += bf2f(a[k]) * bfr(W[(size_t)k * ldw + col]); return wave_sum(s);
}
struct Probe {
    gu32* ctl; int tid, lane, wave; LAS float* sh;
    __device__ __forceinline__ void rec(int id, float got, float ref, float tol = 0.03f) const {
        const float err = fabsf(got - ref) / (fabsf(ref) + 0.05f);
        if (!(err <= tol)) { unsigned expect = 0u; if (__hip_atomic_compare_exchange_strong((unsigned*)(ctl + PR_BASE), &expect, (unsigned)id, __ATOMIC_RELAXED, __ATOMIC_RELAXED, __HIP_MEMORY_SCOPE_AGENT)) __hip_atomic_store((unsigned*)(ctl + PR_BASE + 1), __float_as_uint(err > 1e6f ? 1e6f : err), __ATOMIC_RELAXED, __HIP_MEMORY_SCOPE_AGENT); }
        else atomicMax((unsigned*)(ctl + PR_BASE + 2), __float_as_uint(err));
    }
};
#define RAWP(r, col) wdot(Hb + (size_t)(r) * DM, win, INC, (col), 1024, P.lane)

template <int L>
__device__ __forceinline__ void probe_after_mod1(const Probe& P, const Args& args, unsigned char* ws) {
    const float* mod = (const float*)(ws + WS_MOD) + (size_t)L * 17 * 6144; const bf16* Hb = (const bf16*)(ws + WS_H);
    for (int sidx = P.wave; sidx < 48; sidx += 8) {
        const unsigned hh = hsh(sidx * 977u + 13u + L * 7919u); const int b = hh % 17, j = (hh >> 8) % 6144;
        float s = 0.f; for (int k = P.lane; k < 1024; k += 64) { const float v = b < 16 ? args.in[1][b * 1024 + k] : args.in[3][k]; s += v / (1.f + __expf(-v)) * args.in[4][((size_t)L * 1024 + k) * 6144 + j]; }
        s = wave_sum(s) + args.in[5][L * 6144 + j];
        if (P.lane == 0) P.rec(1 + 20 * L, mod[(size_t)b * 6144 + j], s, 0.002f);
    }
    for (int sidx = P.wave; sidx < 64; sidx += 8) {
        const unsigned hh = hsh(sidx * 31337u + 5u + L); int r = hh % MA; if (sidx < 8) r = ML + (hh % MC); const int c = (hh >> 10) & 1023; const int b = r < ML ? (r >> 12) : 16;
        const float* xr = r < ML ? (L == 0 ? args.in[0] : (const float*)args.out) + (size_t)r * DM : (L == 0 ? args.in[2] : (const float*)(ws + WS_XC)) + (size_t)(r - ML) * DM;
        float ss = 0.f; for (int k = P.lane; k < 1024; k += 64) ss += xr[k] * xr[k]; ss = wave_sum(ss);
        const float ref = xr[c] * (1.f / sqrtf(ss / 1024.f + EPS)) * args.in[6][L * 1024 + c] * (1.f + mod[(size_t)b * 6144 + 1024 + c]) + mod[(size_t)b * 6144 + c];
        if (P.lane == 0) P.rec(2 + 20 * L, bf2f(Hb[(size_t)r * DM + c]), ref, 0.01f);
    }
}
template <int L>
__device__ __forceinline__ void probe_after_big(const Probe& P, const Args& args, unsigned char* ws) {
    const bf16* Hb = (const bf16*)(ws + WS_H); const float* win = args.in[8] + (size_t)L * 1024 * INC;
    for (int sidx = P.wave; sidx < 96; sidx += 8) {
        const unsigned hh = hsh(sidx * 7001u + 77u + L * 3u); int r = hh % ML; if ((sidx & 3) == 3) r = ML + (hh % MC);
        const bool isctx = r >= ML; const int b = isctx ? (r - ML) / CTXL : (r >> 12); const int t = isctx ? 0 : (r & 4095);
        const long krow = isctx ? (long)b * SKV + SEQ + (r - ML) % CTXL : (long)b * SKV + t;
        const int h = (hh >> 17) & 7, m = (hh >> 20) & 1, d = (hh >> 21) & 63;
        for (int qk = 0; qk < 2; ++qk) {
            const int a = d >> 5, wi = d & 31, i = wi & 15, half = wi >> 4;
            const int cbase = (qk == 0 ? 2560 : 3584) + h * 128 + m * 64 + 32 * a;
            const float x0 = RAWP(r, cbase + i), x1 = RAWP(r, cbase + 16 + i);
            float cs = 1.f, sn = 0.f;
            if (!isctx) { const float pos = (float)(a == 0 ? (t >> 6) : (t & 63)); const float inv = exp2f(-(float)i * (13.287712379549449f / 16.f)); const float ang = pos * inv; cs = cosf(ang); sn = sinf(ang); }
            float ref = half == 0 ? x0 * cs - x1 * sn : x1 * cs + x0 * sn; if (qk == 0) ref *= QSCALE;
            const int p = 32 * a + 2 * i + half;
            const bf16* buf = (const bf16*)(ws + (qk == 0 ? WS_Q : WS_K)); const long row = qk == 0 ? (long)r : krow;
            if (P.lane == 0) P.rec(3 + qk + 20 * L, bf2f(buf[(size_t)row * DM + h * 128 + m * 64 + p]), ref, 0.03f);
        }
        const int e = (hh >> 20) & 127;
        { const float ref = RAWP(r, 4608 + h * 128 + e); if (P.lane == 0) P.rec(5 + 20 * L, bf2f(((const bf16*)(ws + WS_V))[(size_t)krow * DM + h * 128 + e]), ref, 0.03f); }
        const int c = (hh >> 9) & 511;
        { const float ref = gelu_tanh_f(RAWP(r, c)); if (P.lane == 0) P.rec(6 + 20 * L, bf2f(((const bf16*)(ws + WS_P0))[(size_t)r * 512 + c]), ref, 0.03f); }
        { const float ref = gelu_tanh_f(RAWP(r, 512 + c)); if (P.lane == 0) P.rec(7 + 20 * L, bf2f(((const bf16*)(ws + WS_P1))[(size_t)r * 512 + c]), ref, 0.03f); }
        { const float ref = RAWP(r, 1024 + c); if (P.lane == 0) P.rec(8 + 20 * L, bf2f(((const bf16*)(ws + WS_P2))[(size_t)r * 512 + c]), ref, 0.03f); }
        { const float ref = RAWP(r, 1536 + c) * RAWP(r, 2048 + c); if (P.lane == 0) P.rec(9 + 20 * L, bf2f(((const bf16*)(ws + WS_P3))[(size_t)r * 512 + c]), ref, 0.04f); }
    }
}
template <int L>
__device__ __forceinline__ void probe_after_mix(const Probe& P, const Args& args, unsigned char* ws) {
    const bf16* Hb = (const bf16*)(ws + WS_H); const float* win = args.in[8] + (size_t)L * 1024 * INC;
    const bf16* P1 = (const bf16*)(ws + WS_P1); const bf16* P3 = (const bf16*)(ws + WS_P3);
#if EN_MIX
    for (int sidx = 0; sidx < 6; ++sidx) {
        const unsigned hh = hsh(sidx * 1237u + 3u + L); int r = hh % (L == 0 ? MA : ML); if (sidx == 5 && L == 0) r = ML + (hh % MC);
        const int c = (hh >> 12) & 511, g = c >> 6, row0 = r & ~127, tt = r & 127;
        __syncthreads();
        if (P.tid < 128) { const bf16* vr = P1 + (size_t)(row0 + P.tid) * 512; float s = 0.f; for (int k = 0; k < 512; ++k) s += bf2f(vr[k]); const float mean = s / 512.f; float q = 0.f; for (int k = 0; k < 512; ++k) { const float dlt = bf2f(vr[k]) - mean; q += dlt * dlt; }
            const float ln = (bf2f(vr[c]) - mean) * (1.f / sqrtf(q / 512.f + EPS)) * args.in[10][L * 512 + c] + args.in[11][L * 512 + c];
            P.sh[P.tid] = args.in[12][(((size_t)L * 8 + g) * 128 + tt) * 128 + P.tid] * ln; }
        __syncthreads();
        if (P.wave == 0) { float s = P.sh[P.lane] + P.sh[64 + P.lane]; s = wave_sum(s) + args.in[13][(L * 8 + g) * 128 + tt];
            const float gu = gelu_tanh_f(RAWP(r, c)); if (P.lane == 0) P.rec(10 + 20 * L, bf2f(((const bf16*)(ws + WS_P0))[(size_t)r * 512 + c]), bfr(gu) * s, 0.04f); }
    }
    for (int sidx = P.wave; sidx < 64; sidx += 8) {
        const unsigned hh = hsh(sidx * 4447u + 9u + L); int r = hh % (L == 0 ? MA : ML); if (sidx < 8) r = (sidx & 1) ? ((hh % BATCH) * SEQ + (sidx & 2 ? 0 : SEQ - 1)) : r; if (sidx >= 8 && sidx < 12 && L == 0) r = ML + (hh % BATCH) * CTXL + (sidx & 1 ? 0 : CTXL - 1);
        const int c = (hh >> 11) & 511; const bool isctx = r >= ML; const int tseq = isctx ? ((r - ML) & 255) : (r & 4095), last = isctx ? 255 : 4095;
        const float zm = tseq > 0 ? bf2f(P3[(size_t)(r - 1) * 512 + c]) : 0.f, zc = bf2f(P3[(size_t)r * 512 + c]), zp = tseq < last ? bf2f(P3[(size_t)(r + 1) * 512 + c]) : 0.f;
        const float bg = bfr(RAWP(r, 1024 + c)); const float* cw = args.in[14] + L * 1536;
        const float ref = bg * (cw[c] * zm + cw[512 + c] * zc + cw[1024 + c] * zp);
        if (P.lane == 0) P.rec(11 + 20 * L, bf2f(((const bf16*)(ws + WS_P2))[(size_t)r * 512 + c]), ref, 0.04f);
    }
#endif
#if EN_ATT
    LAS float* qv = P.sh;
    LAS float* s0 = P.sh + 128;
    LAS float* s1 = P.sh + 128 + 4352;
    LAS float* red = P.sh + 128 + 2 * 4352;
    LAS float* ov = red + 64;
    const float lam = ((const float*)(ws + WS_LAM))[L]; const float oml = L == 0 ? 0.8f : (1.f - (0.8f - 0.6f * 0.7408182206817179f));
    for (int sidx = 0; sidx < (L == 0 ? 5 : 3); ++sidx) {
        const unsigned hh = hsh(sidx * 9173u + 21u + L); const bool isctx = (L == 0 && sidx >= 3); const int b = hh % BATCH, h = (hh >> 8) & 7;
        const int r = isctx ? ML + b * CTXL + ((hh >> 12) % CTXL) : b * SEQ + ((hh >> 12) & 4095); const int t = r & 4095;
        const int nk = isctx ? CTXL : SKV; const long k0 = isctx ? (long)b * SKV + SEQ : (long)b * SKV;
        __syncthreads();
        for (int q = P.wave; q < 128; q += 8) {
            const int m = q >> 6, p = q & 63, a = p >> 5, i = (p & 31) >> 1, half = p & 1; const int cbase = 2560 + h * 128 + m * 64 + 32 * a;
            const float x0 = RAWP(r, cbase + i), x1 = RAWP(r, cbase + 16 + i); float cs = 1.f, sn = 0.f;
            if (!isctx) { const float pos = (float)(a == 0 ? (t >> 6) : (t & 63)); const float inv = exp2f(-(float)i * (13.287712379549449f / 16.f)); cs = cosf(pos * inv); sn = sinf(pos * inv); }
            if (P.lane == 0) qv[q] = bfr((half == 0 ? x0 * cs - x1 * sn : x1 * cs + x0 * sn) * QSCALE);
        }
        __syncthreads();
        const bf16* Kb = (const bf16*)(ws + WS_K); const bf16* Vb = (const bf16*)(ws + WS_V);
        for (int k = P.tid; k < nk; k += NTHREADS) { const bf16* kr = Kb + (size_t)(k0 + k) * DM + h * 128; float a0 = 0.f, a1 = 0.f; for (int dd = 0; dd < 64; ++dd) { a0 += qv[dd] * bf2f(kr[dd]); a1 += qv[64 + dd] * bf2f(kr[64 + dd]); } s0[k] = a0; s1[k] = a1; }
        __syncthreads();
        float m0 = -1e30f, m1 = -1e30f; for (int k = P.tid; k < nk; k += NTHREADS) { m0 = fmaxf(m0, s0[k]); m1 = fmaxf(m1, s1[k]); }
        for (int o = 1; o < 64; o <<= 1) { m0 = fmaxf(m0, __shfl_xor(m0, o)); m1 = fmaxf(m1, __shfl_xor(m1, o)); }
        if (P.lane == 0) { red[P.wave] = m0; red[8 + P.wave] = m1; } __syncthreads();
        m0 = red[0]; m1 = red[8]; for (int w = 1; w < 8; ++w) { m0 = fmaxf(m0, red[w]); m1 = fmaxf(m1, red[8 + w]); } __syncthreads();
        float l0 = 0.f, l1 = 0.f; for (int k = P.tid; k < nk; k += NTHREADS) { const float e0 = exp2f(s0[k] - m0), e1 = exp2f(s1[k] - m1); s0[k] = e0; s1[k] = e1; l0 += e0; l1 += e1; }
        l0 = wave_sum(l0); l1 = wave_sum(l1); if (P.lane == 0) { red[16 + P.wave] = l0; red[24 + P.wave] = l1; } __syncthreads();
        l0 = 0.f; l1 = 0.f; for (int w = 0; w < 8; ++w) { l0 += red[16 + w]; l1 += red[24 + w]; }
        if (P.tid < 128) { float acc = 0.f; for (int k = 0; k < nk; ++k) acc += (s0[k] / l0 - lam * s1[k] / l1) * bf2f(Vb[(size_t)(k0 + k) * DM + h * 128 + P.tid]); ov[P.tid] = acc; }
        __syncthreads();
        if (P.tid < 128) { float ss = 0.f; for (int e = 0; e < 128; ++e) ss += ov[e] * ov[e]; const float ref = ov[P.tid] * (1.f / sqrtf(ss / 128.f + EPS)) * args.in[16][L * 128 + P.tid] * oml;
            if ((P.tid & 15) == (sidx & 15) || P.tid == 77) P.rec((isctx ? 13 : 12) + 20 * L, bf2f(((const bf16*)(ws + WS_Q))[(size_t)r * DM + h * 128 + P.tid]), ref, 0.06f); }
    }
#endif
    __syncthreads();
}
template <int L>
__device__ __forceinline__ void probe_after_gate(const Probe& P, const Args& args, unsigned char* ws) {
    const bf16* Hb = (const bf16*)(ws + WS_H); const float* win = args.in[8] + (size_t)L * 1024 * INC;
    const bf16* WINb = (const bf16*)(ws + WS_WIN + L * WIN_BYTES);
    if (P.tid < 400) P.sh[16 + P.tid] = 0.f;
    __syncthreads();
    for (int sidx = P.wave; sidx < 96; sidx += 8) {
        const unsigned hh = hsh(sidx * 3301u + 11u + L); const int row = 5632 + (sidx % 3) * 1024 + ((hh >> 4) & 1023), k = (hh >> 16) & 1023;
        if (P.lane == 0) P.rec(13 + 20 * L, bf2f(WINb[(size_t)row * 1024 + k]), bfr(win[(size_t)k * INC + row]), 0.001f);
    }
    __syncthreads();
    for (int br = 0; br < 3; ++br) {
        for (int sidx = P.wave; sidx < 64; sidx += 8) {
            const unsigned hh = hsh(sidx * 5501u + 1u + L + br * 77u); const int r = hh % (L == 0 ? MA : ML), n = (hh >> 12) & 1023;
            const float ref = sigmoid_f(RAWP(r, 5632 + br * 1024 + n) + args.in[9][L * 3072 + br * 1024 + n]);
            const bf16* g = br == 0 ? (const bf16*)(ws + WS_K) + (size_t)r * DM + n : (br == 1 ? (const bf16*)(ws + WS_V) + (size_t)r * DM + n : (const bf16*)(ws + (n < 512 ? WS_P1 : WS_P3)) + (size_t)r * 512 + (n & 511));
            if (P.lane == 0) {
                const float got = bf2f(*g);
                if (fabsf(got - ref) / (fabsf(ref) + 0.05f) > 0.03f) { P.sh[16] = 1.f; const int sl = P.wave * 8 + (sidx >> 3); P.sh[128 + 2 * sl] = __uint_as_float((unsigned)((uintptr_t)g & 0xffffffffu)); P.sh[129 + 2 * sl] = __uint_as_float((unsigned)((uintptr_t)g >> 32)); P.sh[300 + sl] = ref; }
                else P.rec(14 + br + 20 * L, got, ref, 0.03f);
            }
        }
        __syncthreads();
        if (P.sh[16] != 0.f) {
            const GAS u32x4* tp = (const GAS u32x4*)args.in[25] + P.tid; u32x4 acc_ = {0u, 0u, 0u, 0u};
            for (int q_ = 0; q_ < 3072; ++q_) { const u32x4 v_ = tp[(size_t)q_ * 512]; acc_.x ^= v_.x; acc_.y ^= v_.y; acc_.z ^= v_.z; acc_.w ^= v_.w; }
            if ((acc_.x ^ acc_.y ^ acc_.z ^ acc_.w) == 0x12345677u) P.sh[100] = 1.f;
            __syncthreads();
            if (P.tid == 0) { for (int q = 0; q < 64; ++q) { const unsigned lo_ = __float_as_uint(P.sh[128 + 2 * q]), hi_ = __float_as_uint(P.sh[129 + 2 * q]); if (lo_ == 0u && hi_ == 0u) continue;
                const bf16* gq = (const bf16*)(((uintptr_t)hi_ << 32) | lo_); const unsigned* gw = (const unsigned*)((uintptr_t)gq & ~(uintptr_t)3); const int sh = ((uintptr_t)gq & 2) ? 16 : 0;
                const float g1 = bf2f((__hip_atomic_load(gw, __ATOMIC_RELAXED, __HIP_MEMORY_SCOPE_AGENT) >> sh) & 0xffffu); const float ref = P.sh[300 + q];
                const bool ok1 = fabsf(g1 - ref) / (fabsf(ref) + 0.05f) <= 0.03f; if (!ok1 && br == 0) {
                    const size_t eo = (size_t)(gq - (const bf16*)(ws + WS_K)); const int kr = (int)(eo >> 10), nn = (int)(eo & 1023); const int bb = kr / SKV, key = kr % SKV; const bool cx = key >= SEQ;
                    const int tok = cx ? ML + bb * CTXL + (key - SEQ) : bb * SEQ + key; const int hh2 = nn >> 7, mm = (nn >> 6) & 1, pp = nn & 63, aa = pp >> 5, ii = (pp & 31) >> 1, hf = pp & 1;
                    const int cb2 = 3584 + hh2 * 128 + mm * 64 + 32 * aa; float x0 = 0.f, x1 = 0.f;
                    for (int k = 0; k < 1024; ++k) { const float hv = bf2f(Hb[(size_t)tok * DM + k]); x0 += hv * bfr(win[(size_t)k * INC + cb2 + ii]); x1 += hv * bfr(win[(size_t)k * INC + cb2 + 16 + ii]); }
                    float cs = 1.f, sn = 0.f; if (!cx) { const float pos = (float)(aa == 0 ? (key >> 6) : (key & 63)); const float inv = exp2f(-(float)ii * (13.287712379549449f / 16.f)); cs = cosf(pos * inv); sn = sinf(pos * inv); }
                    const float kold = hf == 0 ? x0 * cs - x1 * sn : x1 * cs + x0 * sn;
                    if (fabsf(kold - g1) <= 0.03f * (fabsf(kold) + 0.05f)) { unsigned e9 = 0u; __hip_atomic_compare_exchange_strong((unsigned*)(P.ctl + PR_BASE + 6), &e9, 1u, __ATOMIC_RELAXED, __ATOMIC_RELAXED, __HIP_MEMORY_SCOPE_AGENT); }
                }
                if (!ok1) { unsigned expect = 0u; if (__hip_atomic_compare_exchange_strong((unsigned*)(P.ctl + PR_BASE + 3), &expect, __float_as_uint(g1) | 1u, __ATOMIC_RELAXED, __ATOMIC_RELAXED, __HIP_MEMORY_SCOPE_AGENT)) { __hip_atomic_store((unsigned*)(P.ctl + PR_BASE + 4), (unsigned)br + 1u, __ATOMIC_RELAXED, __HIP_MEMORY_SCOPE_AGENT); __hip_atomic_store((unsigned*)(P.ctl + PR_BASE + 5), __float_as_uint(ref), __ATOMIC_RELAXED, __HIP_MEMORY_SCOPE_AGENT); {
                        const size_t eo2 = (size_t)(gq - (const bf16*)(ws + WS_K)); const bf16* rb = (const bf16*)(ws + WS_K) + (eo2 & ~(size_t)63); int cr = 0, cc = 0;
                        for (int q2 = 0; q2 < 64; ++q2) { const float v2 = bf2f(rb[q2]); if (!(v2 >= 0.f && v2 <= 1.f)) ++cr; }
                        const size_t rr2 = (eo2 >> 10) & ~(size_t)63, nn2 = eo2 & 1023;
                        for (int q2 = 0; q2 < 64; ++q2) { const float v2 = bf2f(((const bf16*)(ws + WS_K))[(rr2 + q2) * 1024 + nn2]); if (!(v2 >= 0.f && v2 <= 1.f)) ++cc; }
                        int c16 = 0, c8 = 0; const size_t r0b = eo2 >> 10;
                        for (int q2 = 0; q2 < 64; ++q2) { const float v2 = bf2f(((const bf16*)(ws + WS_K))[(rr2 + q2) * 1024 + nn2]); const bool bad = !(v2 >= 0.f && v2 <= 1.f); if (bad && ((rr2 + q2) & 15) == (r0b & 15)) ++c16; if (bad && ((rr2 + q2) >> 3) == (r0b >> 3)) ++c8; }
                        unsigned m8 = 0u, g8 = 0u; for (int q2 = 0; q2 < 64; ++q2) { const float v2 = bf2f(((const bf16*)(ws + WS_K))[(rr2 + q2) * 1024 + nn2]); const bool bad = !(v2 >= 0.f && v2 <= 1.f); if (bad && ((rr2 + q2) >> 3) == (r0b >> 3)) m8 |= 1u << ((rr2 + q2) & 7); if (bad) g8 |= 1u << (q2 >> 3); }
                        __hip_atomic_store((unsigned*)(P.ctl + PR_BASE + 10), m8 | (g8 << 8), __ATOMIC_RELAXED, __HIP_MEMORY_SCOPE_AGENT);
                        __hip_atomic_store((unsigned*)(P.ctl + PR_BASE + 9), (unsigned)(c16 | (c8 << 8)), __ATOMIC_RELAXED, __HIP_MEMORY_SCOPE_AGENT);
                        __hip_atomic_store((unsigned*)(P.ctl + PR_BASE + 8), (unsigned)(cr | (cc << 8)), __ATOMIC_RELAXED, __HIP_MEMORY_SCOPE_AGENT); }
                    __hip_atomic_store((unsigned*)(P.ctl + PR_BASE + 7), (unsigned)(gq - (const bf16*)(ws + (br == 0 ? WS_K : (br == 1 ? WS_V : WS_P1)))), __ATOMIC_RELAXED, __HIP_MEMORY_SCOPE_AGENT); } } } }
        }
        __syncthreads();
    }
}
template <int L>
__device__ __forceinline__ void probe_after_wo(const Probe& P, const Args& args, unsigned char* ws) {
    const bf16* Hb = (const bf16*)(ws + WS_H); const float* win = args.in[8] + (size_t)L * 1024 * INC;
    const bf16* Y = (const bf16*)(ws + WS_K);
    for (int sidx = P.wave; sidx < 64; sidx += 8) {
        const unsigned hh = hsh(sidx * 811u + 17u + L); int r = hh % (L == 0 ? MA : ML); if (L == 0 && sidx < 8) r = ML + hh % MC; const int n = (hh >> 12) & 1023;
        const float ga = sigmoid_f(RAWP(r, 5632 + n) + args.in[9][L * 3072 + n]), gb = sigmoid_f(RAWP(r, 5632 + 1024 + n) + args.in[9][L * 3072 + 1024 + n]), gc = sigmoid_f(RAWP(r, 5632 + 2048 + n) + args.in[9][L * 3072 + 2048 + n]);
        const float pa = wdot((const bf16*)(ws + WS_P0) + (size_t)r * 512, args.in[17] + (size_t)L * 512 * 1024, 1024, n, 512, P.lane);
        const float pb = wdot((const bf16*)(ws + WS_P2) + (size_t)r * 512, args.in[18] + (size_t)L * 512 * 1024, 1024, n, 512, P.lane);
        const float pc = wdot((const bf16*)(ws + WS_Q) + (size_t)r * DM, args.in[19] + (size_t)L * 1024 * 1024, 1024, n, 1024, P.lane);
        if (P.lane == 0) P.rec(17 + 20 * L, bf2f(Y[(size_t)r * DM + n]), ga * pa + gb * pb + gc * pc, 0.05f);
        const float o = wdot(Y + (size_t)r * DM, args.in[20] + (size_t)L * 1024 * 1024, 1024, n, 1024, P.lane);
        const int b = r < ML ? (r >> 12) : 16; const float g1 = ((const float*)(ws + WS_MOD))[((size_t)L * 17 + b) * 6144 + 2048 + n];
        if (L == 0) { const float x0 = r < ML ? args.in[0][(size_t)r * DM + n] : args.in[2][(size_t)(r - ML) * DM + n];
            const float got = r < ML ? args.out[(size_t)r * DM + n] : ((const float*)(ws + WS_XC))[(size_t)(r - ML) * DM + n];
            if (P.lane == 0) P.rec(18, got - x0, g1 * o, 0.03f); }
    }
}
__device__ __forceinline__ void probe_after_ffn0(const Probe& P, const Args& args, unsigned char* ws) {
    const bf16* Hb = (const bf16*)(ws + WS_H); const bf16* ACT = (const bf16*)(ws + WS_ACT0);
    for (int sidx = P.wave; sidx < 64; sidx += 8) {
        const unsigned hh = hsh(sidx * 60013u + 5u); int r = hh % MA; if (sidx < 8) r = ML + hh % MC; const int j = (hh >> 10) % DFF;
        const float gt = wdot(Hb + (size_t)r * DM, args.in[21], DFF, j, 1024, P.lane), up = wdot(Hb + (size_t)r * DM, args.in[22], DFF, j, 1024, P.lane);
        if (P.lane == 0) P.rec(19, bf2f(ACT[(size_t)r * DFF + j]), silu_f(gt) * up, 0.04f);
    }
}
#undef RAWP
#endif


#define WSB() unsigned char* ws = launder_ptr(args.ws)
#define W_MOD ((float*)(ws + WS_MOD))
#define W_ROPE ((float*)(ws + WS_ROPE))
#define W_LAM ((float*)(ws + WS_LAM))
#define W_AWS ((bf16*)(ws + WS_AWS))
#define W_ROUTE ((unsigned*)(ws + WS_ROUTE))
#define W_XC ((float*)(ws + WS_XC))
#define W_H ((bf16*)(ws + WS_H))
#define W_P0 ((bf16*)(ws + WS_P0))
#define W_P1 ((bf16*)(ws + WS_P1))
#define W_P2 ((bf16*)(ws + WS_P2))
#define W_P3 ((bf16*)(ws + WS_P3))
#define W_Q ((bf16*)(ws + WS_Q))
#define W_K ((bf16*)(ws + WS_K))
#define W_V ((bf16*)(ws + WS_V))
#define W_MODL (W_MOD + (size_t)L * 17 * 6144)
#define W_WIN ((const bf16*)(ws + WS_WIN + L * WIN_BYTES))
#define W_WOUT ((const bf16*)(ws + WS_WOUT + L * WOUT_BYTES))
#define PH_ON (P.lo <= P.ph && P.ph < P.hi)
#ifdef PTIME
#define SEAM() do { if (P.lo <= P.ph && P.ph + 1 < P.hi) xcd_barrier(bar); if (blockIdx.x == 0 && C.tid == 0 && P.ph < 40) ((unsigned long long*)(C.ctl + 16384))[1 + P.ph] = rt(); ++P.ph; } while (0)
#else
#define SEAM() do { if (P.lo <= P.ph && P.ph + 1 < P.hi) xcd_barrier(bar); ++P.ph; } while (0)
#endif
#define ELEM_DELTA(a, b) ((long)(((intptr_t)(a) - (intptr_t)(b)) / 4))

#ifdef PROBE
#define PROBE_HOOK(FN) do { if (P.lo < P.ph && P.ph <= P.hi) { if (blockIdx.x == 0) { WSB(); const Probe PR{C.ctl, C.tid, C.lane, C.wave, (LAS float*)C.lds}; FN(PR, args, ws); } xcd_barrier(bar); } } while (0)
#else
#define PROBE_HOOK(FN) do { } while (0)
#endif

#ifndef REP_BIG
#define REP_BIG 1
#endif
#ifndef REP_GATE
#define REP_GATE 1
#endif
#ifndef REP_UP
#define REP_UP 1
#endif
#ifndef REP_MOEUP
#define REP_MOEUP 1
#endif
#ifndef REP_MOEDN
#define REP_MOEDN 1
#endif
#ifndef ATT_XPF
#define ATT_XPF 0
#endif
#ifndef ATT_ROT
#define ATT_ROT(qb) ((qb) * 2)
#endif
template <int L, int BR>
__device__ __forceinline__ void merge_phase(const Ctx& C, const Args& args, const XcdBarrier& bar, PhaseCtl& P) {
    constexpr int mrows = L == 0 ? MA : ML;
    if (PH_ON) { WSB();
#if (EN_SITES >> 2) & 1
        constexpr size_t aoff = BR == 0 ? WS_P0 : (BR == 1 ? WS_P2 : WS_Q), goff = BR == 0 ? WS_K : (BR == 1 ? WS_V : WS_P1);
        constexpr int K = BR == 2 ? 1024 : 512;
        const bf16* Bt = W_WOUT + (BR == 0 ? 0 : (BR == 1 ? 512 * 1024 : 1024 * 1024));
        pg8::Gemm g{(const bf16*)(ws + aoff), Bt, mrows, 1024, K}; pg8::StaticOrder S; S.init(mrows, 1024, C.G, (int)blockIdx.x);
        EpiMerge E{W_K, (const bf16*)(ws + goff), (long)((WS_P3 - WS_P1) / 2), BR == 2 ? 512 : 1024, BR == 2 ? 2 : 4, BR == 0 ? 1 : 0, 0};
#ifdef DUP_MERGE
        if (L == 0) { EpiMerge Ed = E; Ed.dry = P.hi < 5000 ? 1 : 0; pg8::gemm_phase<EpiMerge, pg8::StaticOrder, PG8_ALIGN, PG8_SP2>(C.lds, g, S, Ed); }
#endif
        pg8::gemm_phase<EpiMerge, pg8::StaticOrder, PG8_ALIGN, PG8_SP2>(C.lds, g, S, E);
#endif
    }
    if (BR == 2) SEAM(); else ++P.ph;
}

template <int L>
__device__ __forceinline__ void layer_body(const Ctx& C, const Args& args, const XcdBarrier& bar, PhaseCtl& P, volatile LAS int* offl) {
    constexpr int mrows = L == 0 ? MA : ML;
    if (PH_ON) { WSB(); modulate_phase(C, L == 0 ? args.in[0] : (const float*)args.out, L == 0 ? args.in[2] : (const float*)W_XC, args.in[6] + L * 1024, W_MODL, 0, 1, W_H, MA);
#ifdef REP_MOD
        if (L == 0) modulate_phase(C, args.in[0], args.in[2], args.in[6], W_MODL, 0, 1, W_H, MA);
#endif
    }
    SEAM();
    PROBE_HOOK(probe_after_mod1<L>);
    if (PH_ON) { WSB();
#if (EN_SITES >> 0) & 1
        LAS float* tab = (LAS float*)(C.lds + 131072);
        for (int i = C.tid; i < 2048; i += NTHREADS) tab[i] = W_ROPE[i];
        __syncthreads();
        pg8::Gemm g{W_H, W_WIN, MA, NBIG, 1024};
        EpiBig E{ws, tab};
        if constexpr (L == 0) { pg8::StaticOrder S; S.init(MA, NBIG, C.G, (int)blockIdx.x); pg8::gemm_phase<EpiBig, pg8::StaticOrder, PG8_ALIGN, PG8_SP2>(C.lds, g, S, E); }
        else { BigOrderL1 S; S.so.init(ML, NBIG, C.G, (int)blockIdx.x); S.G = C.G; S.c = (int)blockIdx.x; pg8::gemm_phase<EpiBig, BigOrderL1, PG8_ALIGN, PG8_SP2>(C.lds, g, S, E); }
#endif
    }
    SEAM();
    PROBE_HOOK(probe_after_big<L>);
    if (PH_ON) { WSB();
#ifdef PROBE_FILL2
        { GAS u32x4* kf = (GAS u32x4*)(ws + WS_K); const u32x4 pat = {0x46404640u, 0x46404640u, 0x46404640u, 0x46404640u};
          for (size_t i = (size_t)C.gw * 64 + C.lane; i < (size_t)MA * DM * 2 / 16; i += (size_t)C.NGW * 64) kf[i] = pat; }
#endif
#if EN_MIX
#ifdef DUP_MIX
        if (L == 0) for (int ch = C.vcu; ch < mrows / 128; ch += C.G)
            mixer_chunk(C, ch, W_P0, W_P1, W_P2, W_P3, args.in[10] + L * 512, args.in[11] + L * 512, W_AWS + (size_t)L * 8 * 128 * 128, args.in[13] + L * 8 * 128, args.in[14] + L * 3 * 512, P.hi > 5000);
#endif
        for (int ch = C.vcu; ch < mrows / 128; ch += C.G)
            mixer_chunk(C, ch, W_P0, W_P1, W_P2, W_P3, args.in[10] + L * 512, args.in[11] + L * 512, W_AWS + (size_t)L * 8 * 128 * 128, args.in[13] + L * 8 * 128, args.in[14] + L * 3 * 512);
#endif
#if EN_ATT
        const float lam = W_LAM[L]; constexpr float oml = L == 0 ? 0.8f : (1.f - (0.8f - 0.6f * 0.7408182206817179f)); const float* subg = args.in[16] + L * 128;
#if ATT_XPF
        att::diff_attn_units<false>(W_Q, W_K, W_V, C.vcu, BATCH * 8 * 32, C.G, lam, subg, oml, (LAS char*)C.lds);
        if (L == 0) att::diff_attn_units<true>(W_Q, W_K, W_V, C.vcu, BATCH * 8 * 2, C.G, lam, subg, oml, (LAS char*)C.lds);
#else
#ifdef DUP_ATT
        const int nrep = L == 0 ? 2 : 1;
        for (int rep = 0; rep < nrep; ++rep)
        for (int u = C.vcu; u < BATCH * 8 * 32; u += C.G) {
            const int bh = u >> 5, qb = u & 31, b = bh >> 3, h = bh & 7;
            bf16* qp = W_Q + ((size_t)b * SEQ + qb * 128) * DM + h * 128;
            att::diff_attn_unit(qp, W_K + (size_t)b * SKV * DM + h * 128, W_V + (size_t)b * SKV * DM + h * 128, qp, SKV / 64, lam, subg, oml, (LAS char*)C.lds, rep + 1 == nrep);
        }
#else
        for (int u = C.vcu; u < BATCH * 8 * 32; u += C.G) {
            const int bh = u >> 5, qb = u & 31, b = bh >> 3, h = bh & 7;
            bf16* qp = W_Q + ((size_t)b * SEQ + qb * 128) * DM + h * 128;
            att::diff_attn_unit(qp, W_K + (size_t)b * SKV * DM + h * 128, W_V + (size_t)b * SKV * DM + h * 128, qp, SKV / 64, lam, subg, oml, (LAS char*)C.lds, true, ATT_ROT(qb));
        }
#endif
        if (L == 0) {
            for (int u = C.vcu; u < BATCH * 8 * 2; u += C.G) {
                const int b = u >> 4, h = (u >> 1) & 7, qb = u & 1;
                bf16* qp = W_Q + ((size_t)ML + b * CTXL + qb * 128) * DM + h * 128;
                att::diff_attn_unit(qp, W_K + ((size_t)b * SKV + SEQ) * DM + h * 128, W_V + ((size_t)b * SKV + SEQ) * DM + h * 128, qp, CTXL / 64, lam, subg, oml, (LAS char*)C.lds);
            }
        }
#endif
#endif
    }
    SEAM();
    PROBE_HOOK(probe_after_mix<L>);
    if (PH_ON) { WSB();
#if (EN_SITES >> 1) & 1
        pg8::Gemm g{W_H, W_WIN + (size_t)NBIG * 1024, mrows, 3072, 1024};
        LAS float* tab = (LAS float*)(C.lds + 131072);
        for (int i = C.tid; i < 3072; i += NTHREADS) tab[i] = args.in[9][L * 3072 + i];
        __syncthreads();
        EpiGate E{ws, tab};
        if constexpr (L == 0) {
            pg8::StaticOrder S; S.init(mrows, 3072, C.G, (int)blockIdx.x);
            pg8::gemm_phase<EpiGate, pg8::StaticOrder, PG8_ALIGN, PG8_SP2>(C.lds, g, S, E);
        } else {
            GateOrder S; S.so.init(mrows, 1024, C.G, (int)blockIdx.x);
            pg8::gemm_phase<EpiGate, GateOrder, PG8_ALIGN, PG8_SP2>(C.lds, g, S, E);
        }
#endif
    }
    if (L == 0) SEAM(); else ++P.ph;
#ifdef PROBE_SCAN
    if (L == 0) { WSB(); unsigned cntk = 0u, cntv = 0u;
        const GAS u32x4* kp = (const GAS u32x4*)(ws + WS_K); const GAS u32x4* vp = (const GAS u32x4*)(ws + WS_V);
        for (size_t i = (size_t)C.gw * 64 + C.lane; i < (size_t)MA * DM * 2 / 16; i += (size_t)C.NGW * 64) {
            const u32x4 a = kp[i], b = vp[i]; f32x4 x0, x1; unpack8(a, x0, x1);
            for (int q = 0; q < 4; ++q) { if (!(x0[q] >= 0.f && x0[q] <= 1.f)) ++cntk; if (!(x1[q] >= 0.f && x1[q] <= 1.f)) ++cntk; }
            unpack8(b, x0, x1);
            for (int q = 0; q < 4; ++q) { if (!(x0[q] >= 0.f && x0[q] <= 1.f)) ++cntv; if (!(x1[q] >= 0.f && x1[q] <= 1.f)) ++cntv; } }
        if (cntk) atomicAdd((unsigned*)(C.ctl + PR_BASE + 12), cntk); if (cntv) atomicAdd((unsigned*)(C.ctl + PR_BASE + 13), cntv);
        xcd_barrier(bar); }
#endif
    merge_phase<L, 0>(C, args, bar, P);
    merge_phase<L, 1>(C, args, bar, P);
    merge_phase<L, 2>(C, args, bar, P);
    if (PH_ON) { WSB();
#if (EN_SITES >> 3) & 1
        pg8::Gemm g{W_K, W_WOUT + 2 * 1024 * 1024, mrows, 1024, 1024}; pg8::StaticOrder S; S.init(mrows, 1024, C.G, (int)blockIdx.x);
        const float* xb = L == 0 ? args.in[0] : (const float*)args.out; const float* cb = L == 0 ? args.in[2] : (const float*)W_XC;
        EpiResid E{xb, args.out, ELEM_DELTA(cb, xb) - (long)ML * DM, ELEM_DELTA(W_XC, args.out) - (long)ML * DM, W_MODL, 2, 0};
        pg8::gemm_phase<EpiResid, pg8::StaticOrder, PG8_ALIGN, PG8_SP2>(C.lds, g, S, E);
#ifdef REP_WO
        if (L == 0) { pg8::gemm_phase<EpiResid, pg8::StaticOrder, PG8_ALIGN, PG8_SP2>(C.lds, g, S, E); }
#endif
#endif
    }
    SEAM();
    PROBE_HOOK(probe_after_wo<L>);
    if (L == 0) {
        if (PH_ON) { WSB(); modulate_phase(C, args.out, W_XC, args.in[7], W_MODL, 3, 4, W_H, MA); }
        SEAM();
        if (PH_ON) { WSB();
#if (EN_SITES >> 4) & 1
            pg8::Gemm g{W_H, (const bf16*)(ws + WS_WFU), MA, 2 * DFF, 1024}; pg8::StaticOrder S; S.init(MA, 2 * DFF, C.G, (int)blockIdx.x);
            EpiSwiGLU E{(bf16*)(ws + WS_ACT0), DFF, 0, 22};
            pg8::gemm_phase<EpiSwiGLU, pg8::StaticOrder, PG8_ALIGN, PG8_SP2>(C.lds, g, S, E);
        if (REP_UP > 1) {
#ifdef REP_BARRIER
            xcd_barrier(bar);
#endif
            pg8::gemm_phase<EpiSwiGLU, pg8::StaticOrder, PG8_ALIGN, PG8_SP2>(C.lds, g, S, E); }
#endif
        }
        SEAM();
        PROBE_HOOK(probe_after_ffn0);
        if (PH_ON) { WSB();
#if (EN_SITES >> 5) & 1
            pg8::Gemm g{(const bf16*)(ws + WS_ACT0), (const bf16*)(ws + WS_WFD), MA, 1024, DFF}; pg8::StaticOrder S; S.init(MA, 1024, C.G, (int)blockIdx.x);
            const long cd = ELEM_DELTA(W_XC, args.out) - (long)ML * DM;
            EpiResid E{args.out, args.out, cd, cd, W_MODL, 5, 0};
#ifdef DUP_DOWN
            { EpiResid Ed = E; Ed.dry = P.hi < 5000 ? 1 : 0; pg8::gemm_phase<EpiResid, pg8::StaticOrder, PG8_ALIGN, PG8_SP2>(C.lds, g, S, Ed); }
#endif
            pg8::gemm_phase<EpiResid, pg8::StaticOrder, PG8_ALIGN, PG8_SP2>(C.lds, g, S, E);
#endif
        }
        SEAM();
    } else {
        if (PH_ON) { WSB();
#ifdef DUP_ROUTE
            route_phase(C, args.out, args.in[7] + 1024, W_MODL, args.in[24], W_H, W_ROUTE, P.hi < 5000); __syncthreads();
#endif
            route_phase(C, args.out, args.in[7] + 1024, W_MODL, args.in[24], W_H, W_ROUTE);
            __syncthreads();
#ifdef REP_MOECVT
            for (int rep_ = 0; rep_ < 2; ++rep_)
#endif
            for (int e = 0; e < NEXP; ++e) {
                tr_matrix<2>(C, args.in[25] + (size_t)e * 1024 * DFE, args.in[26] + (size_t)e * 1024 * DFE, DFE, 1024, 2 * DFE, (bf16*)(ws + WS_MWU) + (size_t)e * 2 * DFE * 1024);
                tr_matrix<0>(C, args.in[27] + (size_t)e * DFE * 1024, nullptr, 1024, DFE, 1024, (bf16*)(ws + WS_MWD) + (size_t)e * 1024 * DFE);
            }
        }
        SEAM();
        if (P.lo < P.ph + 8 && P.ph < P.hi) moe_offsets(C, offl);
        if (PH_ON) { WSB(); gather_phase(C, W_H, (bf16*)(ws + WS_HS), W_ROUTE, offl);
#ifdef REP_GATHER
            gather_phase(C, W_H, (bf16*)(ws + WS_HS), W_ROUTE, offl);
#endif
        }
        SEAM();
        for (int ck = 0; ck < 3; ++ck) {
            const int ntall = offl[8] >> 8; int nt = ntall - ck * MOE_CH; nt = nt < 0 ? 0 : (nt > MOE_CH ? MOE_CH : nt);
            if (PH_ON) { WSB();
#if (EN_SITES >> 6) & 1
                pg8::Gemm g{(const bf16*)(ws + WS_HS), (const bf16*)(ws + WS_MWU), nt * 256, 2 * DFE, 1024};
                MoeOrder S; S.so.init(nt * 256, 2 * DFE, C.G, (int)blockIdx.x); S.tile0 = ck * MOE_CH; S.npe = 28; S.a_global = true; S.offl = offl;
                EpiSwiGLU E{(bf16*)(ws + WS_MACT), DFE, ck * MOE_CH, 28};
                pg8::gemm_phase<EpiSwiGLU, MoeOrder, PG8_ALIGN, PG8_SP2>(C.lds, g, S, E);
        if (REP_MOEUP > 1) { pg8::gemm_phase<EpiSwiGLU, MoeOrder, PG8_ALIGN, PG8_SP2>(C.lds, g, S, E); }
#endif
            }
            SEAM();
            if (PH_ON) { WSB();
#if (EN_SITES >> 7) & 1
                pg8::Gemm g{(const bf16*)(ws + WS_MACT), (const bf16*)(ws + WS_MWD), nt * 256, 1024, DFE};
                MoeOrder S; S.so.init(nt * 256, 1024, C.G, (int)blockIdx.x); S.tile0 = ck * MOE_CH; S.npe = 4; S.a_global = false; S.offl = offl;
                EpiStoreBf16 E{(bf16*)(ws + WS_HS), 1024, ck * MOE_CH, 4};
                pg8::gemm_phase<EpiStoreBf16, MoeOrder, PG8_ALIGN, PG8_SP2>(C.lds, g, S, E);
        if (REP_MOEDN > 1) { pg8::gemm_phase<EpiStoreBf16, MoeOrder, PG8_ALIGN, PG8_SP2>(C.lds, g, S, E); }
#endif
            }
            SEAM();
        }
        if (PH_ON) { WSB();
#ifdef DUP_FINAL
            final_phase(C, args.out, (const bf16*)(ws + WS_HS), W_ROUTE, W_MODL, args.in[28], P.hi < 5000);
#endif
            final_phase(C, args.out, (const bf16*)(ws + WS_HS), W_ROUTE, W_MODL, args.in[28]); }
        SEAM();
    }
}

__global__ void __launch_bounds__(NTHREADS, 2) fwd_kernel(Args args) {
    extern __shared__ __attribute__((aligned(16))) unsigned char lds_raw[];
    Ctx C;
    C.lds = (LAS unsigned char*)lds_raw; C.ctl = (gu32*)(args.ws + WS_CTL);
    C.tid = threadIdx.x; C.lane = C.tid & 63; C.wave = __builtin_amdgcn_readfirstlane(C.tid >> 6);
    C.G = gridDim.x; { const int bx = blockIdx.x; C.vcu = (C.G % 8 == 0) ? (bx % 8) * (C.G / 8) + bx / 8 : bx; }
    C.gw = C.vcu * NWAVES + C.wave; C.NGW = C.G * NWAVES;
    volatile LAS unsigned* MISC = (volatile LAS unsigned*)(C.lds + LDSCTL_OFF);
    volatile LAS int* offl = (volatile LAS int*)(C.lds + LDSCTL_OFF + 64);
    if (C.tid < 64) MISC[C.tid] = 0u;
    __syncthreads();
    const XcdBarrier bar = xcd_barrier_post((unsigned*)(C.ctl + CW_BAR), MISC);
    PhaseCtl P{args.ph_lo, args.ph_hi, 0};
#ifdef PTIME
    if (blockIdx.x == 0 && C.tid == 0) ((unsigned long long*)(C.ctl + 16384))[0] = rt();
#endif

#if EN_PRO
    if (PH_ON) { WSB();
#ifdef REP_PRO
        for (int rep_ = 0; rep_ < 2; ++rep_)
#endif
        for (int l = 0; l < 2; ++l) {
            tr_matrix<1>(C, args.in[8] + (size_t)l * 1024 * INC, nullptr, INC, 1024, INC, (bf16*)(ws + WS_WIN + l * WIN_BYTES));
            bf16* wo = (bf16*)(ws + WS_WOUT + l * WOUT_BYTES);
            tr_matrix<0>(C, args.in[17] + (size_t)l * 512 * 1024, nullptr, 1024, 512, 1024, wo);
            tr_matrix<0>(C, args.in[18] + (size_t)l * 512 * 1024, nullptr, 1024, 512, 1024, wo + 512 * 1024);
            tr_matrix<0>(C, args.in[19] + (size_t)l * 1024 * 1024, nullptr, 1024, 1024, 1024, wo + 1024 * 1024);
            tr_matrix<0>(C, args.in[20] + (size_t)l * 1024 * 1024, nullptr, 1024, 1024, 1024, wo + 2 * 1024 * 1024);
        }
        tr_matrix<2>(C, args.in[21], args.in[22], DFF, 1024, 2 * DFF, (bf16*)(ws + WS_WFU));
        tr_matrix<0>(C, args.in[23], nullptr, 1024, DFF, 1024, (bf16*)(ws + WS_WFD));
        for (int i = C.gw * 64 + C.lane; i < 2 * 8 * 128 * 128; i += C.NGW * 64) W_AWS[i] = (bf16)f2bf(args.in[12][i]);
        __syncthreads();
        mod_phase(C, args.in[1], args.in[3], args.in[4], args.in[5], W_MOD);
        rope_lam_phase(C, args.in[15], W_ROPE, W_LAM);
#ifdef PROBE_FILL
        { GAS u32x4* kf = (GAS u32x4*)(ws + WS_K); const u32x4 pat = {0x46404640u, 0x46404640u, 0x46404640u, 0x46404640u};
          for (size_t i = (size_t)C.gw * 64 + C.lane; i < (size_t)MA * DM * 2 / 16; i += (size_t)C.NGW * 64) kf[i] = pat; }
#endif
    }
#endif
    SEAM();
    layer_body<0>(C, args, bar, P, offl);
#if NLAYERS > 1
    layer_body<1>(C, args, bar, P, offl);
#endif
#ifdef PTIME
    {
        xcd_barrier(bar);
        const unsigned long long* T = (const unsigned long long*)(C.ctl + 16384);
        const float ta = (float)(__hip_atomic_load(T + 1 + PT_A1, __ATOMIC_RELAXED, __HIP_MEMORY_SCOPE_AGENT) - __hip_atomic_load(T + PT_A0, __ATOMIC_RELAXED, __HIP_MEMORY_SCOPE_AGENT)) * 0.01f;
        const float tb = (float)(__hip_atomic_load(T + 1 + PT_B1, __ATOMIC_RELAXED, __HIP_MEMORY_SCOPE_AGENT) - __hip_atomic_load(T + PT_B0, __ATOMIC_RELAXED, __HIP_MEMORY_SCOPE_AGENT)) * 0.01f;
        const float bv = 8.f * sqrtf(tb);
        for (size_t i = (size_t)C.gw * 64 + C.lane; i < (size_t)ML * DM; i += (size_t)C.NGW * 64) args.out[i] = i == 0 ? ta : ((i >= 1024 && i < 1024 + (1u << 20)) ? bv : 0.f);
    }
#endif
#ifdef PROBE
    {
        xcd_barrier(bar);
        const unsigned id = __hip_atomic_load((unsigned*)(C.ctl + PR_BASE), __ATOMIC_RELAXED, __HIP_MEMORY_SCOPE_AGENT);
        const float e1 = __uint_as_float(__hip_atomic_load((unsigned*)(C.ctl + PR_BASE + 1), __ATOMIC_RELAXED, __HIP_MEMORY_SCOPE_AGENT)), e2 = __uint_as_float(__hip_atomic_load((unsigned*)(C.ctl + PR_BASE + 2), __ATOMIC_RELAXED, __HIP_MEMORY_SCOPE_AGENT));
        const float err = id ? e1 : e2; float code = err < 0.05f ? 1000.f * err : 50.f + 100.f * (err > 4.5f ? 4.5f : err); const float bv = 8.f * sqrtf(code);
        const unsigned sv = __hip_atomic_load((unsigned*)(C.ctl + PR_BASE + 3), __ATOMIC_RELAXED, __HIP_MEMORY_SCOPE_AGENT), sb = __hip_atomic_load((unsigned*)(C.ctl + PR_BASE + 4), __ATOMIC_RELAXED, __HIP_MEMORY_SCOPE_AGENT);
        float a0 = 100.f * (float)id, bvv = bv;
        const unsigned eoff = __hip_atomic_load((unsigned*)(C.ctl + PR_BASE + 7), __ATOMIC_RELAXED, __HIP_MEMORY_SCOPE_AGENT);
#ifndef PROBE_SEL
#define PROBE_SEL 0
#endif
        if (PROBE_SEL == 8 && false) {} else if (sv && PROBE_SEL == 1) { const unsigned rr = eoff >> 10, nn = eoff & 1023u; a0 = 100.f * (float)(nn >> 4); bvv = 8.f * sqrtf((float)(rr >> 10)); }
        else if (sv && PROBE_SEL == 2) { const unsigned rr = eoff >> 10, nn = eoff & 1023u; a0 = 100.f * (float)(nn & 15u) + 50.f; bvv = 8.f * sqrtf((float)((rr >> 4) & 63u)); }
        else if (sv && PROBE_SEL == 4) { const unsigned cw = __hip_atomic_load((unsigned*)(C.ctl + PR_BASE + 8), __ATOMIC_RELAXED, __HIP_MEMORY_SCOPE_AGENT); a0 = 100.f * (float)(cw & 0xffu) + 50.f; bvv = 8.f * sqrtf((float)(cw >> 8)); }
        else if (sv && PROBE_SEL == 5) { const unsigned cw = __hip_atomic_load((unsigned*)(C.ctl + PR_BASE + 9), __ATOMIC_RELAXED, __HIP_MEMORY_SCOPE_AGENT); a0 = 100.f * (float)(cw & 0xffu) + 50.f; bvv = 8.f * sqrtf((float)(cw >> 8)); }
        else if (sv && PROBE_SEL == 6) { const unsigned cw = __hip_atomic_load((unsigned*)(C.ctl + PR_BASE + 10), __ATOMIC_RELAXED, __HIP_MEMORY_SCOPE_AGENT); a0 = 100.f * (float)((cw >> 4) & 15u) + 50.f; bvv = 8.f * sqrtf((float)(cw & 15u)); }
        else if (sv && PROBE_SEL == 7) { const unsigned cw = __hip_atomic_load((unsigned*)(C.ctl + PR_BASE + 10), __ATOMIC_RELAXED, __HIP_MEMORY_SCOPE_AGENT) >> 8; a0 = 100.f * (float)((cw >> 4) & 15u) + 50.f; bvv = 8.f * sqrtf((float)(cw & 15u)); }
        else if (PROBE_SEL == 8) { const unsigned ck = __hip_atomic_load((unsigned*)(C.ctl + PR_BASE + 12), __ATOMIC_RELAXED, __HIP_MEMORY_SCOPE_AGENT), cv = __hip_atomic_load((unsigned*)(C.ctl + PR_BASE + 13), __ATOMIC_RELAXED, __HIP_MEMORY_SCOPE_AGENT);
            a0 = 100.f * (float)ck; bvv = 8.f * sqrtf((float)cv); }
        else if (sv && PROBE_SEL == 3) { const unsigned rr = eoff >> 10; a0 = 100.f * (float)(rr & 15u) + 50.f; bvv = 0.f; }
        else if (sv) { const float val = __uint_as_float(sv); a0 = 1000.f * fabsf(val); const unsigned ko = __hip_atomic_load((unsigned*)(C.ctl + PR_BASE + 6), __ATOMIC_RELAXED, __HIP_MEMORY_SCOPE_AGENT); bvv = 8.f * sqrtf(10.f * (float)sb + (val < 0.f ? 5.f : 0.f) + (ko ? 100.f : 0.f)); }
        for (size_t i = (size_t)C.gw * 64 + C.lane; i < (size_t)ML * DM; i += (size_t)C.NGW * 64) args.out[i] = i == 0 ? a0 : ((i >= 1024 && i < 1024 + (1u << 20)) ? bvv : 0.f);
    }
#endif
}
#undef PH_ON
#undef SEAM
#undef WSB

extern "C" void kernel_launch(void* const* d_in, const int* in_sizes, int n_in, void* d_out, int out_size, void* d_ws, size_t ws_size, hipStream_t stream) {
    static int grid = 0;
    if (grid == 0) {
        if (n_in != 29 || in_sizes[0] != ML * DM || out_size != ML * DM || ws_size < WS_END) {
            fprintf(stderr, "kernel_launch: shape mismatch: n_in %d in0 %d out %d ws %zu (need %zu); nothing launched\n", n_in, n_in > 0 ? in_sizes[0] : -1, out_size, ws_size, (size_t)WS_END); grid = -1; return; }
        int dev = 0, cus = 0, per_cu = 0;
        if (hipGetDevice(&dev) != hipSuccess || hipDeviceGetAttribute(&cus, hipDeviceAttributeMultiprocessorCount, dev) != hipSuccess) { fprintf(stderr, "kernel_launch: device query failed\n"); grid = -1; return; }
        if (hipFuncSetAttribute((const void*)fwd_kernel, hipFuncAttributeMaxDynamicSharedMemorySize, LDS_BYTES) != hipSuccess) { fprintf(stderr, "kernel_launch: hipFuncSetAttribute failed\n"); grid = -1; return; }
        if (hipOccupancyMaxActiveBlocksPerMultiprocessor(&per_cu, (const void*)fwd_kernel, NTHREADS, LDS_BYTES) != hipSuccess || per_cu < 1)
            fprintf(stderr, "kernel_launch: note: occupancy query reports %d workgroups per CU\n", per_cu);
        (void)hipGetLastError();
        grid = cus;
    }
    if (grid < 0) return;
    if (hipMemsetAsync((char*)d_ws + WS_CTL, 0, CTL_ZERO_BYTES, stream) != hipSuccess) { fprintf(stderr, "kernel_launch: memset failed\n"); return; }
    Args a{};
    for (int i = 0; i < 29; ++i) a.in[i] = (const float*)d_in[i];
    a.out = (float*)d_out; a.ws = (unsigned char*)d_ws; a.ph_lo = 0; a.ph_hi = 1000;
    hipLaunchKernelGGL(fwd_kernel, dim3(grid), dim3(NTHREADS), LDS_BYTES, stream, a);
    const hipError_t le = hipPeekAtLastError();
    if (le != hipSuccess) fprintf(stderr, "kernel_launch: launch failed: %s\n", hipGetErrorName(le));
}
```

```cpp
#include <hip/hip_runtime.h>
#include <cstdio>
#include <cstdint>
namespace pg8 {
#define PG8_LAS __attribute__((address_space(3)))
typedef unsigned short bf16_t;
typedef short bf16x8 __attribute__((ext_vector_type(8)));
typedef float f32x4 __attribute__((ext_vector_type(4)));
typedef unsigned u32x4 __attribute__((ext_vector_type(4)));
constexpr int BM = 256, BK = 64, HALF = 128, HTB = HALF * BK * 2  , STAGE_BYTES = 8 * HTB, NXCD = 8, WGM = 8;

__host__ __device__ __forceinline__ int lds_byte(int r, int c) { const int st = (r >> 4) * 2 + (c >> 5), rr = r & 15, cc = c & 31, ob = rr * 64 + cc * 2; return st * 1024 + (ob ^ (((ob >> 9) & 1) << 5)); }
__host__ __device__ __forceinline__ void stage_rc(int b, int& R, int& C) { const int st = b / 1024, sb = b % 1024, swz = sb ^ (((sb >> 9) & 1) << 5); R = (st >> 1) * 16 + swz / 64; C = (st & 1) * 32 + (swz % 64) / 2; }
__host__ __device__ __forceinline__ int perm32(int rho) { const int n = rho >> 4, i = rho & 15; return 8 * (i >> 2) + 4 * n + (i & 3); }

struct Unit { int pm, pn; };
struct Gemm { const bf16_t* A; const bf16_t* Bt; int M, N, K; };

struct StaticOrder {
    static constexpr bool GATHER = false;
    int nM, nN, nwg, G, c;
    __host__ __device__ void init(int M, int N, int G_, int c_) { nM = M / BM; nN = N / BM; nwg = nM * nN; G = G_; c = c_; }
    __host__ __device__ bool next(int i, Unit& u) const {
        const long L = (long)i * G + c; if (L >= nwg) return false;
        int wgid = (int)L; { const int q = nwg / NXCD, r = nwg % NXCD, xcd = wgid % NXCD, off = wgid / NXCD; wgid = (xcd < r ? xcd * (q + 1) : r * (q + 1) + (xcd - r) * q) + off; }
        const int nig = WGM * nN, gid = wgid / nig, fm = gid * WGM, gsz = (nM - fm) < WGM ? (nM - fm) : WGM;
        u.pm = fm + ((wgid % nig) % gsz); u.pn = (wgid % nig) / gsz; return true;
    }
    __device__ __forceinline__ void a_ready(const Unit&) const {}
    __device__ __forceinline__ void done(const Unit&) const {}
};

typedef float cvt_f32x2 __attribute__((ext_vector_type(2))); typedef __bf16 cvt_bf16x2 __attribute__((ext_vector_type(2)));
__device__ __forceinline__ unsigned cvt_pk_bf16(float lo, float hi) { const cvt_f32x2 v = {lo, hi}; const cvt_bf16x2 b = __builtin_convertvector(v, cvt_bf16x2); return __builtin_bit_cast(unsigned, b); }
typedef float f32x2 __attribute__((ext_vector_type(2)));
__device__ __forceinline__ f32x2 gelu_pk(f32x2 v) {
    const f32x2 av = __builtin_elementwise_abs(v), d = av * 0.2316418882f + 1.0f;
    f32x2 t; t.x = __builtin_amdgcn_rcpf(d.x); t.y = __builtin_amdgcn_rcpf(d.y);
    f32x2 q = t * 0.5307027145f + (-0.7265760135f); q = q * t + 0.7107068705f; q = q * t + (-0.142248368f); q = q * t + 0.127414796f; q = q * t;
    const f32x2 s = (v * v) * (-0.72134752044f);
    f32x2 e; e.x = __builtin_amdgcn_exp2f(s.x); e.y = __builtin_amdgcn_exp2f(s.y);
    const f32x2 m = v * (q * e), r = v - m;
    f32x2 o; o.x = v.x < 0.f ? m.x : r.x; o.y = v.y < 0.f ? m.y : r.y; return o;
}


template <class Epi, class Sched, bool ALIGN_EPI = false, bool SP2 = false>
__device__ __forceinline__ void gemm_phase(PG8_LAS unsigned char* lds, const Gemm g, const Sched& S, const Epi& E) {
    const int tid = threadIdx.x, wid = __builtin_amdgcn_readfirstlane(tid >> 6), lane = tid & 63, wr = wid >> 2, wc = wid & 3, fr = lane & 15, fq = lane >> 4;
    const int K = g.K, nt = K / BK;
    unsigned voffA[2], voffB[2];
#pragma unroll
    for (int i = 0; i < 2; ++i) { int R, C; stage_rc(tid * 16 + i * 8192, R, C); const int Rb = Epi::PERM ? ((R & ~31) + perm32(R & 31)) : R;
        voffA[i] = (unsigned)(R * K + C) * 2u; voffB[i] = (unsigned)(Rb * K + C) * 2u; }
    const size_t kstep = (size_t)(BK * 2);
    constexpr bool GA = Sched::GATHER;
    unsigned gC[2][2]; int grow[2];
    PG8_LAS unsigned* const rmap_lds = (PG8_LAS unsigned*)(lds + 8 * HTB);
    if constexpr (GA) { int R, C; stage_rc(tid * 16, R, C); grow[0] = R; stage_rc(tid * 16 + 8192, R, C); grow[1] = R; }
#ifndef PG8_KROT
#define PG8_KROT 0
#endif
    static_assert(SP2 || !Sched::GATHER, "gathered A rows are written for the SP2 loop only");
    static_assert(SP2 || !PG8_KROT, "the K-slice rotation is written for the SP2 loop only");
    const int krot = PG8_KROT ? (int)((blockIdx.x >> 3) % (unsigned)(K / BK)) : 0;
#define PG8_KO(j) ((size_t)(((j) + krot) >= nt ? ((j) + krot) - nt : ((j) + krot)) * kstep)
    const size_t hstep = (size_t)HALF * K * 2;
    const size_t tstep = 2 * hstep;
    const unsigned ldsw = (unsigned)wid * 1024u;
    const int aoff = lds_byte(wr * 64 + fr, fq * 8), boff = lds_byte(wc * 32 + fr, fq * 8);
#define PG8_SA(b, h) (((b) * 2 + (h)) * HTB)
#define PG8_SB(b, h) ((4 + (b) * 2 + (h)) * HTB)
#define PG8_STAGE(bufoff, gbase, voff) do { _Pragma("unroll") for (int _i = 0; _i < 2; ++_i) \
        __builtin_amdgcn_global_load_lds((const unsigned*)((const char*)(gbase) + (voff)[_i]), (PG8_LAS unsigned*)(lds + (bufoff) + ldsw + _i * 8192), 16, 0, 0); } while (0)
#define PG8_STAGE_A(bufoff, base, h) do { if constexpr (GA) { PG8_STAGE(bufoff, base, gC[h]); } else { PG8_STAGE(bufoff, (base) + (h) * hstep, voffA); } } while (0)
#define PG8_GC_FROM(src, scale_) do { _Pragma("unroll") for (int h_ = 0; h_ < 2; ++h_) _Pragma("unroll") for (int i_ = 0; i_ < 2; ++i_) gC[h_][i_] = (src)[128 * h_ + grow[i_]] * (unsigned)(scale_) + (voffA[i_] - (unsigned)grow[i_] * (unsigned)(scale_)); } while (0)
#define PG8_LDA(dst, b, h) do { _Pragma("unroll") for (int m = 0; m < 4; ++m) _Pragma("unroll") for (int k = 0; k < 2; ++k) dst[m][k] = *(const PG8_LAS bf16x8*)(lds + PG8_SA(b, h) + aoff + m * 2048 + k * 1024); } while (0)
#define PG8_LDB(dst, b, h) do { _Pragma("unroll") for (int n = 0; n < 2; ++n) _Pragma("unroll") for (int k = 0; k < 2; ++k) dst[n][k] = *(const PG8_LAS bf16x8*)(lds + PG8_SB(b, h) + boff + n * 2048 + k * 1024); } while (0)
#define PG8_MMA(ai, bj, At, Bt) do { __builtin_amdgcn_s_setprio(1); _Pragma("unroll") for (int m = 0; m < 4; ++m) _Pragma("unroll") for (int n = 0; n < 2; ++n) _Pragma("unroll") for (int k = 0; k < 2; ++k) \
        acc[ai][bj][m][n] = __builtin_amdgcn_mfma_f32_16x16x32_bf16(Bt[n][k], At[m][k], acc[ai][bj][m][n], 0, 0, 0); __builtin_amdgcn_s_setprio(0); } while (0)
#define PG8_WAIT_V(n) asm volatile("s_waitcnt vmcnt(" #n ")" ::: "memory")
#define PG8_WAIT_L(n) asm volatile("s_waitcnt lgkmcnt(" #n ")" ::: "memory")
#define PG8_BAR __builtin_amdgcn_s_barrier()
#define PG8_SCHED __builtin_amdgcn_sched_barrier(0)
    Unit cur, nxt; int ui = 0;
    if (!S.next(0, cur)) return;
    f32x4 acc[2][2][4][2];
#pragma unroll
    for (int a = 0; a < 2; ++a)
#pragma unroll
        for (int b = 0; b < 2; ++b)
#pragma unroll
            for (int m = 0; m < 4; ++m)
#pragma unroll
                for (int n = 0; n < 2; ++n) acc[a][b][m][n] = (f32x4){0.f, 0.f, 0.f, 0.f};
    bf16x8 At[4][2], B0[2][2], B1[2][2];
    const char* cA = (const char*)g.A + (GA ? (size_t)0 : (size_t)cur.pm * tstep); const char* cB = (const char*)g.Bt + (size_t)cur.pn * tstep;
    if constexpr (GA) { const unsigned* rm = S.rowmap + (size_t)cur.pm * 256; PG8_GC_FROM(rm, K * 2); }
    S.a_ready(cur);
    if constexpr (SP2) {
        PG8_STAGE(PG8_SB(0, 0), cB + PG8_KO(0), voffB); PG8_STAGE(PG8_SB(0, 1), cB + hstep + PG8_KO(0), voffB); PG8_STAGE_A(PG8_SA(0, 0), cA + PG8_KO(0), 0); PG8_STAGE_A(PG8_SA(0, 1), cA + PG8_KO(0), 1);
        if (wr == 1) PG8_BAR;
        PG8_WAIT_V(2); PG8_BAR;
        PG8_STAGE(PG8_SB(1, 0), cB + PG8_KO(1), voffB); PG8_STAGE_A(PG8_SA(1, 0), cA + PG8_KO(1), 0); PG8_STAGE(PG8_SB(1, 1), cB + hstep + PG8_KO(1), voffB);
        PG8_WAIT_V(6); PG8_BAR;
    } else {
        PG8_STAGE(PG8_SB(0, 0), cB, voffB); PG8_STAGE(PG8_SA(0, 0), cA, voffA); PG8_STAGE(PG8_SB(0, 1), cB + hstep, voffB); PG8_STAGE(PG8_SA(0, 1), cA + hstep, voffA);
        if (wr == 1) PG8_BAR;
        PG8_WAIT_V(4); PG8_BAR;
        PG8_STAGE(PG8_SB(1, 0), cB + kstep, voffB); PG8_STAGE(PG8_SA(1, 0), cA + kstep, voffA); PG8_STAGE(PG8_SB(1, 1), cB + hstep + kstep, voffB);
        PG8_WAIT_V(6); PG8_BAR;
    }
    for (;;) {
        const bool has_next = S.next(ui + 1, nxt);
        const char* nA = (has_next && !GA) ? (const char*)g.A + (size_t)nxt.pm * tstep : cA; const char* nB = has_next ? (const char*)g.Bt + (size_t)nxt.pn * tstep : cB;
        if constexpr (GA) { if (has_next && wid < 4) __builtin_amdgcn_global_load_lds((const unsigned*)(S.rowmap + (size_t)nxt.pm * 256 + wid * 64 + lane), (PG8_LAS unsigned*)(rmap_lds + wid * 64), 4, 0, 0); }
        for (int t = 0; t < nt; t += 2) {
            const bool last = (t == nt - 2);
            const char* a1 = cA + PG8_KO(t + 1);
            const char* a2 = last ? nA + PG8_KO(0) : cA + PG8_KO(t + 2); const char* b2 = last ? nB + PG8_KO(0) : cB + PG8_KO(t + 2);
            const char* a3 = last ? nA + PG8_KO(1) : cA + PG8_KO(t + 3); const char* b3 = last ? nB + PG8_KO(1) : cB + PG8_KO(t + 3);
            if (last && has_next) S.a_ready(nxt);
            if constexpr (SP2) {
            PG8_LDB(B0, 0, 0); PG8_LDB(B1, 0, 1); PG8_SCHED; PG8_LDA(At, 0, 0); PG8_STAGE_A(PG8_SA(1, 1), a1, 1);
            if constexpr (GA) { if (last && has_next) PG8_GC_FROM(rmap_lds, K * 2); }
            PG8_WAIT_V(8); PG8_WAIT_L(0); PG8_BAR; PG8_MMA(0, 0, At, B0); PG8_MMA(0, 1, At, B1); PG8_BAR; PG8_SCHED;
            PG8_LDA(At, 0, 1); PG8_STAGE(PG8_SB(0, 0), b2, voffB); PG8_STAGE(PG8_SB(0, 1), b2 + hstep, voffB); PG8_STAGE_A(PG8_SA(0, 0), a2, 0);
            PG8_WAIT_V(8); PG8_WAIT_L(0); PG8_BAR; PG8_MMA(1, 0, At, B0); PG8_MMA(1, 1, At, B1); PG8_BAR; PG8_SCHED;
            PG8_LDB(B0, 1, 0); PG8_LDB(B1, 1, 1); PG8_SCHED; PG8_LDA(At, 1, 0); PG8_STAGE_A(PG8_SA(0, 1), a2, 1);
            PG8_WAIT_V(8); PG8_WAIT_L(0); PG8_BAR; PG8_MMA(0, 0, At, B0); PG8_MMA(0, 1, At, B1); PG8_BAR; PG8_SCHED;
            PG8_LDA(At, 1, 1); PG8_STAGE(PG8_SB(1, 0), b3, voffB); PG8_STAGE(PG8_SB(1, 1), b3 + hstep, voffB); PG8_STAGE_A(PG8_SA(1, 0), a3, 0);
            PG8_WAIT_V(8); PG8_WAIT_L(0); PG8_BAR; PG8_MMA(1, 0, At, B0); PG8_MMA(1, 1, At, B1); PG8_BAR; PG8_SCHED;
            } else {
            PG8_LDB(B0, 0, 0); PG8_SCHED; PG8_LDA(At, 0, 0); PG8_STAGE(PG8_SA(1, 1), a1 + hstep, voffA);
            PG8_WAIT_L(8); PG8_BAR; PG8_WAIT_L(0); PG8_MMA(0, 0, At, B0); PG8_BAR; PG8_SCHED;
            PG8_LDB(B1, 0, 1); PG8_STAGE(PG8_SB(0, 0), b2, voffB);
            PG8_BAR; PG8_WAIT_L(0); PG8_MMA(0, 1, At, B1); PG8_BAR;
            PG8_LDA(At, 0, 1); PG8_STAGE(PG8_SA(0, 0), a2, voffA);
            PG8_BAR; PG8_WAIT_L(0); PG8_MMA(1, 0, At, B0); PG8_BAR; PG8_SCHED;
            PG8_STAGE(PG8_SB(0, 1), b2 + hstep, voffB);
            PG8_WAIT_V(6); PG8_BAR; PG8_MMA(1, 1, At, B1); PG8_BAR;
            PG8_LDB(B0, 1, 0); PG8_SCHED; PG8_LDA(At, 1, 0); PG8_STAGE(PG8_SA(0, 1), a2 + hstep, voffA);
            PG8_WAIT_L(8); PG8_BAR; PG8_WAIT_L(0); PG8_MMA(0, 0, At, B0); PG8_BAR; PG8_SCHED;
            PG8_LDB(B1, 1, 1); PG8_STAGE(PG8_SB(1, 0), b3, voffB);
            PG8_BAR; PG8_WAIT_L(0); PG8_MMA(0, 1, At, B1); PG8_BAR;
            PG8_LDA(At, 1, 1); PG8_STAGE(PG8_SA(1, 0), a3, voffA);
            PG8_BAR; PG8_WAIT_L(0); PG8_MMA(1, 0, At, B0); PG8_BAR; PG8_SCHED;
            PG8_STAGE(PG8_SB(1, 1), b3 + hstep, voffB);
            PG8_WAIT_V(6); PG8_BAR; PG8_MMA(1, 1, At, B1); PG8_BAR;
            }
        }
        if constexpr (ALIGN_EPI) { if (wr == 0) PG8_BAR; }
        if constexpr (!Epi::AFTER_DRAIN) { E(acc, cur, wr, wc, fr, fq); S.done(cur); }
        if (!has_next) break;
#pragma unroll
        for (int a = 0; a < 2; ++a)
#pragma unroll
            for (int b = 0; b < 2; ++b)
#pragma unroll
                for (int m = 0; m < 4; ++m)
#pragma unroll
                    for (int n = 0; n < 2; ++n) acc[a][b][m][n] = (f32x4){0.f, 0.f, 0.f, 0.f};
        cur = nxt; cA = nA; cB = nB; ++ui;
        if constexpr (ALIGN_EPI) { if (wr == 1) PG8_BAR; }
    }
    PG8_WAIT_V(0);
    if constexpr (!ALIGN_EPI) { if (wr == 0) PG8_BAR; }
    PG8_BAR;
    if constexpr (Epi::AFTER_DRAIN) { E.fused(acc, cur, wr, wc, fr, fq, lds, wid, lane); S.done(cur); }
#undef PG8_SA
#undef PG8_SB
#undef PG8_STAGE
#undef PG8_STAGE_A
#undef PG8_GC_FROM
#undef PG8_LDA
#undef PG8_LDB
#undef PG8_MMA
#undef PG8_WAIT_V
#undef PG8_WAIT_L
#undef PG8_BAR
#undef PG8_SCHED
#undef PG8_KO
}
}

#ifndef PG8_SP2
#define PG8_SP2 true
#endif
#ifndef PG8_ALIGN
#define PG8_ALIGN true
#endif

#define GAS __attribute__((address_space(1)))
#define LAS __attribute__((address_space(3)))
typedef unsigned short bf16;
typedef unsigned v4u __attribute__((ext_vector_type(4)));
typedef float f32x4 __attribute__((ext_vector_type(4)));
typedef short bf16x8 __attribute__((ext_vector_type(8)));
typedef GAS unsigned gu32;
typedef GAS unsigned long long gu64;
#define RLX_AGENT __ATOMIC_RELAXED, __HIP_MEMORY_SCOPE_AGENT
#define LDS_WAIT() asm volatile("s_waitcnt lgkmcnt(0)" ::: "memory")
#define VM_WAIT() asm volatile("s_waitcnt vmcnt(0)" ::: "memory")
__device__ __forceinline__ unsigned long long rt() { return __builtin_amdgcn_s_memrealtime(); }
__device__ __forceinline__ unsigned f2bf(float f) { unsigned u = __builtin_bit_cast(unsigned, f); return (u + 0x7fffu + ((u >> 16) & 1u)) >> 16; }
__device__ __forceinline__ unsigned pk2(float lo, float hi) { return f2bf(lo) | (f2bf(hi) << 16); }

#define XB_TMO      128
#define XB_XCNT(j)  (256  + 64 * (j))
#define XB_XSUB(j)  (1280 + 64 * (j))
#define XB_XGEN(j)  (2304 + 64 * (j))
#define XB_TOP      3328
#define XB_TOPGEN   3392
#define XCD_BAR_WORDS 3456
#define XB_SPIN_CAP (1u << 18)

__device__ __forceinline__ unsigned xb_ld(unsigned* p)              { return __hip_atomic_load(p, __ATOMIC_RELAXED, __HIP_MEMORY_SCOPE_AGENT); }
__device__ __forceinline__ unsigned xb_add(unsigned* p, unsigned v) { return __hip_atomic_fetch_add(p, v, __ATOMIC_RELAXED, __HIP_MEMORY_SCOPE_AGENT); }
__device__ __forceinline__ unsigned xb_xcc_id() { return (unsigned)__builtin_amdgcn_s_getreg((3 << 11) | 20) & 0xFu; }
#define XB_SPIN(cond, bar) do { unsigned _sp = 0; while (cond) { __builtin_amdgcn_s_sleep(1); \
    if ((++_sp & 255u) == 0u) { if (xb_ld(&(bar)[XB_TMO])) break; if (_sp > XB_SPIN_CAP) { atomicAdd(&(bar)[XB_TMO], 1u); break; } } } } while (0)

struct XcdBarrier {
    unsigned* bar; unsigned x;
    volatile LAS unsigned* st;
};

__device__ __forceinline__ XcdBarrier xcd_barrier_post(unsigned* bar, volatile LAS unsigned* st) {
    XcdBarrier b; b.bar = bar; b.x = xb_xcc_id(); b.st = st;
    if (threadIdx.x == 0) (void)xb_add(&bar[XB_XCNT(b.x)], 1u);
    return b;
}
__device__ __forceinline__ void xcd_barrier_complete(unsigned* bar, unsigned x, unsigned& nloc, unsigned& nx) {
    const unsigned G = gridDim.x * gridDim.y * gridDim.z;
    unsigned sum, cnt, mine, sp = 0u;
    for (;;) {
        sum = 0u; cnt = 0u; mine = 0u;
#pragma unroll
        for (unsigned j = 0; j < 16; ++j) { const unsigned c = xb_ld(&bar[XB_XCNT(j)]); sum += c; cnt += (c > 0u) ? 1u : 0u; mine = (j == x) ? c : mine; }
        if (sum == G) break;
        __builtin_amdgcn_s_sleep(1);
        if ((++sp & 255u) == 0u) { if (xb_ld(&bar[XB_TMO])) break; if (sp > XB_SPIN_CAP) { atomicAdd(&bar[XB_TMO], 1u); break; } }
    }
    nloc = mine > 0u ? mine : 1u; nx = cnt > 0u ? cnt : 1u;
}

__device__ __forceinline__ void xcd_barrier(const XcdBarrier& b) {
    asm volatile("s_waitcnt vmcnt(0)" ::: "memory");
    __syncthreads();
    if (threadIdx.x == 0) {
        unsigned* bar = b.bar;
        __builtin_amdgcn_s_waitcnt(0);
        unsigned nloc = b.st[0], nx = b.st[1];
        if (nloc == 0u) { xcd_barrier_complete(bar, b.x, nloc, nx); b.st[0] = nloc; b.st[1] = nx; }
        const unsigned old = xb_add(&bar[XB_XSUB(b.x)], 1u);
        const unsigned gen = old / nloc;
        if (old + 1u == (gen + 1u) * nloc) {
            __builtin_amdgcn_fence(__ATOMIC_RELEASE, "agent");
            asm volatile("s_waitcnt vmcnt(0)" ::: "memory");
            const unsigned og = xb_add(&bar[XB_TOP], 1u);
            const unsigned tg = og / nx;
            if (og + 1u == (tg + 1u) * nx) xb_add(&bar[XB_TOPGEN], 1u);
            else XB_SPIN(xb_ld(&bar[XB_TOPGEN]) == tg, bar);
            __builtin_amdgcn_fence(__ATOMIC_ACQUIRE, "agent");
            xb_add(&bar[XB_XGEN(b.x)], 1u);
            asm volatile("s_waitcnt vmcnt(0)" ::: "memory");
        } else {
            XB_SPIN(xb_ld(&bar[XB_XGEN(b.x)]) == gen, bar);
            __builtin_amdgcn_fence(__ATOMIC_ACQUIRE, "agent");
            asm volatile("s_waitcnt vmcnt(0)" ::: "memory");
        }
    }
    __syncthreads();
}

#ifndef NLAYERS
#define NLAYERS 2
#endif
#ifndef EN_PRO
#define EN_PRO 1
#endif
#ifndef EN_MIX
#define EN_MIX 1
#endif
#ifndef EN_ATT
#define EN_ATT 1
#endif
#ifndef EN_SITES
#define EN_SITES 255
#endif
constexpr int NWAVES = 8, NTHREADS = 512;
constexpr int BATCH = 16, SEQ = 4096, DM = 1024, CTXL = 256;
constexpr int ML = BATCH * SEQ;
constexpr int MC = BATCH * CTXL;
constexpr int MA = ML + MC;
constexpr int SKV = SEQ + CTXL;
constexpr int INC = 8704;
constexpr int NBIG = 5632;
constexpr int DFF = 2816, NEXP = 8, DFE = 3584;
constexpr int MOE_CH = 192;
constexpr float EPS = 1e-6f;
constexpr float QSCALE = 0.125f * 1.4426950408889634f;

constexpr size_t MiB = 1u << 20;
constexpr size_t WS_CTL = 0, CTL_ZERO_BYTES = 1 * MiB;
constexpr size_t WS_MOD = 1 * MiB;
constexpr size_t WS_ROPE = 2 * MiB;
constexpr size_t WS_LAM = 2 * MiB + 16384;
constexpr size_t WS_AWS = 2 * MiB + 65536;
constexpr size_t WS_ROUTE = 4 * MiB;
constexpr size_t WS_RMAP = 6 * MiB;
constexpr size_t WS_WIN = 8 * MiB;
constexpr size_t WIN_BYTES = 17 * MiB;
constexpr size_t WS_WOUT = 42 * MiB;
constexpr size_t WOUT_BYTES = 6 * MiB;
constexpr size_t WS_WFU = 54 * MiB;
constexpr size_t WS_WFD = 65 * MiB;
constexpr size_t WS_X16 = 87 * MiB;
constexpr size_t WS_P0 = 223 * MiB, WS_P1 = 291 * MiB, WS_P2 = 359 * MiB, WS_P3 = 427 * MiB;
constexpr size_t WS_Q = 495 * MiB, WS_K = 631 * MiB, WS_V = 767 * MiB;
constexpr size_t WS_ACT0 = 223 * MiB;
constexpr size_t WS_MWU = 223 * MiB;
constexpr size_t WS_MWD = 335 * MiB;
constexpr size_t WS_HS = 391 * MiB;
constexpr size_t WS_MACT = 651 * MiB;
constexpr size_t WS_END = 1024 * MiB;
static_assert(WS_MACT + (size_t)MOE_CH * 256 * DFE * 2 <= WS_END, "ws map");
static_assert(WS_ACT0 + (size_t)MA * DFF * 2 <= WS_K, "ws map");
constexpr int CW_BAR = 4096;
constexpr int CW_CNT = 8192;

constexpr int LDS_BYTES = 147456;
constexpr int LDSCTL_OFF = LDS_BYTES - 256;

typedef float f32x2 __attribute__((ext_vector_type(2)));
typedef unsigned v2u __attribute__((ext_vector_type(2)));
__device__ __forceinline__ float bf2f(unsigned h) { return __builtin_bit_cast(float, h << 16); }
__device__ __forceinline__ float dpp_add(float v, int ctrl_sel) {
    const int x = __builtin_bit_cast(int, v); int y;
    if (ctrl_sel == 0) y = __builtin_amdgcn_update_dpp(0, x, 0xB1, 0xf, 0xf, false);
    else if (ctrl_sel == 1) y = __builtin_amdgcn_update_dpp(0, x, 0x4E, 0xf, 0xf, false);
    else if (ctrl_sel == 2) y = __builtin_amdgcn_update_dpp(0, x, 0x141, 0xf, 0xf, false);
    else y = __builtin_amdgcn_update_dpp(0, x, 0x140, 0xf, 0xf, false);
    return v + __builtin_bit_cast(float, y);
}
__device__ __forceinline__ float wave_sum(float v) {
    v = dpp_add(v, 0); v = dpp_add(v, 1); v = dpp_add(v, 2); v = dpp_add(v, 3);
    const int x = __builtin_bit_cast(int, v);
    const float s0 = __builtin_bit_cast(float, __builtin_amdgcn_readlane(x, 0)), s1 = __builtin_bit_cast(float, __builtin_amdgcn_readlane(x, 16)),
                s2 = __builtin_bit_cast(float, __builtin_amdgcn_readlane(x, 32)), s3 = __builtin_bit_cast(float, __builtin_amdgcn_readlane(x, 48));
    return (s0 + s1) + (s2 + s3);
}
__device__ __forceinline__ float fast_exp2(float x) { return __builtin_amdgcn_exp2f(x); }
__device__ __forceinline__ float fast_rcp(float x) { return __builtin_amdgcn_rcpf(x); }
__device__ __forceinline__ float sigmoid_f(float x) { return fast_rcp(1.f + fast_exp2(-1.4426950408889634f * x)); }
__device__ __forceinline__ float silu_f(float x) { return x * sigmoid_f(x); }
__device__ __forceinline__ float gelu_tanh_f(float x) { const float u = x * (1.f + 0.044715f * x * x); return x * fast_rcp(1.f + fast_exp2(-2.f * 0.7978845608028654f * 1.4426950408889634f * u)); }

__device__ __forceinline__ unsigned char* launder_ptr(unsigned char* p) { asm volatile("" : "+s"(p)); return p; }
struct Args { const float* in[29]; float* out; unsigned char* ws; int ph_lo, ph_hi; };
static_assert(sizeof(Args) == 256, "Args has no holes");
struct PhaseCtl { int lo, hi, ph; };
struct Ctx {
    LAS unsigned char* lds;
    gu32* ctl;
    int tid, lane, wave, vcu, G, gw, NGW;
};

__device__ __forceinline__ void tr_item(const float* W, int ldw, int scol0, bool perm, bf16* WT, int K, int drow0, int k0, LAS float* scr, int lane) {
#pragma unroll 8
    for (int i = 0; i < 32; ++i) { const int kk = 2 * i + (lane >> 5); scr[kk * 33 + (lane & 31)] = W[(size_t)(k0 + kk) * ldw + scol0 + (lane & 31)]; }
    LDS_WAIT(); asm volatile("" ::: "memory");
    const int c = lane & 7;
#pragma unroll
    for (int j = 0; j < 4; ++j) { const int n = (lane >> 3) + 8 * j; const int sn = perm ? ((n >> 1) + 16 * (n & 1)) : n;
        const LAS float* s = scr + (8 * c) * 33 + sn;
        v4u o; o.x = pk2(s[0 * 33], s[1 * 33]); o.y = pk2(s[2 * 33], s[3 * 33]); o.z = pk2(s[4 * 33], s[5 * 33]); o.w = pk2(s[6 * 33], s[7 * 33]);
        *(GAS v4u*)(WT + (size_t)(drow0 + n) * K + k0 + 8 * c) = o; }
    LDS_WAIT(); asm volatile("" ::: "memory");
}
__device__ __forceinline__ int win_src(int d, bool& perm) {
    perm = false;
    if (d < 1024) { perm = true; return 2560 + d; }
    if (d < 2048) { perm = true; return 3584 + (d - 1024); }
    if (d < 3072) return 4608 + (d - 2048);
    if (d < 3584) return d - 3072;
    if (d < 4096) return 512 + (d - 3584);
    if (d < 4608) return 1024 + (d - 4096);
    if (d < 5632) { const int x = d - 4608, j = x >> 8, w = x & 255; return (w < 128 ? 1536 : 2048) + 128 * j + (w & 127); }
    return d;
}
template <int MODE>
__device__ __forceinline__ void tr_matrix(const Ctx& C, const float* W, const float* W2, int ldw, int K, int ndst, bf16* WT) {
    LAS float* scr = (LAS float*)(C.lds + C.wave * 16384);
    const int nblk = ndst / 32, ni = (K / 64) * nblk;
    for (int it = C.gw; it < ni; it += C.NGW) {
        const int kb = it / nblk, db = it % nblk; const float* src = W; int scol0; bool perm = false;
        if (MODE == 0) scol0 = 32 * db;
        else if (MODE == 1) scol0 = win_src(32 * db, perm);
        else { const int j = db >> 3, w = db & 7; if (w >= 4) src = W2; scol0 = 128 * j + 32 * (w & 3); }
        tr_item(src, ldw, scol0, perm, WT, K, 32 * db, 64 * kb, scr, C.lane);
    }
}

__device__ __forceinline__ void mod_phase(const Ctx& C, const float* c, const float* cctx, const float* w_ada, const float* b_ada, float* mod) {
    LAS float* sc = (LAS float*)C.lds;
    LAS float* red = (LAS float*)(C.lds + 17 * 1024 * 4);
    for (int idx = C.tid; idx < 17 * 1024; idx += NTHREADS) { const int b = idx >> 10, k = idx & 1023; const float v = b < 16 ? c[b * 1024 + k] : cctx[k]; sc[idx] = v / (1.f + __expf(-v)); }
    __syncthreads();
    const int cl = C.tid & 31, ks = C.tid >> 5;
    for (int it = blockIdx.x; it < 2 * 192; it += C.G) {
        const int l = it / 192, cb = it % 192, col = cb * 32 + cl;
        float acc[17];
#pragma unroll
        for (int b = 0; b < 17; ++b) acc[b] = 0.f;
        const float* wp = w_ada + ((size_t)l * 1024 + ks * 64) * 6144 + col;
        for (int kk = 0; kk < 64; ++kk) { const float w = wp[(size_t)kk * 6144]; const int k = ks * 64 + kk;
#pragma unroll
            for (int b = 0; b < 17; ++b) acc[b] += sc[b * 1024 + k] * w; }
#pragma unroll
        for (int b = 0; b < 17; ++b) red[(ks * 17 + b) * 32 + cl] = acc[b];
        __syncthreads();
        for (int o = C.tid; o < 17 * 32; o += NTHREADS) { const int b = o >> 5, cc = o & 31; float s = b_ada[l * 6144 + cb * 32 + cc];
#pragma unroll
            for (int q = 0; q < 16; ++q) s += red[(q * 17 + b) * 32 + cc];
            mod[((size_t)l * 17 + b) * 6144 + cb * 32 + cc] = s; }
        __syncthreads();
    }
}
__device__ __forceinline__ void rope_lam_phase(const Ctx& C, const float* c_lambda, float* rope, float* lam) {
    if (blockIdx.x == 0) {
        for (int idx = C.tid; idx < 1024; idx += NTHREADS) {
            const int pos = idx >> 4, i = idx & 15;
            double th = 1.0; for (int q = 0; q < i; ++q) th *= 0.56234132519034908;
            double c1 = 1.0, s1 = th, tc = 1.0, ts = th; const double t2 = th * th;
            for (int n = 1; n <= 12; ++n) { tc *= -t2 / (double)((2 * n - 1) * (2 * n)); ts *= -t2 / (double)((2 * n) * (2 * n + 1)); c1 += tc; s1 += ts; }
            double cc = 1.0, ss = 0.0; for (int q = 0; q < pos; ++q) { const double nc = cc * c1 - ss * s1, ns = ss * c1 + cc * s1; cc = nc; ss = ns; }
            rope[idx * 2] = (float)cc; rope[idx * 2 + 1] = (float)ss;
        }
        if (C.tid < 2) { const int l = C.tid; const float* p = c_lambda + l * 256; float a = 0.f, b = 0.f;
            for (int d = 0; d < 64; ++d) { a += p[d] * p[64 + d]; b += p[128 + d] * p[192 + d]; }
            const float li = l == 0 ? 0.2f : (0.8f - 0.6f * 0.7408182206817179f);
            lam[l] = __expf(a) - __expf(b) + li; }
    }
}

template <bool XB> __device__ __forceinline__ f32x4 ldrow4(const void* row, int idx) {
    if constexpr (XB) { const v2u w = ((const GAS v2u*)row)[idx]; f32x4 a; a[0] = bf2f(w.x & 0xffffu); a[1] = bf2f(w.x >> 16); a[2] = bf2f(w.y & 0xffffu); a[3] = bf2f(w.y >> 16); return a; }
    else return ((const GAS f32x4*)row)[idx];
}
template <bool XB> __device__ __forceinline__ void modulate_row(const void* xr, const float* gn, const float* scv, const float* shv, bf16* orow, int lane, f32x4 (&y)[4]) {
    f32x4 v[4]; float ss = 0.f;
#pragma unroll
    for (int j = 0; j < 4; ++j) { v[j] = ldrow4<XB>(xr, lane + 64 * j); ss += (v[j].x * v[j].x + v[j].y * v[j].y) + (v[j].z * v[j].z + v[j].w * v[j].w); }
    const float rstd = 1.0f / sqrtf(wave_sum(ss) * (1.f / 1024.f) + EPS);
    GAS v2u* o8 = (GAS v2u*)orow + lane;
#pragma unroll
    for (int j = 0; j < 4; ++j) {
        const f32x4 g = ((const GAS f32x4*)gn)[lane + 64 * j], s = ((const GAS f32x4*)scv)[lane + 64 * j], h = ((const GAS f32x4*)shv)[lane + 64 * j];
        y[j] = (v[j] * rstd) * g * (s + 1.0f) + h;
        v2u w; w.x = pg8::cvt_pk_bf16(y[j].x, y[j].y); w.y = pg8::cvt_pk_bf16(y[j].z, y[j].w); o8[64 * j] = w; }
}
template <bool XB> __device__ __forceinline__ void modulate_phase(const Ctx& C, const void* xl, const void* xcs, const float* gn, const float* modl, int shidx, int scidx, bf16* H, int nrows) {
    const int lane = C.lane;
    for (int r0 = C.gw; r0 < nrows; r0 += 2 * C.NGW) {
        const int r1 = r0 + C.NGW; const bool has1 = r1 < nrows; const int r1c = has1 ? r1 : r0;
        const void* xr0; const void* xr1; const int b0 = r0 < ML ? (r0 >> 12) : 16, b1 = r1c < ML ? (r1c >> 12) : 16;
        if constexpr (XB) { xr0 = (const bf16*)xl + (size_t)r0 * DM; xr1 = (const bf16*)xl + (size_t)r1c * DM; }
        else { xr0 = r0 < ML ? (const float*)xl + (size_t)r0 * DM : (const float*)xcs + (size_t)(r0 - ML) * DM; xr1 = r1c < ML ? (const float*)xl + (size_t)r1c * DM : (const float*)xcs + (size_t)(r1c - ML) * DM; }
        f32x4 v0[4], v1[4]; float s0 = 0.f, s1 = 0.f;
#pragma unroll
        for (int j = 0; j < 4; ++j) { v0[j] = ldrow4<XB>(xr0, lane + 64 * j); v1[j] = ldrow4<XB>(xr1, lane + 64 * j); }
#pragma unroll
        for (int j = 0; j < 4; ++j) { s0 += (v0[j].x * v0[j].x + v0[j].y * v0[j].y) + (v0[j].z * v0[j].z + v0[j].w * v0[j].w); s1 += (v1[j].x * v1[j].x + v1[j].y * v1[j].y) + (v1[j].z * v1[j].z + v1[j].w * v1[j].w); }
        const float rs0 = 1.0f / sqrtf(wave_sum(s0) * (1.f / 1024.f) + EPS), rs1 = 1.0f / sqrtf(wave_sum(s1) * (1.f / 1024.f) + EPS);
        const float* m0 = modl + (size_t)b0 * 6144; const float* m1 = modl + (size_t)b1 * 6144;
        GAS v2u* o0 = (GAS v2u*)(H + (size_t)r0 * DM) + lane; GAS v2u* o1 = (GAS v2u*)(H + (size_t)r1c * DM) + lane;
#pragma unroll
        for (int j = 0; j < 4; ++j) {
            const f32x4 g = ((const GAS f32x4*)gn)[lane + 64 * j];
            const f32x4 sa = ((const GAS f32x4*)(m0 + scidx * 1024))[lane + 64 * j], ha = ((const GAS f32x4*)(m0 + shidx * 1024))[lane + 64 * j];
            const f32x4 ya = (v0[j] * rs0) * g * (sa + 1.0f) + ha;
            v2u w; w.x = pg8::cvt_pk_bf16(ya.x, ya.y); w.y = pg8::cvt_pk_bf16(ya.z, ya.w); o0[64 * j] = w;
            if (has1) { const f32x4 sb = ((const GAS f32x4*)(m1 + scidx * 1024))[lane + 64 * j], hb = ((const GAS f32x4*)(m1 + shidx * 1024))[lane + 64 * j];
                const f32x4 yb = (v1[j] * rs1) * g * (sb + 1.0f) + hb;
                v2u w2; w2.x = pg8::cvt_pk_bf16(yb.x, yb.y); w2.y = pg8::cvt_pk_bf16(yb.z, yb.w); o1[64 * j] = w2; }
        }
    }
}

using pg8::f32x4; using pg8::u32x4; using pg8::Unit; using pg8::cvt_pk_bf16;
__device__ __forceinline__ u32x4 pack8(const f32x4& a, const f32x4& b) { u32x4 w; w.x = cvt_pk_bf16(a[0], a[1]); w.y = cvt_pk_bf16(a[2], a[3]); w.z = cvt_pk_bf16(b[0], b[1]); w.w = cvt_pk_bf16(b[2], b[3]); return w; }
__device__ __forceinline__ void unpack8(const u32x4& w, f32x4& a, f32x4& b) {
    a[0] = bf2f(w.x & 0xffffu); a[1] = bf2f(w.x >> 16); a[2] = bf2f(w.y & 0xffffu); a[3] = bf2f(w.y >> 16);
    b[0] = bf2f(w.z & 0xffffu); b[1] = bf2f(w.z >> 16); b[2] = bf2f(w.w & 0xffffu); b[3] = bf2f(w.w >> 16); }

#ifndef NT_BIG
#define NT_BIG 0
#endif
#if NT_BIG
#define ST16(p, v) __builtin_nontemporal_store((v), (p))
#else
#define ST16(p, v) (*(p) = (v))
#endif
struct EpiBig {
    static constexpr bool PERM = true, AFTER_DRAIN = false;
    unsigned char* wsb; const LAS float* rope;
    __device__ __forceinline__ void operator()(const f32x4 (&acc)[2][2][4][2], const Unit& u, int wr, int wc, int fr, int fq) const {
        const int R0 = u.pm * 256, pn = u.pn; const bool isctx = R0 >= ML;
        const int cin = 32 * wc + 8 * fq;
        if (pn < 12) {
            const int kind = pn >> 2;
            bf16* base = (bf16*)(wsb + WS_Q + (size_t)kind * (WS_K - WS_Q));
            long rowadd = 0;
            if (kind != 0) rowadd = isctx ? ((long)((R0 - ML) >> 8) * SKV + SEQ - R0) : ((long)(R0 >> 12) * (SKV - SEQ));
            const bool rot = (kind != 2) && !isctx; const int axis = wc & 1; const float qs = kind == 0 ? QSCALE : 1.f;
#pragma unroll
            for (int ai = 0; ai < 2; ++ai)
#pragma unroll
                for (int m = 0; m < 4; ++m) {
                    const int r = R0 + ai * 128 + wr * 64 + m * 16 + fr;
                    f32x4 t0 = {1.f, 0.f, 1.f, 0.f}, t1 = {1.f, 0.f, 1.f, 0.f};
                    if (rot) { const int t = r & 4095; const int pos = axis == 0 ? (t >> 6) : (t & 63); const LAS f32x4* tp = (const LAS f32x4*)(rope + (pos * 16 + 4 * fq) * 2); t0 = tp[0]; t1 = tp[1]; }
                    bf16* rowp = base + (size_t)((long)r + rowadd) * DM + (pn & 3) * 256 + cin;
#pragma unroll
                    for (int bj = 0; bj < 2; ++bj) {
                        const f32x4 a = acc[ai][bj][m][0], b = acc[ai][bj][m][1]; f32x4 oa, ob;
                        oa[0] = (a[0] * t0[0] - a[1] * t0[1]) * qs; oa[1] = (a[1] * t0[0] + a[0] * t0[1]) * qs; oa[2] = (a[2] * t0[2] - a[3] * t0[3]) * qs; oa[3] = (a[3] * t0[2] + a[2] * t0[3]) * qs;
                        ob[0] = (b[0] * t1[0] - b[1] * t1[1]) * qs; ob[1] = (b[1] * t1[0] + b[0] * t1[1]) * qs; ob[2] = (b[2] * t1[2] - b[3] * t1[3]) * qs; ob[3] = (b[3] * t1[2] + b[2] * t1[3]) * qs;
                        ST16((GAS u32x4*)(rowp + bj * 128), pack8(oa, ob)); }
                }
        } else if (pn < 18) {
            const int kind = (pn - 12) >> 1;
            bf16* base = (bf16*)(wsb + WS_P0 + (size_t)kind * (WS_P1 - WS_P0)); const int c0 = ((pn - 12) & 1) * 256 + cin;
#pragma unroll
            for (int ai = 0; ai < 2; ++ai)
#pragma unroll
                for (int m = 0; m < 4; ++m) {
                    const int r = R0 + ai * 128 + wr * 64 + m * 16 + fr; bf16* rowp = base + (size_t)r * 512 + c0;
#pragma unroll
                    for (int bj = 0; bj < 2; ++bj) {
                        f32x4 a = acc[ai][bj][m][0], b = acc[ai][bj][m][1];
                        if (kind < 2) {
#pragma unroll
                            for (int q = 0; q < 4; ++q) { a[q] = gelu_tanh_f(a[q]); b[q] = gelu_tanh_f(b[q]); } }
                        ST16((GAS u32x4*)(rowp + bj * 128), pack8(a, b)); }
                }
        } else {
            const int c0 = (pn - 18) * 128 + cin;
#pragma unroll
            for (int ai = 0; ai < 2; ++ai)
#pragma unroll
                for (int m = 0; m < 4; ++m) {
                    const int r = R0 + ai * 128 + wr * 64 + m * 16 + fr;
                    const f32x4 a = acc[ai][0][m][0] * acc[ai][1][m][0], b = acc[ai][0][m][1] * acc[ai][1][m][1];
                    ST16((GAS u32x4*)((bf16*)(wsb + WS_P3) + (size_t)r * 512 + c0), pack8(a, b)); }
        }
    }
};

struct EpiGate {
    static constexpr bool PERM = true, AFTER_DRAIN = false;
    unsigned char* wsb; const LAS float* bias;
    __device__ __forceinline__ void operator()(const f32x4 (&acc)[2][2][4][2], const Unit& u, int wr, int wc, int fr, int fq) const {
        const int R0 = u.pm * 256, pn = u.pn, br = pn >> 2, cin = 32 * wc + 8 * fq;
        const size_t boff = br == 0 ? WS_K : (br == 1 ? WS_V : ((pn & 2) ? WS_P3 : WS_P1));
        bf16* base = (bf16*)(wsb + boff); const int ld = br == 2 ? 512 : 1024, c0 = (br == 2 ? (pn & 1) : (pn & 3)) * 256 + cin;
        f32x4 bv[2][2];
#pragma unroll
        for (int bj = 0; bj < 2; ++bj)
#pragma unroll
            for (int n = 0; n < 2; ++n) bv[bj][n] = *(const LAS f32x4*)(bias + pn * 256 + bj * 128 + cin + 4 * n);
#pragma unroll
        for (int ai = 0; ai < 2; ++ai)
#pragma unroll
            for (int m = 0; m < 4; ++m) {
                const int r = R0 + ai * 128 + wr * 64 + m * 16 + fr; bf16* rowp = base + (size_t)r * ld + c0;
#pragma unroll
                for (int bj = 0; bj < 2; ++bj) {
                    f32x4 a = acc[ai][bj][m][0] + bv[bj][0], b = acc[ai][bj][m][1] + bv[bj][1];
#pragma unroll
                    for (int q = 0; q < 4; ++q) { a[q] = sigmoid_f(a[q]); b[q] = sigmoid_f(b[q]); }
                    ST16((GAS u32x4*)(rowp + bj * 128), pack8(a, b)); }
            }
    }
};

struct EpiMerge {
    static constexpr bool PERM = true, AFTER_DRAIN = false;
    bf16* Y; const bf16* G0; long g1off; int gld; int gsplit_tiles;
    int first; int dry;
    __device__ __forceinline__ void operator()(const f32x4 (&acc)[2][2][4][2], const Unit& u, int wr, int wc, int fr, int fq) const {
        const int R0 = u.pm * 256, pn = u.pn, cin = 32 * wc + 8 * fq;
        const bf16* gb = G0 + (pn < gsplit_tiles ? (long)pn * 256 : g1off + (long)(pn - gsplit_tiles) * 256);
#pragma unroll
        for (int ai = 0; ai < 2; ++ai)
#pragma unroll
            for (int m = 0; m < 4; ++m) {
                const int r = R0 + ai * 128 + wr * 64 + m * 16 + fr; bf16* yp = Y + (size_t)r * DM + pn * 256 + cin; const bf16* gp = gb + (size_t)r * gld + cin;
#pragma unroll
                for (int bj = 0; bj < 2; ++bj) {
                    const u32x4 gw = *(const GAS u32x4*)(gp + bj * 128); f32x4 ga, gb2; unpack8(gw, ga, gb2);
                    f32x4 a = acc[ai][bj][m][0] * ga, b = acc[ai][bj][m][1] * gb2;
                    if (!first) { const u32x4 yw = *(const GAS u32x4*)(yp + bj * 128); f32x4 ya, yb; unpack8(yw, ya, yb); a += ya; b += yb; }
                    if (!dry) *(GAS u32x4*)(yp + bj * 128) = pack8(a, b); }
            }
    }
};

template <bool INF32>
struct EpiResid {
    static constexpr bool PERM = true, AFTER_DRAIN = false;
    const void* xb; bf16* xo; long cbd; const float* modl; int slot; int dry;
    __device__ __forceinline__ void operator()(const f32x4 (&acc)[2][2][4][2], const Unit& u, int wr, int wc, int fr, int fq) const {
        const int R0 = u.pm * 256; const bool isctx = R0 >= ML; const int b = isctx ? 16 : (R0 >> 12);
        const int col0 = u.pn * 256 + wc * 32 + 8 * fq; const float* gp = modl + (size_t)b * 6144 + slot * 1024 + col0;
        f32x4 gv[2][2];
#pragma unroll
        for (int bj = 0; bj < 2; ++bj)
#pragma unroll
            for (int n = 0; n < 2; ++n) gv[bj][n] = *(const GAS f32x4*)(gp + bj * 128 + n * 4);
#pragma unroll
        for (int ai = 0; ai < 2; ++ai)
#pragma unroll
            for (int m = 0; m < 4; ++m) { const size_t off = (size_t)(R0 + ai * 128 + wr * 64 + m * 16 + fr) * DM + col0;
#pragma unroll
                for (int bj = 0; bj < 2; ++bj) {
                    f32x4 b0, b1;
                    if constexpr (INF32) { const float* base = (const float*)xb + (isctx ? cbd : 0l); b0 = *(const GAS f32x4*)(base + off + bj * 128); b1 = *(const GAS f32x4*)(base + off + bj * 128 + 4); }
                    else { const u32x4 w = *(const GAS u32x4*)((const bf16*)xb + off + bj * 128); unpack8(w, b0, b1); }
                    const f32x4 r0 = b0 + gv[bj][0] * acc[ai][bj][m][0], r1 = b1 + gv[bj][1] * acc[ai][bj][m][1];
                    u32x4 o; o.x = pg8::cvt_pk_bf16(r0[0], r0[1]); o.y = pg8::cvt_pk_bf16(r0[2], r0[3]); o.z = pg8::cvt_pk_bf16(r1[0], r1[1]); o.w = pg8::cvt_pk_bf16(r1[2], r1[3]);
                    if (!dry) *(GAS u32x4*)(xo + off + bj * 128) = o; }
            }
    }
};

struct EpiSwiGLU {
    static constexpr bool PERM = true, AFTER_DRAIN = false;
    bf16* ACT; int ld, pm0, npe;
    __device__ __forceinline__ void operator()(const f32x4 (&acc)[2][2][4][2], const Unit& u, int wr, int wc, int fr, int fq) const {
        const int R0 = (u.pm - pm0) * 256, jt = u.pn % npe, c0 = jt * 128 + 32 * wc + 8 * fq;
#pragma unroll
        for (int ai = 0; ai < 2; ++ai)
#pragma unroll
            for (int m = 0; m < 4; ++m) {
                const int r = R0 + ai * 128 + wr * 64 + m * 16 + fr; f32x4 a, b;
#pragma unroll
                for (int q = 0; q < 4; ++q) { a[q] = silu_f(acc[ai][0][m][0][q]) * acc[ai][1][m][0][q]; b[q] = silu_f(acc[ai][0][m][1][q]) * acc[ai][1][m][1][q]; }
#ifdef NT_ACT
                __builtin_nontemporal_store(pack8(a, b), (GAS u32x4*)(ACT + (size_t)r * ld + c0)); }
#else
                *(GAS u32x4*)(ACT + (size_t)r * ld + c0) = pack8(a, b); }
#endif
    }
};

struct EpiStoreBf16 {
    static constexpr bool PERM = true, AFTER_DRAIN = false;
    bf16* O; int ld, pm0, npe;
    __device__ __forceinline__ void operator()(const f32x4 (&acc)[2][2][4][2], const Unit& u, int wr, int wc, int fr, int fq) const {
        const int R0 = (pm0 + u.pm) * 256, c0 = (u.pn % npe) * 256 + 32 * wc + 8 * fq;
#pragma unroll
        for (int ai = 0; ai < 2; ++ai)
#pragma unroll
            for (int m = 0; m < 4; ++m) { bf16* rowp = O + (size_t)(R0 + ai * 128 + wr * 64 + m * 16 + fr) * ld + c0;
#pragma unroll
#ifdef NT_PAIR
                for (int bj = 0; bj < 2; ++bj) __builtin_nontemporal_store(pack8(acc[ai][bj][m][0], acc[ai][bj][m][1]), (GAS u32x4*)(rowp + bj * 128)); }
#else
                for (int bj = 0; bj < 2; ++bj) *(GAS u32x4*)(rowp + bj * 128) = pack8(acc[ai][bj][m][0], acc[ai][bj][m][1]); }
#endif
    }
};

struct MoeOrder {
    static constexpr bool GATHER = false;
    pg8::StaticOrder so; int tile0, npe; bool a_global; const volatile LAS int* offl;
    __device__ __forceinline__ bool next(int i, Unit& u) const {
        Unit v; if (!so.next(i, v)) return false;
        const int gt = tile0 + v.pm, row = gt * 256; int e = 0;
#pragma unroll
        for (int q = 1; q < 8; ++q) e += (offl[q] <= row) ? 1 : 0;
        u.pm = a_global ? gt : v.pm; u.pn = e * npe + v.pn; return true;
    }
    __device__ __forceinline__ void a_ready(const Unit&) const {}
    __device__ __forceinline__ void done(const Unit&) const {}
};

struct MoeOrderG {
    static constexpr bool GATHER = true;
    MoeOrder mo; const unsigned* rowmap;
    __device__ __forceinline__ bool next(int i, Unit& u) const { return mo.next(i, u); }
    __device__ __forceinline__ void a_ready(const Unit&) const {}
    __device__ __forceinline__ void done(const Unit&) const {}
};

struct GateOrder {
    static constexpr bool GATHER = false;
    pg8::StaticOrder so;
    __device__ __forceinline__ bool next(int i, Unit& u) const { Unit v; if (!so.next(i / 3, v)) return false; u.pm = v.pm; u.pn = v.pn + 4 * (i % 3); return true; }
    __device__ __forceinline__ void a_ready(const Unit&) const {}
    __device__ __forceinline__ void done(const Unit&) const {}
};

struct BigOrderL1 {
    static constexpr bool GATHER = false;
    pg8::StaticOrder so; int G, c;
    __device__ __forceinline__ bool next(int i, Unit& u) const {
        const int L = i * G + c, nlat = (ML / 256) * (NBIG / 256);
        if (L < nlat) return so.next(i, u);
        const int k = L - nlat; if (k >= (MC / 256) * 8) return false;
        u.pm = ML / 256 + (k >> 3); u.pn = 4 + (k & 7); return true;
    }
    __device__ __forceinline__ void a_ready(const Unit&) const {}
    __device__ __forceinline__ void done(const Unit&) const {}
};


namespace att {
using bf16x8 = __attribute__((ext_vector_type(8))) short;
using s16x4  = __attribute__((ext_vector_type(4))) short;
using f32x16 = __attribute__((ext_vector_type(16))) float;
constexpr int NW = 8, QBLK = 32, KVBLK = 64, LD = 1024;
constexpr int SHM_V = KVBLK * 128 * 2, SHM_K = KVBLK * 128 * 2, SHM_ATTN = 2 * SHM_V + 2 * SHM_K + NW * 64 * 4;
#define KSWZ(row, colB) ((row) * 256 + ((colB) ^ (((row) & 7) << 4)))
#define SBAR() __builtin_amdgcn_sched_barrier(0)
__device__ __forceinline__ int crow(int r, int hi) { return (r & 3) + 8 * (r >> 2) + 4 * hi; }
__device__ __forceinline__ unsigned cvtpk(float lo, float hi) { return pg8::cvt_pk_bf16(lo, hi); }

__device__ __forceinline__ void partialSM(f32x16& p0) {
#pragma unroll
  for (int r = 0; r < 16; ++r) p0[r] = __builtin_amdgcn_exp2f(p0[r]);
}
__device__ __forceinline__ void finishSM(f32x16& p0, f32x16& p1, float& l_reg, bf16x8& pa0, bf16x8& pa1, bf16x8& pa2, bf16x8& pa3) {
#pragma unroll
  for (int r = 0; r < 16; ++r) p1[r] = __builtin_amdgcn_exp2f(p1[r]);
  float ps = 0;
#pragma unroll
  for (int r = 0; r < 16; ++r) ps += p0[r];
#pragma unroll
  for (int r = 0; r < 16; ++r) ps += p1[r];
  l_reg += ps;
#define PK4(P, BASE, OUT) do { unsigned a0 = cvtpk(P[BASE + 0], P[BASE + 1]), a1 = cvtpk(P[BASE + 2], P[BASE + 3]);   \
    unsigned b0 = cvtpk(P[BASE + 4], P[BASE + 5]), b1 = cvtpk(P[BASE + 6], P[BASE + 7]);                              \
    auto r0 = __builtin_amdgcn_permlane32_swap(a0, b0, false, false); auto r1 = __builtin_amdgcn_permlane32_swap(a1, b1, false, false); \
    u32x4 w = {r0[0], r1[0], r0[1], r1[1]}; OUT = __builtin_bit_cast(bf16x8, w); } while (0)
  PK4(p0, 0, pa0); PK4(p0, 8, pa1); PK4(p1, 0, pa2); PK4(p1, 8, pa3);
#undef PK4
}
__device__ __forceinline__ void qkt(f32x16& p0, f32x16& p1, const LAS char* Ks, const bf16x8* qr, int r32, int hi, int mp) {
  p0 = f32x16{}; p1 = f32x16{};
#ifdef ATT_PRIO
  __builtin_amdgcn_s_setprio(1);
#endif
#pragma unroll
  for (int d0 = 0; d0 < 4; ++d0) { const int cb = (mp * 64 + d0 * 16 + hi * 8) * 2;
    const bf16x8 b0 = *(const LAS bf16x8*)(Ks + KSWZ(r32, cb));
    const bf16x8 b1 = *(const LAS bf16x8*)(Ks + KSWZ(32 + r32, cb));
    p0 = __builtin_amdgcn_mfma_f32_32x32x16_bf16(b0, qr[d0], p0, 0, 0, 0);
    p1 = __builtin_amdgcn_mfma_f32_32x32x16_bf16(b1, qr[d0], p1, 0, 0, 0); }
#ifdef ATT_PRIO
  __builtin_amdgcn_s_setprio(0);
#endif
}
__device__ __forceinline__ int v_st(int k, int c) { const int kk = (k & ~0xC) | ((k & 4) << 1) | ((k & 8) >> 1); return ((kk >> 3) * 4 + (c >> 5)) * 512 + ((kk & 7) * 32 + (c & 31)) * 2; }
__device__ __forceinline__ int v_rd_base(int lane) { return ((lane & 3) << 3) | (((lane >> 2) & 3) << 6) | (((lane >> 4) & 1) << 5) | (((lane >> 5) & 1) << 8); }
constexpr int v_rd_off(int d0, int ks, int half) { return d0 * 512 + ks * 4096 + half * 2048; }
template <int OFF> __device__ __forceinline__ s16x4 tr_read(int vb) {
  s16x4 r; asm volatile("ds_read_b64_tr_b16 %0, %1 offset:%2" : "=&v"(r) : "v"(vb), "i"(OFF) : "memory"); return r;
}
template <int D0> __device__ __forceinline__ void pv_one(f32x16& od, int vb, bf16x8 pa0, bf16x8 pa1, bf16x8 pa2, bf16x8 pa3) {
  const s16x4 l0 = tr_read<v_rd_off(D0, 0, 0)>(vb), h0 = tr_read<v_rd_off(D0, 0, 1)>(vb), l1 = tr_read<v_rd_off(D0, 1, 0)>(vb), h1 = tr_read<v_rd_off(D0, 1, 1)>(vb);
  const s16x4 l2 = tr_read<v_rd_off(D0, 2, 0)>(vb), h2 = tr_read<v_rd_off(D0, 2, 1)>(vb), l3 = tr_read<v_rd_off(D0, 3, 0)>(vb), h3 = tr_read<v_rd_off(D0, 3, 1)>(vb);
  asm volatile("s_waitcnt lgkmcnt(0)" ::: "memory"); SBAR();
#define PK(L, H) (bf16x8){L[0], L[1], L[2], L[3], H[0], H[1], H[2], H[3]}
  od = __builtin_amdgcn_mfma_f32_32x32x16_bf16(pa0, PK(l0, h0), od, 0, 0, 0);
  od = __builtin_amdgcn_mfma_f32_32x32x16_bf16(pa1, PK(l1, h1), od, 0, 0, 0);
  od = __builtin_amdgcn_mfma_f32_32x32x16_bf16(pa2, PK(l2, h2), od, 0, 0, 0);
  od = __builtin_amdgcn_mfma_f32_32x32x16_bf16(pa3, PK(l3, h3), od, 0, 0, 0);
#undef PK
}
__device__ __forceinline__ void pv_d0(f32x16* o, int vb, bf16x8 pa0, bf16x8 pa1, bf16x8 pa2, bf16x8 pa3) {
  pv_one<0>(o[0], vb, pa0, pa1, pa2, pa3); pv_one<1>(o[1], vb, pa0, pa1, pa2, pa3); pv_one<2>(o[2], vb, pa0, pa1, pa2, pa3); pv_one<3>(o[3], vb, pa0, pa1, pa2, pa3);
}

struct VFrag { s16x4 l0, h0, l1, h1, l2, h2, l3, h3; };
template <int D0> __device__ __forceinline__ void v_load(VFrag& f, int vb) {
  f.l0 = tr_read<v_rd_off(D0, 0, 0)>(vb); f.h0 = tr_read<v_rd_off(D0, 0, 1)>(vb); f.l1 = tr_read<v_rd_off(D0, 1, 0)>(vb); f.h1 = tr_read<v_rd_off(D0, 1, 1)>(vb);
  f.l2 = tr_read<v_rd_off(D0, 2, 0)>(vb); f.h2 = tr_read<v_rd_off(D0, 2, 1)>(vb); f.l3 = tr_read<v_rd_off(D0, 3, 0)>(vb); f.h3 = tr_read<v_rd_off(D0, 3, 1)>(vb);
}
__device__ __forceinline__ void pv_mma(f32x16& od, const VFrag& f, bf16x8 pa0, bf16x8 pa1, bf16x8 pa2, bf16x8 pa3) {
#define PK(L, H) (bf16x8){L[0], L[1], L[2], L[3], H[0], H[1], H[2], H[3]}
#ifdef ATT_PRIO
  __builtin_amdgcn_s_setprio(1);
#endif
  od = __builtin_amdgcn_mfma_f32_32x32x16_bf16(pa0, PK(f.l0, f.h0), od, 0, 0, 0);
  od = __builtin_amdgcn_mfma_f32_32x32x16_bf16(pa1, PK(f.l1, f.h1), od, 0, 0, 0);
  od = __builtin_amdgcn_mfma_f32_32x32x16_bf16(pa2, PK(f.l2, f.h2), od, 0, 0, 0);
  od = __builtin_amdgcn_mfma_f32_32x32x16_bf16(pa3, PK(f.l3, f.h3), od, 0, 0, 0);
#ifdef ATT_PRIO
  __builtin_amdgcn_s_setprio(0);
#endif
#undef PK
}
#define LWAIT(n) do { asm volatile("s_waitcnt lgkmcnt(" #n ")" ::: "memory"); SBAR(); } while (0)
__device__ __forceinline__ void pv_pipe(f32x16* o, int vb, VFrag& f0, bf16x8 pa0, bf16x8 pa1, bf16x8 pa2, bf16x8 pa3) {
  VFrag f1;
  v_load<1>(f1, vb); LWAIT(8); pv_mma(o[0], f0, pa0, pa1, pa2, pa3); SBAR();
  v_load<2>(f0, vb); LWAIT(8); pv_mma(o[1], f1, pa0, pa1, pa2, pa3); SBAR();
  v_load<3>(f1, vb); LWAIT(8); pv_mma(o[2], f0, pa0, pa1, pa2, pa3); SBAR();
  LWAIT(0); pv_mma(o[3], f1, pa0, pa1, pa2, pa3);
}

#ifndef ATT_VPIPE
#define ATT_VPIPE 1
#endif
#if ATT_VPIPE
#define ATT_STEP_BODY(b) qkt(p0, p1, K_lds + (b) * SHM_K, qr, r32, hi, mp); SBAR(); VFrag vf0; v_load<0>(vf0, vb0 + (b) * SHM_V); SBAR(); \
    partialSM(p0); finishSM(p0, p1, l_reg, pa0, pa1, pa2, pa3); SBAR(); pv_pipe(o, vb0 + (b) * SHM_V, vf0, pa0, pa1, pa2, pa3); SBAR();
#else
#define ATT_STEP_BODY(b) qkt(p0, p1, K_lds + (b) * SHM_K, qr, r32, hi, mp); partialSM(p0); finishSM(p0, p1, l_reg, pa0, pa1, pa2, pa3); SBAR(); pv_d0(o, vb0 + (b) * SHM_V, pa0, pa1, pa2, pa3); SBAR();
#endif
__device__ __forceinline__ void diff_attn_unit(const bf16* Qb_, const bf16* Kh_, const bf16* Vh_, bf16* Ob_, int NT,
                                               float lam, const float* subg_, float oml, LAS char* lds, bool dostore = true, int rot = 0) {
  const GAS bf16* Qb = (const GAS bf16*)Qb_; const GAS bf16* Kh = (const GAS bf16*)Kh_; const GAS bf16* Vh = (const GAS bf16*)Vh_; GAS bf16* Ob = (GAS bf16*)Ob_; const GAS float* subg = (const GAS float*)subg_;
  const int tid = threadIdx.x, wid = tid >> 6, lane = tid & 63, r32 = lane & 31, hi = lane >> 5, qg = wid >> 1, mp = wid & 1;
  LAS char* V_lds = lds; LAS char* K_lds = lds + 2 * SHM_V;
  LAS float* ws = (LAS float*)(lds + 2 * SHM_V + 2 * SHM_K) + wid * 64; LAS float* li_l = ws; LAS float* al_l = ws + 32;
  float l_reg = 0; f32x16 o[4] = {}; bf16x8 qr[4];
  const GAS bf16* Qw = Qb + (long)(qg * QBLK + r32) * LD + mp * 64 + hi * 8;
#pragma unroll
  for (int d0 = 0; d0 < 4; ++d0) qr[d0] = *(const GAS bf16x8*)(Qw + d0 * 16);
  const int vb0 = (int)(unsigned)(uintptr_t)V_lds + v_rd_base(lane);
  int offK[2], offV[2];
#pragma unroll
  for (int i = 0; i < 2; ++i) { const int c = wid * 2 + i;
    { const int row = 4 * c + (lane >> 4), p = (lane & 15) ^ (row & 7); offK[i] = row * LD + p * 8; }
    { const int st = 2 * c + (lane >> 5), li = lane & 31, kk = (st >> 2) * 8 + (li >> 2), col = (st & 3) * 32 + (li & 3) * 8, k = (kk & ~0xC) | ((kk & 8) >> 1) | ((kk & 4) << 1); offV[i] = k * LD + col; } }
#define DMA_TILE(b, k0) do { _Pragma("unroll") for (int i_ = 0; i_ < 2; ++i_) {                                                                              \
      __builtin_amdgcn_global_load_lds((const GAS unsigned*)(Kh + (long)(k0) * LD + offK[i_]), (LAS unsigned*)(K_lds + (b) * SHM_K + (wid * 2 + i_) * 1024), 16, 0, 0);  \
      __builtin_amdgcn_global_load_lds((const GAS unsigned*)(Vh + (long)(k0) * LD + offV[i_]), (LAS unsigned*)(V_lds + (b) * SHM_V + (wid * 2 + i_) * 1024), 16, 0, 0); } } while (0)
#define TILE_STEP(b, t) do { f32x16 p0, p1; bf16x8 pa0, pa1, pa2, pa3; SBAR();                                   \
    ATT_STEP_BODY(b)                                                                                              \
    asm volatile("s_waitcnt vmcnt(0)" ::: "memory"); __syncthreads();                                            \
    if ((t) + 2 < NT) DMA_TILE(b, KT((t) + 2) * KVBLK); } while (0)
#define KT(t_) (((t_) + rot) >= NT ? ((t_) + rot) - NT : ((t_) + rot))
  DMA_TILE(0, KT(0) * KVBLK); DMA_TILE(1, KT(1) * KVBLK); asm volatile("s_waitcnt vmcnt(0)" ::: "memory"); __syncthreads();
  for (int t = 0; t < NT; t += 2) { TILE_STEP(0, t); TILE_STEP(1, t + 1); }
#undef TILE_STEP
#undef DMA_TILE
#undef KT
  int lane_e = lane;
#if 1
  asm volatile("" : "+v"(lane_e));
#endif
  { auto rr = __builtin_amdgcn_permlane32_swap(__float_as_uint(l_reg), __float_as_uint(l_reg), false, false); l_reg = __uint_as_float(rr[0]) + __uint_as_float(rr[1]); }
  if (hi == 0) li_l[r32] = l_reg; asm volatile("s_waitcnt lgkmcnt(0)" ::: "memory");
  const int r32e = lane_e & 31, hie = lane_e >> 5;
  float rli[16];
#pragma unroll
  for (int r = 0; r < 16; ++r) rli[r] = __builtin_amdgcn_rcpf(li_l[crow(r, hie)]);
  __syncthreads();
  LAS float* X = (LAS float*)lds + qg * 4096;
  if (mp == 1) {
#pragma unroll
    for (int d0 = 0; d0 < 4; ++d0)
#pragma unroll
      for (int r = 0; r < 16; ++r) X[(d0 * 16 + r) * 64 + lane_e] = o[d0][r] * rli[r] * (-lam);
  }
  __syncthreads();
  if (mp == 0) {
#pragma unroll
    for (int d0 = 0; d0 < 4; ++d0) {
#pragma unroll
      for (int r = 0; r < 16; ++r) o[d0][r] = o[d0][r] * rli[r] + X[(d0 * 16 + r) * 64 + lane_e];
      asm volatile("" ::: "memory");
    }
    float g4[4];
#pragma unroll
    for (int d0 = 0; d0 < 4; ++d0) g4[d0] = subg[32 * d0 + r32e] * oml;
    GAS bf16* Ow = Ob + (long)(qg * QBLK) * LD;
#pragma unroll
    for (int r = 0; r < 16; ++r) {
      float ss = (o[0][r] * o[0][r] + o[1][r] * o[1][r]) + (o[2][r] * o[2][r] + o[3][r] * o[3][r]);
      ss += __shfl_xor(ss, 1); ss += __shfl_xor(ss, 2); ss += __shfl_xor(ss, 4); ss += __shfl_xor(ss, 8); ss += __shfl_xor(ss, 16);
      const float rs = 1.0f / sqrtf(ss * (1.f / 128.f) + EPS); const int orow = crow(r, hie);
#pragma unroll
      for (int d0 = 0; d0 < 4; ++d0) if (dostore) Ow[(long)orow * LD + d0 * 32 + r32e] = (bf16)f2bf(o[d0][r] * rs * g4[d0]);
    }
  }
  __syncthreads();
}

template <bool CTX>
__device__ __forceinline__ void diff_attn_units(const bf16* Q_, const bf16* K_, const bf16* V_, int first, int count, int stride,
                                                float lam, const float* subg_, float oml, LAS char* lds) {
  constexpr int NT = CTX ? CTXL / 64 : SKV / 64;
  if (first >= count) return;
  const GAS bf16* Qg = (const GAS bf16*)Q_; const GAS bf16* Kg = (const GAS bf16*)K_; const GAS bf16* Vg = (const GAS bf16*)V_; const GAS float* subg = (const GAS float*)subg_;
  const int tid = threadIdx.x, wid = tid >> 6, lane = tid & 63, r32 = lane & 31, hi = lane >> 5, qg = wid >> 1, mp = wid & 1;
  LAS char* V_lds = lds; LAS char* K_lds = lds + 2 * SHM_V;
  LAS float* ws = (LAS float*)(lds + 2 * SHM_V + 2 * SHM_K) + wid * 64; LAS float* li_l = ws;
  LAS float* X = (LAS float*)(lds + SHM_ATTN) + qg * 4096;
  const int vb0 = (int)(unsigned)(uintptr_t)V_lds + v_rd_base(lane);
  int offK[2], offV[2];
#pragma unroll
  for (int i = 0; i < 2; ++i) { const int c = wid * 2 + i;
    { const int row = 4 * c + (lane >> 4), p = (lane & 15) ^ (row & 7); offK[i] = row * LD + p * 8; }
    { const int st = 2 * c + (lane >> 5), li = lane & 31, kk = (st >> 2) * 8 + (li >> 2), col = (st & 3) * 32 + (li & 3) * 8, k = (kk & ~0xC) | ((kk & 8) >> 1) | ((kk & 4) << 1); offV[i] = k * LD + col; } }
#define UNIT_Q(u_) (CTX ? ((size_t)ML + ((u_) >> 4) * CTXL + ((u_) & 1) * 128) * DM + (((u_) >> 1) & 7) * 128 : ((size_t)((u_) >> 8) * SEQ + ((u_) & 31) * 128) * DM + (((u_) >> 5) & 7) * 128)
#define UNIT_K(u_) (CTX ? ((size_t)((u_) >> 4) * SKV + SEQ) * DM + (((u_) >> 1) & 7) * 128 : (size_t)((u_) >> 8) * SKV * DM + (((u_) >> 5) & 7) * 128)
#define UNIT_ROT(u_) (CTX ? 0 : ((u_) & 31) * 2)
#define DMA_TILE(b, k0) do { _Pragma("unroll") for (int i_ = 0; i_ < 2; ++i_) {                                                                              \
      __builtin_amdgcn_global_load_lds((const GAS unsigned*)(Kh + (long)(k0) * LD + offK[i_]), (LAS unsigned*)(K_lds + (b) * SHM_K + (wid * 2 + i_) * 1024), 16, 0, 0);  \
      __builtin_amdgcn_global_load_lds((const GAS unsigned*)(Vh + (long)(k0) * LD + offV[i_]), (LAS unsigned*)(V_lds + (b) * SHM_V + (wid * 2 + i_) * 1024), 16, 0, 0); } } while (0)
#define KT(t_) (((t_) + rot) >= NT ? ((t_) + rot) - NT : ((t_) + rot))
#define TILE_STEP(b, t) do { f32x16 p0, p1; bf16x8 pa0, pa1, pa2, pa3; SBAR();                                   \
    ATT_STEP_BODY(b)                                                                                              \
    asm volatile("s_waitcnt vmcnt(0)" ::: "memory"); __syncthreads();                                            \
    if ((t) + 2 < NT) DMA_TILE(b, KT((t) + 2) * KVBLK); } while (0)
  int u = first; int rot = UNIT_ROT(u);
  const GAS bf16* Kh = Kg + UNIT_K(u); const GAS bf16* Vh = Vg + UNIT_K(u); size_t qoff = UNIT_Q(u);
  bf16x8 qr[4];
  { const GAS bf16* Qw = Qg + qoff + (long)(qg * QBLK + r32) * LD + mp * 64 + hi * 8;
#pragma unroll
    for (int d0 = 0; d0 < 4; ++d0) qr[d0] = *(const GAS bf16x8*)(Qw + d0 * 16); }
  DMA_TILE(0, KT(0) * KVBLK); DMA_TILE(1, KT(1) * KVBLK); asm volatile("s_waitcnt vmcnt(0)" ::: "memory"); __syncthreads();
  for (;;) {
    float l_reg = 0; f32x16 o[4] = {};
    for (int t = 0; t < NT; t += 2) { TILE_STEP(0, t); TILE_STEP(1, t + 1); }
    GAS bf16* Ob = (GAS bf16*)Qg + qoff;
    const int un = u + stride; const bool has_next = un < count;
    if (has_next) {
      rot = UNIT_ROT(un); Kh = Kg + UNIT_K(un); Vh = Vg + UNIT_K(un); qoff = UNIT_Q(un);
      const GAS bf16* Qw = Qg + qoff + (long)(qg * QBLK + r32) * LD + mp * 64 + hi * 8;
#pragma unroll
      for (int d0 = 0; d0 < 4; ++d0) qr[d0] = *(const GAS bf16x8*)(Qw + d0 * 16);
      DMA_TILE(0, KT(0) * KVBLK); DMA_TILE(1, KT(1) * KVBLK);
    }
    int lane_e = lane; asm volatile("" : "+v"(lane_e));
    { auto rr = __builtin_amdgcn_permlane32_swap(__float_as_uint(l_reg), __float_as_uint(l_reg), false, false); l_reg = __uint_as_float(rr[0]) + __uint_as_float(rr[1]); }
    if (hi == 0) li_l[r32] = l_reg; asm volatile("s_waitcnt lgkmcnt(0)" ::: "memory");
    const int r32e = lane_e & 31, hie = lane_e >> 5;
    float rli[16];
#pragma unroll
    for (int r = 0; r < 16; ++r) rli[r] = __builtin_amdgcn_rcpf(li_l[crow(r, hie)]);
    if (mp == 1) {
#pragma unroll
      for (int d0 = 0; d0 < 4; ++d0)
#pragma unroll
        for (int r = 0; r < 16; ++r) X[(d0 * 16 + r) * 64 + lane_e] = o[d0][r] * rli[r] * (-lam);
    }
    asm volatile("s_waitcnt lgkmcnt(0)" ::: "memory"); __builtin_amdgcn_s_barrier(); asm volatile("" ::: "memory");
    if (mp == 0) {
#pragma unroll
      for (int d0 = 0; d0 < 4; ++d0) {
#pragma unroll
        for (int r = 0; r < 16; ++r) o[d0][r] = o[d0][r] * rli[r] + X[(d0 * 16 + r) * 64 + lane_e];
        asm volatile("" ::: "memory");
      }
      float g4[4];
#pragma unroll
      for (int d0 = 0; d0 < 4; ++d0) g4[d0] = subg[32 * d0 + r32e] * oml;
      GAS bf16* Ow = Ob + (long)(qg * QBLK) * LD;
#pragma unroll
      for (int r = 0; r < 16; ++r) {
        float ss = (o[0][r] * o[0][r] + o[1][r] * o[1][r]) + (o[2][r] * o[2][r] + o[3][r] * o[3][r]);
        ss += __shfl_xor(ss, 1); ss += __shfl_xor(ss, 2); ss += __shfl_xor(ss, 4); ss += __shfl_xor(ss, 8); ss += __shfl_xor(ss, 16);
        const float rs = 1.0f / sqrtf(ss * (1.f / 128.f) + EPS); const int orow = crow(r, hie);
#pragma unroll
        for (int d0 = 0; d0 < 4; ++d0) Ow[(long)orow * LD + d0 * 32 + r32e] = (bf16)f2bf(o[d0][r] * rs * g4[d0]);
      }
    }
    asm volatile("s_waitcnt vmcnt(0) lgkmcnt(0)" ::: "memory"); __syncthreads();
    if (!has_next) break;
    u = un;
  }
#undef TILE_STEP
#undef DMA_TILE
#undef KT
#undef UNIT_Q
#undef UNIT_K
#undef UNIT_ROT
}
#undef KSWZ
#undef SBAR
}

constexpr int VT_PITCH = 272;
constexpr int MIX_VT_BYTES = 512 * VT_PITCH;
constexpr int MIX_ST_OFF = MIX_VT_BYTES;
static_assert(MIX_ST_OFF + 1024 <= LDSCTL_OFF, "mixer LDS");
__device__ __forceinline__ void mixer_chunk(const Ctx& C, int ch, bf16* P0, const bf16* P1, bf16* P2, const bf16* P3,
                                            const float* ln_g, const float* ln_b, const bf16* aws  , const float* abs_  , const float* convw  , bool dostore = true) {
    const int row0 = ch * 128, tid = C.tid, lane = C.lane, wid = C.wave;
    LAS unsigned char* VT = C.lds; LAS f32x2* ST = (LAS f32x2*)(C.lds + MIX_ST_OFF);
#pragma unroll 2
    for (int i = 0; i < 16; ++i) {
        const int s = wid * 16 + i; const u32x4 w = *(const GAS u32x4*)(P1 + (size_t)(row0 + s) * 512 + lane * 8);
        f32x4 a, b; unpack8(w, a, b);
        const float mean = wave_sum((a[0] + a[1]) + (a[2] + a[3]) + (b[0] + b[1]) + (b[2] + b[3])) * (1.f / 512.f);
        a = a - mean; b = b - mean;
        const float var = wave_sum((a[0] * a[0] + a[1] * a[1]) + (a[2] * a[2] + a[3] * a[3]) + (b[0] * b[0] + b[1] * b[1]) + (b[2] * b[2] + b[3] * b[3])) * (1.f / 512.f);
        if (lane == 0) ST[s] = (f32x2){mean, 1.0f / sqrtf(var + EPS)};
    }
    __syncthreads();
    {
        const int s = tid & 127, q = tid >> 7; const f32x2 st = ST[s]; const bf16* src = P1 + (size_t)(row0 + s) * 512 + q * 128;
#pragma unroll 2
        for (int i = 0; i < 16; ++i) {
            const int c0 = q * 128 + i * 8; const u32x4 w = *(const GAS u32x4*)(src + i * 8); f32x4 a, b; unpack8(w, a, b);
            const f32x4 g0 = *(const GAS f32x4*)(ln_g + c0), g1 = *(const GAS f32x4*)(ln_g + c0 + 4), b0 = *(const GAS f32x4*)(ln_b + c0), b1 = *(const GAS f32x4*)(ln_b + c0 + 4);
            a = (a - st.x) * st.y * g0 + b0; b = (b - st.x) * st.y * g1 + b1;
#pragma unroll
            for (int e = 0; e < 4; ++e) { *(LAS bf16*)(VT + (c0 + e) * VT_PITCH + s * 2) = (bf16)f2bf(a[e]); *(LAS bf16*)(VT + (c0 + 4 + e) * VT_PITCH + s * 2) = (bf16)f2bf(b[e]); }
        }
    }
    __syncthreads();
    {
        const int g = wid, fr = lane & 15, fq = lane >> 4;
        const bf16* wg = aws + (size_t)g * 128 * 128;
#pragma unroll 1
        for (int th = 0; th < 2; ++th) {
            f32x4 acc[4][4];
#pragma unroll
            for (int ti = 0; ti < 4; ++ti)
#pragma unroll
                for (int ei = 0; ei < 4; ++ei) acc[ti][ei] = (f32x4){0.f, 0.f, 0.f, 0.f};
#pragma unroll 1
            for (int kk = 0; kk < 4; ++kk) {
                bf16x8 xf[4], yf[4];
#pragma unroll
                for (int ei = 0; ei < 4; ++ei) xf[ei] = *(const LAS bf16x8*)(VT + (g * 64 + 16 * ei + fr) * VT_PITCH + (32 * kk + 8 * fq) * 2);
#pragma unroll
                for (int ti = 0; ti < 4; ++ti) yf[ti] = *(const GAS bf16x8*)(wg + (size_t)(64 * th + 16 * ti + fr) * 128 + 32 * kk + 8 * fq);
#pragma unroll
                for (int ti = 0; ti < 4; ++ti)
#pragma unroll
                    for (int ei = 0; ei < 4; ++ei) acc[ti][ei] = __builtin_amdgcn_mfma_f32_16x16x32_bf16(xf[ei], yf[ti], acc[ti][ei], 0, 0, 0);
            }
#pragma unroll
            for (int ti = 0; ti < 4; ++ti) {
                const int t = 64 * th + 16 * ti + fr; const float bs = abs_[g * 128 + t];
#pragma unroll
                for (int ei = 0; ei < 4; ++ei) {
                    bf16* p = P0 + (size_t)(row0 + t) * 512 + g * 64 + 16 * ei + 4 * fq; const v2u uw = *(const GAS v2u*)p;
                    const f32x4 a = acc[ti][ei] + bs;
                    v2u ow; ow.x = cvt_pk_bf16(bf2f(uw.x & 0xffffu) * a[0], bf2f(uw.x >> 16) * a[1]); ow.y = cvt_pk_bf16(bf2f(uw.y & 0xffffu) * a[2], bf2f(uw.y >> 16) * a[3]);
                    if (dostore) *(GAS v2u*)p = ow; }
            }
        }
    }
    {
        const int c0 = lane * 8;
        f32x4 w0a = *(const GAS f32x4*)(convw + c0), w0b = *(const GAS f32x4*)(convw + c0 + 4), w1a = *(const GAS f32x4*)(convw + 512 + c0), w1b = *(const GAS f32x4*)(convw + 512 + c0 + 4),
              w2a = *(const GAS f32x4*)(convw + 1024 + c0), w2b = *(const GAS f32x4*)(convw + 1024 + c0 + 4);
#pragma unroll 2
        for (int i = 0; i < 16; ++i) {
            const int r = row0 + wid * 16 + i; const bool isctx = r >= ML; const int tseq = isctx ? ((r - ML) & 255) : (r & 4095), last = isctx ? 255 : 4095;
            const u32x4 zero = {0u, 0u, 0u, 0u};
            const u32x4 zm = tseq > 0 ? *(const GAS u32x4*)(P3 + (size_t)(r - 1) * 512 + c0) : zero;
            const u32x4 zc = *(const GAS u32x4*)(P3 + (size_t)r * 512 + c0);
            const u32x4 zp = tseq < last ? *(const GAS u32x4*)(P3 + (size_t)(r + 1) * 512 + c0) : zero;
            const u32x4 bw = *(const GAS u32x4*)(P2 + (size_t)r * 512 + c0);
            f32x4 ma, mb, ca, cb, pa, pb, ba, bb; unpack8(zm, ma, mb); unpack8(zc, ca, cb); unpack8(zp, pa, pb); unpack8(bw, ba, bb);
            const f32x4 ya = ba * (w0a * ma + w1a * ca + w2a * pa), yb = bb * (w0b * mb + w1b * cb + w2b * pb);
            if (dostore) *(GAS u32x4*)(P2 + (size_t)r * 512 + c0) = pack8(ya, yb);
        }
    }
    __syncthreads();
}

__device__ __forceinline__ void route_phase(const Ctx& C, const bf16* x, const float* gn, const float* modl, const float* w_router, bf16* H, unsigned* route, bool dry = false) {
    LAS float* Wl = (LAS float*)C.lds;
    for (int idx = C.tid; idx < 8192; idx += NTHREADS) { const int k = idx >> 3, e = idx & 7; Wl[((k & 3) + 4 * (k >> 8)) * 512 + ((k >> 2) & 63) * 8 + e] = w_router[idx]; }
    __syncthreads();
    const int RPW = (ML + C.NGW - 1) / C.NGW;
    const int lane = C.lane; const int r0 = C.gw * RPW;
    unsigned long long lc = 0ull;
    unsigned my_e = 0u, my_p = 0u; float my_w1 = 0.f, my_w2 = 0.f;
    for (int it = 0; it < RPW; ++it) {
        const int r = r0 + it; if (r >= ML) break;
        const int b = r >> 12; f32x4 y[4];
        modulate_row<true>(x + (size_t)r * DM, gn, modl + (size_t)b * 6144 + 4 * 1024, modl + (size_t)b * 6144 + 3 * 1024, H + (size_t)r * DM, lane, y);
        float lg[8];
#pragma unroll
        for (int e = 0; e < 8; ++e) lg[e] = 0.f;
#pragma unroll
        for (int j = 0; j < 4; ++j)
#pragma unroll
            for (int i = 0; i < 4; ++i) { const LAS f32x4* wp = (const LAS f32x4*)(Wl + (i + 4 * j) * 512 + lane * 8); const f32x4 wa = wp[0], wb = wp[1]; const float v = y[j][i];
                lg[0] += v * wa[0]; lg[1] += v * wa[1]; lg[2] += v * wa[2]; lg[3] += v * wa[3]; lg[4] += v * wb[0]; lg[5] += v * wb[1]; lg[6] += v * wb[2]; lg[7] += v * wb[3]; }
#pragma unroll
        for (int e = 0; e < 8; ++e) lg[e] = wave_sum(lg[e]);
        int i1 = 0; float v1 = lg[0];
#pragma unroll
        for (int e = 1; e < 8; ++e) if (lg[e] > v1) { v1 = lg[e]; i1 = e; }
        int i2 = -1; float v2 = -3.0e38f;
#pragma unroll
        for (int e = 0; e < 8; ++e) if (e != i1 && lg[e] > v2) { v2 = lg[e]; i2 = e; }
        const float w1 = 1.f / (1.f + __expf(v2 - v1)), w2 = 1.f - w1;
        const unsigned p1 = (unsigned)(lc >> (8 * i1)) & 0xffu; lc += 1ull << (8 * i1);
        const unsigned p2 = (unsigned)(lc >> (8 * i2)) & 0xffu; lc += 1ull << (8 * i2);
        if (lane == it) { my_e = (unsigned)i1 | ((unsigned)i2 << 8); my_p = p1 | (p2 << 8); my_w1 = w1; my_w2 = w2; }
    }
    unsigned base = 0u;
    if (lane < 8 && !dry) { const unsigned n = (unsigned)(lc >> (8 * lane)) & 0xffu; base = __hip_atomic_fetch_add((unsigned*)(C.ctl + CW_CNT + 64 * lane), n, __ATOMIC_RELAXED, __HIP_MEMORY_SCOPE_AGENT); }
    const unsigned b1 = __shfl(base, (int)(my_e & 0xffu)), b2 = __shfl(base, (int)(my_e >> 8));
    const int r = r0 + lane;
    if (lane < RPW && r < ML && !dry) { u32x4 w; w.x = my_e; w.y = __float_as_uint(my_w1); w.z = __float_as_uint(my_w2); w.w = b1 + (my_p & 0xffu); *(GAS u32x4*)(route + (size_t)r * 8) = w; route[(size_t)r * 8 + 4] = b2 + (my_p >> 8); }
}
__device__ __forceinline__ void moe_offsets(const Ctx& C, volatile LAS int* offl) {
    if (C.tid == 0) { int o = 0;
        for (int e = 0; e < 8; ++e) { const int c = (int)__hip_atomic_load((unsigned*)(C.ctl + CW_CNT + 64 * e), __ATOMIC_RELAXED, __HIP_MEMORY_SCOPE_AGENT); offl[e] = o; offl[16 + e] = c; o += (c + 255) & ~255; }
        offl[8] = o; }
    __syncthreads();
}
__device__ __forceinline__ void gather_phase(const Ctx& C, const bf16* H, bf16* HS, unsigned* route, const volatile LAS int* offl) {
    const int lane = C.lane;
    for (int t = C.gw; t < ML; t += C.NGW) {
        const u32x4 w = *(const GAS u32x4*)(route + (size_t)t * 8); const unsigned p2 = route[(size_t)t * 8 + 4];
        const int e1 = w.x & 0xff, e2 = (w.x >> 8) & 0xff; const int s1 = offl[e1] + (int)w.w, s2 = offl[e2] + (int)p2;
        const GAS u32x4* src = (const GAS u32x4*)(H + (size_t)t * DM) + lane; const u32x4 a = src[0], b = src[64];
        GAS u32x4* d1 = (GAS u32x4*)(HS + (size_t)s1 * DM) + lane; GAS u32x4* d2 = (GAS u32x4*)(HS + (size_t)s2 * DM) + lane;
        d1[0] = a; d1[64] = b; d2[0] = a; d2[64] = b;
        if (lane == 0) { route[(size_t)t * 8 + 5] = (unsigned)s1; route[(size_t)t * 8 + 6] = (unsigned)s2; }
    }
    for (int v = C.gw; v < 8 * 256; v += C.NGW) { const int e = v >> 8, i = v & 255; const int row = offl[e] + offl[16 + e] + i;
        if (row < offl[e + 1]) { GAS u32x4* d = (GAS u32x4*)(HS + (size_t)row * DM) + lane; const u32x4 z = {0u, 0u, 0u, 0u}; d[0] = z; d[64] = z; } }
}
__device__ __forceinline__ void rowmap_phase(const Ctx& C, unsigned* rowmap, unsigned* route, const volatile LAS int* offl) {
    for (int t = C.vcu * NTHREADS + C.tid; t < ML; t += C.G * NTHREADS) {
        const u32x4 w = *(const GAS u32x4*)(route + (size_t)t * 8); const unsigned p2 = route[(size_t)t * 8 + 4];
        const int e1 = w.x & 0xff, e2 = (w.x >> 8) & 0xff; const int s1 = offl[e1] + (int)w.w, s2 = offl[e2] + (int)p2;
        rowmap[s1] = (unsigned)t; rowmap[s2] = (unsigned)t;
        route[(size_t)t * 8 + 5] = (unsigned)s1; route[(size_t)t * 8 + 6] = (unsigned)s2;
    }
    for (int v = C.vcu * NTHREADS + C.tid; v < 8 * 256; v += C.G * NTHREADS) { const int e = v >> 8, i = v & 255; const int row = offl[e] + offl[16 + e] + i;
        if (row < offl[e + 1]) rowmap[row] = 0u; }
}
__device__ __forceinline__ void final_phase(const Ctx& C, const bf16* x16, float* xo, const bf16* HS, const unsigned* route, const float* modl, const float* fg, bool dry = false) {
    const int lane = C.lane;
    for (int t = C.gw; t < ML; t += C.NGW) {
        const u32x4 w = *(const GAS u32x4*)(route + (size_t)t * 8); const unsigned s1 = route[(size_t)t * 8 + 5], s2 = route[(size_t)t * 8 + 6];
        const float w1 = __uint_as_float(w.y), w2 = __uint_as_float(w.z); const int b = t >> 12;
        const float* g2 = modl + (size_t)b * 6144 + 5 * 1024;
        f32x4 v[4]; float ss = 0.f;
#pragma unroll
        for (int h = 0; h < 2; ++h) {
            const int c0 = h * 512 + lane * 8;
            const u32x4 oa = *(const GAS u32x4*)(HS + (size_t)s1 * DM + c0), ob = *(const GAS u32x4*)(HS + (size_t)s2 * DM + c0);
            f32x4 a0, a1, b0, b1; unpack8(oa, a0, a1); unpack8(ob, b0, b1);
            f32x4 x0, x1; { const u32x4 xw = *(const GAS u32x4*)(x16 + (size_t)t * DM + c0); unpack8(xw, x0, x1); }
            const f32x4 g0 = *(const GAS f32x4*)(g2 + c0), g1 = *(const GAS f32x4*)(g2 + c0 + 4);
            v[2 * h] = x0 + g0 * (a0 * w1 + b0 * w2); v[2 * h + 1] = x1 + g1 * (a1 * w1 + b1 * w2);
        }
#pragma unroll
        for (int j = 0; j < 4; ++j) ss += (v[j].x * v[j].x + v[j].y * v[j].y) + (v[j].z * v[j].z + v[j].w * v[j].w);
        const float rstd = 1.0f / sqrtf(wave_sum(ss) * (1.f / 1024.f) + EPS);
#pragma unroll
        for (int h = 0; h < 2; ++h) { const int c0 = h * 512 + lane * 8;
            const f32x4 f0 = *(const GAS f32x4*)(fg + c0), f1 = *(const GAS f32x4*)(fg + c0 + 4);
            if (!dry) { *(GAS f32x4*)(xo + (size_t)t * DM + c0) = v[2 * h] * rstd * f0; *(GAS f32x4*)(xo + (size_t)t * DM + c0 + 4) = v[2 * h + 1] * rstd * f1; } }
    }
}

#ifdef PROBE
constexpr int PR_BASE = 12288;
__device__ __forceinline__ unsigned hsh(unsigned x) { x ^= x >> 16; x *= 0x7feb352du; x ^= x >> 15; x *= 0x846ca68bu; x ^= x >> 16; return x; }
__device__ __forceinline__ float bfr(float f) { return bf2f(f2bf(f)); }
__device__ __forceinline__ float wdot(const bf16* a, const float* W, int ldw, int col, int K, int lane) {
    float s = 0.f; for (int k = lane; k < K; k += 64) s += bf2f(a[k]) * bfr(W[(size_t)k * ldw + col]); return wave_sum(s);
}
struct Probe {
    gu32* ctl; int tid, lane, wave; LAS float* sh;
    __device__ __forceinline__ void rec(int id, float got, float ref, float tol = 0.03f) const {
        const float err = fabsf(got - ref) / (fabsf(ref) + 0.05f);
        if (!(err <= tol)) { unsigned expect = 0u; if (__hip_atomic_compare_exchange_strong((unsigned*)(ctl + PR_BASE), &expect, (unsigned)id, __ATOMIC_RELAXED, __ATOMIC_RELAXED, __HIP_MEMORY_SCOPE_AGENT)) __hip_atomic_store((unsigned*)(ctl + PR_BASE + 1), __float_as_uint(err > 1e6f ? 1e6f : err), __ATOMIC_RELAXED, __HIP_MEMORY_SCOPE_AGENT); }
        else atomicMax((unsigned*)(ctl + PR_BASE + 2), __float_as_uint(err));
    }
};
#define RAWP(r, col) wdot(Hb + (size_t)(r) * DM, win, INC, (col), 1024, P.lane)

template <int L>
__device__ __forceinline__ void probe_after_mod1(const Probe& P, const Args& args, unsigned char* ws) {
    const float* mod = (const float*)(ws + WS_MOD) + (size_t)L * 17 * 6144; const bf16* Hb = (const bf16*)(ws + WS_H);
    for (int sidx = P.wave; sidx < 48; sidx += 8) {
        const unsigned hh = hsh(sidx * 977u + 13u + L * 7919u); const int b = hh % 17, j = (hh >> 8) % 6144;
        float s = 0.f; for (int k = P.lane; k < 1024; k += 64) { const float v = b < 16 ? args.in[1][b * 1024 + k] : args.in[3][k]; s += v / (1.f + __expf(-v)) * args.in[4][((size_t)L * 1024 + k) * 6144 + j]; }
        s = wave_sum(s) + args.in[5][L * 6144 + j];
        if (P.lane == 0) P.rec(1 + 20 * L, mod[(size_t)b * 6144 + j], s, 0.002f);
    }
    for (int sidx = P.wave; sidx < 64; sidx += 8) {
        const unsigned hh = hsh(sidx * 31337u + 5u + L); int r = hh % MA; if (sidx < 8) r = ML + (hh % MC); const int c = (hh >> 10) & 1023; const int b = r < ML ? (r >> 12) : 16;
        const float* xr = r < ML ? (L == 0 ? args.in[0] : (const float*)args.out) + (size_t)r * DM : (L == 0 ? args.in[2] : (const float*)(ws + WS_XC)) + (size_t)(r - ML) * DM;
        float ss = 0.f; for (int k = P.lane; k < 1024; k += 64) ss += xr[k] * xr[k]; ss = wave_sum(ss);
        const float ref = xr[c] * (1.f / sqrtf(ss / 1024.f + EPS)) * args.in[6][L * 1024 + c] * (1.f + mod[(size_t)b * 6144 + 1024 + c]) + mod[(size_t)b * 6144 + c];
        if (P.lane == 0) P.rec(2 + 20 * L, bf2f(Hb[(size_t)r * DM + c]), ref, 0.01f);
    }
}
template <int L>
__device__ __forceinline__ void probe_after_big(const Probe& P, const Args& args, unsigned char* ws) {
    const bf16* Hb = (const bf16*)(ws + WS_H); const float* win = args.in[8] + (size_t)L * 1024 * INC;
    for (int sidx = P.wave; sidx < 96; sidx += 8) {
        const unsigned hh = hsh(sidx * 7001u + 77u + L * 3u); int r = hh % ML; if ((sidx & 3) == 3) r = ML + (hh % MC);
        const bool isctx = r >= ML; const int b = isctx ? (r - ML) / CTXL : (r >> 12); const int t = isctx ? 0 : (r & 4095);
        const long krow = isctx ? (long)b * SKV + SEQ + (r - ML) % CTXL : (long)b * SKV + t;
        const int h = (hh >> 17) & 7, m = (hh >> 20) & 1, d = (hh >> 21) & 63;
        for (int qk = 0; qk < 2; ++qk) {
            const int a = d >> 5, wi = d & 31, i = wi & 15, half = wi >> 4;
            const int cbase = (qk == 0 ? 2560 : 3584) + h * 128 + m * 64 + 32 * a;
            const float x0 = RAWP(r, cbase + i), x1 = RAWP(r, cbase + 16 + i);
            float cs = 1.f, sn = 0.f;
            if (!isctx) { const float pos = (float)(a == 0 ? (t >> 6) : (t & 63)); const float inv = exp2f(-(float)i * (13.287712379549449f / 16.f)); const float ang = pos * inv; cs = cosf(ang); sn = sinf(ang); }
            float ref = half == 0 ? x0 * cs - x1 * sn : x1 * cs + x0 * sn; if (qk == 0) ref *= QSCALE;
            const int p = 32 * a + 2 * i + half;
            const bf16* buf = (const bf16*)(ws + (qk == 0 ? WS_Q : WS_K)); const long row = qk == 0 ? (long)r : krow;
            if (P.lane == 0) P.rec(3 + qk + 20 * L, bf2f(buf[(size_t)row * DM + h * 128 + m * 64 + p]), ref, 0.03f);
        }
        const int e = (hh >> 20) & 127;
        { const float ref = RAWP(r, 4608 + h * 128 + e); if (P.lane == 0) P.rec(5 + 20 * L, bf2f(((const bf16*)(ws + WS_V))[(size_t)krow * DM + h * 128 + e]), ref, 0.03f); }
        const int c = (hh >> 9) & 511;
        { const float ref = gelu_tanh_f(RAWP(r, c)); if (P.lane == 0) P.rec(6 + 20 * L, bf2f(((const bf16*)(ws + WS_P0))[(size_t)r * 512 + c]), ref, 0.03f); }
        { const float ref = gelu_tanh_f(RAWP(r, 512 + c)); if (P.lane == 0) P.rec(7 + 20 * L, bf2f(((const bf16*)(ws + WS_P1))[(size_t)r * 512 + c]), ref, 0.03f); }
        { const float ref = RAWP(r, 1024 + c); if (P.lane == 0) P.rec(8 + 20 * L, bf2f(((const bf16*)(ws + WS_P2))[(size_t)r * 512 + c]), ref, 0.03f); }
        { const float ref = RAWP(r, 1536 + c) * RAWP(r, 2048 + c); if (P.lane == 0) P.rec(9 + 20 * L, bf2f(((const bf16*)(ws + WS_P3))[(size_t)r * 512 + c]), ref, 0.04f); }
    }
}
template <int L>
__device__ __forceinline__ void probe_after_mix(const Probe& P, const Args& args, unsigned char* ws) {
    const bf16* Hb = (const bf16*)(ws + WS_H); const float* win = args.in[8] + (size_t)L * 1024 * INC;
    const bf16* P1 = (const bf16*)(ws + WS_P1); const bf16* P3 = (const bf16*)(ws + WS_P3);
#if EN_MIX
    for (int sidx = 0; sidx < 6; ++sidx) {
        const unsigned hh = hsh(sidx * 1237u + 3u + L); int r = hh % (L == 0 ? MA : ML); if (sidx == 5 && L == 0) r = ML + (hh % MC);
        const int c = (hh >> 12) & 511, g = c >> 6, row0 = r & ~127, tt = r & 127;
        __syncthreads();
        if (P.tid < 128) { const bf16* vr = P1 + (size_t)(row0 + P.tid) * 512; float s = 0.f; for (int k = 0; k < 512; ++k) s += bf2f(vr[k]); const float mean = s / 512.f; float q = 0.f; for (int k = 0; k < 512; ++k) { const float dlt = bf2f(vr[k]) - mean; q += dlt * dlt; }
            const float ln = (bf2f(vr[c]) - mean) * (1.f / sqrtf(q / 512.f + EPS)) * args.in[10][L * 512 + c] + args.in[11][L * 512 + c];
            P.sh[P.tid] = args.in[12][(((size_t)L * 8 + g) * 128 + tt) * 128 + P.tid] * ln; }
        __syncthreads();
        if (P.wave == 0) { float s = P.sh[P.lane] + P.sh[64 + P.lane]; s = wave_sum(s) + args.in[13][(L * 8 + g) * 128 + tt];
            const float gu = gelu_tanh_f(RAWP(r, c)); if (P.lane == 0) P.rec(10 + 20 * L, bf2f(((const bf16*)(ws + WS_P0))[(size_t)r * 512 + c]), bfr(gu) * s, 0.04f); }
    }
    for (int sidx = P.wave; sidx < 64; sidx += 8) {
        const unsigned hh = hsh(sidx * 4447u + 9u + L); int r = hh % (L == 0 ? MA : ML); if (sidx < 8) r = (sidx & 1) ? ((hh % BATCH) * SEQ + (sidx & 2 ? 0 : SEQ - 1)) : r; if (sidx >= 8 && sidx < 12 && L == 0) r = ML + (hh % BATCH) * CTXL + (sidx & 1 ? 0 : CTXL - 1);
        const int c = (hh >> 11) & 511; const bool isctx = r >= ML; const int tseq = isctx ? ((r - ML) & 255) : (r & 4095), last = isctx ? 255 : 4095;
        const float zm = tseq > 0 ? bf2f(P3[(size_t)(r - 1) * 512 + c]) : 0.f, zc = bf2f(P3[(size_t)r * 512 + c]), zp = tseq < last ? bf2f(P3[(size_t)(r + 1) * 512 + c]) : 0.f;
        const float bg = bfr(RAWP(r, 1024 + c)); const float* cw = args.in[14] + L * 1536;
        const float ref = bg * (cw[c] * zm + cw[512 + c] * zc + cw[1024 + c] * zp);
        if (P.lane == 0) P.rec(11 + 20 * L, bf2f(((const bf16*)(ws + WS_P2))[(size_t)r * 512 + c]), ref, 0.04f);
    }
#endif
#if EN_ATT
    LAS float* qv = P.sh;
    LAS float* s0 = P.sh + 128;
    LAS float* s1 = P.sh + 128 + 4352;
    LAS float* red = P.sh + 128 + 2 * 4352;
    LAS float* ov = red + 64;
    const float lam = ((const float*)(ws + WS_LAM))[L]; const float oml = L == 0 ? 0.8f : (1.f - (0.8f - 0.6f * 0.7408182206817179f));
    for (int sidx = 0; sidx < (L == 0 ? 5 : 3); ++sidx) {
        const unsigned hh = hsh(sidx * 9173u + 21u + L); const bool isctx = (L == 0 && sidx >= 3); const int b = hh % BATCH, h = (hh >> 8) & 7;
        const int r = isctx ? ML + b * CTXL + ((hh >> 12) % CTXL) : b * SEQ + ((hh >> 12) & 4095); const int t = r & 4095;
        const int nk = isctx ? CTXL : SKV; const long k0 = isctx ? (long)b * SKV + SEQ : (long)b * SKV;
        __syncthreads();
        for (int q = P.wave; q < 128; q += 8) {
            const int m = q >> 6, p = q & 63, a = p >> 5, i = (p & 31) >> 1, half = p & 1; const int cbase = 2560 + h * 128 + m * 64 + 32 * a;
            const float x0 = RAWP(r, cbase + i), x1 = RAWP(r, cbase + 16 + i); float cs = 1.f, sn = 0.f;
            if (!isctx) { const float pos = (float)(a == 0 ? (t >> 6) : (t & 63)); const float inv = exp2f(-(float)i * (13.287712379549449f / 16.f)); cs = cosf(pos * inv); sn = sinf(pos * inv); }
            if (P.lane == 0) qv[q] = bfr((half == 0 ? x0 * cs - x1 * sn : x1 * cs + x0 * sn) * QSCALE);
        }
        __syncthreads();
        const bf16* Kb = (const bf16*)(ws + WS_K); const bf16* Vb = (const bf16*)(ws + WS_V);
        for (int k = P.tid; k < nk; k += NTHREADS) { const bf16* kr = Kb + (size_t)(k0 + k) * DM + h * 128; float a0 = 0.f, a1 = 0.f; for (int dd = 0; dd < 64; ++dd) { a0 += qv[dd] * bf2f(kr[dd]); a1 += qv[64 + dd] * bf2f(kr[64 + dd]); } s0[k] = a0; s1[k] = a1; }
        __syncthreads();
        float m0 = -1e30f, m1 = -1e30f; for (int k = P.tid; k < nk; k += NTHREADS) { m0 = fmaxf(m0, s0[k]); m1 = fmaxf(m1, s1[k]); }
        for (int o = 1; o < 64; o <<= 1) { m0 = fmaxf(m0, __shfl_xor(m0, o)); m1 = fmaxf(m1, __shfl_xor(m1, o)); }
        if (P.lane == 0) { red[P.wave] = m0; red[8 + P.wave] = m1; } __syncthreads();
        m0 = red[0]; m1 = red[8]; for (int w = 1; w < 8; ++w) { m0 = fmaxf(m0, red[w]); m1 = fmaxf(m1, red[8 + w]); } __syncthreads();
        float l0 = 0.f, l1 = 0.f; for (int k = P.tid; k < nk; k += NTHREADS) { const float e0 = exp2f(s0[k] - m0), e1 = exp2f(s1[k] - m1); s0[k] = e0; s1[k] = e1; l0 += e0; l1 += e1; }
        l0 = wave_sum(l0); l1 = wave_sum(l1); if (P.lane == 0) { red[16 + P.wave] = l0; red[24 + P.wave] = l1; } __syncthreads();
        l0 = 0.f; l1 = 0.f; for (int w = 0; w < 8; ++w) { l0 += red[16 + w]; l1 += red[24 + w]; }
        if (P.tid < 128) { float acc = 0.f; for (int k = 0; k < nk; ++k) acc += (s0[k] / l0 - lam * s1[k] / l1) * bf2f(Vb[(size_t)(k0 + k) * DM + h * 128 + P.tid]); ov[P.tid] = acc; }
        __syncthreads();
        if (P.tid < 128) { float ss = 0.f; for (int e = 0; e < 128; ++e) ss += ov[e] * ov[e]; const float ref = ov[P.tid] * (1.f / sqrtf(ss / 128.f + EPS)) * args.in[16][L * 128 + P.tid] * oml;
            if ((P.tid & 15) == (sidx & 15) || P.tid == 77) P.rec((isctx ? 13 : 12) + 20 * L, bf2f(((const bf16*)(ws + WS_Q))[(size_t)r * DM + h * 128 + P.tid]), ref, 0.06f); }
    }
#endif
    __syncthreads();
}
template <int L>
__device__ __forceinline__ void probe_after_gate(const Probe& P, const Args& args, unsigned char* ws) {
    const bf16* Hb = (const bf16*)(ws + WS_H); const float* win = args.in[8] + (size_t)L * 1024 * INC;
    const bf16* WINb = (const bf16*)(ws + WS_WIN + L * WIN_BYTES);
    if (P.tid < 400) P.sh[16 + P.tid] = 0.f;
    __syncthreads();
    for (int sidx = P.wave; sidx < 96; sidx += 8) {
        const unsigned hh = hsh(sidx * 3301u + 11u + L); const int row = 5632 + (sidx % 3) * 1024 + ((hh >> 4) & 1023), k = (hh >> 16) & 1023;
        if (P.lane == 0) P.rec(13 + 20 * L, bf2f(WINb[(size_t)row * 1024 + k]), bfr(win[(size_t)k * INC + row]), 0.001f);
    }
    __syncthreads();
    for (int br = 0; br < 3; ++br) {
        for (int sidx = P.wave; sidx < 64; sidx += 8) {
            const unsigned hh = hsh(sidx * 5501u + 1u + L + br * 77u); const int r = hh % (L == 0 ? MA : ML), n = (hh >> 12) & 1023;
            const float ref = sigmoid_f(RAWP(r, 5632 + br * 1024 + n) + args.in[9][L * 3072 + br * 1024 + n]);
            const bf16* g = br == 0 ? (const bf16*)(ws + WS_K) + (size_t)r * DM + n : (br == 1 ? (const bf16*)(ws + WS_V) + (size_t)r * DM + n : (const bf16*)(ws + (n < 512 ? WS_P1 : WS_P3)) + (size_t)r * 512 + (n & 511));
            if (P.lane == 0) {
                const float got = bf2f(*g);
                if (fabsf(got - ref) / (fabsf(ref) + 0.05f) > 0.03f) { P.sh[16] = 1.f; const int sl = P.wave * 8 + (sidx >> 3); P.sh[128 + 2 * sl] = __uint_as_float((unsigned)((uintptr_t)g & 0xffffffffu)); P.sh[129 + 2 * sl] = __uint_as_float((unsigned)((uintptr_t)g >> 32)); P.sh[300 + sl] = ref; }
                else P.rec(14 + br + 20 * L, got, ref, 0.03f);
            }
        }
        __syncthreads();
        if (P.sh[16] != 0.f) {
            const GAS u32x4* tp = (const GAS u32x4*)args.in[25] + P.tid; u32x4 acc_ = {0u, 0u, 0u, 0u};
            for (int q_ = 0; q_ < 3072; ++q_) { const u32x4 v_ = tp[(size_t)q_ * 512]; acc_.x ^= v_.x; acc_.y ^= v_.y; acc_.z ^= v_.z; acc_.w ^= v_.w; }
            if ((acc_.x ^ acc_.y ^ acc_.z ^ acc_.w) == 0x12345677u) P.sh[100] = 1.f;
            __syncthreads();
            if (P.tid == 0) { for (int q = 0; q < 64; ++q) { const unsigned lo_ = __float_as_uint(P.sh[128 + 2 * q]), hi_ = __float_as_uint(P.sh[129 + 2 * q]); if (lo_ == 0u && hi_ == 0u) continue;
                const bf16* gq = (const bf16*)(((uintptr_t)hi_ << 32) | lo_); const unsigned* gw = (const unsigned*)((uintptr_t)gq & ~(uintptr_t)3); const int sh = ((uintptr_t)gq & 2) ? 16 : 0;
                const float g1 = bf2f((__hip_atomic_load(gw, __ATOMIC_RELAXED, __HIP_MEMORY_SCOPE_AGENT) >> sh) & 0xffffu); const float ref = P.sh[300 + q];
                const bool ok1 = fabsf(g1 - ref) / (fabsf(ref) + 0.05f) <= 0.03f; if (!ok1 && br == 0) {
                    const size_t eo = (size_t)(gq - (const bf16*)(ws + WS_K)); const int kr = (int)(eo >> 10), nn = (int)(eo & 1023); const int bb = kr / SKV, key = kr % SKV; const bool cx = key >= SEQ;
                    const int tok = cx ? ML + bb * CTXL + (key - SEQ) : bb * SEQ + key; const int hh2 = nn >> 7, mm = (nn >> 6) & 1, pp = nn & 63, aa = pp >> 5, ii = (pp & 31) >> 1, hf = pp & 1;
                    const int cb2 = 3584 + hh2 * 128 + mm * 64 + 32 * aa; float x0 = 0.f, x1 = 0.f;
                    for (int k = 0; k < 1024; ++k) { const float hv = bf2f(Hb[(size_t)tok * DM + k]); x0 += hv * bfr(win[(size_t)k * INC + cb2 + ii]); x1 += hv * bfr(win[(size_t)k * INC + cb2 + 16 + ii]); }
                    float cs = 1.f, sn = 0.f; if (!cx) { const float pos = (float)(aa == 0 ? (key >> 6) : (key & 63)); const float inv = exp2f(-(float)ii * (13.287712379549449f / 16.f)); cs = cosf(pos * inv); sn = sinf(pos * inv); }
                    const float kold = hf == 0 ? x0 * cs - x1 * sn : x1 * cs + x0 * sn;
                    if (fabsf(kold - g1) <= 0.03f * (fabsf(kold) + 0.05f)) { unsigned e9 = 0u; __hip_atomic_compare_exchange_strong((unsigned*)(P.ctl + PR_BASE + 6), &e9, 1u, __ATOMIC_RELAXED, __ATOMIC_RELAXED, __HIP_MEMORY_SCOPE_AGENT); }
                }
                if (!ok1) { unsigned expect = 0u; if (__hip_atomic_compare_exchange_strong((unsigned*)(P.ctl + PR_BASE + 3), &expect, __float_as_uint(g1) | 1u, __ATOMIC_RELAXED, __ATOMIC_RELAXED, __HIP_MEMORY_SCOPE_AGENT)) { __hip_atomic_store((unsigned*)(P.ctl + PR_BASE + 4), (unsigned)br + 1u, __ATOMIC_RELAXED, __HIP_MEMORY_SCOPE_AGENT); __hip_atomic_store((unsigned*)(P.ctl + PR_BASE + 5), __float_as_uint(ref), __ATOMIC_RELAXED, __HIP_MEMORY_SCOPE_AGENT); {
                        const size_t eo2 = (size_t)(gq - (const bf16*)(ws + WS_K)); const bf16* rb = (const bf16*)(ws + WS_K) + (eo2 & ~(size_t)63); int cr = 0, cc = 0;
                        for (int q2 = 0; q2 < 64; ++q2) { const float v2 = bf2f(rb[q2]); if (!(v2 >= 0.f && v2 <= 1.f)) ++cr; }
                        const size_t rr2 = (eo2 >> 10) & ~(size_t)63, nn2 = eo2 & 1023;
                        for (int q2 = 0; q2 < 64; ++q2) { const float v2 = bf2f(((const bf16*)(ws + WS_K))[(rr2 + q2) * 1024 + nn2]); if (!(v2 >= 0.f && v2 <= 1.f)) ++cc; }
                        int c16 = 0, c8 = 0; const size_t r0b = eo2 >> 10;
                        for (int q2 = 0; q2 < 64; ++q2) { const float v2 = bf2f(((const bf16*)(ws + WS_K))[(rr2 + q2) * 1024 + nn2]); const bool bad = !(v2 >= 0.f && v2 <= 1.f); if (bad && ((rr2 + q2) & 15) == (r0b & 15)) ++c16; if (bad && ((rr2 + q2) >> 3) == (r0b >> 3)) ++c8; }
                        unsigned m8 = 0u, g8 = 0u; for (int q2 = 0; q2 < 64; ++q2) { const float v2 = bf2f(((const bf16*)(ws + WS_K))[(rr2 + q2) * 1024 + nn2]); const bool bad = !(v2 >= 0.f && v2 <= 1.f); if (bad && ((rr2 + q2) >> 3) == (r0b >> 3)) m8 |= 1u << ((rr2 + q2) & 7); if (bad) g8 |= 1u << (q2 >> 3); }
                        __hip_atomic_store((unsigned*)(P.ctl + PR_BASE + 10), m8 | (g8 << 8), __ATOMIC_RELAXED, __HIP_MEMORY_SCOPE_AGENT);
                        __hip_atomic_store((unsigned*)(P.ctl + PR_BASE + 9), (unsigned)(c16 | (c8 << 8)), __ATOMIC_RELAXED, __HIP_MEMORY_SCOPE_AGENT);
                        __hip_atomic_store((unsigned*)(P.ctl + PR_BASE + 8), (unsigned)(cr | (cc << 8)), __ATOMIC_RELAXED, __HIP_MEMORY_SCOPE_AGENT); }
                    __hip_atomic_store((unsigned*)(P.ctl + PR_BASE + 7), (unsigned)(gq - (const bf16*)(ws + (br == 0 ? WS_K : (br == 1 ? WS_V : WS_P1)))), __ATOMIC_RELAXED, __HIP_MEMORY_SCOPE_AGENT); } } } }
        }
        __syncthreads();
    }
}
template <int L>
__device__ __forceinline__ void probe_after_wo(const Probe& P, const Args& args, unsigned char* ws) {
    const bf16* Hb = (const bf16*)(ws + WS_H); const float* win = args.in[8] + (size_t)L * 1024 * INC;
    const bf16* Y = (const bf16*)(ws + WS_K);
    for (int sidx = P.wave; sidx < 64; sidx += 8) {
        const unsigned hh = hsh(sidx * 811u + 17u + L); int r = hh % (L == 0 ? MA : ML); if (L == 0 && sidx < 8) r = ML + hh % MC; const int n = (hh >> 12) & 1023;
        const float ga = sigmoid_f(RAWP(r, 5632 + n) + args.in[9][L * 3072 + n]), gb = sigmoid_f(RAWP(r, 5632 + 1024 + n) + args.in[9][L * 3072 + 1024 + n]), gc = sigmoid_f(RAWP(r, 5632 + 2048 + n) + args.in[9][L * 3072 + 2048 + n]);
        const float pa = wdot((const bf16*)(ws + WS_P0) + (size_t)r * 512, args.in[17] + (size_t)L * 512 * 1024, 1024, n, 512, P.lane);
        const float pb = wdot((const bf16*)(ws + WS_P2) + (size_t)r * 512, args.in[18] + (size_t)L * 512 * 1024, 1024, n, 512, P.lane);
        const float pc = wdot((const bf16*)(ws + WS_Q) + (size_t)r * DM, args.in[19] + (size_t)L * 1024 * 1024, 1024, n, 1024, P.lane);
        if (P.lane == 0) P.rec(17 + 20 * L, bf2f(Y[(size_t)r * DM + n]), ga * pa + gb * pb + gc * pc, 0.05f);
        const float o = wdot(Y + (size_t)r * DM, args.in[20] + (size_t)L * 1024 * 1024, 1024, n, 1024, P.lane);
        const int b = r < ML ? (r >> 12) : 16; const float g1 = ((const float*)(ws + WS_MOD))[((size_t)L * 17 + b) * 6144 + 2048 + n];
        if (L == 0) { const float x0 = r < ML ? args.in[0][(size_t)r * DM + n] : args.in[2][(size_t)(r - ML) * DM + n];
            const float got = r < ML ? args.out[(size_t)r * DM + n] : ((const float*)(ws + WS_XC))[(size_t)(r - ML) * DM + n];
            if (P.lane == 0) P.rec(18, got - x0, g1 * o, 0.03f); }
    }
}
__device__ __forceinline__ void probe_after_ffn0(const Probe& P, const Args& args, unsigned char* ws) {
    const bf16* Hb = (const bf16*)(ws + WS_H); const bf16* ACT = (const bf16*)(ws + WS_ACT0);
    for (int sidx = P.wave; sidx < 64; sidx += 8) {
        const unsigned hh = hsh(sidx * 60013u + 5u); int r = hh % MA; if (sidx < 8) r = ML + hh % MC; const int j = (hh >> 10) % DFF;
        const float gt = wdot(Hb + (size_t)r * DM, args.in[21], DFF, j, 1024, P.lane), up = wdot(Hb + (size_t)r * DM, args.in[22], DFF, j, 1024, P.lane);
        if (P.lane == 0) P.rec(19, bf2f(ACT[(size_t)r * DFF + j]), silu_f(gt) * up, 0.04f);
    }
}
#undef RAWP
#endif


#define WSB() unsigned char* ws = launder_ptr(args.ws)
#define W_MOD ((float*)(ws + WS_MOD))
#define W_ROPE ((float*)(ws + WS_ROPE))
#define W_LAM ((float*)(ws + WS_LAM))
#define W_AWS ((bf16*)(ws + WS_AWS))
#define W_ROUTE ((unsigned*)(ws + WS_ROUTE))
#define W_X16 ((bf16*)(ws + WS_X16))
#define W_H ((bf16*)args.out)
#define W_P0 ((bf16*)(ws + WS_P0))
#define W_P1 ((bf16*)(ws + WS_P1))
#define W_P2 ((bf16*)(ws + WS_P2))
#define W_P3 ((bf16*)(ws + WS_P3))
#define W_Q ((bf16*)(ws + WS_Q))
#define W_K ((bf16*)(ws + WS_K))
#define W_V ((bf16*)(ws + WS_V))
#define W_MODL (W_MOD + (size_t)L * 17 * 6144)
#define W_WIN ((const bf16*)(ws + WS_WIN + L * WIN_BYTES))
#define W_WOUT ((const bf16*)(ws + WS_WOUT + L * WOUT_BYTES))
#define PH_ON (P.lo <= P.ph && P.ph < P.hi)
#ifdef PTIME
#define SEAM() do { if (P.lo <= P.ph && P.ph + 1 < P.hi) xcd_barrier(bar); if (blockIdx.x == 0 && C.tid == 0 && P.ph < 40) ((unsigned long long*)(C.ctl + 16384))[1 + P.ph] = rt(); ++P.ph; } while (0)
#else
#define SEAM() do { if (P.lo <= P.ph && P.ph + 1 < P.hi) xcd_barrier(bar); ++P.ph; } while (0)
#endif
#define ELEM_DELTA(a, b) ((long)(((intptr_t)(a) - (intptr_t)(b)) / 4))

#ifdef PROBE
#define PROBE_HOOK(FN) do { if (P.lo < P.ph && P.ph <= P.hi) { if (blockIdx.x == 0) { WSB(); const Probe PR{C.ctl, C.tid, C.lane, C.wave, (LAS float*)C.lds}; FN(PR, args, ws); } xcd_barrier(bar); } } while (0)
#else
#define PROBE_HOOK(FN) do { } while (0)
#endif

#ifndef REP_BIG
#define REP_BIG 1
#endif
#ifndef REP_GATE
#define REP_GATE 1
#endif
#ifndef REP_UP
#define REP_UP 1
#endif
#ifndef REP_MOEUP
#define REP_MOEUP 1
#endif
#ifndef REP_MOEDN
#define REP_MOEDN 1
#endif
#ifndef MOE_GATHER
#define MOE_GATHER 1
#endif
#ifndef ATT_XPF
#define ATT_XPF 0
#endif
#ifndef ATT_ROT
#define ATT_ROT(qb) ((qb) * 2)
#endif
template <int L, int BR>
__device__ __forceinline__ void merge_phase(const Ctx& C, const Args& args, const XcdBarrier& bar, PhaseCtl& P) {
    constexpr int mrows = L == 0 ? MA : ML;
    if (PH_ON) { WSB();
#if (EN_SITES >> 2) & 1
        constexpr size_t aoff = BR == 0 ? WS_P0 : (BR == 1 ? WS_P2 : WS_Q), goff = BR == 0 ? WS_K : (BR == 1 ? WS_V : WS_P1);
        constexpr int K = BR == 2 ? 1024 : 512;
        const bf16* Bt = W_WOUT + (BR == 0 ? 0 : (BR == 1 ? 512 * 1024 : 1024 * 1024));
        pg8::Gemm g{(const bf16*)(ws + aoff), Bt, mrows, 1024, K}; pg8::StaticOrder S; S.init(mrows, 1024, C.G, (int)blockIdx.x);
        EpiMerge E{W_K, (const bf16*)(ws + goff), (long)((WS_P3 - WS_P1) / 2), BR == 2 ? 512 : 1024, BR == 2 ? 2 : 4, BR == 0 ? 1 : 0, 0};
#ifdef DUP_MERGE
        if (L == 0) { EpiMerge Ed = E; Ed.dry = P.hi < 5000 ? 1 : 0; pg8::gemm_phase<EpiMerge, pg8::StaticOrder, PG8_ALIGN, PG8_SP2>(C.lds, g, S, Ed); }
#endif
        pg8::gemm_phase<EpiMerge, pg8::StaticOrder, PG8_ALIGN, PG8_SP2>(C.lds, g, S, E);
#endif
    }
    if (BR == 2) SEAM(); else ++P.ph;
}

template <int L>
__device__ __forceinline__ void layer_body(const Ctx& C, const Args& args, const XcdBarrier& bar, PhaseCtl& P, volatile LAS int* offl) {
    constexpr int mrows = L == 0 ? MA : ML;
    if (PH_ON) { WSB(); if constexpr (L == 0) modulate_phase<false>(C, args.in[0], args.in[2], args.in[6], W_MODL, 0, 1, W_H, MA); else modulate_phase<true>(C, W_X16, nullptr, args.in[6] + 1024, W_MODL, 0, 1, W_H, MA);
#ifdef REP_MOD
        if (L == 0) modulate_phase<false>(C, args.in[0], args.in[2], args.in[6], W_MODL, 0, 1, W_H, MA);
#endif
    }
    SEAM();
    PROBE_HOOK(probe_after_mod1<L>);
    if (PH_ON) { WSB();
#if (EN_SITES >> 0) & 1
        LAS float* tab = (LAS float*)(C.lds + 131072);
        for (int i = C.tid; i < 2048; i += NTHREADS) tab[i] = W_ROPE[i];
        __syncthreads();
        pg8::Gemm g{W_H, W_WIN, MA, NBIG, 1024};
        EpiBig E{ws, tab};
        if constexpr (L == 0) { pg8::StaticOrder S; S.init(MA, NBIG, C.G, (int)blockIdx.x); pg8::gemm_phase<EpiBig, pg8::StaticOrder, PG8_ALIGN, PG8_SP2>(C.lds, g, S, E); }
        else { BigOrderL1 S; S.so.init(ML, NBIG, C.G, (int)blockIdx.x); S.G = C.G; S.c = (int)blockIdx.x; pg8::gemm_phase<EpiBig, BigOrderL1, PG8_ALIGN, PG8_SP2>(C.lds, g, S, E); }
#endif
    }
    SEAM();
    PROBE_HOOK(probe_after_big<L>);
    if (PH_ON) { WSB();
#ifdef PROBE_FILL2
        { GAS u32x4* kf = (GAS u32x4*)(ws + WS_K); const u32x4 pat = {0x46404640u, 0x46404640u, 0x46404640u, 0x46404640u};
          for (size_t i = (size_t)C.gw * 64 + C.lane; i < (size_t)MA * DM * 2 / 16; i += (size_t)C.NGW * 64) kf[i] = pat; }
#endif
#if EN_MIX
#ifdef DUP_MIX
        if (L == 0) for (int ch = C.vcu; ch < mrows / 128; ch += C.G)
            mixer_chunk(C, ch, W_P0, W_P1, W_P2, W_P3, args.in[10] + L * 512, args.in[11] + L * 512, W_AWS + (size_t)L * 8 * 128 * 128, args.in[13] + L * 8 * 128, args.in[14] + L * 3 * 512, P.hi > 5000);
#endif
        for (int ch = C.vcu; ch < mrows / 128; ch += C.G)
            mixer_chunk(C, ch, W_P0, W_P1, W_P2, W_P3, args.in[10] + L * 512, args.in[11] + L * 512, W_AWS + (size_t)L * 8 * 128 * 128, args.in[13] + L * 8 * 128, args.in[14] + L * 3 * 512);
#endif
#if EN_ATT
        const float lam = W_LAM[L]; constexpr float oml = L == 0 ? 0.8f : (1.f - (0.8f - 0.6f * 0.7408182206817179f)); const float* subg = args.in[16] + L * 128;
#if ATT_XPF
        att::diff_attn_units<false>(W_Q, W_K, W_V, C.vcu, BATCH * 8 * 32, C.G, lam, subg, oml, (LAS char*)C.lds);
        if (L == 0) att::diff_attn_units<true>(W_Q, W_K, W_V, C.vcu, BATCH * 8 * 2, C.G, lam, subg, oml, (LAS char*)C.lds);
#else
#ifdef DUP_ATT
        const int nrep = L == 0 ? 2 : 1;
        for (int rep = 0; rep < nrep; ++rep)
        for (int u = C.vcu; u < BATCH * 8 * 32; u += C.G) {
            const int bh = u >> 5, qb = u & 31, b = bh >> 3, h = bh & 7;
            bf16* qp = W_Q + ((size_t)b * SEQ + qb * 128) * DM + h * 128;
            att::diff_attn_unit(qp, W_K + (size_t)b * SKV * DM + h * 128, W_V + (size_t)b * SKV * DM + h * 128, qp, SKV / 64, lam, subg, oml, (LAS char*)C.lds, rep + 1 == nrep);
        }
#else
        for (int u = C.vcu; u < BATCH * 8 * 32; u += C.G) {
            const int bh = u >> 5, qb = u & 31, b = bh >> 3, h = bh & 7;
            bf16* qp = W_Q + ((size_t)b * SEQ + qb * 128) * DM + h * 128;
            att::diff_attn_unit(qp, W_K + (size_t)b * SKV * DM + h * 128, W_V + (size_t)b * SKV * DM + h * 128, qp, SKV / 64, lam, subg, oml, (LAS char*)C.lds, true, ATT_ROT(qb));
        }
#endif
        if (L == 0) {
            for (int u = C.vcu; u < BATCH * 8 * 2; u += C.G) {
                const int b = u >> 4, h = (u >> 1) & 7, qb = u & 1;
                bf16* qp = W_Q + ((size_t)ML + b * CTXL + qb * 128) * DM + h * 128;
                att::diff_attn_unit(qp, W_K + ((size_t)b * SKV + SEQ) * DM + h * 128, W_V + ((size_t)b * SKV + SEQ) * DM + h * 128, qp, CTXL / 64, lam, subg, oml, (LAS char*)C.lds);
            }
        }
#endif
#endif
    }
    SEAM();
    PROBE_HOOK(probe_after_mix<L>);
    if (PH_ON) { WSB();
#if (EN_SITES >> 1) & 1
        pg8::Gemm g{W_H, W_WIN + (size_t)NBIG * 1024, mrows, 3072, 1024};
        LAS float* tab = (LAS float*)(C.lds + 131072);
        for (int i = C.tid; i < 3072; i += NTHREADS) tab[i] = args.in[9][L * 3072 + i];
        __syncthreads();
        EpiGate E{ws, tab};
        if constexpr (L == 0) {
            pg8::StaticOrder S; S.init(mrows, 3072, C.G, (int)blockIdx.x);
            pg8::gemm_phase<EpiGate, pg8::StaticOrder, PG8_ALIGN, PG8_SP2>(C.lds, g, S, E);
        } else {
            GateOrder S; S.so.init(mrows, 1024, C.G, (int)blockIdx.x);
            pg8::gemm_phase<EpiGate, GateOrder, PG8_ALIGN, PG8_SP2>(C.lds, g, S, E);
        }
#endif
    }
    if (L == 0) SEAM(); else ++P.ph;
#ifdef PROBE_SCAN
    if (L == 0) { WSB(); unsigned cntk = 0u, cntv = 0u;
        const GAS u32x4* kp = (const GAS u32x4*)(ws + WS_K); const GAS u32x4* vp = (const GAS u32x4*)(ws + WS_V);
        for (size_t i = (size_t)C.gw * 64 + C.lane; i < (size_t)MA * DM * 2 / 16; i += (size_t)C.NGW * 64) {
            const u32x4 a = kp[i], b = vp[i]; f32x4 x0, x1; unpack8(a, x0, x1);
            for (int q = 0; q < 4; ++q) { if (!(x0[q] >= 0.f && x0[q] <= 1.f)) ++cntk; if (!(x1[q] >= 0.f && x1[q] <= 1.f)) ++cntk; }
            unpack8(b, x0, x1);
            for (int q = 0; q < 4; ++q) { if (!(x0[q] >= 0.f && x0[q] <= 1.f)) ++cntv; if (!(x1[q] >= 0.f && x1[q] <= 1.f)) ++cntv; } }
        if (cntk) atomicAdd((unsigned*)(C.ctl + PR_BASE + 12), cntk); if (cntv) atomicAdd((unsigned*)(C.ctl + PR_BASE + 13), cntv);
        xcd_barrier(bar); }
#endif
    merge_phase<L, 0>(C, args, bar, P);
    merge_phase<L, 1>(C, args, bar, P);
    merge_phase<L, 2>(C, args, bar, P);
    if (PH_ON) { WSB();
#if (EN_SITES >> 3) & 1
        pg8::Gemm g{W_K, W_WOUT + 2 * 1024 * 1024, mrows, 1024, 1024}; pg8::StaticOrder S; S.init(mrows, 1024, C.G, (int)blockIdx.x);
        if constexpr (L == 0) { EpiResid<true> E{args.in[0], W_X16, ELEM_DELTA(args.in[2], args.in[0]) - (long)ML * DM, W_MODL, 2, 0};
            pg8::gemm_phase<EpiResid<true>, pg8::StaticOrder, PG8_ALIGN, PG8_SP2>(C.lds, g, S, E); }
        else { EpiResid<false> E{W_X16, W_X16, 0l, W_MODL, 2, 0};
            pg8::gemm_phase<EpiResid<false>, pg8::StaticOrder, PG8_ALIGN, PG8_SP2>(C.lds, g, S, E); }
#endif
    }
    SEAM();
    PROBE_HOOK(probe_after_wo<L>);
    if (L == 0) {
        if (PH_ON) { WSB(); modulate_phase<true>(C, W_X16, nullptr, args.in[7], W_MODL, 3, 4, W_H, MA); }
        SEAM();
        if (PH_ON) { WSB();
#if (EN_SITES >> 4) & 1
            pg8::Gemm g{W_H, (const bf16*)(ws + WS_WFU), MA, 2 * DFF, 1024}; pg8::StaticOrder S; S.init(MA, 2 * DFF, C.G, (int)blockIdx.x);
            EpiSwiGLU E{(bf16*)(ws + WS_ACT0), DFF, 0, 22};
            pg8::gemm_phase<EpiSwiGLU, pg8::StaticOrder, PG8_ALIGN, PG8_SP2>(C.lds, g, S, E);
        if (REP_UP > 1) {
#ifdef REP_BARRIER
            xcd_barrier(bar);
#endif
            pg8::gemm_phase<EpiSwiGLU, pg8::StaticOrder, PG8_ALIGN, PG8_SP2>(C.lds, g, S, E); }
#endif
        }
        SEAM();
        PROBE_HOOK(probe_after_ffn0);
        if (PH_ON) { WSB();
#if (EN_SITES >> 5) & 1
            pg8::Gemm g{(const bf16*)(ws + WS_ACT0), (const bf16*)(ws + WS_WFD), MA, 1024, DFF}; pg8::StaticOrder S; S.init(MA, 1024, C.G, (int)blockIdx.x);
            EpiResid<false> E{W_X16, W_X16, 0l, W_MODL, 5, 0};
            pg8::gemm_phase<EpiResid<false>, pg8::StaticOrder, PG8_ALIGN, PG8_SP2>(C.lds, g, S, E);
#endif
        }
        SEAM();
    } else {
        if (PH_ON) { WSB();
#ifdef DUP_ROUTE
            route_phase(C, W_X16, args.in[7] + 1024, W_MODL, args.in[24], W_H, W_ROUTE, P.hi < 5000); __syncthreads();
#endif
            route_phase(C, W_X16, args.in[7] + 1024, W_MODL, args.in[24], W_H, W_ROUTE);
            __syncthreads();
#ifdef REP_MOECVT
            for (int rep_ = 0; rep_ < 2; ++rep_)
#endif
            for (int e = 0; e < NEXP; ++e) {
                tr_matrix<2>(C, args.in[25] + (size_t)e * 1024 * DFE, args.in[26] + (size_t)e * 1024 * DFE, DFE, 1024, 2 * DFE, (bf16*)(ws + WS_MWU) + (size_t)e * 2 * DFE * 1024);
                tr_matrix<0>(C, args.in[27] + (size_t)e * DFE * 1024, nullptr, 1024, DFE, 1024, (bf16*)(ws + WS_MWD) + (size_t)e * 1024 * DFE);
            }
        }
        SEAM();
        if (P.lo < P.ph + 8 && P.ph < P.hi) moe_offsets(C, offl);
#if MOE_GATHER
        if (PH_ON) { WSB(); gather_phase(C, W_H, (bf16*)(ws + WS_HS), W_ROUTE, offl); }
#else
        if (PH_ON) { WSB(); rowmap_phase(C, (unsigned*)(ws + WS_RMAP), W_ROUTE, offl); }
#endif
        SEAM();
        for (int ck = 0; ck < 3; ++ck) {
            const int ntall = offl[8] >> 8; int nt = ntall - ck * MOE_CH; nt = nt < 0 ? 0 : (nt > MOE_CH ? MOE_CH : nt);
            if (PH_ON) { WSB();
#if (EN_SITES >> 6) & 1
                EpiSwiGLU E{(bf16*)(ws + WS_MACT), DFE, ck * MOE_CH, 28};
#if MOE_GATHER
                pg8::Gemm g{(const bf16*)(ws + WS_HS), (const bf16*)(ws + WS_MWU), nt * 256, 2 * DFE, 1024};
                MoeOrder S; S.so.init(nt * 256, 2 * DFE, C.G, (int)blockIdx.x); S.tile0 = ck * MOE_CH; S.npe = 28; S.a_global = true; S.offl = offl;
                pg8::gemm_phase<EpiSwiGLU, MoeOrder, PG8_ALIGN, PG8_SP2>(C.lds, g, S, E);
#else
                pg8::Gemm g{W_H, (const bf16*)(ws + WS_MWU), nt * 256, 2 * DFE, 1024};
                MoeOrderG S; S.mo.so.init(nt * 256, 2 * DFE, C.G, (int)blockIdx.x); S.mo.tile0 = ck * MOE_CH; S.mo.npe = 28; S.mo.a_global = true; S.mo.offl = offl; S.rowmap = (const unsigned*)(ws + WS_RMAP);
                pg8::gemm_phase<EpiSwiGLU, MoeOrderG, PG8_ALIGN, PG8_SP2>(C.lds, g, S, E);
#endif
#endif
            }
            SEAM();
            if (PH_ON) { WSB();
#if (EN_SITES >> 7) & 1
                pg8::Gemm g{(const bf16*)(ws + WS_MACT), (const bf16*)(ws + WS_MWD), nt * 256, 1024, DFE};
                MoeOrder S; S.so.init(nt * 256, 1024, C.G, (int)blockIdx.x); S.tile0 = ck * MOE_CH; S.npe = 4; S.a_global = false; S.offl = offl;
                EpiStoreBf16 E{(bf16*)(ws + WS_HS), 1024, ck * MOE_CH, 4};
                pg8::gemm_phase<EpiStoreBf16, MoeOrder, PG8_ALIGN, PG8_SP2>(C.lds, g, S, E);
        if (REP_MOEDN > 1) { pg8::gemm_phase<EpiStoreBf16, MoeOrder, PG8_ALIGN, PG8_SP2>(C.lds, g, S, E); }
#endif
            }
            SEAM();
        }
        if (PH_ON) { WSB();
#ifdef DUP_FINAL
            final_phase(C, W_X16, args.out, (const bf16*)(ws + WS_HS), W_ROUTE, W_MODL, args.in[28], P.hi < 5000);
#endif
            final_phase(C, W_X16, args.out, (const bf16*)(ws + WS_HS), W_ROUTE, W_MODL, args.in[28]); }
        SEAM();
    }
}

__global__ void __launch_bounds__(NTHREADS, 2) fwd_kernel(Args args) {
    extern __shared__ __attribute__((aligned(16))) unsigned char lds_raw[];
    Ctx C;
    C.lds = (LAS unsigned char*)lds_raw; C.ctl = (gu32*)(args.ws + WS_CTL);
    C.tid = threadIdx.x; C.lane = C.tid & 63; C.wave = __builtin_amdgcn_readfirstlane(C.tid >> 6);
    C.G = gridDim.x; { const int bx = blockIdx.x; C.vcu = (C.G % 8 == 0) ? (bx % 8) * (C.G / 8) + bx / 8 : bx; }
    C.gw = C.vcu * NWAVES + C.wave; C.NGW = C.G * NWAVES;
    volatile LAS unsigned* MISC = (volatile LAS unsigned*)(C.lds + LDSCTL_OFF);
    volatile LAS int* offl = (volatile LAS int*)(C.lds + LDSCTL_OFF + 64);
    if (C.tid < 64) MISC[C.tid] = 0u;
    __syncthreads();
    const XcdBarrier bar = xcd_barrier_post((unsigned*)(C.ctl + CW_BAR), MISC);
    PhaseCtl P{args.ph_lo, args.ph_hi, 0};
#ifdef PTIME
    if (blockIdx.x == 0 && C.tid == 0) ((unsigned long long*)(C.ctl + 16384))[0] = rt();
#endif

#if EN_PRO
    if (PH_ON) { WSB();
#ifdef REP_PRO
        for (int rep_ = 0; rep_ < 2; ++rep_)
#endif
        for (int l = 0; l < 2; ++l) {
            tr_matrix<1>(C, args.in[8] + (size_t)l * 1024 * INC, nullptr, INC, 1024, INC, (bf16*)(ws + WS_WIN + l * WIN_BYTES));
            bf16* wo = (bf16*)(ws + WS_WOUT + l * WOUT_BYTES);
            tr_matrix<0>(C, args.in[17] + (size_t)l * 512 * 1024, nullptr, 1024, 512, 1024, wo);
            tr_matrix<0>(C, args.in[18] + (size_t)l * 512 * 1024, nullptr, 1024, 512, 1024, wo + 512 * 1024);
            tr_matrix<0>(C, args.in[19] + (size_t)l * 1024 * 1024, nullptr, 1024, 1024, 1024, wo + 1024 * 1024);
            tr_matrix<0>(C, args.in[20] + (size_t)l * 1024 * 1024, nullptr, 1024, 1024, 1024, wo + 2 * 1024 * 1024);
        }
        tr_matrix<2>(C, args.in[21], args.in[22], DFF, 1024, 2 * DFF, (bf16*)(ws + WS_WFU));
        tr_matrix<0>(C, args.in[23], nullptr, 1024, DFF, 1024, (bf16*)(ws + WS_WFD));
        for (int i = C.gw * 64 + C.lane; i < 2 * 8 * 128 * 128; i += C.NGW * 64) W_AWS[i] = (bf16)f2bf(args.in[12][i]);
        __syncthreads();
        mod_phase(C, args.in[1], args.in[3], args.in[4], args.in[5], W_MOD);
        rope_lam_phase(C, args.in[15], W_ROPE, W_LAM);
#ifdef PROBE_FILL
        { GAS u32x4* kf = (GAS u32x4*)(ws + WS_K); const u32x4 pat = {0x46404640u, 0x46404640u, 0x46404640u, 0x46404640u};
          for (size_t i = (size_t)C.gw * 64 + C.lane; i < (size_t)MA * DM * 2 / 16; i += (size_t)C.NGW * 64) kf[i] = pat; }
#endif
    }
#endif
    SEAM();
    layer_body<0>(C, args, bar, P, offl);
#if NLAYERS > 1
    layer_body<1>(C, args, bar, P, offl);
#endif
#ifdef PTIME
    {
        xcd_barrier(bar);
        const unsigned long long* T = (const unsigned long long*)(C.ctl + 16384);
        const float ta = (float)(__hip_atomic_load(T + 1 + PT_A1, __ATOMIC_RELAXED, __HIP_MEMORY_SCOPE_AGENT) - __hip_atomic_load(T + PT_A0, __ATOMIC_RELAXED, __HIP_MEMORY_SCOPE_AGENT)) * 0.01f;
        const float tb = (float)(__hip_atomic_load(T + 1 + PT_B1, __ATOMIC_RELAXED, __HIP_MEMORY_SCOPE_AGENT) - __hip_atomic_load(T + PT_B0, __ATOMIC_RELAXED, __HIP_MEMORY_SCOPE_AGENT)) * 0.01f;
        const float bv = 8.f * sqrtf(tb);
        for (size_t i = (size_t)C.gw * 64 + C.lane; i < (size_t)ML * DM; i += (size_t)C.NGW * 64) args.out[i] = i == 0 ? ta : ((i >= 1024 && i < 1024 + (1u << 20)) ? bv : 0.f);
    }
#endif
#ifdef PROBE
    {
        xcd_barrier(bar);
        const unsigned id = __hip_atomic_load((unsigned*)(C.ctl + PR_BASE), __ATOMIC_RELAXED, __HIP_MEMORY_SCOPE_AGENT);
        const float e1 = __uint_as_float(__hip_atomic_load((unsigned*)(C.ctl + PR_BASE + 1), __ATOMIC_RELAXED, __HIP_MEMORY_SCOPE_AGENT)), e2 = __uint_as_float(__hip_atomic_load((unsigned*)(C.ctl + PR_BASE + 2), __ATOMIC_RELAXED, __HIP_MEMORY_SCOPE_AGENT));
        const float err = id ? e1 : e2; float code = err < 0.05f ? 1000.f * err : 50.f + 100.f * (err > 4.5f ? 4.5f : err); const float bv = 8.f * sqrtf(code);
        const unsigned sv = __hip_atomic_load((unsigned*)(C.ctl + PR_BASE + 3), __ATOMIC_RELAXED, __HIP_MEMORY_SCOPE_AGENT), sb = __hip_atomic_load((unsigned*)(C.ctl + PR_BASE + 4), __ATOMIC_RELAXED, __HIP_MEMORY_SCOPE_AGENT);
        float a0 = 100.f * (float)id, bvv = bv;
        const unsigned eoff = __hip_atomic_load((unsigned*)(C.ctl + PR_BASE + 7), __ATOMIC_RELAXED, __HIP_MEMORY_SCOPE_AGENT);
#ifndef PROBE_SEL
#define PROBE_SEL 0
#endif
        if (PROBE_SEL == 8 && false) {} else if (sv && PROBE_SEL == 1) { const unsigned rr = eoff >> 10, nn = eoff & 1023u; a0 = 100.f * (float)(nn >> 4); bvv = 8.f * sqrtf((float)(rr >> 10)); }
        else if (sv && PROBE_SEL == 2) { const unsigned rr = eoff >> 10, nn = eoff & 1023u; a0 = 100.f * (float)(nn & 15u) + 50.f; bvv = 8.f * sqrtf((float)((rr >> 4) & 63u)); }
        else if (sv && PROBE_SEL == 4) { const unsigned cw = __hip_atomic_load((unsigned*)(C.ctl + PR_BASE + 8), __ATOMIC_RELAXED, __HIP_MEMORY_SCOPE_AGENT); a0 = 100.f * (float)(cw & 0xffu) + 50.f; bvv = 8.f * sqrtf((float)(cw >> 8)); }
        else if (sv && PROBE_SEL == 5) { const unsigned cw = __hip_atomic_load((unsigned*)(C.ctl + PR_BASE + 9), __ATOMIC_RELAXED, __HIP_MEMORY_SCOPE_AGENT); a0 = 100.f * (float)(cw & 0xffu) + 50.f; bvv = 8.f * sqrtf((float)(cw >> 8)); }
        else if (sv && PROBE_SEL == 6) { const unsigned cw = __hip_atomic_load((unsigned*)(C.ctl + PR_BASE + 10), __ATOMIC_RELAXED, __HIP_MEMORY_SCOPE_AGENT); a0 = 100.f * (float)((cw >> 4) & 15u) + 50.f; bvv = 8.f * sqrtf((float)(cw & 15u)); }
        else if (sv && PROBE_SEL == 7) { const unsigned cw = __hip_atomic_load((unsigned*)(C.ctl + PR_BASE + 10), __ATOMIC_RELAXED, __HIP_MEMORY_SCOPE_AGENT) >> 8; a0 = 100.f * (float)((cw >> 4) & 15u) + 50.f; bvv = 8.f * sqrtf((float)(cw & 15u)); }
        else if (PROBE_SEL == 8) { const unsigned ck = __hip_atomic_load((unsigned*)(C.ctl + PR_BASE + 12), __ATOMIC_RELAXED, __HIP_MEMORY_SCOPE_AGENT), cv = __hip_atomic_load((unsigned*)(C.ctl + PR_BASE + 13), __ATOMIC_RELAXED, __HIP_MEMORY_SCOPE_AGENT);
            a0 = 100.f * (float)ck; bvv = 8.f * sqrtf((float)cv); }
        else if (sv && PROBE_SEL == 3) { const unsigned rr = eoff >> 10; a0 = 100.f * (float)(rr & 15u) + 50.f; bvv = 0.f; }
        else if (sv) { const float val = __uint_as_float(sv); a0 = 1000.f * fabsf(val); const unsigned ko = __hip_atomic_load((unsigned*)(C.ctl + PR_BASE + 6), __ATOMIC_RELAXED, __HIP_MEMORY_SCOPE_AGENT); bvv = 8.f * sqrtf(10.f * (float)sb + (val < 0.f ? 5.f : 0.f) + (ko ? 100.f : 0.f)); }
        for (size_t i = (size_t)C.gw * 64 + C.lane; i < (size_t)ML * DM; i += (size_t)C.NGW * 64) args.out[i] = i == 0 ? a0 : ((i >= 1024 && i < 1024 + (1u << 20)) ? bvv : 0.f);
    }
#endif
}
#undef PH_ON
#undef SEAM
#undef WSB

extern "C" void kernel_launch(void* const* d_in, const int* in_sizes, int n_in, void* d_out, int out_size, void* d_ws, size_t ws_size, hipStream_t stream) {
    static int grid = 0;
    if (grid == 0) {
        if (n_in != 29 || in_sizes[0] != ML * DM || out_size != ML * DM || ws_size < WS_END) {
            fprintf(stderr, "kernel_launch: shape mismatch: n_in %d in0 %d out %d ws %zu (need %zu); nothing launched\n", n_in, n_in > 0 ? in_sizes[0] : -1, out_size, ws_size, (size_t)WS_END); grid = -1; return; }
        int dev = 0, cus = 0, per_cu = 0;
        if (hipGetDevice(&dev) != hipSuccess || hipDeviceGetAttribute(&cus, hipDeviceAttributeMultiprocessorCount, dev) != hipSuccess) { fprintf(stderr, "kernel_launch: device query failed\n"); grid = -1; return; }
        if (hipFuncSetAttribute((const void*)fwd_kernel, hipFuncAttributeMaxDynamicSharedMemorySize, LDS_BYTES) != hipSuccess) { fprintf(stderr, "kernel_launch: hipFuncSetAttribute failed\n"); grid = -1; return; }
        if (hipOccupancyMaxActiveBlocksPerMultiprocessor(&per_cu, (const void*)fwd_kernel, NTHREADS, LDS_BYTES) != hipSuccess || per_cu < 1)
            fprintf(stderr, "kernel_launch: note: occupancy query reports %d workgroups per CU\n", per_cu);
        (void)hipGetLastError();
        grid = cus;
    }
    if (grid < 0) return;
    if (hipMemsetAsync((char*)d_ws + WS_CTL, 0, CTL_ZERO_BYTES, stream) != hipSuccess) { fprintf(stderr, "kernel_launch: memset failed\n"); return; }
    Args a{};
    for (int i = 0; i < 29; ++i) a.in[i] = (const float*)d_in[i];
    a.out = (float*)d_out; a.ws = (unsigned char*)d_ws; a.ph_lo = 0; a.ph_hi = 1000;
    hipLaunchKernelGGL(fwd_kernel, dim3(grid), dim3(NTHREADS), LDS_BYTES, stream, a);
    const hipError_t le = hipPeekAtLastError();
    if (le != hipSuccess) fprintf(stderr, "kernel_launch: launch failed: %s\n", hipGetErrorName(le));
}
```

```cpp
#include <hip/hip_runtime.h>
#include <cstdio>
#include <cstdint>
namespace pg8 {
#define PG8_LAS __attribute__((address_space(3)))
typedef unsigned short bf16_t;
typedef short bf16x8 __attribute__((ext_vector_type(8)));
typedef float f32x4 __attribute__((ext_vector_type(4)));
typedef unsigned u32x4 __attribute__((ext_vector_type(4)));
constexpr int BM = 256, BK = 64, HALF = 128, HTB = HALF * BK * 2  , STAGE_BYTES = 8 * HTB, NXCD = 8, WGM = 8;

__host__ __device__ __forceinline__ int lds_byte(int r, int c) { const int st = (r >> 4) * 2 + (c >> 5), rr = r & 15, cc = c & 31, ob = rr * 64 + cc * 2; return st * 1024 + (ob ^ (((ob >> 9) & 1) << 5)); }
__host__ __device__ __forceinline__ void stage_rc(int b, int& R, int& C) { const int st = b / 1024, sb = b % 1024, swz = sb ^ (((sb >> 9) & 1) << 5); R = (st >> 1) * 16 + swz / 64; C = (st & 1) * 32 + (swz % 64) / 2; }
__host__ __device__ __forceinline__ int perm32(int rho) { const int n = rho >> 4, i = rho & 15; return 8 * (i >> 2) + 4 * n + (i & 3); }

struct Unit { int pm, pn; };
struct Gemm { const bf16_t* A; const bf16_t* Bt; int M, N, K; };

struct StaticOrder {
    static constexpr bool GATHER = false;
    int nM, nN, nwg, G, c;
    __host__ __device__ void init(int M, int N, int G_, int c_) { nM = M / BM; nN = N / BM; nwg = nM * nN; G = G_; c = c_; }
    __host__ __device__ bool next(int i, Unit& u) const {
        const long L = (long)i * G + c; if (L >= nwg) return false;
        int wgid = (int)L; { const int q = nwg / NXCD, r = nwg % NXCD, xcd = wgid % NXCD, off = wgid / NXCD; wgid = (xcd < r ? xcd * (q + 1) : r * (q + 1) + (xcd - r) * q) + off; }
        const int nig = WGM * nN, gid = wgid / nig, fm = gid * WGM, gsz = (nM - fm) < WGM ? (nM - fm) : WGM;
        u.pm = fm + ((wgid % nig) % gsz); u.pn = (wgid % nig) / gsz; return true;
    }
    __device__ __forceinline__ void a_ready(const Unit&) const {}
    __device__ __forceinline__ void done(const Unit&) const {}
};

typedef float cvt_f32x2 __attribute__((ext_vector_type(2))); typedef __bf16 cvt_bf16x2 __attribute__((ext_vector_type(2)));
__device__ __forceinline__ unsigned cvt_pk_bf16(float lo, float hi) { const cvt_f32x2 v = {lo, hi}; const cvt_bf16x2 b = __builtin_convertvector(v, cvt_bf16x2); return __builtin_bit_cast(unsigned, b); }
typedef float f32x2 __attribute__((ext_vector_type(2)));
__device__ __forceinline__ f32x2 gelu_pk(f32x2 v) {
    const f32x2 av = __builtin_elementwise_abs(v), d = av * 0.2316418882f + 1.0f;
    f32x2 t; t.x = __builtin_amdgcn_rcpf(d.x); t.y = __builtin_amdgcn_rcpf(d.y);
    f32x2 q = t * 0.5307027145f + (-0.7265760135f); q = q * t + 0.7107068705f; q = q * t + (-0.142248368f); q = q * t + 0.127414796f; q = q * t;
    const f32x2 s = (v * v) * (-0.72134752044f);
    f32x2 e; e.x = __builtin_amdgcn_exp2f(s.x); e.y = __builtin_amdgcn_exp2f(s.y);
    const f32x2 m = v * (q * e), r = v - m;
    f32x2 o; o.x = v.x < 0.f ? m.x : r.x; o.y = v.y < 0.f ? m.y : r.y; return o;
}


template <class Epi, class Sched, bool ALIGN_EPI = false, bool SP2 = false>
__device__ __forceinline__ void gemm_phase(PG8_LAS unsigned char* lds, const Gemm g, const Sched& S, const Epi& E) {
    const int tid = threadIdx.x, wid = __builtin_amdgcn_readfirstlane(tid >> 6), lane = tid & 63, wr = wid >> 2, wc = wid & 3, fr = lane & 15, fq = lane >> 4;
    const int K = g.K, nt = K / BK;
    unsigned voffA[2], voffB[2];
#pragma unroll
    for (int i = 0; i < 2; ++i) { int R, C; stage_rc(tid * 16 + i * 8192, R, C); const int Rb = Epi::PERM ? ((R & ~31) + perm32(R & 31)) : R;
        voffA[i] = (unsigned)(R * K + C) * 2u; voffB[i] = (unsigned)(Rb * K + C) * 2u; }
    const size_t kstep = (size_t)(BK * 2);
    constexpr bool GA = Sched::GATHER;
    unsigned gC[2][2]; int grow[2];
    PG8_LAS unsigned* const rmap_lds = (PG8_LAS unsigned*)(lds + 8 * HTB);
    if constexpr (GA) { int R, C; stage_rc(tid * 16, R, C); grow[0] = R; stage_rc(tid * 16 + 8192, R, C); grow[1] = R; }
#ifndef PG8_KROT
#define PG8_KROT 0
#endif
    static_assert(SP2 || !Sched::GATHER, "gathered A rows are written for the SP2 loop only");
    static_assert(SP2 || !PG8_KROT, "the K-slice rotation is written for the SP2 loop only");
    const int krot = PG8_KROT ? (int)((blockIdx.x >> 3) % (unsigned)(K / BK)) : 0;
#define PG8_KO(j) ((size_t)(((j) + krot) >= nt ? ((j) + krot) - nt : ((j) + krot)) * kstep)
    const size_t hstep = (size_t)HALF * K * 2;
    const size_t tstep = 2 * hstep;
    const unsigned ldsw = (unsigned)wid * 1024u;
    const int aoff = lds_byte(wr * 64 + fr, fq * 8), boff = lds_byte(wc * 32 + fr, fq * 8);
#define PG8_SA(b, h) (((b) * 2 + (h)) * HTB)
#define PG8_SB(b, h) ((4 + (b) * 2 + (h)) * HTB)
#define PG8_STAGE(bufoff, gbase, voff) do { _Pragma("unroll") for (int _i = 0; _i < 2; ++_i) \
        __builtin_amdgcn_global_load_lds((const unsigned*)((const char*)(gbase) + (voff)[_i]), (PG8_LAS unsigned*)(lds + (bufoff) + ldsw + _i * 8192), 16, 0, 0); } while (0)
#define PG8_STAGE_A(bufoff, base, h) do { if constexpr (GA) { PG8_STAGE(bufoff, base, gC[h]); } else { PG8_STAGE(bufoff, (base) + (h) * hstep, voffA); } } while (0)
#define PG8_GC_FROM(src, scale_) do { _Pragma("unroll") for (int h_ = 0; h_ < 2; ++h_) _Pragma("unroll") for (int i_ = 0; i_ < 2; ++i_) gC[h_][i_] = (src)[128 * h_ + grow[i_]] * (unsigned)(scale_) + (voffA[i_] - (unsigned)grow[i_] * (unsigned)(scale_)); } while (0)
#define PG8_LDA(dst, b, h) do { _Pragma("unroll") for (int m = 0; m < 4; ++m) _Pragma("unroll") for (int k = 0; k < 2; ++k) dst[m][k] = *(const PG8_LAS bf16x8*)(lds + PG8_SA(b, h) + aoff + m * 2048 + k * 1024); } while (0)
#define PG8_LDB(dst, b, h) do { _Pragma("unroll") for (int n = 0; n < 2; ++n) _Pragma("unroll") for (int k = 0; k < 2; ++k) dst[n][k] = *(const PG8_LAS bf16x8*)(lds + PG8_SB(b, h) + boff + n * 2048 + k * 1024); } while (0)
#define PG8_MMA(ai, bj, At, Bt) do { __builtin_amdgcn_s_setprio(1); _Pragma("unroll") for (int m = 0; m < 4; ++m) _Pragma("unroll") for (int n = 0; n < 2; ++n) _Pragma("unroll") for (int k = 0; k < 2; ++k) \
        acc[ai][bj][m][n] = __builtin_amdgcn_mfma_f32_16x16x32_bf16(Bt[n][k], At[m][k], acc[ai][bj][m][n], 0, 0, 0); __builtin_amdgcn_s_setprio(0); } while (0)
#define PG8_WAIT_V(n) asm volatile("s_waitcnt vmcnt(" #n ")" ::: "memory")
#define PG8_WAIT_L(n) asm volatile("s_waitcnt lgkmcnt(" #n ")" ::: "memory")
#define PG8_BAR __builtin_amdgcn_s_barrier()
#define PG8_SCHED __builtin_amdgcn_sched_barrier(0)
    Unit cur, nxt; int ui = 0;
    if (!S.next(0, cur)) return;
    f32x4 acc[2][2][4][2];
#pragma unroll
    for (int a = 0; a < 2; ++a)
#pragma unroll
        for (int b = 0; b < 2; ++b)
#pragma unroll
            for (int m = 0; m < 4; ++m)
#pragma unroll
                for (int n = 0; n < 2; ++n) acc[a][b][m][n] = (f32x4){0.f, 0.f, 0.f, 0.f};
    bf16x8 At[4][2], B0[2][2], B1[2][2];
    const char* cA = (const char*)g.A + (GA ? (size_t)0 : (size_t)cur.pm * tstep); const char* cB = (const char*)g.Bt + (size_t)cur.pn * tstep;
    if constexpr (GA) { const unsigned* rm = S.rowmap + (size_t)cur.pm * 256; PG8_GC_FROM(rm, K * 2); }
    S.a_ready(cur);
    if constexpr (SP2) {
        PG8_STAGE(PG8_SB(0, 0), cB + PG8_KO(0), voffB); PG8_STAGE(PG8_SB(0, 1), cB + hstep + PG8_KO(0), voffB); PG8_STAGE_A(PG8_SA(0, 0), cA + PG8_KO(0), 0); PG8_STAGE_A(PG8_SA(0, 1), cA + PG8_KO(0), 1);
        if (wr == 1) PG8_BAR;
        PG8_WAIT_V(2); PG8_BAR;
        PG8_STAGE(PG8_SB(1, 0), cB + PG8_KO(1), voffB); PG8_STAGE_A(PG8_SA(1, 0), cA + PG8_KO(1), 0); PG8_STAGE(PG8_SB(1, 1), cB + hstep + PG8_KO(1), voffB);
        PG8_WAIT_V(6); PG8_BAR;
    } else {
        PG8_STAGE(PG8_SB(0, 0), cB, voffB); PG8_STAGE(PG8_SA(0, 0), cA, voffA); PG8_STAGE(PG8_SB(0, 1), cB + hstep, voffB); PG8_STAGE(PG8_SA(0, 1), cA + hstep, voffA);
        if (wr == 1) PG8_BAR;
        PG8_WAIT_V(4); PG8_BAR;
        PG8_STAGE(PG8_SB(1, 0), cB + kstep, voffB); PG8_STAGE(PG8_SA(1, 0), cA + kstep, voffA); PG8_STAGE(PG8_SB(1, 1), cB + hstep + kstep, voffB);
        PG8_WAIT_V(6); PG8_BAR;
    }
    for (;;) {
        const bool has_next = S.next(ui + 1, nxt);
        const char* nA = (has_next && !GA) ? (const char*)g.A + (size_t)nxt.pm * tstep : cA; const char* nB = has_next ? (const char*)g.Bt + (size_t)nxt.pn * tstep : cB;
        if constexpr (GA) { if (has_next && wid < 4) __builtin_amdgcn_global_load_lds((const unsigned*)(S.rowmap + (size_t)nxt.pm * 256 + wid * 64 + lane), (PG8_LAS unsigned*)(rmap_lds + wid * 64), 4, 0, 0); }
        for (int t = 0; t < nt; t += 2) {
            const bool last = (t == nt - 2);
            const char* a1 = cA + PG8_KO(t + 1);
            const char* a2 = last ? nA + PG8_KO(0) : cA + PG8_KO(t + 2); const char* b2 = last ? nB + PG8_KO(0) : cB + PG8_KO(t + 2);
            const char* a3 = last ? nA + PG8_KO(1) : cA + PG8_KO(t + 3); const char* b3 = last ? nB + PG8_KO(1) : cB + PG8_KO(t + 3);
            if (last && has_next) S.a_ready(nxt);
            if constexpr (SP2) {
            PG8_LDB(B0, 0, 0); PG8_LDB(B1, 0, 1); PG8_SCHED; PG8_LDA(At, 0, 0); PG8_STAGE_A(PG8_SA(1, 1), a1, 1);
            if constexpr (GA) { if (last && has_next) PG8_GC_FROM(rmap_lds, K * 2); }
            PG8_WAIT_V(8); PG8_WAIT_L(0); PG8_BAR; PG8_MMA(0, 0, At, B0); PG8_MMA(0, 1, At, B1); PG8_BAR; PG8_SCHED;
            PG8_LDA(At, 0, 1); PG8_STAGE(PG8_SB(0, 0), b2, voffB); PG8_STAGE(PG8_SB(0, 1), b2 + hstep, voffB); PG8_STAGE_A(PG8_SA(0, 0), a2, 0);
            PG8_WAIT_V(8); PG8_WAIT_L(0); PG8_BAR; PG8_MMA(1, 0, At, B0); PG8_MMA(1, 1, At, B1); PG8_BAR; PG8_SCHED;
            PG8_LDB(B0, 1, 0); PG8_LDB(B1, 1, 1); PG8_SCHED; PG8_LDA(At, 1, 0); PG8_STAGE_A(PG8_SA(0, 1), a2, 1);
            PG8_WAIT_V(8); PG8_WAIT_L(0); PG8_BAR; PG8_MMA(0, 0, At, B0); PG8_MMA(0, 1, At, B1); PG8_BAR; PG8_SCHED;
            PG8_LDA(At, 1, 1); PG8_STAGE(PG8_SB(1, 0), b3, voffB); PG8_STAGE(PG8_SB(1, 1), b3 + hstep, voffB); PG8_STAGE_A(PG8_SA(1, 0), a3, 0);
            PG8_WAIT_V(8); PG8_WAIT_L(0); PG8_BAR; PG8_MMA(1, 0, At, B0); PG8_MMA(1, 1, At, B1); PG8_BAR; PG8_SCHED;
            } else {
            PG8_LDB(B0, 0, 0); PG8_SCHED; PG8_LDA(At, 0, 0); PG8_STAGE(PG8_SA(1, 1), a1 + hstep, voffA);
            PG8_WAIT_L(8); PG8_BAR; PG8_WAIT_L(0); PG8_MMA(0, 0, At, B0); PG8_BAR; PG8_SCHED;
            PG8_LDB(B1, 0, 1); PG8_STAGE(PG8_SB(0, 0), b2, voffB);
            PG8_BAR; PG8_WAIT_L(0); PG8_MMA(0, 1, At, B1); PG8_BAR;
            PG8_LDA(At, 0, 1); PG8_STAGE(PG8_SA(0, 0), a2, voffA);
            PG8_BAR; PG8_WAIT_L(0); PG8_MMA(1, 0, At, B0); PG8_BAR; PG8_SCHED;
            PG8_STAGE(PG8_SB(0, 1), b2 + hstep, voffB);
            PG8_WAIT_V(6); PG8_BAR; PG8_MMA(1, 1, At, B1); PG8_BAR;
            PG8_LDB(B0, 1, 0); PG8_SCHED; PG8_LDA(At, 1, 0); PG8_STAGE(PG8_SA(0, 1), a2 + hstep, voffA);
            PG8_WAIT_L(8); PG8_BAR; PG8_WAIT_L(0); PG8_MMA(0, 0, At, B0); PG8_BAR; PG8_SCHED;
            PG8_LDB(B1, 1, 1); PG8_STAGE(PG8_SB(1, 0), b3, voffB);
            PG8_BAR; PG8_WAIT_L(0); PG8_MMA(0, 1, At, B1); PG8_BAR;
            PG8_LDA(At, 1, 1); PG8_STAGE(PG8_SA(1, 0), a3, voffA);
            PG8_BAR; PG8_WAIT_L(0); PG8_MMA(1, 0, At, B0); PG8_BAR; PG8_SCHED;
            PG8_STAGE(PG8_SB(1, 1), b3 + hstep, voffB);
            PG8_WAIT_V(6); PG8_BAR; PG8_MMA(1, 1, At, B1); PG8_BAR;
            }
        }
        if constexpr (ALIGN_EPI) { if (wr == 0) PG8_BAR; }
        if constexpr (!Epi::AFTER_DRAIN) { E(acc, cur, wr, wc, fr, fq); S.done(cur); }
        if (!has_next) break;
#pragma unroll
        for (int a = 0; a < 2; ++a)
#pragma unroll
            for (int b = 0; b < 2; ++b)
#pragma unroll
                for (int m = 0; m < 4; ++m)
#pragma unroll
                    for (int n = 0; n < 2; ++n) acc[a][b][m][n] = (f32x4){0.f, 0.f, 0.f, 0.f};
        cur = nxt; cA = nA; cB = nB; ++ui;
        if constexpr (ALIGN_EPI) { if (wr == 1) PG8_BAR; }
    }
    PG8_WAIT_V(0);
    if constexpr (!ALIGN_EPI) { if (wr == 0) PG8_BAR; }
    PG8_BAR;
    if constexpr (Epi::AFTER_DRAIN) { E.fused(acc, cur, wr, wc, fr, fq, lds, wid, lane); S.done(cur); }
#undef PG8_SA
#undef PG8_SB
#undef PG8_STAGE
#undef PG8_STAGE_A
#undef PG8_GC_FROM
#undef PG8_LDA
#undef PG8_LDB
#undef PG8_MMA
#undef PG8_WAIT_V
#undef PG8_WAIT_L
#undef PG8_BAR
#undef PG8_SCHED
#undef PG8_KO
}
}

#ifndef PG8_SP2
#define PG8_SP2 true
#endif
#ifndef PG8_ALIGN
#define PG8_ALIGN true
#endif

#define GAS __attribute__((address_space(1)))
#define LAS __attribute__((address_space(3)))
typedef unsigned short bf16;
typedef unsigned v4u __attribute__((ext_vector_type(4)));
typedef float f32x4 __attribute__((ext_vector_type(4)));
typedef short bf16x8 __attribute__((ext_vector_type(8)));
typedef GAS unsigned gu32;
typedef GAS unsigned long long gu64;
#define RLX_AGENT __ATOMIC_RELAXED, __HIP_MEMORY_SCOPE_AGENT
#define LDS_WAIT() asm volatile("s_waitcnt lgkmcnt(0)" ::: "memory")
#define VM_WAIT() asm volatile("s_waitcnt vmcnt(0)" ::: "memory")
__device__ __forceinline__ unsigned long long rt() { return __builtin_amdgcn_s_memrealtime(); }
__device__ __forceinline__ unsigned f2bf(float f) { unsigned u = __builtin_bit_cast(unsigned, f); return (u + 0x7fffu + ((u >> 16) & 1u)) >> 16; }
__device__ __forceinline__ unsigned pk2(float lo, float hi) { return f2bf(lo) | (f2bf(hi) << 16); }

#define XB_TMO      128
#define XB_XCNT(j)  (256  + 64 * (j))
#define XB_XSUB(j)  (1280 + 64 * (j))
#define XB_XGEN(j)  (2304 + 64 * (j))
#define XB_TOP      3328
#define XB_TOPGEN   3392
#define XCD_BAR_WORDS 3456
#define XB_SPIN_CAP (1u << 18)

__device__ __forceinline__ unsigned xb_ld(unsigned* p)              { return __hip_atomic_load(p, __ATOMIC_RELAXED, __HIP_MEMORY_SCOPE_AGENT); }
__device__ __forceinline__ unsigned xb_add(unsigned* p, unsigned v) { return __hip_atomic_fetch_add(p, v, __ATOMIC_RELAXED, __HIP_MEMORY_SCOPE_AGENT); }
__device__ __forceinline__ unsigned xb_xcc_id() { return (unsigned)__builtin_amdgcn_s_getreg((3 << 11) | 20) & 0xFu; }
#define XB_SPIN(cond, bar) do { unsigned _sp = 0; while (cond) { __builtin_amdgcn_s_sleep(1); \
    if ((++_sp & 255u) == 0u) { if (xb_ld(&(bar)[XB_TMO])) break; if (_sp > XB_SPIN_CAP) { atomicAdd(&(bar)[XB_TMO], 1u); break; } } } } while (0)

struct XcdBarrier {
    unsigned* bar; unsigned x;
    volatile LAS unsigned* st;
};

__device__ __forceinline__ XcdBarrier xcd_barrier_post(unsigned* bar, volatile LAS unsigned* st) {
    XcdBarrier b; b.bar = bar; b.x = xb_xcc_id(); b.st = st;
    if (threadIdx.x == 0) (void)xb_add(&bar[XB_XCNT(b.x)], 1u);
    return b;
}
__device__ __forceinline__ void xcd_barrier_complete(unsigned* bar, unsigned x, unsigned& nloc, unsigned& nx) {
    const unsigned G = gridDim.x * gridDim.y * gridDim.z;
    unsigned sum, cnt, mine, sp = 0u;
    for (;;) {
        sum = 0u; cnt = 0u; mine = 0u;
#pragma unroll
        for (unsigned j = 0; j < 16; ++j) { const unsigned c = xb_ld(&bar[XB_XCNT(j)]); sum += c; cnt += (c > 0u) ? 1u : 0u; mine = (j == x) ? c : mine; }
        if (sum == G) break;
        __builtin_amdgcn_s_sleep(1);
        if ((++sp & 255u) == 0u) { if (xb_ld(&bar[XB_TMO])) break; if (sp > XB_SPIN_CAP) { atomicAdd(&bar[XB_TMO], 1u); break; } }
    }
    nloc = mine > 0u ? mine : 1u; nx = cnt > 0u ? cnt : 1u;
}

__device__ __forceinline__ void xcd_barrier(const XcdBarrier& b) {
    asm volatile("s_waitcnt vmcnt(0)" ::: "memory");
    __syncthreads();
    if (threadIdx.x == 0) {
        unsigned* bar = b.bar;
        __builtin_amdgcn_s_waitcnt(0);
        unsigned nloc = b.st[0], nx = b.st[1];
        if (nloc == 0u) { xcd_barrier_complete(bar, b.x, nloc, nx); b.st[0] = nloc; b.st[1] = nx; }
        const unsigned old = xb_add(&bar[XB_XSUB(b.x)], 1u);
        const unsigned gen = old / nloc;
        if (old + 1u == (gen + 1u) * nloc) {
            __builtin_amdgcn_fence(__ATOMIC_RELEASE, "agent");
            asm volatile("s_waitcnt vmcnt(0)" ::: "memory");
            const unsigned og = xb_add(&bar[XB_TOP], 1u);
            const unsigned tg = og / nx;
            if (og + 1u == (tg + 1u) * nx) xb_add(&bar[XB_TOPGEN], 1u);
            else XB_SPIN(xb_ld(&bar[XB_TOPGEN]) == tg, bar);
            __builtin_amdgcn_fence(__ATOMIC_ACQUIRE, "agent");
            xb_add(&bar[XB_XGEN(b.x)], 1u);
            asm volatile("s_waitcnt vmcnt(0)" ::: "memory");
        } else {
            XB_SPIN(xb_ld(&bar[XB_XGEN(b.x)]) == gen, bar);
            __builtin_amdgcn_fence(__ATOMIC_ACQUIRE, "agent");
            asm volatile("s_waitcnt vmcnt(0)" ::: "memory");
        }
    }
    __syncthreads();
}

#ifndef NLAYERS
#define NLAYERS 2
#endif
#ifndef EN_PRO
#define EN_PRO 1
#endif
#ifndef EN_MIX
#define EN_MIX 1
#endif
#ifndef EN_ATT
#define EN_ATT 1
#endif
#ifndef EN_SITES
#define EN_SITES 255
#endif
constexpr int NWAVES = 8, NTHREADS = 512;
constexpr int BATCH = 16, SEQ = 4096, DM = 1024, CTXL = 256;
constexpr int ML = BATCH * SEQ;
constexpr int MC = BATCH * CTXL;
constexpr int MA = ML + MC;
constexpr int SKV = SEQ + CTXL;
constexpr int INC = 8704;
constexpr int NBIG = 5632;
constexpr int DFF = 2816, NEXP = 8, DFE = 3584;
constexpr int MOE_CH = 192;
constexpr float EPS = 1e-6f;
constexpr float QSCALE = 0.125f * 1.4426950408889634f;

constexpr size_t MiB = 1u << 20;
constexpr size_t WS_CTL = 0, CTL_ZERO_BYTES = 1 * MiB;
constexpr size_t WS_MOD = 1 * MiB;
constexpr size_t WS_ROPE = 2 * MiB;
constexpr size_t WS_LAM = 2 * MiB + 16384;
constexpr size_t WS_AWS = 2 * MiB + 65536;
constexpr size_t WS_ROUTE = 4 * MiB;
constexpr size_t WS_RMAP = 6 * MiB;
constexpr size_t WS_WIN = 8 * MiB;
constexpr size_t WIN_BYTES = 17 * MiB;
constexpr size_t WS_WOUT = 42 * MiB;
constexpr size_t WOUT_BYTES = 6 * MiB;
constexpr size_t WS_WFU = 54 * MiB;
constexpr size_t WS_WFD = 65 * MiB;
constexpr size_t WS_X16 = 87 * MiB;
constexpr size_t WS_P0 = 223 * MiB, WS_P1 = 291 * MiB, WS_P2 = 359 * MiB, WS_P3 = 427 * MiB;
constexpr size_t WS_Q = 495 * MiB, WS_K = 631 * MiB, WS_V = 767 * MiB;
constexpr size_t WS_ACT0 = 223 * MiB;
constexpr size_t WS_MWU = 223 * MiB;
constexpr size_t WS_MWD = 335 * MiB;
constexpr size_t WS_HS = 391 * MiB;
constexpr size_t WS_MACT = 651 * MiB;
constexpr size_t WS_END = 1024 * MiB;
static_assert(WS_MACT + (size_t)MOE_CH * 256 * DFE * 2 <= WS_END, "ws map");
static_assert(WS_ACT0 + (size_t)MA * DFF * 2 <= WS_K, "ws map");
constexpr int CW_BAR = 4096;
constexpr int CW_CNT = 8192;

constexpr int LDS_BYTES = 147456;
constexpr int LDSCTL_OFF = LDS_BYTES - 256;

typedef float f32x2 __attribute__((ext_vector_type(2)));
typedef unsigned v2u __attribute__((ext_vector_type(2)));
__device__ __forceinline__ float bf2f(unsigned h) { return __builtin_bit_cast(float, h << 16); }
__device__ __forceinline__ float dpp_add(float v, int ctrl_sel) {
    const int x = __builtin_bit_cast(int, v); int y;
    if (ctrl_sel == 0) y = __builtin_amdgcn_update_dpp(0, x, 0xB1, 0xf, 0xf, false);
    else if (ctrl_sel == 1) y = __builtin_amdgcn_update_dpp(0, x, 0x4E, 0xf, 0xf, false);
    else if (ctrl_sel == 2) y = __builtin_amdgcn_update_dpp(0, x, 0x141, 0xf, 0xf, false);
    else y = __builtin_amdgcn_update_dpp(0, x, 0x140, 0xf, 0xf, false);
    return v + __builtin_bit_cast(float, y);
}
__device__ __forceinline__ float wave_sum(float v) {
    v = dpp_add(v, 0); v = dpp_add(v, 1); v = dpp_add(v, 2); v = dpp_add(v, 3);
    const int x = __builtin_bit_cast(int, v);
    const float s0 = __builtin_bit_cast(float, __builtin_amdgcn_readlane(x, 0)), s1 = __builtin_bit_cast(float, __builtin_amdgcn_readlane(x, 16)),
                s2 = __builtin_bit_cast(float, __builtin_amdgcn_readlane(x, 32)), s3 = __builtin_bit_cast(float, __builtin_amdgcn_readlane(x, 48));
    return (s0 + s1) + (s2 + s3);
}
__device__ __forceinline__ float fast_exp2(float x) { return __builtin_amdgcn_exp2f(x); }
__device__ __forceinline__ float fast_rcp(float x) { return __builtin_amdgcn_rcpf(x); }
__device__ __forceinline__ float sigmoid_f(float x) { return fast_rcp(1.f + fast_exp2(-1.4426950408889634f * x)); }
__device__ __forceinline__ float silu_f(float x) { return x * sigmoid_f(x); }
__device__ __forceinline__ float gelu_tanh_f(float x) { const float u = x * (1.f + 0.044715f * x * x); return x * fast_rcp(1.f + fast_exp2(-2.f * 0.7978845608028654f * 1.4426950408889634f * u)); }

__device__ __forceinline__ unsigned char* launder_ptr(unsigned char* p) { asm volatile("" : "+s"(p)); return p; }
struct Args { const float* in[29]; float* out; unsigned char* ws; int ph_lo, ph_hi; };
static_assert(sizeof(Args) == 256, "Args has no holes");
struct PhaseCtl { int lo, hi, ph; };
struct Ctx {
    LAS unsigned char* lds;
    gu32* ctl;
    int tid, lane, wave, vcu, G, gw, NGW;
};

__device__ __forceinline__ void tr_item(const float* W, int ldw, int scol0, bool perm, bf16* WT, int K, int drow0, int k0, LAS float* scr, int lane) {
#pragma unroll 8
    for (int i = 0; i < 32; ++i) { const int kk = 2 * i + (lane >> 5); scr[kk * 33 + (lane & 31)] = W[(size_t)(k0 + kk) * ldw + scol0 + (lane & 31)]; }
    LDS_WAIT(); asm volatile("" ::: "memory");
    const int c = lane & 7;
#pragma unroll
    for (int j = 0; j < 4; ++j) { const int n = (lane >> 3) + 8 * j; const int sn = perm ? ((n >> 1) + 16 * (n & 1)) : n;
        const LAS float* s = scr + (8 * c) * 33 + sn;
        v4u o; o.x = pk2(s[0 * 33], s[1 * 33]); o.y = pk2(s[2 * 33], s[3 * 33]); o.z = pk2(s[4 * 33], s[5 * 33]); o.w = pk2(s[6 * 33], s[7 * 33]);
        *(GAS v4u*)(WT + (size_t)(drow0 + n) * K + k0 + 8 * c) = o; }
    LDS_WAIT(); asm volatile("" ::: "memory");
}
__device__ __forceinline__ int win_src(int d, bool& perm) {
    perm = false;
    if (d < 1024) { perm = true; return 2560 + d; }
    if (d < 2048) { perm = true; return 3584 + (d - 1024); }
    if (d < 3072) return 4608 + (d - 2048);
    if (d < 3584) return d - 3072;
    if (d < 4096) return 512 + (d - 3584);
    if (d < 4608) return 1024 + (d - 4096);
    if (d < 5632) { const int x = d - 4608, j = x >> 8, w = x & 255; return (w < 128 ? 1536 : 2048) + 128 * j + (w & 127); }
    return d;
}
template <int MODE>
__device__ __forceinline__ void tr_matrix(const Ctx& C, const float* W, const float* W2, int ldw, int K, int ndst, bf16* WT) {
    LAS float* scr = (LAS float*)(C.lds + C.wave * 16384);
    const int nblk = ndst / 32, ni = (K / 64) * nblk;
    for (int it = C.gw; it < ni; it += C.NGW) {
        const int kb = it / nblk, db = it % nblk; const float* src = W; int scol0; bool perm = false;
        if (MODE == 0) scol0 = 32 * db;
        else if (MODE == 1) scol0 = win_src(32 * db, perm);
        else { const int j = db >> 3, w = db & 7; if (w >= 4) src = W2; scol0 = 128 * j + 32 * (w & 3); }
        tr_item(src, ldw, scol0, perm, WT, K, 32 * db, 64 * kb, scr, C.lane);
    }
}

__device__ __forceinline__ void mod_phase(const Ctx& C, const float* c, const float* cctx, const float* w_ada, const float* b_ada, float* mod) {
    LAS float* sc = (LAS float*)C.lds;
    LAS float* red = (LAS float*)(C.lds + 17 * 1024 * 4);
    for (int idx = C.tid; idx < 17 * 1024; idx += NTHREADS) { const int b = idx >> 10, k = idx & 1023; const float v = b < 16 ? c[b * 1024 + k] : cctx[k]; sc[idx] = v / (1.f + __expf(-v)); }
    __syncthreads();
    const int cl = C.tid & 31, ks = C.tid >> 5;
    for (int it = blockIdx.x; it < 2 * 192; it += C.G) {
        const int l = it / 192, cb = it % 192, col = cb * 32 + cl;
        float acc[17];
#pragma unroll
        for (int b = 0; b < 17; ++b) acc[b] = 0.f;
        const float* wp = w_ada + ((size_t)l * 1024 + ks * 64) * 6144 + col;
        for (int kk = 0; kk < 64; ++kk) { const float w = wp[(size_t)kk * 6144]; const int k = ks * 64 + kk;
#pragma unroll
            for (int b = 0; b < 17; ++b) acc[b] += sc[b * 1024 + k] * w; }
#pragma unroll
        for (int b = 0; b < 17; ++b) red[(ks * 17 + b) * 32 + cl] = acc[b];
        __syncthreads();
        for (int o = C.tid; o < 17 * 32; o += NTHREADS) { const int b = o >> 5, cc = o & 31; float s = b_ada[l * 6144 + cb * 32 + cc];
#pragma unroll
            for (int q = 0; q < 16; ++q) s += red[(q * 17 + b) * 32 + cc];
            mod[((size_t)l * 17 + b) * 6144 + cb * 32 + cc] = s; }
        __syncthreads();
    }
}
__device__ __forceinline__ void rope_lam_phase(const Ctx& C, const float* c_lambda, float* rope, float* lam) {
    if (blockIdx.x == 0) {
        for (int idx = C.tid; idx < 1024; idx += NTHREADS) {
            const int pos = idx >> 4, i = idx & 15;
            double th = 1.0; for (int q = 0; q < i; ++q) th *= 0.56234132519034908;
            double c1 = 1.0, s1 = th, tc = 1.0, ts = th; const double t2 = th * th;
            for (int n = 1; n <= 12; ++n) { tc *= -t2 / (double)((2 * n - 1) * (2 * n)); ts *= -t2 / (double)((2 * n) * (2 * n + 1)); c1 += tc; s1 += ts; }
            double cc = 1.0, ss = 0.0; for (int q = 0; q < pos; ++q) { const double nc = cc * c1 - ss * s1, ns = ss * c1 + cc * s1; cc = nc; ss = ns; }
            rope[idx * 2] = (float)cc; rope[idx * 2 + 1] = (float)ss;
        }
        if (C.tid < 2) { const int l = C.tid; const float* p = c_lambda + l * 256; float a = 0.f, b = 0.f;
            for (int d = 0; d < 64; ++d) { a += p[d] * p[64 + d]; b += p[128 + d] * p[192 + d]; }
            const float li = l == 0 ? 0.2f : (0.8f - 0.6f * 0.7408182206817179f);
            lam[l] = __expf(a) - __expf(b) + li; }
    }
}

template <bool XB> __device__ __forceinline__ f32x4 ldrow4(const void* row, int idx) {
    if constexpr (XB) { const v2u w = ((const GAS v2u*)row)[idx]; f32x4 a; a[0] = bf2f(w.x & 0xffffu); a[1] = bf2f(w.x >> 16); a[2] = bf2f(w.y & 0xffffu); a[3] = bf2f(w.y >> 16); return a; }
    else return ((const GAS f32x4*)row)[idx];
}
template <bool XB> __device__ __forceinline__ void modulate_row(const void* xr, const float* gn, const float* scv, const float* shv, bf16* orow, int lane, f32x4 (&y)[4]) {
    f32x4 v[4]; float ss = 0.f;
#pragma unroll
    for (int j = 0; j < 4; ++j) { v[j] = ldrow4<XB>(xr, lane + 64 * j); ss += (v[j].x * v[j].x + v[j].y * v[j].y) + (v[j].z * v[j].z + v[j].w * v[j].w); }
    const float rstd = 1.0f / sqrtf(wave_sum(ss) * (1.f / 1024.f) + EPS);
    GAS v2u* o8 = (GAS v2u*)orow + lane;
#pragma unroll
    for (int j = 0; j < 4; ++j) {
        const f32x4 g = ((const GAS f32x4*)gn)[lane + 64 * j], s = ((const GAS f32x4*)scv)[lane + 64 * j], h = ((const GAS f32x4*)shv)[lane + 64 * j];
        y[j] = (v[j] * rstd) * g * (s + 1.0f) + h;
        v2u w; w.x = pg8::cvt_pk_bf16(y[j].x, y[j].y); w.y = pg8::cvt_pk_bf16(y[j].z, y[j].w); o8[64 * j] = w; }
}
template <bool XB> __device__ __forceinline__ void modulate_phase(const Ctx& C, const void* xl, const void* xcs, const float* gn, const float* modl, int shidx, int scidx, bf16* H, int nrows) {
    const int lane = C.lane;
    for (int r0 = C.gw; r0 < nrows; r0 += 2 * C.NGW) {
        const int r1 = r0 + C.NGW; const bool has1 = r1 < nrows; const int r1c = has1 ? r1 : r0;
        const void* xr0; const void* xr1; const int b0 = r0 < ML ? (r0 >> 12) : 16, b1 = r1c < ML ? (r1c >> 12) : 16;
        if constexpr (XB) { xr0 = (const bf16*)xl + (size_t)r0 * DM; xr1 = (const bf16*)xl + (size_t)r1c * DM; }
        else { xr0 = r0 < ML ? (const float*)xl + (size_t)r0 * DM : (const float*)xcs + (size_t)(r0 - ML) * DM; xr1 = r1c < ML ? (const float*)xl + (size_t)r1c * DM : (const float*)xcs + (size_t)(r1c - ML) * DM; }
        f32x4 v0[4], v1[4]; float s0 = 0.f, s1 = 0.f;
#pragma unroll
        for (int j = 0; j < 4; ++j) { v0[j] = ldrow4<XB>(xr0, lane + 64 * j); v1[j] = ldrow4<XB>(xr1, lane + 64 * j); }
#pragma unroll
        for (int j = 0; j < 4; ++j) { s0 += (v0[j].x * v0[j].x + v0[j].y * v0[j].y) + (v0[j].z * v0[j].z + v0[j].w * v0[j].w); s1 += (v1[j].x * v1[j].x + v1[j].y * v1[j].y) + (v1[j].z * v1[j].z + v1[j].w * v1[j].w); }
        const float rs0 = 1.0f / sqrtf(wave_sum(s0) * (1.f / 1024.f) + EPS), rs1 = 1.0f / sqrtf(wave_sum(s1) * (1.f / 1024.f) + EPS);
        const float* m0 = modl + (size_t)b0 * 6144; const float* m1 = modl + (size_t)b1 * 6144;
        GAS v2u* o0 = (GAS v2u*)(H + (size_t)r0 * DM) + lane; GAS v2u* o1 = (GAS v2u*)(H + (size_t)r1c * DM) + lane;
#pragma unroll
        for (int j = 0; j < 4; ++j) {
            const f32x4 g = ((const GAS f32x4*)gn)[lane + 64 * j];
            const f32x4 sa = ((const GAS f32x4*)(m0 + scidx * 1024))[lane + 64 * j], ha = ((const GAS f32x4*)(m0 + shidx * 1024))[lane + 64 * j];
            const f32x4 ya = (v0[j] * rs0) * g * (sa + 1.0f) + ha;
            v2u w; w.x = pg8::cvt_pk_bf16(ya.x, ya.y); w.y = pg8::cvt_pk_bf16(ya.z, ya.w); o0[64 * j] = w;
            if (has1) { const f32x4 sb = ((const GAS f32x4*)(m1 + scidx * 1024))[lane + 64 * j], hb = ((const GAS f32x4*)(m1 + shidx * 1024))[lane + 64 * j];
                const f32x4 yb = (v1[j] * rs1) * g * (sb + 1.0f) + hb;
                v2u w2; w2.x = pg8::cvt_pk_bf16(yb.x, yb.y); w2.y = pg8::cvt_pk_bf16(yb.z, yb.w); o1[64 * j] = w2; }
        }
    }
}

using pg8::f32x4; using pg8::u32x4; using pg8::Unit; using pg8::cvt_pk_bf16;
__device__ __forceinline__ u32x4 pack8(const f32x4& a, const f32x4& b) { u32x4 w; w.x = cvt_pk_bf16(a[0], a[1]); w.y = cvt_pk_bf16(a[2], a[3]); w.z = cvt_pk_bf16(b[0], b[1]); w.w = cvt_pk_bf16(b[2], b[3]); return w; }
__device__ __forceinline__ void unpack8(const u32x4& w, f32x4& a, f32x4& b) {
    a[0] = bf2f(w.x & 0xffffu); a[1] = bf2f(w.x >> 16); a[2] = bf2f(w.y & 0xffffu); a[3] = bf2f(w.y >> 16);
    b[0] = bf2f(w.z & 0xffffu); b[1] = bf2f(w.z >> 16); b[2] = bf2f(w.w & 0xffffu); b[3] = bf2f(w.w >> 16); }

#ifndef NT_BIG
#define NT_BIG 0
#endif
#if NT_BIG
#define ST16(p, v) __builtin_nontemporal_store((v), (p))
#else
#define ST16(p, v) (*(p) = (v))
#endif
struct EpiBig {
    static constexpr bool PERM = true, AFTER_DRAIN = false;
    unsigned char* wsb; const LAS float* rope;
    __device__ __forceinline__ void operator()(const f32x4 (&acc)[2][2][4][2], const Unit& u, int wr, int wc, int fr, int fq) const {
        const int R0 = u.pm * 256, pn = u.pn; const bool isctx = R0 >= ML;
        const int cin = 32 * wc + 8 * fq;
        if (pn < 12) {
            const int kind = pn >> 2;
            bf16* base = (bf16*)(wsb + WS_Q + (size_t)kind * (WS_K - WS_Q));
            long rowadd = 0;
            if (kind != 0) rowadd = isctx ? ((long)((R0 - ML) >> 8) * SKV + SEQ - R0) : ((long)(R0 >> 12) * (SKV - SEQ));
            const bool rot = (kind != 2) && !isctx; const int axis = wc & 1; const float qs = kind == 0 ? QSCALE : 1.f;
#pragma unroll
            for (int ai = 0; ai < 2; ++ai)
#pragma unroll
                for (int m = 0; m < 4; ++m) {
                    const int r = R0 + ai * 128 + wr * 64 + m * 16 + fr;
                    f32x4 t0 = {1.f, 0.f, 1.f, 0.f}, t1 = {1.f, 0.f, 1.f, 0.f};
                    if (rot) { const int t = r & 4095; const int pos = axis == 0 ? (t >> 6) : (t & 63); const LAS f32x4* tp = (const LAS f32x4*)(rope + (pos * 16 + 4 * fq) * 2); t0 = tp[0]; t1 = tp[1]; }
                    bf16* rowp = base + (size_t)((long)r + rowadd) * DM + (pn & 3) * 256 + cin;
#pragma unroll
                    for (int bj = 0; bj < 2; ++bj) {
                        const f32x4 a = acc[ai][bj][m][0], b = acc[ai][bj][m][1]; f32x4 oa, ob;
                        oa[0] = (a[0] * t0[0] - a[1] * t0[1]) * qs; oa[1] = (a[1] * t0[0] + a[0] * t0[1]) * qs; oa[2] = (a[2] * t0[2] - a[3] * t0[3]) * qs; oa[3] = (a[3] * t0[2] + a[2] * t0[3]) * qs;
                        ob[0] = (b[0] * t1[0] - b[1] * t1[1]) * qs; ob[1] = (b[1] * t1[0] + b[0] * t1[1]) * qs; ob[2] = (b[2] * t1[2] - b[3] * t1[3]) * qs; ob[3] = (b[3] * t1[2] + b[2] * t1[3]) * qs;
                        ST16((GAS u32x4*)(rowp + bj * 128), pack8(oa, ob)); }
                }
        } else if (pn < 18) {
            const int kind = (pn - 12) >> 1;
            bf16* base = (bf16*)(wsb + WS_P0 + (size_t)kind * (WS_P1 - WS_P0)); const int c0 = ((pn - 12) & 1) * 256 + cin;
#pragma unroll
            for (int ai = 0; ai < 2; ++ai)
#pragma unroll
                for (int m = 0; m < 4; ++m) {
                    const int r = R0 + ai * 128 + wr * 64 + m * 16 + fr; bf16* rowp = base + (size_t)r * 512 + c0;
#pragma unroll
                    for (int bj = 0; bj < 2; ++bj) {
                        f32x4 a = acc[ai][bj][m][0], b = acc[ai][bj][m][1];
                        if (kind < 2) {
#pragma unroll
                            for (int q = 0; q < 4; ++q) { a[q] = gelu_tanh_f(a[q]); b[q] = gelu_tanh_f(b[q]); } }
                        ST16((GAS u32x4*)(rowp + bj * 128), pack8(a, b)); }
                }
        } else {
            const int c0 = (pn - 18) * 128 + cin;
#pragma unroll
            for (int ai = 0; ai < 2; ++ai)
#pragma unroll
                for (int m = 0; m < 4; ++m) {
                    const int r = R0 + ai * 128 + wr * 64 + m * 16 + fr;
                    const f32x4 a = acc[ai][0][m][0] * acc[ai][1][m][0], b = acc[ai][0][m][1] * acc[ai][1][m][1];
                    ST16((GAS u32x4*)((bf16*)(wsb + WS_P3) + (size_t)r * 512 + c0), pack8(a, b)); }
        }
    }
};

struct EpiGate {
    static constexpr bool PERM = true, AFTER_DRAIN = false;
    unsigned char* wsb; const LAS float* bias;
    __device__ __forceinline__ void operator()(const f32x4 (&acc)[2][2][4][2], const Unit& u, int wr, int wc, int fr, int fq) const {
        const int R0 = u.pm * 256, pn = u.pn, br = pn >> 2, cin = 32 * wc + 8 * fq;
        const size_t boff = br == 0 ? WS_K : (br == 1 ? WS_V : ((pn & 2) ? WS_P3 : WS_P1));
        bf16* base = (bf16*)(wsb + boff); const int ld = br == 2 ? 512 : 1024, c0 = (br == 2 ? (pn & 1) : (pn & 3)) * 256 + cin;
        f32x4 bv[2][2];
#pragma unroll
        for (int bj = 0; bj < 2; ++bj)
#pragma unroll
            for (int n = 0; n < 2; ++n) bv[bj][n] = *(const LAS f32x4*)(bias + pn * 256 + bj * 128 + cin + 4 * n);
#pragma unroll
        for (int ai = 0; ai < 2; ++ai)
#pragma unroll
            for (int m = 0; m < 4; ++m) {
                const int r = R0 + ai * 128 + wr * 64 + m * 16 + fr; bf16* rowp = base + (size_t)r * ld + c0;
#pragma unroll
                for (int bj = 0; bj < 2; ++bj) {
                    f32x4 a = acc[ai][bj][m][0] + bv[bj][0], b = acc[ai][bj][m][1] + bv[bj][1];
#pragma unroll
                    for (int q = 0; q < 4; ++q) { a[q] = sigmoid_f(a[q]); b[q] = sigmoid_f(b[q]); }
                    ST16((GAS u32x4*)(rowp + bj * 128), pack8(a, b)); }
            }
    }
};

struct EpiMerge {
    static constexpr bool PERM = true, AFTER_DRAIN = false;
    bf16* Y; const bf16* G0; long g1off; int gld; int gsplit_tiles;
    int first; int dry;
    __device__ __forceinline__ void operator()(const f32x4 (&acc)[2][2][4][2], const Unit& u, int wr, int wc, int fr, int fq) const {
        const int R0 = u.pm * 256, pn = u.pn, cin = 32 * wc + 8 * fq;
        const bf16* gb = G0 + (pn < gsplit_tiles ? (long)pn * 256 : g1off + (long)(pn - gsplit_tiles) * 256);
#pragma unroll
        for (int ai = 0; ai < 2; ++ai)
#pragma unroll
            for (int m = 0; m < 4; ++m) {
                const int r = R0 + ai * 128 + wr * 64 + m * 16 + fr; bf16* yp = Y + (size_t)r * DM + pn * 256 + cin; const bf16* gp = gb + (size_t)r * gld + cin;
#pragma unroll
                for (int bj = 0; bj < 2; ++bj) {
                    const u32x4 gw = *(const GAS u32x4*)(gp + bj * 128); f32x4 ga, gb2; unpack8(gw, ga, gb2);
                    f32x4 a = acc[ai][bj][m][0] * ga, b = acc[ai][bj][m][1] * gb2;
                    if (!first) { const u32x4 yw = *(const GAS u32x4*)(yp + bj * 128); f32x4 ya, yb; unpack8(yw, ya, yb); a += ya; b += yb; }
                    if (!dry) *(GAS u32x4*)(yp + bj * 128) = pack8(a, b); }
            }
    }
};

template <bool INF32>
struct EpiResid {
    static constexpr bool PERM = true, AFTER_DRAIN = false;
    const void* xb; bf16* xo; long cbd; const float* modl; int slot; int dry;
    __device__ __forceinline__ void operator()(const f32x4 (&acc)[2][2][4][2], const Unit& u, int wr, int wc, int fr, int fq) const {
        const int R0 = u.pm * 256; const bool isctx = R0 >= ML; const int b = isctx ? 16 : (R0 >> 12);
        const int col0 = u.pn * 256 + wc * 32 + 8 * fq; const float* gp = modl + (size_t)b * 6144 + slot * 1024 + col0;
        f32x4 gv[2][2];
#pragma unroll
        for (int bj = 0; bj < 2; ++bj)
#pragma unroll
            for (int n = 0; n < 2; ++n) gv[bj][n] = *(const GAS f32x4*)(gp + bj * 128 + n * 4);
#pragma unroll
        for (int ai = 0; ai < 2; ++ai)
#pragma unroll
            for (int m = 0; m < 4; ++m) { const size_t off = (size_t)(R0 + ai * 128 + wr * 64 + m * 16 + fr) * DM + col0;
#pragma unroll
                for (int bj = 0; bj < 2; ++bj) {
                    f32x4 b0, b1;
                    if constexpr (INF32) { const float* base = (const float*)xb + (isctx ? cbd : 0l); b0 = *(const GAS f32x4*)(base + off + bj * 128); b1 = *(const GAS f32x4*)(base + off + bj * 128 + 4); }
                    else { const u32x4 w = *(const GAS u32x4*)((const bf16*)xb + off + bj * 128); unpack8(w, b0, b1); }
                    const f32x4 r0 = b0 + gv[bj][0] * acc[ai][bj][m][0], r1 = b1 + gv[bj][1] * acc[ai][bj][m][1];
                    u32x4 o; o.x = pg8::cvt_pk_bf16(r0[0], r0[1]); o.y = pg8::cvt_pk_bf16(r0[2], r0[3]); o.z = pg8::cvt_pk_bf16(r1[0], r1[1]); o.w = pg8::cvt_pk_bf16(r1[2], r1[3]);
                    if (!dry) *(GAS u32x4*)(xo + off + bj * 128) = o; }
            }
    }
};

struct EpiSwiGLU {
    static constexpr bool PERM = true, AFTER_DRAIN = false;
    bf16* ACT; int ld, pm0, npe;
    __device__ __forceinline__ void operator()(const f32x4 (&acc)[2][2][4][2], const Unit& u, int wr, int wc, int fr, int fq) const {
        const int R0 = (u.pm - pm0) * 256, jt = u.pn % npe, c0 = jt * 128 + 32 * wc + 8 * fq;
#pragma unroll
        for (int ai = 0; ai < 2; ++ai)
#pragma unroll
            for (int m = 0; m < 4; ++m) {
                const int r = R0 + ai * 128 + wr * 64 + m * 16 + fr; f32x4 a, b;
#pragma unroll
                for (int q = 0; q < 4; ++q) { a[q] = silu_f(acc[ai][0][m][0][q]) * acc[ai][1][m][0][q]; b[q] = silu_f(acc[ai][0][m][1][q]) * acc[ai][1][m][1][q]; }
#ifdef NT_ACT
                __builtin_nontemporal_store(pack8(a, b), (GAS u32x4*)(ACT + (size_t)r * ld + c0)); }
#else
                *(GAS u32x4*)(ACT + (size_t)r * ld + c0) = pack8(a, b); }
#endif
    }
};

struct EpiStoreBf16 {
    static constexpr bool PERM = true, AFTER_DRAIN = false;
    bf16* O; int ld, pm0, npe;
    __device__ __forceinline__ void operator()(const f32x4 (&acc)[2][2][4][2], const Unit& u, int wr, int wc, int fr, int fq) const {
        const int R0 = (pm0 + u.pm) * 256, c0 = (u.pn % npe) * 256 + 32 * wc + 8 * fq;
#pragma unroll
        for (int ai = 0; ai < 2; ++ai)
#pragma unroll
            for (int m = 0; m < 4; ++m) { bf16* rowp = O + (size_t)(R0 + ai * 128 + wr * 64 + m * 16 + fr) * ld + c0;
#pragma unroll
#ifdef NT_PAIR
                for (int bj = 0; bj < 2; ++bj) __builtin_nontemporal_store(pack8(acc[ai][bj][m][0], acc[ai][bj][m][1]), (GAS u32x4*)(rowp + bj * 128)); }
#else
                for (int bj = 0; bj < 2; ++bj) *(GAS u32x4*)(rowp + bj * 128) = pack8(acc[ai][bj][m][0], acc[ai][bj][m][1]); }
#endif
    }
};

struct MoeOrder {
    static constexpr bool GATHER = false;
    pg8::StaticOrder so; int tile0, npe; bool a_global; const volatile LAS int* offl;
    __device__ __forceinline__ bool next(int i, Unit& u) const {
        Unit v; if (!so.next(i, v)) return false;
        const int gt = tile0 + v.pm, row = gt * 256; int e = 0;
#pragma unroll
        for (int q = 1; q < 8; ++q) e += (offl[q] <= row) ? 1 : 0;
        u.pm = a_global ? gt : v.pm; u.pn = e * npe + v.pn; return true;
    }
    __device__ __forceinline__ void a_ready(const Unit&) const {}
    __device__ __forceinline__ void done(const Unit&) const {}
};

struct MoeOrderG {
    static constexpr bool GATHER = true;
    MoeOrder mo; const unsigned* rowmap;
    __device__ __forceinline__ bool next(int i, Unit& u) const { return mo.next(i, u); }
    __device__ __forceinline__ void a_ready(const Unit&) const {}
    __device__ __forceinline__ void done(const Unit&) const {}
};

struct GateOrder {
    static constexpr bool GATHER = false;
    pg8::StaticOrder so;
    __device__ __forceinline__ bool next(int i, Unit& u) const { Unit v; if (!so.next(i / 3, v)) return false; u.pm = v.pm; u.pn = v.pn + 4 * (i % 3); return true; }
    __device__ __forceinline__ void a_ready(const Unit&) const {}
    __device__ __forceinline__ void done(const Unit&) const {}
};

struct BigOrderL1 {
    static constexpr bool GATHER = false;
    pg8::StaticOrder so; int G, c;
    __device__ __forceinline__ bool next(int i, Unit& u) const {
        const int L = i * G + c, nlat = (ML / 256) * (NBIG / 256);
        if (L < nlat) return so.next(i, u);
        const int k = L - nlat; if (k >= (MC / 256) * 8) return false;
        u.pm = ML / 256 + (k >> 3); u.pn = 4 + (k & 7); return true;
    }
    __device__ __forceinline__ void a_ready(const Unit&) const {}
    __device__ __forceinline__ void done(const Unit&) const {}
};


namespace att {
using bf16x8 = __attribute__((ext_vector_type(8))) short;
using s16x4  = __attribute__((ext_vector_type(4))) short;
using f32x16 = __attribute__((ext_vector_type(16))) float;
constexpr int NW = 8, QBLK = 32, KVBLK = 64, LD = 1024;
constexpr int SHM_V = KVBLK * 128 * 2, SHM_K = KVBLK * 128 * 2, SHM_ATTN = 2 * SHM_V + 2 * SHM_K + NW * 64 * 4;
#define KSWZ(row, colB) ((row) * 256 + ((colB) ^ (((row) & 7) << 4)))
#define SBAR() __builtin_amdgcn_sched_barrier(0)
__device__ __forceinline__ int crow(int r, int hi) { return (r & 3) + 8 * (r >> 2) + 4 * hi; }
__device__ __forceinline__ unsigned cvtpk(float lo, float hi) { return pg8::cvt_pk_bf16(lo, hi); }

__device__ __forceinline__ void partialSM(f32x16& p0) {
#pragma unroll
  for (int r = 0; r < 16; ++r) p0[r] = __builtin_amdgcn_exp2f(p0[r]);
}
__device__ __forceinline__ void finishSM(f32x16& p0, f32x16& p1, float& l_reg, bf16x8& pa0, bf16x8& pa1, bf16x8& pa2, bf16x8& pa3) {
#pragma unroll
  for (int r = 0; r < 16; ++r) p1[r] = __builtin_amdgcn_exp2f(p1[r]);
  float ps = 0;
#pragma unroll
  for (int r = 0; r < 16; ++r) ps += p0[r];
#pragma unroll
  for (int r = 0; r < 16; ++r) ps += p1[r];
  l_reg += ps;
#define PK4(P, BASE, OUT) do { unsigned a0 = cvtpk(P[BASE + 0], P[BASE + 1]), a1 = cvtpk(P[BASE + 2], P[BASE + 3]);   \
    unsigned b0 = cvtpk(P[BASE + 4], P[BASE + 5]), b1 = cvtpk(P[BASE + 6], P[BASE + 7]);                              \
    auto r0 = __builtin_amdgcn_permlane32_swap(a0, b0, false, false); auto r1 = __builtin_amdgcn_permlane32_swap(a1, b1, false, false); \
    u32x4 w = {r0[0], r1[0], r0[1], r1[1]}; OUT = __builtin_bit_cast(bf16x8, w); } while (0)
  PK4(p0, 0, pa0); PK4(p0, 8, pa1); PK4(p1, 0, pa2); PK4(p1, 8, pa3);
#undef PK4
}
__device__ __forceinline__ void qkt(f32x16& p0, f32x16& p1, const LAS char* Ks, const bf16x8* qr, int r32, int hi, int mp) {
  p0 = f32x16{}; p1 = f32x16{};
#ifdef ATT_PRIO
  __builtin_amdgcn_s_setprio(1);
#endif
#pragma unroll
  for (int d0 = 0; d0 < 4; ++d0) { const int cb = (mp * 64 + d0 * 16 + hi * 8) * 2;
    const bf16x8 b0 = *(const LAS bf16x8*)(Ks + KSWZ(r32, cb));
    const bf16x8 b1 = *(const LAS bf16x8*)(Ks + KSWZ(32 + r32, cb));
    p0 = __builtin_amdgcn_mfma_f32_32x32x16_bf16(b0, qr[d0], p0, 0, 0, 0);
    p1 = __builtin_amdgcn_mfma_f32_32x32x16_bf16(b1, qr[d0], p1, 0, 0, 0); }
#ifdef ATT_PRIO
  __builtin_amdgcn_s_setprio(0);
#endif
}
__device__ __forceinline__ int v_st(int k, int c) { const int kk = (k & ~0xC) | ((k & 4) << 1) | ((k & 8) >> 1); return ((kk >> 3) * 4 + (c >> 5)) * 512 + ((kk & 7) * 32 + (c & 31)) * 2; }
__device__ __forceinline__ int v_rd_base(int lane) { return ((lane & 3) << 3) | (((lane >> 2) & 3) << 6) | (((lane >> 4) & 1) << 5) | (((lane >> 5) & 1) << 8); }
constexpr int v_rd_off(int d0, int ks, int half) { return d0 * 512 + ks * 4096 + half * 2048; }
template <int OFF> __device__ __forceinline__ s16x4 tr_read(int vb) {
  s16x4 r; asm volatile("ds_read_b64_tr_b16 %0, %1 offset:%2" : "=&v"(r) : "v"(vb), "i"(OFF) : "memory"); return r;
}
template <int D0> __device__ __forceinline__ void pv_one(f32x16& od, int vb, bf16x8 pa0, bf16x8 pa1, bf16x8 pa2, bf16x8 pa3) {
  const s16x4 l0 = tr_read<v_rd_off(D0, 0, 0)>(vb), h0 = tr_read<v_rd_off(D0, 0, 1)>(vb), l1 = tr_read<v_rd_off(D0, 1, 0)>(vb), h1 = tr_read<v_rd_off(D0, 1, 1)>(vb);
  const s16x4 l2 = tr_read<v_rd_off(D0, 2, 0)>(vb), h2 = tr_read<v_rd_off(D0, 2, 1)>(vb), l3 = tr_read<v_rd_off(D0, 3, 0)>(vb), h3 = tr_read<v_rd_off(D0, 3, 1)>(vb);
  asm volatile("s_waitcnt lgkmcnt(0)" ::: "memory"); SBAR();
#define PK(L, H) (bf16x8){L[0], L[1], L[2], L[3], H[0], H[1], H[2], H[3]}
  od = __builtin_amdgcn_mfma_f32_32x32x16_bf16(pa0, PK(l0, h0), od, 0, 0, 0);
  od = __builtin_amdgcn_mfma_f32_32x32x16_bf16(pa1, PK(l1, h1), od, 0, 0, 0);
  od = __builtin_amdgcn_mfma_f32_32x32x16_bf16(pa2, PK(l2, h2), od, 0, 0, 0);
  od = __builtin_amdgcn_mfma_f32_32x32x16_bf16(pa3, PK(l3, h3), od, 0, 0, 0);
#undef PK
}
__device__ __forceinline__ void pv_d0(f32x16* o, int vb, bf16x8 pa0, bf16x8 pa1, bf16x8 pa2, bf16x8 pa3) {
  pv_one<0>(o[0], vb, pa0, pa1, pa2, pa3); pv_one<1>(o[1], vb, pa0, pa1, pa2, pa3); pv_one<2>(o[2], vb, pa0, pa1, pa2, pa3); pv_one<3>(o[3], vb, pa0, pa1, pa2, pa3);
}

struct VFrag { s16x4 l0, h0, l1, h1, l2, h2, l3, h3; };
template <int D0> __device__ __forceinline__ void v_load(VFrag& f, int vb) {
  f.l0 = tr_read<v_rd_off(D0, 0, 0)>(vb); f.h0 = tr_read<v_rd_off(D0, 0, 1)>(vb); f.l1 = tr_read<v_rd_off(D0, 1, 0)>(vb); f.h1 = tr_read<v_rd_off(D0, 1, 1)>(vb);
  f.l2 = tr_read<v_rd_off(D0, 2, 0)>(vb); f.h2 = tr_read<v_rd_off(D0, 2, 1)>(vb); f.l3 = tr_read<v_rd_off(D0, 3, 0)>(vb); f.h3 = tr_read<v_rd_off(D0, 3, 1)>(vb);
}
__device__ __forceinline__ void pv_mma(f32x16& od, const VFrag& f, bf16x8 pa0, bf16x8 pa1, bf16x8 pa2, bf16x8 pa3) {
#define PK(L, H) (bf16x8){L[0], L[1], L[2], L[3], H[0], H[1], H[2], H[3]}
#ifdef ATT_PRIO
  __builtin_amdgcn_s_setprio(1);
#endif
  od = __builtin_amdgcn_mfma_f32_32x32x16_bf16(pa0, PK(f.l0, f.h0), od, 0, 0, 0);
  od = __builtin_amdgcn_mfma_f32_32x32x16_bf16(pa1, PK(f.l1, f.h1), od, 0, 0, 0);
  od = __builtin_amdgcn_mfma_f32_32x32x16_bf16(pa2, PK(f.l2, f.h2), od, 0, 0, 0);
  od = __builtin_amdgcn_mfma_f32_32x32x16_bf16(pa3, PK(f.l3, f.h3), od, 0, 0, 0);
#ifdef ATT_PRIO
  __builtin_amdgcn_s_setprio(0);
#endif
#undef PK
}
#define LWAIT(n) do { asm volatile("s_waitcnt lgkmcnt(" #n ")" ::: "memory"); SBAR(); } while (0)
__device__ __forceinline__ void pv_pipe(f32x16* o, int vb, VFrag& f0, bf16x8 pa0, bf16x8 pa1, bf16x8 pa2, bf16x8 pa3) {
  VFrag f1;
  v_load<1>(f1, vb); LWAIT(8); pv_mma(o[0], f0, pa0, pa1, pa2, pa3); SBAR();
  v_load<2>(f0, vb); LWAIT(8); pv_mma(o[1], f1, pa0, pa1, pa2, pa3); SBAR();
  v_load<3>(f1, vb); LWAIT(8); pv_mma(o[2], f0, pa0, pa1, pa2, pa3); SBAR();
  LWAIT(0); pv_mma(o[3], f1, pa0, pa1, pa2, pa3);
}

#ifndef ATT_VPIPE
#define ATT_VPIPE 1
#endif
#if ATT_VPIPE
#define ATT_STEP_BODY(b) qkt(p0, p1, K_lds + (b) * SHM_K, qr, r32, hi, mp); SBAR(); VFrag vf0; v_load<0>(vf0, vb0 + (b) * SHM_V); SBAR(); \
    partialSM(p0); finishSM(p0, p1, l_reg, pa0, pa1, pa2, pa3); SBAR(); pv_pipe(o, vb0 + (b) * SHM_V, vf0, pa0, pa1, pa2, pa3); SBAR();
#else
#define ATT_STEP_BODY(b) qkt(p0, p1, K_lds + (b) * SHM_K, qr, r32, hi, mp); partialSM(p0); finishSM(p0, p1, l_reg, pa0, pa1, pa2, pa3); SBAR(); pv_d0(o, vb0 + (b) * SHM_V, pa0, pa1, pa2, pa3); SBAR();
#endif
__device__ __forceinline__ void diff_attn_unit(const bf16* Qb_, const bf16* Kh_, const bf16* Vh_, bf16* Ob_, int NT,
                                               float lam, const float* subg_, float oml, LAS char* lds, bool dostore = true, int rot = 0) {
  const GAS bf16* Qb = (const GAS bf16*)Qb_; const GAS bf16* Kh = (const GAS bf16*)Kh_; const GAS bf16* Vh = (const GAS bf16*)Vh_; GAS bf16* Ob = (GAS bf16*)Ob_; const GAS float* subg = (const GAS float*)subg_;
  const int tid = threadIdx.x, wid = tid >> 6, lane = tid & 63, r32 = lane & 31, hi = lane >> 5, qg = wid >> 1, mp = wid & 1;
  LAS char* V_lds = lds; LAS char* K_lds = lds + 2 * SHM_V;
  LAS float* ws = (LAS float*)(lds + 2 * SHM_V + 2 * SHM_K) + wid * 64; LAS float* li_l = ws; LAS float* al_l = ws + 32;
  float l_reg = 0; f32x16 o[4] = {}; bf16x8 qr[4];
  const GAS bf16* Qw = Qb + (long)(qg * QBLK + r32) * LD + mp * 64 + hi * 8;
#pragma unroll
  for (int d0 = 0; d0 < 4; ++d0) qr[d0] = *(const GAS bf16x8*)(Qw + d0 * 16);
  const int vb0 = (int)(unsigned)(uintptr_t)V_lds + v_rd_base(lane);
  int offK[2], offV[2];
#pragma unroll
  for (int i = 0; i < 2; ++i) { const int c = wid * 2 + i;
    { const int row = 4 * c + (lane >> 4), p = (lane & 15) ^ (row & 7); offK[i] = row * LD + p * 8; }
    { const int st = 2 * c + (lane >> 5), li = lane & 31, kk = (st >> 2) * 8 + (li >> 2), col = (st & 3) * 32 + (li & 3) * 8, k = (kk & ~0xC) | ((kk & 8) >> 1) | ((kk & 4) << 1); offV[i] = k * LD + col; } }
#define DMA_TILE(b, k0) do { _Pragma("unroll") for (int i_ = 0; i_ < 2; ++i_) {                                                                              \
      __builtin_amdgcn_global_load_lds((const GAS unsigned*)(Kh + (long)(k0) * LD + offK[i_]), (LAS unsigned*)(K_lds + (b) * SHM_K + (wid * 2 + i_) * 1024), 16, 0, 0);  \
      __builtin_amdgcn_global_load_lds((const GAS unsigned*)(Vh + (long)(k0) * LD + offV[i_]), (LAS unsigned*)(V_lds + (b) * SHM_V + (wid * 2 + i_) * 1024), 16, 0, 0); } } while (0)
#define TILE_STEP(b, t) do { f32x16 p0, p1; bf16x8 pa0, pa1, pa2, pa3; SBAR();                                   \
    ATT_STEP_BODY(b)                                                                                              \
    asm volatile("s_waitcnt vmcnt(0)" ::: "memory"); __syncthreads();                                            \
    if ((t) + 2 < NT) DMA_TILE(b, KT((t) + 2) * KVBLK); } while (0)
#define KT(t_) (((t_) + rot) >= NT ? ((t_) + rot) - NT : ((t_) + rot))
  DMA_TILE(0, KT(0) * KVBLK); DMA_TILE(1, KT(1) * KVBLK); asm volatile("s_waitcnt vmcnt(0)" ::: "memory"); __syncthreads();
  for (int t = 0; t < NT; t += 2) { TILE_STEP(0, t); TILE_STEP(1, t + 1); }
#undef TILE_STEP
#undef DMA_TILE
#undef KT
  int lane_e = lane;
#if 1
  asm volatile("" : "+v"(lane_e));
#endif
  { auto rr = __builtin_amdgcn_permlane32_swap(__float_as_uint(l_reg), __float_as_uint(l_reg), false, false); l_reg = __uint_as_float(rr[0]) + __uint_as_float(rr[1]); }
  if (hi == 0) li_l[r32] = l_reg; asm volatile("s_waitcnt lgkmcnt(0)" ::: "memory");
  const int r32e = lane_e & 31, hie = lane_e >> 5;
  float rli[16];
#pragma unroll
  for (int r = 0; r < 16; ++r) rli[r] = __builtin_amdgcn_rcpf(li_l[crow(r, hie)]);
  __syncthreads();
  LAS float* X = (LAS float*)lds + qg * 4096;
  if (mp == 1) {
#pragma unroll
    for (int d0 = 0; d0 < 4; ++d0)
#pragma unroll
      for (int r = 0; r < 16; ++r) X[(d0 * 16 + r) * 64 + lane_e] = o[d0][r] * rli[r] * (-lam);
  }
  __syncthreads();
  if (mp == 0) {
#pragma unroll
    for (int d0 = 0; d0 < 4; ++d0) {
#pragma unroll
      for (int r = 0; r < 16; ++r) o[d0][r] = o[d0][r] * rli[r] + X[(d0 * 16 + r) * 64 + lane_e];
      asm volatile("" ::: "memory");
    }
    float g4[4];
#pragma unroll
    for (int d0 = 0; d0 < 4; ++d0) g4[d0] = subg[32 * d0 + r32e] * oml;
    GAS bf16* Ow = Ob + (long)(qg * QBLK) * LD;
#pragma unroll
    for (int r = 0; r < 16; ++r) {
      float ss = (o[0][r] * o[0][r] + o[1][r] * o[1][r]) + (o[2][r] * o[2][r] + o[3][r] * o[3][r]);
      ss += __shfl_xor(ss, 1); ss += __shfl_xor(ss, 2); ss += __shfl_xor(ss, 4); ss += __shfl_xor(ss, 8); ss += __shfl_xor(ss, 16);
      const float rs = 1.0f / sqrtf(ss * (1.f / 128.f) + EPS); const int orow = crow(r, hie);
#pragma unroll
      for (int d0 = 0; d0 < 4; ++d0) if (dostore) Ow[(long)orow * LD + d0 * 32 + r32e] = (bf16)f2bf(o[d0][r] * rs * g4[d0]);
    }
  }
  __syncthreads();
}

template <bool CTX>
__device__ __forceinline__ void diff_attn_units(const bf16* Q_, const bf16* K_, const bf16* V_, int first, int count, int stride,
                                                float lam, const float* subg_, float oml, LAS char* lds) {
  constexpr int NT = CTX ? CTXL / 64 : SKV / 64;
  if (first >= count) return;
  const GAS bf16* Qg = (const GAS bf16*)Q_; const GAS bf16* Kg = (const GAS bf16*)K_; const GAS bf16* Vg = (const GAS bf16*)V_; const GAS float* subg = (const GAS float*)subg_;
  const int tid = threadIdx.x, wid = tid >> 6, lane = tid & 63, r32 = lane & 31, hi = lane >> 5, qg = wid >> 1, mp = wid & 1;
  LAS char* V_lds = lds; LAS char* K_lds = lds + 2 * SHM_V;
  LAS float* ws = (LAS float*)(lds + 2 * SHM_V + 2 * SHM_K) + wid * 64; LAS float* li_l = ws;
  LAS float* X = (LAS float*)(lds + SHM_ATTN) + qg * 4096;
  const int vb0 = (int)(unsigned)(uintptr_t)V_lds + v_rd_base(lane);
  int offK[2], offV[2];
#pragma unroll
  for (int i = 0; i < 2; ++i) { const int c = wid * 2 + i;
    { const int row = 4 * c + (lane >> 4), p = (lane & 15) ^ (row & 7); offK[i] = row * LD + p * 8; }
    { const int st = 2 * c + (lane >> 5), li = lane & 31, kk = (st >> 2) * 8 + (li >> 2), col = (st & 3) * 32 + (li & 3) * 8, k = (kk & ~0xC) | ((kk & 8) >> 1) | ((kk & 4) << 1); offV[i] = k * LD + col; } }
#define UNIT_Q(u_) (CTX ? ((size_t)ML + ((u_) >> 4) * CTXL + ((u_) & 1) * 128) * DM + (((u_) >> 1) & 7) * 128 : ((size_t)((u_) >> 8) * SEQ + ((u_) & 31) * 128) * DM + (((u_) >> 5) & 7) * 128)
#define UNIT_K(u_) (CTX ? ((size_t)((u_) >> 4) * SKV + SEQ) * DM + (((u_) >> 1) & 7) * 128 : (size_t)((u_) >> 8) * SKV * DM + (((u_) >> 5) & 7) * 128)
#define UNIT_ROT(u_) (CTX ? 0 : ((u_) & 31) * 2)
#define DMA_TILE(b, k0) do { _Pragma("unroll") for (int i_ = 0; i_ < 2; ++i_) {                                                                              \
      __builtin_amdgcn_global_load_lds((const GAS unsigned*)(Kh + (long)(k0) * LD + offK[i_]), (LAS unsigned*)(K_lds + (b) * SHM_K + (wid * 2 + i_) * 1024), 16, 0, 0);  \
      __builtin_amdgcn_global_load_lds((const GAS unsigned*)(Vh + (long)(k0) * LD + offV[i_]), (LAS unsigned*)(V_lds + (b) * SHM_V + (wid * 2 + i_) * 1024), 16, 0, 0); } } while (0)
#define KT(t_) (((t_) + rot) >= NT ? ((t_) + rot) - NT : ((t_) + rot))
#define TILE_STEP(b, t) do { f32x16 p0, p1; bf16x8 pa0, pa1, pa2, pa3; SBAR();                                   \
    ATT_STEP_BODY(b)                                                                                              \
    asm volatile("s_waitcnt vmcnt(0)" ::: "memory"); __syncthreads();                                            \
    if ((t) + 2 < NT) DMA_TILE(b, KT((t) + 2) * KVBLK); } while (0)
  int u = first; int rot = UNIT_ROT(u);
  const GAS bf16* Kh = Kg + UNIT_K(u); const GAS bf16* Vh = Vg + UNIT_K(u); size_t qoff = UNIT_Q(u);
  bf16x8 qr[4];
  { const GAS bf16* Qw = Qg + qoff + (long)(qg * QBLK + r32) * LD + mp * 64 + hi * 8;
#pragma unroll
    for (int d0 = 0; d0 < 4; ++d0) qr[d0] = *(const GAS bf16x8*)(Qw + d0 * 16); }
  DMA_TILE(0, KT(0) * KVBLK); DMA_TILE(1, KT(1) * KVBLK); asm volatile("s_waitcnt vmcnt(0)" ::: "memory"); __syncthreads();
  for (;;) {
    float l_reg = 0; f32x16 o[4] = {};
    for (int t = 0; t < NT; t += 2) { TILE_STEP(0, t); TILE_STEP(1, t + 1); }
    GAS bf16* Ob = (GAS bf16*)Qg + qoff;
    const int un = u + stride; const bool has_next = un < count;
    if (has_next) {
      rot = UNIT_ROT(un); Kh = Kg + UNIT_K(un); Vh = Vg + UNIT_K(un); qoff = UNIT_Q(un);
      const GAS bf16* Qw = Qg + qoff + (long)(qg * QBLK + r32) * LD + mp * 64 + hi * 8;
#pragma unroll
      for (int d0 = 0; d0 < 4; ++d0) qr[d0] = *(const GAS bf16x8*)(Qw + d0 * 16);
      DMA_TILE(0, KT(0) * KVBLK); DMA_TILE(1, KT(1) * KVBLK);
    }
    int lane_e = lane; asm volatile("" : "+v"(lane_e));
    { auto rr = __builtin_amdgcn_permlane32_swap(__float_as_uint(l_reg), __float_as_uint(l_reg), false, false); l_reg = __uint_as_float(rr[0]) + __uint_as_float(rr[1]); }
    if (hi == 0) li_l[r32] = l_reg; asm volatile("s_waitcnt lgkmcnt(0)" ::: "memory");
    const int r32e = lane_e & 31, hie = lane_e >> 5;
    float rli[16];
#pragma unroll
    for (int r = 0; r < 16; ++r) rli[r] = __builtin_amdgcn_rcpf(li_l[crow(r, hie)]);
    if (mp == 1) {
#pragma unroll
      for (int d0 = 0; d0 < 4; ++d0)
#pragma unroll
        for (int r = 0; r < 16; ++r) X[(d0 * 16 + r) * 64 + lane_e] = o[d0][r] * rli[r] * (-lam);
    }
    asm volatile("s_waitcnt lgkmcnt(0)" ::: "memory"); __builtin_amdgcn_s_barrier(); asm volatile("" ::: "memory");
    if (mp == 0) {
#pragma unroll
      for (int d0 = 0; d0 < 4; ++d0) {
#pragma unroll
        for (int r = 0; r < 16; ++r) o[d0][r] = o[d0][r] * rli[r] + X[(d0 * 16 + r) * 64 + lane_e];
        asm volatile("" ::: "memory");
      }
      float g4[4];
#pragma unroll
      for (int d0 = 0; d0 < 4; ++d0) g4[d0] = subg[32 * d0 + r32e] * oml;
      GAS bf16* Ow = Ob + (long)(qg * QBLK) * LD;
#pragma unroll
      for (int r = 0; r < 16; ++r) {
        float ss = (o[0][r] * o[0][r] + o[1][r] * o[1][r]) + (o[2][r] * o[2][r] + o[3][r] * o[3][r]);
        ss += __shfl_xor(ss, 1); ss += __shfl_xor(ss, 2); ss += __shfl_xor(ss, 4); ss += __shfl_xor(ss, 8); ss += __shfl_xor(ss, 16);
        const float rs = 1.0f / sqrtf(ss * (1.f / 128.f) + EPS); const int orow = crow(r, hie);
#pragma unroll
        for (int d0 = 0; d0 < 4; ++d0) Ow[(long)orow * LD + d0 * 32 + r32e] = (bf16)f2bf(o[d0][r] * rs * g4[d0]);
      }
    }
    asm volatile("s_waitcnt vmcnt(0) lgkmcnt(0)" ::: "memory"); __syncthreads();
    if (!has_next) break;
    u = un;
  }
#undef TILE_STEP
#undef DMA_TILE
#undef KT
#undef UNIT_Q
#undef UNIT_K
#undef UNIT_ROT
}
#undef KSWZ
#undef SBAR
}

constexpr int VT_PITCH = 272;
constexpr int MIX_VT_BYTES = 512 * VT_PITCH;
constexpr int MIX_ST_OFF = MIX_VT_BYTES;
static_assert(MIX_ST_OFF + 1024 <= LDSCTL_OFF, "mixer LDS");
__device__ __forceinline__ void mixer_chunk(const Ctx& C, int ch, bf16* P0, const bf16* P1, bf16* P2, const bf16* P3,
                                            const float* ln_g, const float* ln_b, const bf16* aws  , const float* abs_  , const float* convw  , bool dostore = true) {
    const int row0 = ch * 128, tid = C.tid, lane = C.lane, wid = C.wave;
    LAS unsigned char* VT = C.lds; LAS f32x2* ST = (LAS f32x2*)(C.lds + MIX_ST_OFF);
#pragma unroll 2
    for (int i = 0; i < 16; ++i) {
        const int s = wid * 16 + i; const u32x4 w = *(const GAS u32x4*)(P1 + (size_t)(row0 + s) * 512 + lane * 8);
        f32x4 a, b; unpack8(w, a, b);
        const float mean = wave_sum((a[0] + a[1]) + (a[2] + a[3]) + (b[0] + b[1]) + (b[2] + b[3])) * (1.f / 512.f);
        a = a - mean; b = b - mean;
        const float var = wave_sum((a[0] * a[0] + a[1] * a[1]) + (a[2] * a[2] + a[3] * a[3]) + (b[0] * b[0] + b[1] * b[1]) + (b[2] * b[2] + b[3] * b[3])) * (1.f / 512.f);
        if (lane == 0) ST[s] = (f32x2){mean, 1.0f / sqrtf(var + EPS)};
    }
    __syncthreads();
    {
        const int s = tid & 127, q = tid >> 7; const f32x2 st = ST[s]; const bf16* src = P1 + (size_t)(row0 + s) * 512 + q * 128;
#pragma unroll 2
        for (int i = 0; i < 16; ++i) {
            const int c0 = q * 128 + i * 8; const u32x4 w = *(const GAS u32x4*)(src + i * 8); f32x4 a, b; unpack8(w, a, b);
            const f32x4 g0 = *(const GAS f32x4*)(ln_g + c0), g1 = *(const GAS f32x4*)(ln_g + c0 + 4), b0 = *(const GAS f32x4*)(ln_b + c0), b1 = *(const GAS f32x4*)(ln_b + c0 + 4);
            a = (a - st.x) * st.y * g0 + b0; b = (b - st.x) * st.y * g1 + b1;
#pragma unroll
            for (int e = 0; e < 4; ++e) { *(LAS bf16*)(VT + (c0 + e) * VT_PITCH + s * 2) = (bf16)f2bf(a[e]); *(LAS bf16*)(VT + (c0 + 4 + e) * VT_PITCH + s * 2) = (bf16)f2bf(b[e]); }
        }
    }
    __syncthreads();
    {
        const int g = wid, fr = lane & 15, fq = lane >> 4;
        const bf16* wg = aws + (size_t)g * 128 * 128;
#pragma unroll 1
        for (int th = 0; th < 2; ++th) {
            f32x4 acc[4][4];
#pragma unroll
            for (int ti = 0; ti < 4; ++ti)
#pragma unroll
                for (int ei = 0; ei < 4; ++ei) acc[ti][ei] = (f32x4){0.f, 0.f, 0.f, 0.f};
#pragma unroll 1
            for (int kk = 0; kk < 4; ++kk) {
                bf16x8 xf[4], yf[4];
#pragma unroll
                for (int ei = 0; ei < 4; ++ei) xf[ei] = *(const LAS bf16x8*)(VT + (g * 64 + 16 * ei + fr) * VT_PITCH + (32 * kk + 8 * fq) * 2);
#pragma unroll
                for (int ti = 0; ti < 4; ++ti) yf[ti] = *(const GAS bf16x8*)(wg + (size_t)(64 * th + 16 * ti + fr) * 128 + 32 * kk + 8 * fq);
#pragma unroll
                for (int ti = 0; ti < 4; ++ti)
#pragma unroll
                    for (int ei = 0; ei < 4; ++ei) acc[ti][ei] = __builtin_amdgcn_mfma_f32_16x16x32_bf16(xf[ei], yf[ti], acc[ti][ei], 0, 0, 0);
            }
#pragma unroll
            for (int ti = 0; ti < 4; ++ti) {
                const int t = 64 * th + 16 * ti + fr; const float bs = abs_[g * 128 + t];
#pragma unroll
                for (int ei = 0; ei < 4; ++ei) {
                    bf16* p = P0 + (size_t)(row0 + t) * 512 + g * 64 + 16 * ei + 4 * fq; const v2u uw = *(const GAS v2u*)p;
                    const f32x4 a = acc[ti][ei] + bs;
                    v2u ow; ow.x = cvt_pk_bf16(bf2f(uw.x & 0xffffu) * a[0], bf2f(uw.x >> 16) * a[1]); ow.y = cvt_pk_bf16(bf2f(uw.y & 0xffffu) * a[2], bf2f(uw.y >> 16) * a[3]);
                    if (dostore) *(GAS v2u*)p = ow; }
            }
        }
    }
    {
        const int c0 = lane * 8;
        f32x4 w0a = *(const GAS f32x4*)(convw + c0), w0b = *(const GAS f32x4*)(convw + c0 + 4), w1a = *(const GAS f32x4*)(convw + 512 + c0), w1b = *(const GAS f32x4*)(convw + 512 + c0 + 4),
              w2a = *(const GAS f32x4*)(convw + 1024 + c0), w2b = *(const GAS f32x4*)(convw + 1024 + c0 + 4);
#pragma unroll 2
        for (int i = 0; i < 16; ++i) {
            const int r = row0 + wid * 16 + i; const bool isctx = r >= ML; const int tseq = isctx ? ((r - ML) & 255) : (r & 4095), last = isctx ? 255 : 4095;
            const u32x4 zero = {0u, 0u, 0u, 0u};
            const u32x4 zm = tseq > 0 ? *(const GAS u32x4*)(P3 + (size_t)(r - 1) * 512 + c0) : zero;
            const u32x4 zc = *(const GAS u32x4*)(P3 + (size_t)r * 512 + c0);
            const u32x4 zp = tseq < last ? *(const GAS u32x4*)(P3 + (size_t)(r + 1) * 512 + c0) : zero;
            const u32x4 bw = *(const GAS u32x4*)(P2 + (size_t)r * 512 + c0);
            f32x4 ma, mb, ca, cb, pa, pb, ba, bb; unpack8(zm, ma, mb); unpack8(zc, ca, cb); unpack8(zp, pa, pb); unpack8(bw, ba, bb);
            const f32x4 ya = ba * (w0a * ma + w1a * ca + w2a * pa), yb = bb * (w0b * mb + w1b * cb + w2b * pb);
            if (dostore) *(GAS u32x4*)(P2 + (size_t)r * 512 + c0) = pack8(ya, yb);
        }
    }
    __syncthreads();
}

__device__ __forceinline__ void route_phase(const Ctx& C, const bf16* x, const float* gn, const float* modl, const float* w_router, bf16* H, unsigned* route, bool dry = false) {
    LAS float* Wl = (LAS float*)C.lds;
    for (int idx = C.tid; idx < 8192; idx += NTHREADS) { const int k = idx >> 3, e = idx & 7; Wl[((k & 3) + 4 * (k >> 8)) * 512 + ((k >> 2) & 63) * 8 + e] = w_router[idx]; }
    __syncthreads();
    const int RPW = (ML + C.NGW - 1) / C.NGW;
    const int lane = C.lane; const int r0 = C.gw * RPW;
    unsigned long long lc = 0ull;
    unsigned my_e = 0u, my_p = 0u; float my_w1 = 0.f, my_w2 = 0.f;
    f32x4 mg[4], msc[4], msh[4]; v2u raw[4];
    { const int bq = (r0 < ML ? r0 : 0) >> 12; const float* scv = modl + (size_t)bq * 6144 + 4 * 1024; const float* shv = modl + (size_t)bq * 6144 + 3 * 1024;
#pragma unroll
      for (int j = 0; j < 4; ++j) { mg[j] = ((const GAS f32x4*)gn)[lane + 64 * j]; msc[j] = ((const GAS f32x4*)scv)[lane + 64 * j]; msh[j] = ((const GAS f32x4*)shv)[lane + 64 * j]; }
      const int rq = r0 < ML ? r0 : 0;
#pragma unroll
      for (int j = 0; j < 4; ++j) raw[j] = ((const GAS v2u*)(x + (size_t)rq * DM))[lane + 64 * j]; }
    for (int it = 0; it < RPW; ++it) {
        const int r = r0 + it; if (r >= ML) break;
        if ((r >> 12) != (r0 >> 12) && (r & 4095) == 0) {
            const float* scv = modl + (size_t)(r >> 12) * 6144 + 4 * 1024; const float* shv = modl + (size_t)(r >> 12) * 6144 + 3 * 1024;
#pragma unroll
            for (int j = 0; j < 4; ++j) { msc[j] = ((const GAS f32x4*)scv)[lane + 64 * j]; msh[j] = ((const GAS f32x4*)shv)[lane + 64 * j]; } }
        v2u nraw[4]; const int rn = (it + 1 < RPW && r + 1 < ML) ? r + 1 : r;
#pragma unroll
        for (int j = 0; j < 4; ++j) nraw[j] = ((const GAS v2u*)(x + (size_t)rn * DM))[lane + 64 * j];
        f32x4 y[4];
        { f32x4 v[4]; float ss = 0.f;
#pragma unroll
          for (int j = 0; j < 4; ++j) { v[j][0] = bf2f(raw[j].x & 0xffffu); v[j][1] = bf2f(raw[j].x >> 16); v[j][2] = bf2f(raw[j].y & 0xffffu); v[j][3] = bf2f(raw[j].y >> 16);
              ss += (v[j].x * v[j].x + v[j].y * v[j].y) + (v[j].z * v[j].z + v[j].w * v[j].w); }
          const float rstd = 1.0f / sqrtf(wave_sum(ss) * (1.f / 1024.f) + EPS);
          GAS v2u* o8 = (GAS v2u*)(H + (size_t)r * DM) + lane;
#pragma unroll
          for (int j = 0; j < 4; ++j) { y[j] = (v[j] * rstd) * mg[j] * (msc[j] + 1.0f) + msh[j];
              v2u w; w.x = pg8::cvt_pk_bf16(y[j].x, y[j].y); w.y = pg8::cvt_pk_bf16(y[j].z, y[j].w); o8[64 * j] = w; }
#pragma unroll
          for (int j = 0; j < 4; ++j) raw[j] = nraw[j]; }
        float lg[8];
#pragma unroll
        for (int e = 0; e < 8; ++e) lg[e] = 0.f;
#pragma unroll
        for (int j = 0; j < 4; ++j)
#pragma unroll
            for (int i = 0; i < 4; ++i) { const LAS f32x4* wp = (const LAS f32x4*)(Wl + (i + 4 * j) * 512 + lane * 8); const f32x4 wa = wp[0], wb = wp[1]; const float v = y[j][i];
                lg[0] += v * wa[0]; lg[1] += v * wa[1]; lg[2] += v * wa[2]; lg[3] += v * wa[3]; lg[4] += v * wb[0]; lg[5] += v * wb[1]; lg[6] += v * wb[2]; lg[7] += v * wb[3]; }
#pragma unroll
        for (int e = 0; e < 8; ++e) lg[e] = wave_sum(lg[e]);
        int i1 = 0; float v1 = lg[0];
#pragma unroll
        for (int e = 1; e < 8; ++e) if (lg[e] > v1) { v1 = lg[e]; i1 = e; }
        int i2 = -1; float v2 = -3.0e38f;
#pragma unroll
        for (int e = 0; e < 8; ++e) if (e != i1 && lg[e] > v2) { v2 = lg[e]; i2 = e; }
        const float w1 = 1.f / (1.f + __expf(v2 - v1)), w2 = 1.f - w1;
        const unsigned p1 = (unsigned)(lc >> (8 * i1)) & 0xffu; lc += 1ull << (8 * i1);
        const unsigned p2 = (unsigned)(lc >> (8 * i2)) & 0xffu; lc += 1ull << (8 * i2);
        if (lane == it) { my_e = (unsigned)i1 | ((unsigned)i2 << 8); my_p = p1 | (p2 << 8); my_w1 = w1; my_w2 = w2; }
    }
    unsigned base = 0u;
    if (lane < 8 && !dry) { const unsigned n = (unsigned)(lc >> (8 * lane)) & 0xffu; base = __hip_atomic_fetch_add((unsigned*)(C.ctl + CW_CNT + 64 * lane), n, __ATOMIC_RELAXED, __HIP_MEMORY_SCOPE_AGENT); }
    const unsigned b1 = __shfl(base, (int)(my_e & 0xffu)), b2 = __shfl(base, (int)(my_e >> 8));
    const int r = r0 + lane;
    if (lane < RPW && r < ML && !dry) { u32x4 w; w.x = my_e; w.y = __float_as_uint(my_w1); w.z = __float_as_uint(my_w2); w.w = b1 + (my_p & 0xffu); *(GAS u32x4*)(route + (size_t)r * 8) = w; route[(size_t)r * 8 + 4] = b2 + (my_p >> 8); }
}
__device__ __forceinline__ void moe_offsets(const Ctx& C, volatile LAS int* offl) {
    if (C.tid == 0) { int o = 0;
        for (int e = 0; e < 8; ++e) { const int c = (int)__hip_atomic_load((unsigned*)(C.ctl + CW_CNT + 64 * e), __ATOMIC_RELAXED, __HIP_MEMORY_SCOPE_AGENT); offl[e] = o; offl[16 + e] = c; o += (c + 255) & ~255; }
        offl[8] = o; }
    __syncthreads();
}
__device__ __forceinline__ void gather_phase(const Ctx& C, const bf16* H, bf16* HS, unsigned* route, const volatile LAS int* offl) {
    const int lane = C.lane;
    u32x4 wn = {0u, 0u, 0u, 0u}; unsigned p2n = 0u;
    if (C.gw < ML) { wn = *(const GAS u32x4*)(route + (size_t)C.gw * 8); p2n = route[(size_t)C.gw * 8 + 4]; }
    for (int t = C.gw; t < ML; t += C.NGW) {
        const u32x4 w = wn; const unsigned p2 = p2n;
        const GAS u32x4* src = (const GAS u32x4*)(H + (size_t)t * DM) + lane; const u32x4 a = src[0], b = src[64];
        { const int tn = t + C.NGW < ML ? t + C.NGW : t; wn = *(const GAS u32x4*)(route + (size_t)tn * 8); p2n = route[(size_t)tn * 8 + 4]; }
        const int e1 = w.x & 0xff, e2 = (w.x >> 8) & 0xff; const int s1 = offl[e1] + (int)w.w, s2 = offl[e2] + (int)p2;
        GAS u32x4* d1 = (GAS u32x4*)(HS + (size_t)s1 * DM) + lane; GAS u32x4* d2 = (GAS u32x4*)(HS + (size_t)s2 * DM) + lane;
        d1[0] = a; d1[64] = b; d2[0] = a; d2[64] = b;
        if (lane == 0) { route[(size_t)t * 8 + 5] = (unsigned)s1; route[(size_t)t * 8 + 6] = (unsigned)s2; }
    }
    for (int v = C.gw; v < 8 * 256; v += C.NGW) { const int e = v >> 8, i = v & 255; const int row = offl[e] + offl[16 + e] + i;
        if (row < offl[e + 1]) { GAS u32x4* d = (GAS u32x4*)(HS + (size_t)row * DM) + lane; const u32x4 z = {0u, 0u, 0u, 0u}; d[0] = z; d[64] = z; } }
}
__device__ __forceinline__ void rowmap_phase(const Ctx& C, unsigned* rowmap, unsigned* route, const volatile LAS int* offl) {
    for (int t = C.vcu * NTHREADS + C.tid; t < ML; t += C.G * NTHREADS) {
        const u32x4 w = *(const GAS u32x4*)(route + (size_t)t * 8); const unsigned p2 = route[(size_t)t * 8 + 4];
        const int e1 = w.x & 0xff, e2 = (w.x >> 8) & 0xff; const int s1 = offl[e1] + (int)w.w, s2 = offl[e2] + (int)p2;
        rowmap[s1] = (unsigned)t; rowmap[s2] = (unsigned)t;
        route[(size_t)t * 8 + 5] = (unsigned)s1; route[(size_t)t * 8 + 6] = (unsigned)s2;
    }
    for (int v = C.vcu * NTHREADS + C.tid; v < 8 * 256; v += C.G * NTHREADS) { const int e = v >> 8, i = v & 255; const int row = offl[e] + offl[16 + e] + i;
        if (row < offl[e + 1]) rowmap[row] = 0u; }
}
__device__ __forceinline__ void final_phase(const Ctx& C, const bf16* x16, float* xo, const bf16* HS, const unsigned* route, const float* modl, const float* fg, bool dry = false) {
    const int lane = C.lane;
    f32x4 fgv[4];
#pragma unroll
    for (int h = 0; h < 2; ++h) { fgv[2 * h] = *(const GAS f32x4*)(fg + h * 512 + lane * 8); fgv[2 * h + 1] = *(const GAS f32x4*)(fg + h * 512 + lane * 8 + 4); }
    u32x4 wn = {0u, 0u, 0u, 0u}; unsigned s1n = 0u, s2n = 0u;
    if (C.gw < ML) { wn = *(const GAS u32x4*)(route + (size_t)C.gw * 8); s1n = route[(size_t)C.gw * 8 + 5]; s2n = route[(size_t)C.gw * 8 + 6]; }
    for (int t = C.gw; t < ML; t += C.NGW) {
        const u32x4 w = wn; const unsigned s1 = s1n, s2 = s2n;
        const float w1 = __uint_as_float(w.y), w2 = __uint_as_float(w.z); const int b = t >> 12;
        const float* g2 = modl + (size_t)b * 6144 + 5 * 1024;
        f32x4 v[4]; float ss = 0.f;
#pragma unroll
        for (int h = 0; h < 2; ++h) {
            const int c0 = h * 512 + lane * 8;
            const u32x4 oa = *(const GAS u32x4*)(HS + (size_t)s1 * DM + c0), ob = *(const GAS u32x4*)(HS + (size_t)s2 * DM + c0);
            f32x4 a0, a1, b0, b1; unpack8(oa, a0, a1); unpack8(ob, b0, b1);
            f32x4 x0, x1; { const u32x4 xw = *(const GAS u32x4*)(x16 + (size_t)t * DM + c0); unpack8(xw, x0, x1); }
            const f32x4 g0 = *(const GAS f32x4*)(g2 + c0), g1 = *(const GAS f32x4*)(g2 + c0 + 4);
            v[2 * h] = x0 + g0 * (a0 * w1 + b0 * w2); v[2 * h + 1] = x1 + g1 * (a1 * w1 + b1 * w2);
        }
        { const int tn = t + C.NGW < ML ? t + C.NGW : t; wn = *(const GAS u32x4*)(route + (size_t)tn * 8); s1n = route[(size_t)tn * 8 + 5]; s2n = route[(size_t)tn * 8 + 6]; }
#pragma unroll
        for (int j = 0; j < 4; ++j) ss += (v[j].x * v[j].x + v[j].y * v[j].y) + (v[j].z * v[j].z + v[j].w * v[j].w);
        const float rstd = 1.0f / sqrtf(wave_sum(ss) * (1.f / 1024.f) + EPS);
#pragma unroll
        for (int h = 0; h < 2; ++h) { const int c0 = h * 512 + lane * 8;
            if (!dry) { *(GAS f32x4*)(xo + (size_t)t * DM + c0) = v[2 * h] * rstd * fgv[2 * h]; *(GAS f32x4*)(xo + (size_t)t * DM + c0 + 4) = v[2 * h + 1] * rstd * fgv[2 * h + 1]; } }
    }
}

#ifdef PROBE
constexpr int PR_BASE = 12288;
__device__ __forceinline__ unsigned hsh(unsigned x) { x ^= x >> 16; x *= 0x7feb352du; x ^= x >> 15; x *= 0x846ca68bu; x ^= x >> 16; return x; }
__device__ __forceinline__ float bfr(float f) { return bf2f(f2bf(f)); }
__device__ __forceinline__ float wdot(const bf16* a, const float* W, int ldw, int col, int K, int lane) {
    float s = 0.f; for (int k = lane; k < K; k += 64) s += bf2f(a[k]) * bfr(W[(size_t)k * ldw + col]); return wave_sum(s);
}
struct Probe {
    gu32* ctl; int tid, lane, wave; LAS float* sh;
    __device__ __forceinline__ void rec(int id, float got, float ref, float tol = 0.03f) const {
        const float err = fabsf(got - ref) / (fabsf(ref) + 0.05f);
        if (!(err <= tol)) { unsigned expect = 0u; if (__hip_atomic_compare_exchange_strong((unsigned*)(ctl + PR_BASE), &expect, (unsigned)id, __ATOMIC_RELAXED, __ATOMIC_RELAXED, __HIP_MEMORY_SCOPE_AGENT)) __hip_atomic_store((unsigned*)(ctl + PR_BASE + 1), __float_as_uint(err > 1e6f ? 1e6f : err), __ATOMIC_RELAXED, __HIP_MEMORY_SCOPE_AGENT); }
        else atomicMax((unsigned*)(ctl + PR_BASE + 2), __float_as_uint(err));
    }
};
#define RAWP(r, col) wdot(Hb + (size_t)(r) * DM, win, INC, (col), 1024, P.lane)

template <int L>
__device__ __forceinline__ void probe_after_mod1(const Probe& P, const Args& args, unsigned char* ws) {
    const float* mod = (const float*)(ws + WS_MOD) + (size_t)L * 17 * 6144; const bf16* Hb = (const bf16*)(ws + WS_H);
    for (int sidx = P.wave; sidx < 48; sidx += 8) {
        const unsigned hh = hsh(sidx * 977u + 13u + L * 7919u); const int b = hh % 17, j = (hh >> 8) % 6144;
        float s = 0.f; for (int k = P.lane; k < 1024; k += 64) { const float v = b < 16 ? args.in[1][b * 1024 + k] : args.in[3][k]; s += v / (1.f + __expf(-v)) * args.in[4][((size_t)L * 1024 + k) * 6144 + j]; }
        s = wave_sum(s) + args.in[5][L * 6144 + j];
        if (P.lane == 0) P.rec(1 + 20 * L, mod[(size_t)b * 6144 + j], s, 0.002f);
    }
    for (int sidx = P.wave; sidx < 64; sidx += 8) {
        const unsigned hh = hsh(sidx * 31337u + 5u + L); int r = hh % MA; if (sidx < 8) r = ML + (hh % MC); const int c = (hh >> 10) & 1023; const int b = r < ML ? (r >> 12) : 16;
        const float* xr = r < ML ? (L == 0 ? args.in[0] : (const float*)args.out) + (size_t)r * DM : (L == 0 ? args.in[2] : (const float*)(ws + WS_XC)) + (size_t)(r - ML) * DM;
        float ss = 0.f; for (int k = P.lane; k < 1024; k += 64) ss += xr[k] * xr[k]; ss = wave_sum(ss);
        const float ref = xr[c] * (1.f / sqrtf(ss / 1024.f + EPS)) * args.in[6][L * 1024 + c] * (1.f + mod[(size_t)b * 6144 + 1024 + c]) + mod[(size_t)b * 6144 + c];
        if (P.lane == 0) P.rec(2 + 20 * L, bf2f(Hb[(size_t)r * DM + c]), ref, 0.01f);
    }
}
template <int L>
__device__ __forceinline__ void probe_after_big(const Probe& P, const Args& args, unsigned char* ws) {
    const bf16* Hb = (const bf16*)(ws + WS_H); const float* win = args.in[8] + (size_t)L * 1024 * INC;
    for (int sidx = P.wave; sidx < 96; sidx += 8) {
        const unsigned hh = hsh(sidx * 7001u + 77u + L * 3u); int r = hh % ML; if ((sidx & 3) == 3) r = ML + (hh % MC);
        const bool isctx = r >= ML; const int b = isctx ? (r - ML) / CTXL : (r >> 12); const int t = isctx ? 0 : (r & 4095);
        const long krow = isctx ? (long)b * SKV + SEQ + (r - ML) % CTXL : (long)b * SKV + t;
        const int h = (hh >> 17) & 7, m = (hh >> 20) & 1, d = (hh >> 21) & 63;
        for (int qk = 0; qk < 2; ++qk) {
            const int a = d >> 5, wi = d & 31, i = wi & 15, half = wi >> 4;
            const int cbase = (qk == 0 ? 2560 : 3584) + h * 128 + m * 64 + 32 * a;
            const float x0 = RAWP(r, cbase + i), x1 = RAWP(r, cbase + 16 + i);
            float cs = 1.f, sn = 0.f;
            if (!isctx) { const float pos = (float)(a == 0 ? (t >> 6) : (t & 63)); const float inv = exp2f(-(float)i * (13.287712379549449f / 16.f)); const float ang = pos * inv; cs = cosf(ang); sn = sinf(ang); }
            float ref = half == 0 ? x0 * cs - x1 * sn : x1 * cs + x0 * sn; if (qk == 0) ref *= QSCALE;
            const int p = 32 * a + 2 * i + half;
            const bf16* buf = (const bf16*)(ws + (qk == 0 ? WS_Q : WS_K)); const long row = qk == 0 ? (long)r : krow;
            if (P.lane == 0) P.rec(3 + qk + 20 * L, bf2f(buf[(size_t)row * DM + h * 128 + m * 64 + p]), ref, 0.03f);
        }
        const int e = (hh >> 20) & 127;
        { const float ref = RAWP(r, 4608 + h * 128 + e); if (P.lane == 0) P.rec(5 + 20 * L, bf2f(((const bf16*)(ws + WS_V))[(size_t)krow * DM + h * 128 + e]), ref, 0.03f); }
        const int c = (hh >> 9) & 511;
        { const float ref = gelu_tanh_f(RAWP(r, c)); if (P.lane == 0) P.rec(6 + 20 * L, bf2f(((const bf16*)(ws + WS_P0))[(size_t)r * 512 + c]), ref, 0.03f); }
        { const float ref = gelu_tanh_f(RAWP(r, 512 + c)); if (P.lane == 0) P.rec(7 + 20 * L, bf2f(((const bf16*)(ws + WS_P1))[(size_t)r * 512 + c]), ref, 0.03f); }
        { const float ref = RAWP(r, 1024 + c); if (P.lane == 0) P.rec(8 + 20 * L, bf2f(((const bf16*)(ws + WS_P2))[(size_t)r * 512 + c]), ref, 0.03f); }
        { const float ref = RAWP(r, 1536 + c) * RAWP(r, 2048 + c); if (P.lane == 0) P.rec(9 + 20 * L, bf2f(((const bf16*)(ws + WS_P3))[(size_t)r * 512 + c]), ref, 0.04f); }
    }
}
template <int L>
__device__ __forceinline__ void probe_after_mix(const Probe& P, const Args& args, unsigned char* ws) {
    const bf16* Hb = (const bf16*)(ws + WS_H); const float* win = args.in[8] + (size_t)L * 1024 * INC;
    const bf16* P1 = (const bf16*)(ws + WS_P1); const bf16* P3 = (const bf16*)(ws + WS_P3);
#if EN_MIX
    for (int sidx = 0; sidx < 6; ++sidx) {
        const unsigned hh = hsh(sidx * 1237u + 3u + L); int r = hh % (L == 0 ? MA : ML); if (sidx == 5 && L == 0) r = ML + (hh % MC);
        const int c = (hh >> 12) & 511, g = c >> 6, row0 = r & ~127, tt = r & 127;
        __syncthreads();
        if (P.tid < 128) { const bf16* vr = P1 + (size_t)(row0 + P.tid) * 512; float s = 0.f; for (int k = 0; k < 512; ++k) s += bf2f(vr[k]); const float mean = s / 512.f; float q = 0.f; for (int k = 0; k < 512; ++k) { const float dlt = bf2f(vr[k]) - mean; q += dlt * dlt; }
            const float ln = (bf2f(vr[c]) - mean) * (1.f / sqrtf(q / 512.f + EPS)) * args.in[10][L * 512 + c] + args.in[11][L * 512 + c];
            P.sh[P.tid] = args.in[12][(((size_t)L * 8 + g) * 128 + tt) * 128 + P.tid] * ln; }
        __syncthreads();
        if (P.wave == 0) { float s = P.sh[P.lane] + P.sh[64 + P.lane]; s = wave_sum(s) + args.in[13][(L * 8 + g) * 128 + tt];
            const float gu = gelu_tanh_f(RAWP(r, c)); if (P.lane == 0) P.rec(10 + 20 * L, bf2f(((const bf16*)(ws + WS_P0))[(size_t)r * 512 + c]), bfr(gu) * s, 0.04f); }
    }
    for (int sidx = P.wave; sidx < 64; sidx += 8) {
        const unsigned hh = hsh(sidx * 4447u + 9u + L); int r = hh % (L == 0 ? MA : ML); if (sidx < 8) r = (sidx & 1) ? ((hh % BATCH) * SEQ + (sidx & 2 ? 0 : SEQ - 1)) : r; if (sidx >= 8 && sidx < 12 && L == 0) r = ML + (hh % BATCH) * CTXL + (sidx & 1 ? 0 : CTXL - 1);
        const int c = (hh >> 11) & 511; const bool isctx = r >= ML; const int tseq = isctx ? ((r - ML) & 255) : (r & 4095), last = isctx ? 255 : 4095;
        const float zm = tseq > 0 ? bf2f(P3[(size_t)(r - 1) * 512 + c]) : 0.f, zc = bf2f(P3[(size_t)r * 512 + c]), zp = tseq < last ? bf2f(P3[(size_t)(r + 1) * 512 + c]) : 0.f;
        const float bg = bfr(RAWP(r, 1024 + c)); const float* cw = args.in[14] + L * 1536;
        const float ref = bg * (cw[c] * zm + cw[512 + c] * zc + cw[1024 + c] * zp);
        if (P.lane == 0) P.rec(11 + 20 * L, bf2f(((const bf16*)(ws + WS_P2))[(size_t)r * 512 + c]), ref, 0.04f);
    }
#endif
#if EN_ATT
    LAS float* qv = P.sh;
    LAS float* s0 = P.sh + 128;
    LAS float* s1 = P.sh + 128 + 4352;
    LAS float* red = P.sh + 128 + 2 * 4352;
    LAS float* ov = red + 64;
    const float lam = ((const float*)(ws + WS_LAM))[L]; const float oml = L == 0 ? 0.8f : (1.f - (0.8f - 0.6f * 0.7408182206817179f));
    for (int sidx = 0; sidx < (L == 0 ? 5 : 3); ++sidx) {
        const unsigned hh = hsh(sidx * 9173u + 21u + L); const bool isctx = (L == 0 && sidx >= 3); const int b = hh % BATCH, h = (hh >> 8) & 7;
        const int r = isctx ? ML + b * CTXL + ((hh >> 12) % CTXL) : b * SEQ + ((hh >> 12) & 4095); const int t = r & 4095;
        const int nk = isctx ? CTXL : SKV; const long k0 = isctx ? (long)b * SKV + SEQ : (long)b * SKV;
        __syncthreads();
        for (int q = P.wave; q < 128; q += 8) {
            const int m = q >> 6, p = q & 63, a = p >> 5, i = (p & 31) >> 1, half = p & 1; const int cbase = 2560 + h * 128 + m * 64 + 32 * a;
            const float x0 = RAWP(r, cbase + i), x1 = RAWP(r, cbase + 16 + i); float cs = 1.f, sn = 0.f;
            if (!isctx) { const float pos = (float)(a == 0 ? (t >> 6) : (t & 63)); const float inv = exp2f(-(float)i * (13.287712379549449f / 16.f)); cs = cosf(pos * inv); sn = sinf(pos * inv); }
            if (P.lane == 0) qv[q] = bfr((half == 0 ? x0 * cs - x1 * sn : x1 * cs + x0 * sn) * QSCALE);
        }
        __syncthreads();
        const bf16* Kb = (const bf16*)(ws + WS_K); const bf16* Vb = (const bf16*)(ws + WS_V);
        for (int k = P.tid; k < nk; k += NTHREADS) { const bf16* kr = Kb + (size_t)(k0 + k) * DM + h * 128; float a0 = 0.f, a1 = 0.f; for (int dd = 0; dd < 64; ++dd) { a0 += qv[dd] * bf2f(kr[dd]); a1 += qv[64 + dd] * bf2f(kr[64 + dd]); } s0[k] = a0; s1[k] = a1; }
        __syncthreads();
        float m0 = -1e30f, m1 = -1e30f; for (int k = P.tid; k < nk; k += NTHREADS) { m0 = fmaxf(m0, s0[k]); m1 = fmaxf(m1, s1[k]); }
        for (int o = 1; o < 64; o <<= 1) { m0 = fmaxf(m0, __shfl_xor(m0, o)); m1 = fmaxf(m1, __shfl_xor(m1, o)); }
        if (P.lane == 0) { red[P.wave] = m0; red[8 + P.wave] = m1; } __syncthreads();
        m0 = red[0]; m1 = red[8]; for (int w = 1; w < 8; ++w) { m0 = fmaxf(m0, red[w]); m1 = fmaxf(m1, red[8 + w]); } __syncthreads();
        float l0 = 0.f, l1 = 0.f; for (int k = P.tid; k < nk; k += NTHREADS) { const float e0 = exp2f(s0[k] - m0), e1 = exp2f(s1[k] - m1); s0[k] = e0; s1[k] = e1; l0 += e0; l1 += e1; }
        l0 = wave_sum(l0); l1 = wave_sum(l1); if (P.lane == 0) { red[16 + P.wave] = l0; red[24 + P.wave] = l1; } __syncthreads();
        l0 = 0.f; l1 = 0.f; for (int w = 0; w < 8; ++w) { l0 += red[16 + w]; l1 += red[24 + w]; }
        if (P.tid < 128) { float acc = 0.f; for (int k = 0; k < nk; ++k) acc += (s0[k] / l0 - lam * s1[k] / l1) * bf2f(Vb[(size_t)(k0 + k) * DM + h * 128 + P.tid]); ov[P.tid] = acc; }
        __syncthreads();
        if (P.tid < 128) { float ss = 0.f; for (int e = 0; e < 128; ++e) ss += ov[e] * ov[e]; const float ref = ov[P.tid] * (1.f / sqrtf(ss / 128.f + EPS)) * args.in[16][L * 128 + P.tid] * oml;
            if ((P.tid & 15) == (sidx & 15) || P.tid == 77) P.rec((isctx ? 13 : 12) + 20 * L, bf2f(((const bf16*)(ws + WS_Q))[(size_t)r * DM + h * 128 + P.tid]), ref, 0.06f); }
    }
#endif
    __syncthreads();
}
template <int L>
__device__ __forceinline__ void probe_after_gate(const Probe& P, const Args& args, unsigned char* ws) {
    const bf16* Hb = (const bf16*)(ws + WS_H); const float* win = args.in[8] + (size_t)L * 1024 * INC;
    const bf16* WINb = (const bf16*)(ws + WS_WIN + L * WIN_BYTES);
    if (P.tid < 400) P.sh[16 + P.tid] = 0.f;
    __syncthreads();
    for (int sidx = P.wave; sidx < 96; sidx += 8) {
        const unsigned hh = hsh(sidx * 3301u + 11u + L); const int row = 5632 + (sidx % 3) * 1024 + ((hh >> 4) & 1023), k = (hh >> 16) & 1023;
        if (P.lane == 0) P.rec(13 + 20 * L, bf2f(WINb[(size_t)row * 1024 + k]), bfr(win[(size_t)k * INC + row]), 0.001f);
    }
    __syncthreads();
    for (int br = 0; br < 3; ++br) {
        for (int sidx = P.wave; sidx < 64; sidx += 8) {
            const unsigned hh = hsh(sidx * 5501u + 1u + L + br * 77u); const int r = hh % (L == 0 ? MA : ML), n = (hh >> 12) & 1023;
            const float ref = sigmoid_f(RAWP(r, 5632 + br * 1024 + n) + args.in[9][L * 3072 + br * 1024 + n]);
            const bf16* g = br == 0 ? (const bf16*)(ws + WS_K) + (size_t)r * DM + n : (br == 1 ? (const bf16*)(ws + WS_V) + (size_t)r * DM + n : (const bf16*)(ws + (n < 512 ? WS_P1 : WS_P3)) + (size_t)r * 512 + (n & 511));
            if (P.lane == 0) {
                const float got = bf2f(*g);
                if (fabsf(got - ref) / (fabsf(ref) + 0.05f) > 0.03f) { P.sh[16] = 1.f; const int sl = P.wave * 8 + (sidx >> 3); P.sh[128 + 2 * sl] = __uint_as_float((unsigned)((uintptr_t)g & 0xffffffffu)); P.sh[129 + 2 * sl] = __uint_as_float((unsigned)((uintptr_t)g >> 32)); P.sh[300 + sl] = ref; }
                else P.rec(14 + br + 20 * L, got, ref, 0.03f);
            }
        }
        __syncthreads();
        if (P.sh[16] != 0.f) {
            const GAS u32x4* tp = (const GAS u32x4*)args.in[25] + P.tid; u32x4 acc_ = {0u, 0u, 0u, 0u};
            for (int q_ = 0; q_ < 3072; ++q_) { const u32x4 v_ = tp[(size_t)q_ * 512]; acc_.x ^= v_.x; acc_.y ^= v_.y; acc_.z ^= v_.z; acc_.w ^= v_.w; }
            if ((acc_.x ^ acc_.y ^ acc_.z ^ acc_.w) == 0x12345677u) P.sh[100] = 1.f;
            __syncthreads();
            if (P.tid == 0) { for (int q = 0; q < 64; ++q) { const unsigned lo_ = __float_as_uint(P.sh[128 + 2 * q]), hi_ = __float_as_uint(P.sh[129 + 2 * q]); if (lo_ == 0u && hi_ == 0u) continue;
                const bf16* gq = (const bf16*)(((uintptr_t)hi_ << 32) | lo_); const unsigned* gw = (const unsigned*)((uintptr_t)gq & ~(uintptr_t)3); const int sh = ((uintptr_t)gq & 2) ? 16 : 0;
                const float g1 = bf2f((__hip_atomic_load(gw, __ATOMIC_RELAXED, __HIP_MEMORY_SCOPE_AGENT) >> sh) & 0xffffu); const float ref = P.sh[300 + q];
                const bool ok1 = fabsf(g1 - ref) / (fabsf(ref) + 0.05f) <= 0.03f; if (!ok1 && br == 0) {
                    const size_t eo = (size_t)(gq - (const bf16*)(ws + WS_K)); const int kr = (int)(eo >> 10), nn = (int)(eo & 1023); const int bb = kr / SKV, key = kr % SKV; const bool cx = key >= SEQ;
                    const int tok = cx ? ML + bb * CTXL + (key - SEQ) : bb * SEQ + key; const int hh2 = nn >> 7, mm = (nn >> 6) & 1, pp = nn & 63, aa = pp >> 5, ii = (pp & 31) >> 1, hf = pp & 1;
                    const int cb2 = 3584 + hh2 * 128 + mm * 64 + 32 * aa; float x0 = 0.f, x1 = 0.f;
                    for (int k = 0; k < 1024; ++k) { const float hv = bf2f(Hb[(size_t)tok * DM + k]); x0 += hv * bfr(win[(size_t)k * INC + cb2 + ii]); x1 += hv * bfr(win[(size_t)k * INC + cb2 + 16 + ii]); }
                    float cs = 1.f, sn = 0.f; if (!cx) { const float pos = (float)(aa == 0 ? (key >> 6) : (key & 63)); const float inv = exp2f(-(float)ii * (13.287712379549449f / 16.f)); cs = cosf(pos * inv); sn = sinf(pos * inv); }
                    const float kold = hf == 0 ? x0 * cs - x1 * sn : x1 * cs + x0 * sn;
                    if (fabsf(kold - g1) <= 0.03f * (fabsf(kold) + 0.05f)) { unsigned e9 = 0u; __hip_atomic_compare_exchange_strong((unsigned*)(P.ctl + PR_BASE + 6), &e9, 1u, __ATOMIC_RELAXED, __ATOMIC_RELAXED, __HIP_MEMORY_SCOPE_AGENT); }
                }
                if (!ok1) { unsigned expect = 0u; if (__hip_atomic_compare_exchange_strong((unsigned*)(P.ctl + PR_BASE + 3), &expect, __float_as_uint(g1) | 1u, __ATOMIC_RELAXED, __ATOMIC_RELAXED, __HIP_MEMORY_SCOPE_AGENT)) { __hip_atomic_store((unsigned*)(P.ctl + PR_BASE + 4), (unsigned)br + 1u, __ATOMIC_RELAXED, __HIP_MEMORY_SCOPE_AGENT); __hip_atomic_store((unsigned*)(P.ctl + PR_BASE + 5), __float_as_uint(ref), __ATOMIC_RELAXED, __HIP_MEMORY_SCOPE_AGENT); {
                        const size_t eo2 = (size_t)(gq - (const bf16*)(ws + WS_K)); const bf16* rb = (const bf16*)(ws + WS_K) + (eo2 & ~(size_t)63); int cr = 0, cc = 0;
                        for (int q2 = 0; q2 < 64; ++q2) { const float v2 = bf2f(rb[q2]); if (!(v2 >= 0.f && v2 <= 1.f)) ++cr; }
                        const size_t rr2 = (eo2 >> 10) & ~(size_t)63, nn2 = eo2 & 1023;
                        for (int q2 = 0; q2 < 64; ++q2) { const float v2 = bf2f(((const bf16*)(ws + WS_K))[(rr2 + q2) * 1024 + nn2]); if (!(v2 >= 0.f && v2 <= 1.f)) ++cc; }
                        int c16 = 0, c8 = 0; const size_t r0b = eo2 >> 10;
                        for (int q2 = 0; q2 < 64; ++q2) { const float v2 = bf2f(((const bf16*)(ws + WS_K))[(rr2 + q2) * 1024 + nn2]); const bool bad = !(v2 >= 0.f && v2 <= 1.f); if (bad && ((rr2 + q2) & 15) == (r0b & 15)) ++c16; if (bad && ((rr2 + q2) >> 3) == (r0b >> 3)) ++c8; }
                        unsigned m8 = 0u, g8 = 0u; for (int q2 = 0; q2 < 64; ++q2) { const float v2 = bf2f(((const bf16*)(ws + WS_K))[(rr2 + q2) * 1024 + nn2]); const bool bad = !(v2 >= 0.f && v2 <= 1.f); if (bad && ((rr2 + q2) >> 3) == (r0b >> 3)) m8 |= 1u << ((rr2 + q2) & 7); if (bad) g8 |= 1u << (q2 >> 3); }
                        __hip_atomic_store((unsigned*)(P.ctl + PR_BASE + 10), m8 | (g8 << 8), __ATOMIC_RELAXED, __HIP_MEMORY_SCOPE_AGENT);
                        __hip_atomic_store((unsigned*)(P.ctl + PR_BASE + 9), (unsigned)(c16 | (c8 << 8)), __ATOMIC_RELAXED, __HIP_MEMORY_SCOPE_AGENT);
                        __hip_atomic_store((unsigned*)(P.ctl + PR_BASE + 8), (unsigned)(cr | (cc << 8)), __ATOMIC_RELAXED, __HIP_MEMORY_SCOPE_AGENT); }
                    __hip_atomic_store((unsigned*)(P.ctl + PR_BASE + 7), (unsigned)(gq - (const bf16*)(ws + (br == 0 ? WS_K : (br == 1 ? WS_V : WS_P1)))), __ATOMIC_RELAXED, __HIP_MEMORY_SCOPE_AGENT); } } } }
        }
        __syncthreads();
    }
}
template <int L>
__device__ __forceinline__ void probe_after_wo(const Probe& P, const Args& args, unsigned char* ws) {
    const bf16* Hb = (const bf16*)(ws + WS_H); const float* win = args.in[8] + (size_t)L * 1024 * INC;
    const bf16* Y = (const bf16*)(ws + WS_K);
    for (int sidx = P.wave; sidx < 64; sidx += 8) {
        const unsigned hh = hsh(sidx * 811u + 17u + L); int r = hh % (L == 0 ? MA : ML); if (L == 0 && sidx < 8) r = ML + hh % MC; const int n = (hh >> 12) & 1023;
        const float ga = sigmoid_f(RAWP(r, 5632 + n) + args.in[9][L * 3072 + n]), gb = sigmoid_f(RAWP(r, 5632 + 1024 + n) + args.in[9][L * 3072 + 1024 + n]), gc = sigmoid_f(RAWP(r, 5632 + 2048 + n) + args.in[9][L * 3072 + 2048 + n]);
        const float pa = wdot((const bf16*)(ws + WS_P0) + (size_t)r * 512, args.in[17] + (size_t)L * 512 * 1024, 1024, n, 512, P.lane);
        const float pb = wdot((const bf16*)(ws + WS_P2) + (size_t)r * 512, args.in[18] + (size_t)L * 512 * 1024, 1024, n, 512, P.lane);
        const float pc = wdot((const bf16*)(ws + WS_Q) + (size_t)r * DM, args.in[19] + (size_t)L * 1024 * 1024, 1024, n, 1024, P.lane);
        if (P.lane == 0) P.rec(17 + 20 * L, bf2f(Y[(size_t)r * DM + n]), ga * pa + gb * pb + gc * pc, 0.05f);
        const float o = wdot(Y + (size_t)r * DM, args.in[20] + (size_t)L * 1024 * 1024, 1024, n, 1024, P.lane);
        const int b = r < ML ? (r >> 12) : 16; const float g1 = ((const float*)(ws + WS_MOD))[((size_t)L * 17 + b) * 6144 + 2048 + n];
        if (L == 0) { const float x0 = r < ML ? args.in[0][(size_t)r * DM + n] : args.in[2][(size_t)(r - ML) * DM + n];
            const float got = r < ML ? args.out[(size_t)r * DM + n] : ((const float*)(ws + WS_XC))[(size_t)(r - ML) * DM + n];
            if (P.lane == 0) P.rec(18, got - x0, g1 * o, 0.03f); }
    }
}
__device__ __forceinline__ void probe_after_ffn0(const Probe& P, const Args& args, unsigned char* ws) {
    const bf16* Hb = (const bf16*)(ws + WS_H); const bf16* ACT = (const bf16*)(ws + WS_ACT0);
    for (int sidx = P.wave; sidx < 64; sidx += 8) {
        const unsigned hh = hsh(sidx * 60013u + 5u); int r = hh % MA; if (sidx < 8) r = ML + hh % MC; const int j = (hh >> 10) % DFF;
        const float gt = wdot(Hb + (size_t)r * DM, args.in[21], DFF, j, 1024, P.lane), up = wdot(Hb + (size_t)r * DM, args.in[22], DFF, j, 1024, P.lane);
        if (P.lane == 0) P.rec(19, bf2f(ACT[(size_t)r * DFF + j]), silu_f(gt) * up, 0.04f);
    }
}
#undef RAWP
#endif


#define WSB() unsigned char* ws = launder_ptr(args.ws)
#define W_MOD ((float*)(ws + WS_MOD))
#define W_ROPE ((float*)(ws + WS_ROPE))
#define W_LAM ((float*)(ws + WS_LAM))
#define W_AWS ((bf16*)(ws + WS_AWS))
#define W_ROUTE ((unsigned*)(ws + WS_ROUTE))
#define W_X16 ((bf16*)(ws + WS_X16))
#define W_H ((bf16*)args.out)
#define W_P0 ((bf16*)(ws + WS_P0))
#define W_P1 ((bf16*)(ws + WS_P1))
#define W_P2 ((bf16*)(ws + WS_P2))
#define W_P3 ((bf16*)(ws + WS_P3))
#define W_Q ((bf16*)(ws + WS_Q))
#define W_K ((bf16*)(ws + WS_K))
#define W_V ((bf16*)(ws + WS_V))
#define W_MODL (W_MOD + (size_t)L * 17 * 6144)
#define W_WIN ((const bf16*)(ws + WS_WIN + L * WIN_BYTES))
#define W_WOUT ((const bf16*)(ws + WS_WOUT + L * WOUT_BYTES))
#define PH_ON (P.lo <= P.ph && P.ph < P.hi)
#ifdef PTIME
#define SEAM() do { if (P.lo <= P.ph && P.ph + 1 < P.hi) xcd_barrier(bar); if (blockIdx.x == 0 && C.tid == 0 && P.ph < 40) ((unsigned long long*)(C.ctl + 16384))[1 + P.ph] = rt(); ++P.ph; } while (0)
#else
#define SEAM() do { if (P.lo <= P.ph && P.ph + 1 < P.hi) xcd_barrier(bar); ++P.ph; } while (0)
#endif
#define ELEM_DELTA(a, b) ((long)(((intptr_t)(a) - (intptr_t)(b)) / 4))

#ifdef PROBE
#define PROBE_HOOK(FN) do { if (P.lo < P.ph && P.ph <= P.hi) { if (blockIdx.x == 0) { WSB(); const Probe PR{C.ctl, C.tid, C.lane, C.wave, (LAS float*)C.lds}; FN(PR, args, ws); } xcd_barrier(bar); } } while (0)
#else
#define PROBE_HOOK(FN) do { } while (0)
#endif

#ifndef REP_BIG
#define REP_BIG 1
#endif
#ifndef REP_GATE
#define REP_GATE 1
#endif
#ifndef REP_UP
#define REP_UP 1
#endif
#ifndef REP_MOEUP
#define REP_MOEUP 1
#endif
#ifndef REP_MOEDN
#define REP_MOEDN 1
#endif
#ifndef MOE_GATHER
#define MOE_GATHER 1
#endif
#ifndef ATT_XPF
#define ATT_XPF 0
#endif
#ifndef ATT_ROT
#define ATT_ROT(qb) ((qb) * 2)
#endif
template <int L, int BR>
__device__ __forceinline__ void merge_phase(const Ctx& C, const Args& args, const XcdBarrier& bar, PhaseCtl& P) {
    constexpr int mrows = L == 0 ? MA : ML;
    if (PH_ON) { WSB();
#if (EN_SITES >> 2) & 1
        constexpr size_t aoff = BR == 0 ? WS_P0 : (BR == 1 ? WS_P2 : WS_Q), goff = BR == 0 ? WS_K : (BR == 1 ? WS_V : WS_P1);
        constexpr int K = BR == 2 ? 1024 : 512;
        const bf16* Bt = W_WOUT + (BR == 0 ? 0 : (BR == 1 ? 512 * 1024 : 1024 * 1024));
        pg8::Gemm g{(const bf16*)(ws + aoff), Bt, mrows, 1024, K}; pg8::StaticOrder S; S.init(mrows, 1024, C.G, (int)blockIdx.x);
        EpiMerge E{W_K, (const bf16*)(ws + goff), (long)((WS_P3 - WS_P1) / 2), BR == 2 ? 512 : 1024, BR == 2 ? 2 : 4, BR == 0 ? 1 : 0, 0};
#ifdef DUP_MERGE
        if (L == 0) { EpiMerge Ed = E; Ed.dry = P.hi < 5000 ? 1 : 0; pg8::gemm_phase<EpiMerge, pg8::StaticOrder, PG8_ALIGN, PG8_SP2>(C.lds, g, S, Ed); }
#endif
        pg8::gemm_phase<EpiMerge, pg8::StaticOrder, PG8_ALIGN, PG8_SP2>(C.lds, g, S, E);
#endif
    }
    if (BR == 2) SEAM(); else ++P.ph;
}

template <int L>
__device__ __forceinline__ void layer_body(const Ctx& C, const Args& args, const XcdBarrier& bar, PhaseCtl& P, volatile LAS int* offl) {
    constexpr int mrows = L == 0 ? MA : ML;
    if (PH_ON) { WSB(); if constexpr (L == 0) modulate_phase<false>(C, args.in[0], args.in[2], args.in[6], W_MODL, 0, 1, W_H, MA); else modulate_phase<true>(C, W_X16, nullptr, args.in[6] + 1024, W_MODL, 0, 1, W_H, MA);
#ifdef REP_MOD
        if (L == 0) modulate_phase<false>(C, args.in[0], args.in[2], args.in[6], W_MODL, 0, 1, W_H, MA);
#endif
    }
    SEAM();
    PROBE_HOOK(probe_after_mod1<L>);
    if (PH_ON) { WSB();
#if (EN_SITES >> 0) & 1
        LAS float* tab = (LAS float*)(C.lds + 131072);
        for (int i = C.tid; i < 2048; i += NTHREADS) tab[i] = W_ROPE[i];
        __syncthreads();
        pg8::Gemm g{W_H, W_WIN, MA, NBIG, 1024};
        EpiBig E{ws, tab};
        if constexpr (L == 0) { pg8::StaticOrder S; S.init(MA, NBIG, C.G, (int)blockIdx.x); pg8::gemm_phase<EpiBig, pg8::StaticOrder, PG8_ALIGN, PG8_SP2>(C.lds, g, S, E); }
        else { BigOrderL1 S; S.so.init(ML, NBIG, C.G, (int)blockIdx.x); S.G = C.G; S.c = (int)blockIdx.x; pg8::gemm_phase<EpiBig, BigOrderL1, PG8_ALIGN, PG8_SP2>(C.lds, g, S, E); }
#endif
    }
    SEAM();
    PROBE_HOOK(probe_after_big<L>);
    if (PH_ON) { WSB();
#ifdef PROBE_FILL2
        { GAS u32x4* kf = (GAS u32x4*)(ws + WS_K); const u32x4 pat = {0x46404640u, 0x46404640u, 0x46404640u, 0x46404640u};
          for (size_t i = (size_t)C.gw * 64 + C.lane; i < (size_t)MA * DM * 2 / 16; i += (size_t)C.NGW * 64) kf[i] = pat; }
#endif
#if EN_MIX
#ifdef DUP_MIX
        if (L == 0) for (int ch = C.vcu; ch < mrows / 128; ch += C.G)
            mixer_chunk(C, ch, W_P0, W_P1, W_P2, W_P3, args.in[10] + L * 512, args.in[11] + L * 512, W_AWS + (size_t)L * 8 * 128 * 128, args.in[13] + L * 8 * 128, args.in[14] + L * 3 * 512, P.hi > 5000);
#endif
        for (int ch = C.vcu; ch < mrows / 128; ch += C.G)
            mixer_chunk(C, ch, W_P0, W_P1, W_P2, W_P3, args.in[10] + L * 512, args.in[11] + L * 512, W_AWS + (size_t)L * 8 * 128 * 128, args.in[13] + L * 8 * 128, args.in[14] + L * 3 * 512);
#endif
#if EN_ATT
        const float lam = W_LAM[L]; constexpr float oml = L == 0 ? 0.8f : (1.f - (0.8f - 0.6f * 0.7408182206817179f)); const float* subg = args.in[16] + L * 128;
#if ATT_XPF
        att::diff_attn_units<false>(W_Q, W_K, W_V, C.vcu, BATCH * 8 * 32, C.G, lam, subg, oml, (LAS char*)C.lds);
        if (L == 0) att::diff_attn_units<true>(W_Q, W_K, W_V, C.vcu, BATCH * 8 * 2, C.G, lam, subg, oml, (LAS char*)C.lds);
#else
#ifdef DUP_ATT
        const int nrep = L == 0 ? 2 : 1;
        for (int rep = 0; rep < nrep; ++rep)
        for (int u = C.vcu; u < BATCH * 8 * 32; u += C.G) {
            const int bh = u >> 5, qb = u & 31, b = bh >> 3, h = bh & 7;
            bf16* qp = W_Q + ((size_t)b * SEQ + qb * 128) * DM + h * 128;
            att::diff_attn_unit(qp, W_K + (size_t)b * SKV * DM + h * 128, W_V + (size_t)b * SKV * DM + h * 128, qp, SKV / 64, lam, subg, oml, (LAS char*)C.lds, rep + 1 == nrep);
        }
#else
        for (int u = C.vcu; u < BATCH * 8 * 32; u += C.G) {
            const int bh = u >> 5, qb = u & 31, b = bh >> 3, h = bh & 7;
            bf16* qp = W_Q + ((size_t)b * SEQ + qb * 128) * DM + h * 128;
            att::diff_attn_unit(qp, W_K + (size_t)b * SKV * DM + h * 128, W_V + (size_t)b * SKV * DM + h * 128, qp, SKV / 64, lam, subg, oml, (LAS char*)C.lds, true, ATT_ROT(qb));
        }
#endif
        if (L == 0) {
            for (int u = C.vcu; u < BATCH * 8 * 2; u += C.G) {
                const int b = u >> 4, h = (u >> 1) & 7, qb = u & 1;
                bf16* qp = W_Q + ((size_t)ML + b * CTXL + qb * 128) * DM + h * 128;
                att::diff_attn_unit(qp, W_K + ((size_t)b * SKV + SEQ) * DM + h * 128, W_V + ((size_t)b * SKV + SEQ) * DM + h * 128, qp, CTXL / 64, lam, subg, oml, (LAS char*)C.lds);
            }
        }
#endif
#endif
    }
    SEAM();
    PROBE_HOOK(probe_after_mix<L>);
    if (PH_ON) { WSB();
#if (EN_SITES >> 1) & 1
        pg8::Gemm g{W_H, W_WIN + (size_t)NBIG * 1024, mrows, 3072, 1024};
        LAS float* tab = (LAS float*)(C.lds + 131072);
        for (int i = C.tid; i < 3072; i += NTHREADS) tab[i] = args.in[9][L * 3072 + i];
        __syncthreads();
        EpiGate E{ws, tab};
        if constexpr (L == 0) {
            pg8::StaticOrder S; S.init(mrows, 3072, C.G, (int)blockIdx.x);
            pg8::gemm_phase<EpiGate, pg8::StaticOrder, PG8_ALIGN, PG8_SP2>(C.lds, g, S, E);
        } else {
            GateOrder S; S.so.init(mrows, 1024, C.G, (int)blockIdx.x);
            pg8::gemm_phase<EpiGate, GateOrder, PG8_ALIGN, PG8_SP2>(C.lds, g, S, E);
        }
#endif
    }
    if (L == 0) SEAM(); else ++P.ph;
#ifdef PROBE_SCAN
    if (L == 0) { WSB(); unsigned cntk = 0u, cntv = 0u;
        const GAS u32x4* kp = (const GAS u32x4*)(ws + WS_K); const GAS u32x4* vp = (const GAS u32x4*)(ws + WS_V);
        for (size_t i = (size_t)C.gw * 64 + C.lane; i < (size_t)MA * DM * 2 / 16; i += (size_t)C.NGW * 64) {
            const u32x4 a = kp[i], b = vp[i]; f32x4 x0, x1; unpack8(a, x0, x1);
            for (int q = 0; q < 4; ++q) { if (!(x0[q] >= 0.f && x0[q] <= 1.f)) ++cntk; if (!(x1[q] >= 0.f && x1[q] <= 1.f)) ++cntk; }
            unpack8(b, x0, x1);
            for (int q = 0; q < 4; ++q) { if (!(x0[q] >= 0.f && x0[q] <= 1.f)) ++cntv; if (!(x1[q] >= 0.f && x1[q] <= 1.f)) ++cntv; } }
        if (cntk) atomicAdd((unsigned*)(C.ctl + PR_BASE + 12), cntk); if (cntv) atomicAdd((unsigned*)(C.ctl + PR_BASE + 13), cntv);
        xcd_barrier(bar); }
#endif
    merge_phase<L, 0>(C, args, bar, P);
    merge_phase<L, 1>(C, args, bar, P);
    merge_phase<L, 2>(C, args, bar, P);
    if (PH_ON) { WSB();
#if (EN_SITES >> 3) & 1
        pg8::Gemm g{W_K, W_WOUT + 2 * 1024 * 1024, mrows, 1024, 1024}; pg8::StaticOrder S; S.init(mrows, 1024, C.G, (int)blockIdx.x);
        if constexpr (L == 0) { EpiResid<true> E{args.in[0], W_X16, ELEM_DELTA(args.in[2], args.in[0]) - (long)ML * DM, W_MODL, 2, 0};
            pg8::gemm_phase<EpiResid<true>, pg8::StaticOrder, PG8_ALIGN, PG8_SP2>(C.lds, g, S, E); }
        else { EpiResid<false> E{W_X16, W_X16, 0l, W_MODL, 2, 0};
            pg8::gemm_phase<EpiResid<false>, pg8::StaticOrder, PG8_ALIGN, PG8_SP2>(C.lds, g, S, E); }
#endif
    }
    SEAM();
    PROBE_HOOK(probe_after_wo<L>);
    if (L == 0) {
        if (PH_ON) { WSB(); modulate_phase<true>(C, W_X16, nullptr, args.in[7], W_MODL, 3, 4, W_H, MA); }
        SEAM();
        if (PH_ON) { WSB();
#if (EN_SITES >> 4) & 1
            pg8::Gemm g{W_H, (const bf16*)(ws + WS_WFU), MA, 2 * DFF, 1024}; pg8::StaticOrder S; S.init(MA, 2 * DFF, C.G, (int)blockIdx.x);
            EpiSwiGLU E{(bf16*)(ws + WS_ACT0), DFF, 0, 22};
            pg8::gemm_phase<EpiSwiGLU, pg8::StaticOrder, PG8_ALIGN, PG8_SP2>(C.lds, g, S, E);
        if (REP_UP > 1) {
#ifdef REP_BARRIER
            xcd_barrier(bar);
#endif
            pg8::gemm_phase<EpiSwiGLU, pg8::StaticOrder, PG8_ALIGN, PG8_SP2>(C.lds, g, S, E); }
#endif
        }
        SEAM();
        PROBE_HOOK(probe_after_ffn0);
        if (PH_ON) { WSB();
#if (EN_SITES >> 5) & 1
            pg8::Gemm g{(const bf16*)(ws + WS_ACT0), (const bf16*)(ws + WS_WFD), MA, 1024, DFF}; pg8::StaticOrder S; S.init(MA, 1024, C.G, (int)blockIdx.x);
            EpiResid<false> E{W_X16, W_X16, 0l, W_MODL, 5, 0};
            pg8::gemm_phase<EpiResid<false>, pg8::StaticOrder, PG8_ALIGN, PG8_SP2>(C.lds, g, S, E);
#endif
        }
        SEAM();
    } else {
        if (PH_ON) { WSB();
#ifdef DUP_ROUTE
            route_phase(C, W_X16, args.in[7] + 1024, W_MODL, args.in[24], W_H, W_ROUTE, P.hi < 5000); __syncthreads();
#endif
            route_phase(C, W_X16, args.in[7] + 1024, W_MODL, args.in[24], W_H, W_ROUTE);
            __syncthreads();
#ifdef REP_MOECVT
            for (int rep_ = 0; rep_ < 2; ++rep_)
#endif
            for (int e = 0; e < NEXP; ++e) {
                tr_matrix<2>(C, args.in[25] + (size_t)e * 1024 * DFE, args.in[26] + (size_t)e * 1024 * DFE, DFE, 1024, 2 * DFE, (bf16*)(ws + WS_MWU) + (size_t)e * 2 * DFE * 1024);
                tr_matrix<0>(C, args.in[27] + (size_t)e * DFE * 1024, nullptr, 1024, DFE, 1024, (bf16*)(ws + WS_MWD) + (size_t)e * 1024 * DFE);
            }
        }
        SEAM();
        if (P.lo < P.ph + 8 && P.ph < P.hi) moe_offsets(C, offl);
#if MOE_GATHER
        if (PH_ON) { WSB(); gather_phase(C, W_H, (bf16*)(ws + WS_HS), W_ROUTE, offl); }
#else
        if (PH_ON) { WSB(); rowmap_phase(C, (unsigned*)(ws + WS_RMAP), W_ROUTE, offl); }
#endif
        SEAM();
        for (int ck = 0; ck < 3; ++ck) {
            const int ntall = offl[8] >> 8; int nt = ntall - ck * MOE_CH; nt = nt < 0 ? 0 : (nt > MOE_CH ? MOE_CH : nt);
            if (PH_ON) { WSB();
#if (EN_SITES >> 6) & 1
                EpiSwiGLU E{(bf16*)(ws + WS_MACT), DFE, ck * MOE_CH, 28};
#if MOE_GATHER
                pg8::Gemm g{(const bf16*)(ws + WS_HS), (const bf16*)(ws + WS_MWU), nt * 256, 2 * DFE, 1024};
                MoeOrder S; S.so.init(nt * 256, 2 * DFE, C.G, (int)blockIdx.x); S.tile0 = ck * MOE_CH; S.npe = 28; S.a_global = true; S.offl = offl;
                pg8::gemm_phase<EpiSwiGLU, MoeOrder, PG8_ALIGN, PG8_SP2>(C.lds, g, S, E);
#else
                pg8::Gemm g{W_H, (const bf16*)(ws + WS_MWU), nt * 256, 2 * DFE, 1024};
                MoeOrderG S; S.mo.so.init(nt * 256, 2 * DFE, C.G, (int)blockIdx.x); S.mo.tile0 = ck * MOE_CH; S.mo.npe = 28; S.mo.a_global = true; S.mo.offl = offl; S.rowmap = (const unsigned*)(ws + WS_RMAP);
                pg8::gemm_phase<EpiSwiGLU, MoeOrderG, PG8_ALIGN, PG8_SP2>(C.lds, g, S, E);
#endif
#endif
            }
            SEAM();
            if (PH_ON) { WSB();
#if (EN_SITES >> 7) & 1
                pg8::Gemm g{(const bf16*)(ws + WS_MACT), (const bf16*)(ws + WS_MWD), nt * 256, 1024, DFE};
                MoeOrder S; S.so.init(nt * 256, 1024, C.G, (int)blockIdx.x); S.tile0 = ck * MOE_CH; S.npe = 4; S.a_global = false; S.offl = offl;
                EpiStoreBf16 E{(bf16*)(ws + WS_HS), 1024, ck * MOE_CH, 4};
                pg8::gemm_phase<EpiStoreBf16, MoeOrder, PG8_ALIGN, PG8_SP2>(C.lds, g, S, E);
        if (REP_MOEDN > 1) { pg8::gemm_phase<EpiStoreBf16, MoeOrder, PG8_ALIGN, PG8_SP2>(C.lds, g, S, E); }
#endif
            }
            SEAM();
        }
        if (PH_ON) { WSB();
#ifdef DUP_FINAL
            final_phase(C, W_X16, args.out, (const bf16*)(ws + WS_HS), W_ROUTE, W_MODL, args.in[28], P.hi < 5000);
#endif
            final_phase(C, W_X16, args.out, (const bf16*)(ws + WS_HS), W_ROUTE, W_MODL, args.in[28]); }
        SEAM();
    }
}

__global__ void __launch_bounds__(NTHREADS, 2) fwd_kernel(Args args) {
    extern __shared__ __attribute__((aligned(16))) unsigned char lds_raw[];
    Ctx C;
    C.lds = (LAS unsigned char*)lds_raw; C.ctl = (gu32*)(args.ws + WS_CTL);
    C.tid = threadIdx.x; C.lane = C.tid & 63; C.wave = __builtin_amdgcn_readfirstlane(C.tid >> 6);
    C.G = gridDim.x; { const int bx = blockIdx.x; C.vcu = (C.G % 8 == 0) ? (bx % 8) * (C.G / 8) + bx / 8 : bx; }
    C.gw = C.vcu * NWAVES + C.wave; C.NGW = C.G * NWAVES;
    volatile LAS unsigned* MISC = (volatile LAS unsigned*)(C.lds + LDSCTL_OFF);
    volatile LAS int* offl = (volatile LAS int*)(C.lds + LDSCTL_OFF + 64);
    if (C.tid < 64) MISC[C.tid] = 0u;
    __syncthreads();
    const XcdBarrier bar = xcd_barrier_post((unsigned*)(C.ctl + CW_BAR), MISC);
    PhaseCtl P{args.ph_lo, args.ph_hi, 0};
#ifdef PTIME
    if (blockIdx.x == 0 && C.tid == 0) ((unsigned long long*)(C.ctl + 16384))[0] = rt();
#endif

#if EN_PRO
    if (PH_ON) { WSB();
#ifdef REP_PRO
        for (int rep_ = 0; rep_ < 2; ++rep_)
#endif
        for (int l = 0; l < 2; ++l) {
            tr_matrix<1>(C, args.in[8] + (size_t)l * 1024 * INC, nullptr, INC, 1024, INC, (bf16*)(ws + WS_WIN + l * WIN_BYTES));
            bf16* wo = (bf16*)(ws + WS_WOUT + l * WOUT_BYTES);
            tr_matrix<0>(C, args.in[17] + (size_t)l * 512 * 1024, nullptr, 1024, 512, 1024, wo);
            tr_matrix<0>(C, args.in[18] + (size_t)l * 512 * 1024, nullptr, 1024, 512, 1024, wo + 512 * 1024);
            tr_matrix<0>(C, args.in[19] + (size_t)l * 1024 * 1024, nullptr, 1024, 1024, 1024, wo + 1024 * 1024);
            tr_matrix<0>(C, args.in[20] + (size_t)l * 1024 * 1024, nullptr, 1024, 1024, 1024, wo + 2 * 1024 * 1024);
        }
        tr_matrix<2>(C, args.in[21], args.in[22], DFF, 1024, 2 * DFF, (bf16*)(ws + WS_WFU));
        tr_matrix<0>(C, args.in[23], nullptr, 1024, DFF, 1024, (bf16*)(ws + WS_WFD));
        for (int i = C.gw * 64 + C.lane; i < 2 * 8 * 128 * 128; i += C.NGW * 64) W_AWS[i] = (bf16)f2bf(args.in[12][i]);
        __syncthreads();
        mod_phase(C, args.in[1], args.in[3], args.in[4], args.in[5], W_MOD);
        rope_lam_phase(C, args.in[15], W_ROPE, W_LAM);
#ifdef PROBE_FILL
        { GAS u32x4* kf = (GAS u32x4*)(ws + WS_K); const u32x4 pat = {0x46404640u, 0x46404640u, 0x46404640u, 0x46404640u};
          for (size_t i = (size_t)C.gw * 64 + C.lane; i < (size_t)MA * DM * 2 / 16; i += (size_t)C.NGW * 64) kf[i] = pat; }
#endif
    }
#endif
    SEAM();
    layer_body<0>(C, args, bar, P, offl);
#if NLAYERS > 1
    layer_body<1>(C, args, bar, P, offl);
#endif
#ifdef PTIME
    {
        xcd_barrier(bar);
        const unsigned long long* T = (const unsigned long long*)(C.ctl + 16384);
        const float ta = (float)(__hip_atomic_load(T + 1 + PT_A1, __ATOMIC_RELAXED, __HIP_MEMORY_SCOPE_AGENT) - __hip_atomic_load(T + PT_A0, __ATOMIC_RELAXED, __HIP_MEMORY_SCOPE_AGENT)) * 0.01f;
        const float tb = (float)(__hip_atomic_load(T + 1 + PT_B1, __ATOMIC_RELAXED, __HIP_MEMORY_SCOPE_AGENT) - __hip_atomic_load(T + PT_B0, __ATOMIC_RELAXED, __HIP_MEMORY_SCOPE_AGENT)) * 0.01f;
        const float bv = 8.f * sqrtf(tb);
        for (size_t i = (size_t)C.gw * 64 + C.lane; i < (size_t)ML * DM; i += (size_t)C.NGW * 64) args.out[i] = i == 0 ? ta : ((i >= 1024 && i < 1024 + (1u << 20)) ? bv : 0.f);
    }
#endif
#ifdef PROBE
    {
        xcd_barrier(bar);
        const unsigned id = __hip_atomic_load((unsigned*)(C.ctl + PR_BASE), __ATOMIC_RELAXED, __HIP_MEMORY_SCOPE_AGENT);
        const float e1 = __uint_as_float(__hip_atomic_load((unsigned*)(C.ctl + PR_BASE + 1), __ATOMIC_RELAXED, __HIP_MEMORY_SCOPE_AGENT)), e2 = __uint_as_float(__hip_atomic_load((unsigned*)(C.ctl + PR_BASE + 2), __ATOMIC_RELAXED, __HIP_MEMORY_SCOPE_AGENT));
        const float err = id ? e1 : e2; float code = err < 0.05f ? 1000.f * err : 50.f + 100.f * (err > 4.5f ? 4.5f : err); const float bv = 8.f * sqrtf(code);
        const unsigned sv = __hip_atomic_load((unsigned*)(C.ctl + PR_BASE + 3), __ATOMIC_RELAXED, __HIP_MEMORY_SCOPE_AGENT), sb = __hip_atomic_load((unsigned*)(C.ctl + PR_BASE + 4), __ATOMIC_RELAXED, __HIP_MEMORY_SCOPE_AGENT);
        float a0 = 100.f * (float)id, bvv = bv;
        const unsigned eoff = __hip_atomic_load((unsigned*)(C.ctl + PR_BASE + 7), __ATOMIC_RELAXED, __HIP_MEMORY_SCOPE_AGENT);
#ifndef PROBE_SEL
#define PROBE_SEL 0
#endif
        if (PROBE_SEL == 8 && false) {} else if (sv && PROBE_SEL == 1) { const unsigned rr = eoff >> 10, nn = eoff & 1023u; a0 = 100.f * (float)(nn >> 4); bvv = 8.f * sqrtf((float)(rr >> 10)); }
        else if (sv && PROBE_SEL == 2) { const unsigned rr = eoff >> 10, nn = eoff & 1023u; a0 = 100.f * (float)(nn & 15u) + 50.f; bvv = 8.f * sqrtf((float)((rr >> 4) & 63u)); }
        else if (sv && PROBE_SEL == 4) { const unsigned cw = __hip_atomic_load((unsigned*)(C.ctl + PR_BASE + 8), __ATOMIC_RELAXED, __HIP_MEMORY_SCOPE_AGENT); a0 = 100.f * (float)(cw & 0xffu) + 50.f; bvv = 8.f * sqrtf((float)(cw >> 8)); }
        else if (sv && PROBE_SEL == 5) { const unsigned cw = __hip_atomic_load((unsigned*)(C.ctl + PR_BASE + 9), __ATOMIC_RELAXED, __HIP_MEMORY_SCOPE_AGENT); a0 = 100.f * (float)(cw & 0xffu) + 50.f; bvv = 8.f * sqrtf((float)(cw >> 8)); }
        else if (sv && PROBE_SEL == 6) { const unsigned cw = __hip_atomic_load((unsigned*)(C.ctl + PR_BASE + 10), __ATOMIC_RELAXED, __HIP_MEMORY_SCOPE_AGENT); a0 = 100.f * (float)((cw >> 4) & 15u) + 50.f; bvv = 8.f * sqrtf((float)(cw & 15u)); }
        else if (sv && PROBE_SEL == 7) { const unsigned cw = __hip_atomic_load((unsigned*)(C.ctl + PR_BASE + 10), __ATOMIC_RELAXED, __HIP_MEMORY_SCOPE_AGENT) >> 8; a0 = 100.f * (float)((cw >> 4) & 15u) + 50.f; bvv = 8.f * sqrtf((float)(cw & 15u)); }
        else if (PROBE_SEL == 8) { const unsigned ck = __hip_atomic_load((unsigned*)(C.ctl + PR_BASE + 12), __ATOMIC_RELAXED, __HIP_MEMORY_SCOPE_AGENT), cv = __hip_atomic_load((unsigned*)(C.ctl + PR_BASE + 13), __ATOMIC_RELAXED, __HIP_MEMORY_SCOPE_AGENT);
            a0 = 100.f * (float)ck; bvv = 8.f * sqrtf((float)cv); }
        else if (sv && PROBE_SEL == 3) { const unsigned rr = eoff >> 10; a0 = 100.f * (float)(rr & 15u) + 50.f; bvv = 0.f; }
        else if (sv) { const float val = __uint_as_float(sv); a0 = 1000.f * fabsf(val); const unsigned ko = __hip_atomic_load((unsigned*)(C.ctl + PR_BASE + 6), __ATOMIC_RELAXED, __HIP_MEMORY_SCOPE_AGENT); bvv = 8.f * sqrtf(10.f * (float)sb + (val < 0.f ? 5.f : 0.f) + (ko ? 100.f : 0.f)); }
        for (size_t i = (size_t)C.gw * 64 + C.lane; i < (size_t)ML * DM; i += (size_t)C.NGW * 64) args.out[i] = i == 0 ? a0 : ((i >= 1024 && i < 1024 + (1u << 20)) ? bvv : 0.f);
    }
#endif
}
#undef PH_ON
#undef SEAM
#undef WSB

extern "C" void kernel_launch(void* const* d_in, const int* in_sizes, int n_in, void* d_out, int out_size, void* d_ws, size_t ws_size, hipStream_t stream) {
    static int grid = 0;
    if (grid == 0) {
        if (n_in != 29 || in_sizes[0] != ML * DM || out_size != ML * DM || ws_size < WS_END) {
            fprintf(stderr, "kernel_launch: shape mismatch: n_in %d in0 %d out %d ws %zu (need %zu); nothing launched\n", n_in, n_in > 0 ? in_sizes[0] : -1, out_size, ws_size, (size_t)WS_END); grid = -1; return; }
        int dev = 0, cus = 0, per_cu = 0;
        if (hipGetDevice(&dev) != hipSuccess || hipDeviceGetAttribute(&cus, hipDeviceAttributeMultiprocessorCount, dev) != hipSuccess) { fprintf(stderr, "kernel_launch: device query failed\n"); grid = -1; return; }
        if (hipFuncSetAttribute((const void*)fwd_kernel, hipFuncAttributeMaxDynamicSharedMemorySize, LDS_BYTES) != hipSuccess) { fprintf(stderr, "kernel_launch: hipFuncSetAttribute failed\n"); grid = -1; return; }
        if (hipOccupancyMaxActiveBlocksPerMultiprocessor(&per_cu, (const void*)fwd_kernel, NTHREADS, LDS_BYTES) != hipSuccess || per_cu < 1)
            fprintf(stderr, "kernel_launch: note: occupancy query reports %d workgroups per CU\n", per_cu);
        (void)hipGetLastError();
        grid = cus;
    }
    if (grid < 0) return;
    if (hipMemsetAsync((char*)d_ws + WS_CTL, 0, CTL_ZERO_BYTES, stream) != hipSuccess) { fprintf(stderr, "kernel_launch: memset failed\n"); return; }
    Args a{};
    for (int i = 0; i < 29; ++i) a.in[i] = (const float*)d_in[i];
    a.out = (float*)d_out; a.ws = (unsigned char*)d_ws; a.ph_lo = 0; a.ph_hi = 1000;
    hipLaunchKernelGGL(fwd_kernel, dim3(grid), dim3(NTHREADS), LDS_BYTES, stream, a);
    const hipError_t le = hipPeekAtLastError();
    if (le != hipSuccess) fprintf(stderr, "kernel_launch: launch failed: %s\n", hipGetErrorName(le));
}
```

```cpp
#include <hip/hip_runtime.h>
#include <cstdio>
#include <cstdint>
namespace pg8 {
#define PG8_LAS __attribute__((address_space(3)))
typedef unsigned short bf16_t;
typedef short bf16x8 __attribute__((ext_vector_type(8)));
typedef float f32x4 __attribute__((ext_vector_type(4)));
typedef unsigned u32x4 __attribute__((ext_vector_type(4)));
constexpr int BM = 256, BK = 64, HALF = 128, HTB = HALF * BK * 2  , STAGE_BYTES = 8 * HTB, NXCD = 8, WGM = 8;

__host__ __device__ __forceinline__ int lds_byte(int r, int c) { const int st = (r >> 4) * 2 + (c >> 5), rr = r & 15, cc = c & 31, ob = rr * 64 + cc * 2; return st * 1024 + (ob ^ (((ob >> 9) & 1) << 5)); }
__host__ __device__ __forceinline__ void stage_rc(int b, int& R, int& C) { const int st = b / 1024, sb = b % 1024, swz = sb ^ (((sb >> 9) & 1) << 5); R = (st >> 1) * 16 + swz / 64; C = (st & 1) * 32 + (swz % 64) / 2; }
__host__ __device__ __forceinline__ int perm32(int rho) { const int n = rho >> 4, i = rho & 15; return 8 * (i >> 2) + 4 * n + (i & 3); }

struct Unit { int pm, pn; };
struct Gemm { const bf16_t* A; const bf16_t* Bt; int M, N, K; };

struct StaticOrder {
    static constexpr bool GATHER = false;
    int nM, nN, nwg, G, c;
    __host__ __device__ void init(int M, int N, int G_, int c_) { nM = M / BM; nN = N / BM; nwg = nM * nN; G = G_; c = c_; }
    __host__ __device__ bool next(int i, Unit& u) const {
        const long L = (long)i * G + c; if (L >= nwg) return false;
        int wgid = (int)L; { const int q = nwg / NXCD, r = nwg % NXCD, xcd = wgid % NXCD, off = wgid / NXCD; wgid = (xcd < r ? xcd * (q + 1) : r * (q + 1) + (xcd - r) * q) + off; }
        const int nig = WGM * nN, gid = wgid / nig, fm = gid * WGM, gsz = (nM - fm) < WGM ? (nM - fm) : WGM;
        u.pm = fm + ((wgid % nig) % gsz); u.pn = (wgid % nig) / gsz; return true;
    }
    __device__ __forceinline__ void a_ready(const Unit&) const {}
    __device__ __forceinline__ void done(const Unit&) const {}
};

typedef float cvt_f32x2 __attribute__((ext_vector_type(2))); typedef __bf16 cvt_bf16x2 __attribute__((ext_vector_type(2)));
__device__ __forceinline__ unsigned cvt_pk_bf16(float lo, float hi) { const cvt_f32x2 v = {lo, hi}; const cvt_bf16x2 b = __builtin_convertvector(v, cvt_bf16x2); return __builtin_bit_cast(unsigned, b); }
typedef float f32x2 __attribute__((ext_vector_type(2)));
__device__ __forceinline__ f32x2 gelu_pk(f32x2 v) {
    const f32x2 av = __builtin_elementwise_abs(v), d = av * 0.2316418882f + 1.0f;
    f32x2 t; t.x = __builtin_amdgcn_rcpf(d.x); t.y = __builtin_amdgcn_rcpf(d.y);
    f32x2 q = t * 0.5307027145f + (-0.7265760135f); q = q * t + 0.7107068705f; q = q * t + (-0.142248368f); q = q * t + 0.127414796f; q = q * t;
    const f32x2 s = (v * v) * (-0.72134752044f);
    f32x2 e; e.x = __builtin_amdgcn_exp2f(s.x); e.y = __builtin_amdgcn_exp2f(s.y);
    const f32x2 m = v * (q * e), r = v - m;
    f32x2 o; o.x = v.x < 0.f ? m.x : r.x; o.y = v.y < 0.f ? m.y : r.y; return o;
}


template <class Epi, class Sched, bool ALIGN_EPI = false, bool SP2 = false>
__device__ __forceinline__ void gemm_phase(PG8_LAS unsigned char* lds, const Gemm g, const Sched& S, const Epi& E) {
    const int tid = threadIdx.x, wid = __builtin_amdgcn_readfirstlane(tid >> 6), lane = tid & 63, wr = wid >> 2, wc = wid & 3, fr = lane & 15, fq = lane >> 4;
    const int K = g.K, nt = K / BK;
    unsigned voffA[2], voffB[2];
#pragma unroll
    for (int i = 0; i < 2; ++i) { int R, C; stage_rc(tid * 16 + i * 8192, R, C); const int Rb = Epi::PERM ? ((R & ~31) + perm32(R & 31)) : R;
        voffA[i] = (unsigned)(R * K + C) * 2u; voffB[i] = (unsigned)(Rb * K + C) * 2u; }
    const size_t kstep = (size_t)(BK * 2);
    constexpr bool GA = Sched::GATHER;
    unsigned gC[2][2]; int grow[2];
    PG8_LAS unsigned* const rmap_lds = (PG8_LAS unsigned*)(lds + 8 * HTB);
    if constexpr (GA) { int R, C; stage_rc(tid * 16, R, C); grow[0] = R; stage_rc(tid * 16 + 8192, R, C); grow[1] = R; }
#ifndef PG8_KROT
#define PG8_KROT 0
#endif
    static_assert(SP2 || !Sched::GATHER, "gathered A rows are written for the SP2 loop only");
    static_assert(SP2 || !PG8_KROT, "the K-slice rotation is written for the SP2 loop only");
    const int krot = PG8_KROT ? (int)((blockIdx.x >> 3) % (unsigned)(K / BK)) : 0;
#define PG8_KO(j) ((size_t)(((j) + krot) >= nt ? ((j) + krot) - nt : ((j) + krot)) * kstep)
    const size_t hstep = (size_t)HALF * K * 2;
    const size_t tstep = 2 * hstep;
    const unsigned ldsw = (unsigned)wid * 1024u;
    const int aoff = lds_byte(wr * 64 + fr, fq * 8), boff = lds_byte(wc * 32 + fr, fq * 8);
#define PG8_SA(b, h) (((b) * 2 + (h)) * HTB)
#define PG8_SB(b, h) ((4 + (b) * 2 + (h)) * HTB)
#define PG8_STAGE(bufoff, gbase, voff) do { _Pragma("unroll") for (int _i = 0; _i < 2; ++_i) \
        __builtin_amdgcn_global_load_lds((const unsigned*)((const char*)(gbase) + (voff)[_i]), (PG8_LAS unsigned*)(lds + (bufoff) + ldsw + _i * 8192), 16, 0, 0); } while (0)
#define PG8_STAGE_A(bufoff, base, h) do { if constexpr (GA) { PG8_STAGE(bufoff, base, gC[h]); } else { PG8_STAGE(bufoff, (base) + (h) * hstep, voffA); } } while (0)
#define PG8_GC_FROM(src, scale_) do { _Pragma("unroll") for (int h_ = 0; h_ < 2; ++h_) _Pragma("unroll") for (int i_ = 0; i_ < 2; ++i_) gC[h_][i_] = (src)[128 * h_ + grow[i_]] * (unsigned)(scale_) + (voffA[i_] - (unsigned)grow[i_] * (unsigned)(scale_)); } while (0)
#define PG8_LDA(dst, b, h) do { _Pragma("unroll") for (int m = 0; m < 4; ++m) _Pragma("unroll") for (int k = 0; k < 2; ++k) dst[m][k] = *(const PG8_LAS bf16x8*)(lds + PG8_SA(b, h) + aoff + m * 2048 + k * 1024); } while (0)
#define PG8_LDB(dst, b, h) do { _Pragma("unroll") for (int n = 0; n < 2; ++n) _Pragma("unroll") for (int k = 0; k < 2; ++k) dst[n][k] = *(const PG8_LAS bf16x8*)(lds + PG8_SB(b, h) + boff + n * 2048 + k * 1024); } while (0)
#define PG8_MMA(ai, bj, At, Bt) do { __builtin_amdgcn_s_setprio(1); _Pragma("unroll") for (int m = 0; m < 4; ++m) _Pragma("unroll") for (int n = 0; n < 2; ++n) _Pragma("unroll") for (int k = 0; k < 2; ++k) \
        acc[ai][bj][m][n] = __builtin_amdgcn_mfma_f32_16x16x32_bf16(Bt[n][k], At[m][k], acc[ai][bj][m][n], 0, 0, 0); __builtin_amdgcn_s_setprio(0); } while (0)
#define PG8_WAIT_V(n) asm volatile("s_waitcnt vmcnt(" #n ")" ::: "memory")
#define PG8_WAIT_L(n) asm volatile("s_waitcnt lgkmcnt(" #n ")" ::: "memory")
#define PG8_BAR __builtin_amdgcn_s_barrier()
#define PG8_SCHED __builtin_amdgcn_sched_barrier(0)
    Unit cur, nxt; int ui = 0;
    if (!S.next(0, cur)) return;
    f32x4 acc[2][2][4][2];
#pragma unroll
    for (int a = 0; a < 2; ++a)
#pragma unroll
        for (int b = 0; b < 2; ++b)
#pragma unroll
            for (int m = 0; m < 4; ++m)
#pragma unroll
                for (int n = 0; n < 2; ++n) acc[a][b][m][n] = (f32x4){0.f, 0.f, 0.f, 0.f};
    bf16x8 At[4][2], B0[2][2], B1[2][2];
    const char* cA = (const char*)g.A + (GA ? (size_t)0 : (size_t)cur.pm * tstep); const char* cB = (const char*)g.Bt + (size_t)cur.pn * tstep;
    if constexpr (GA) { const unsigned* rm = S.rowmap + (size_t)cur.pm * 256; PG8_GC_FROM(rm, K * 2); }
    S.a_ready(cur);
    if constexpr (SP2) {
        PG8_STAGE(PG8_SB(0, 0), cB + PG8_KO(0), voffB); PG8_STAGE(PG8_SB(0, 1), cB + hstep + PG8_KO(0), voffB); PG8_STAGE_A(PG8_SA(0, 0), cA + PG8_KO(0), 0); PG8_STAGE_A(PG8_SA(0, 1), cA + PG8_KO(0), 1);
        if (wr == 1) PG8_BAR;
        PG8_WAIT_V(2); PG8_BAR;
        PG8_STAGE(PG8_SB(1, 0), cB + PG8_KO(1), voffB); PG8_STAGE_A(PG8_SA(1, 0), cA + PG8_KO(1), 0); PG8_STAGE(PG8_SB(1, 1), cB + hstep + PG8_KO(1), voffB);
        PG8_WAIT_V(6); PG8_BAR;
    } else {
        PG8_STAGE(PG8_SB(0, 0), cB, voffB); PG8_STAGE(PG8_SA(0, 0), cA, voffA); PG8_STAGE(PG8_SB(0, 1), cB + hstep, voffB); PG8_STAGE(PG8_SA(0, 1), cA + hstep, voffA);
        if (wr == 1) PG8_BAR;
        PG8_WAIT_V(4); PG8_BAR;
        PG8_STAGE(PG8_SB(1, 0), cB + kstep, voffB); PG8_STAGE(PG8_SA(1, 0), cA + kstep, voffA); PG8_STAGE(PG8_SB(1, 1), cB + hstep + kstep, voffB);
        PG8_WAIT_V(6); PG8_BAR;
    }
    for (;;) {
        const bool has_next = S.next(ui + 1, nxt);
        const char* nA = (has_next && !GA) ? (const char*)g.A + (size_t)nxt.pm * tstep : cA; const char* nB = has_next ? (const char*)g.Bt + (size_t)nxt.pn * tstep : cB;
        if constexpr (GA) { if (has_next && wid < 4) __builtin_amdgcn_global_load_lds((const unsigned*)(S.rowmap + (size_t)nxt.pm * 256 + wid * 64 + lane), (PG8_LAS unsigned*)(rmap_lds + wid * 64), 4, 0, 0); }
        for (int t = 0; t < nt; t += 2) {
            const bool last = (t == nt - 2);
            const char* a1 = cA + PG8_KO(t + 1);
            const char* a2 = last ? nA + PG8_KO(0) : cA + PG8_KO(t + 2); const char* b2 = last ? nB + PG8_KO(0) : cB + PG8_KO(t + 2);
            const char* a3 = last ? nA + PG8_KO(1) : cA + PG8_KO(t + 3); const char* b3 = last ? nB + PG8_KO(1) : cB + PG8_KO(t + 3);
            if (last && has_next) S.a_ready(nxt);
            if constexpr (SP2) {
            PG8_LDB(B0, 0, 0); PG8_LDB(B1, 0, 1); PG8_SCHED; PG8_LDA(At, 0, 0); PG8_STAGE_A(PG8_SA(1, 1), a1, 1);
            if constexpr (GA) { if (last && has_next) PG8_GC_FROM(rmap_lds, K * 2); }
            PG8_WAIT_V(8); PG8_WAIT_L(0); PG8_BAR; PG8_MMA(0, 0, At, B0); PG8_MMA(0, 1, At, B1); PG8_BAR; PG8_SCHED;
            PG8_LDA(At, 0, 1); PG8_STAGE(PG8_SB(0, 0), b2, voffB); PG8_STAGE(PG8_SB(0, 1), b2 + hstep, voffB); PG8_STAGE_A(PG8_SA(0, 0), a2, 0);
            PG8_WAIT_V(8); PG8_WAIT_L(0); PG8_BAR; PG8_MMA(1, 0, At, B0); PG8_MMA(1, 1, At, B1); PG8_BAR; PG8_SCHED;
            PG8_LDB(B0, 1, 0); PG8_LDB(B1, 1, 1); PG8_SCHED; PG8_LDA(At, 1, 0); PG8_STAGE_A(PG8_SA(0, 1), a2, 1);
            PG8_WAIT_V(8); PG8_WAIT_L(0); PG8_BAR; PG8_MMA(0, 0, At, B0); PG8_MMA(0, 1, At, B1); PG8_BAR; PG8_SCHED;
            PG8_LDA(At, 1, 1); PG8_STAGE(PG8_SB(1, 0), b3, voffB); PG8_STAGE(PG8_SB(1, 1), b3 + hstep, voffB); PG8_STAGE_A(PG8_SA(1, 0), a3, 0);
            PG8_WAIT_V(8); PG8_WAIT_L(0); PG8_BAR; PG8_MMA(1, 0, At, B0); PG8_MMA(1, 1, At, B1); PG8_BAR; PG8_SCHED;
            } else {
            PG8_LDB(B0, 0, 0); PG8_SCHED; PG8_LDA(At, 0, 0); PG8_STAGE(PG8_SA(1, 1), a1 + hstep, voffA);
            PG8_WAIT_L(8); PG8_BAR; PG8_WAIT_L(0); PG8_MMA(0, 0, At, B0); PG8_BAR; PG8_SCHED;
            PG8_LDB(B1, 0, 1); PG8_STAGE(PG8_SB(0, 0), b2, voffB);
            PG8_BAR; PG8_WAIT_L(0); PG8_MMA(0, 1, At, B1); PG8_BAR;
            PG8_LDA(At, 0, 1); PG8_STAGE(PG8_SA(0, 0), a2, voffA);
            PG8_BAR; PG8_WAIT_L(0); PG8_MMA(1, 0, At, B0); PG8_BAR; PG8_SCHED;
            PG8_STAGE(PG8_SB(0, 1), b2 + hstep, voffB);
            PG8_WAIT_V(6); PG8_BAR; PG8_MMA(1, 1, At, B1); PG8_BAR;
            PG8_LDB(B0, 1, 0); PG8_SCHED; PG8_LDA(At, 1, 0); PG8_STAGE(PG8_SA(0, 1), a2 + hstep, voffA);
            PG8_WAIT_L(8); PG8_BAR; PG8_WAIT_L(0); PG8_MMA(0, 0, At, B0); PG8_BAR; PG8_SCHED;
            PG8_LDB(B1, 1, 1); PG8_STAGE(PG8_SB(1, 0), b3, voffB);
            PG8_BAR; PG8_WAIT_L(0); PG8_MMA(0, 1, At, B1); PG8_BAR;
            PG8_LDA(At, 1, 1); PG8_STAGE(PG8_SA(1, 0), a3, voffA);
            PG8_BAR; PG8_WAIT_L(0); PG8_MMA(1, 0, At, B0); PG8_BAR; PG8_SCHED;
            PG8_STAGE(PG8_SB(1, 1), b3 + hstep, voffB);
            PG8_WAIT_V(6); PG8_BAR; PG8_MMA(1, 1, At, B1); PG8_BAR;
            }
        }
        if constexpr (ALIGN_EPI) { if (wr == 0) PG8_BAR; }
        if constexpr (!Epi::AFTER_DRAIN) { E(acc, cur, wr, wc, fr, fq); S.done(cur); }
        if (!has_next) break;
#pragma unroll
        for (int a = 0; a < 2; ++a)
#pragma unroll
            for (int b = 0; b < 2; ++b)
#pragma unroll
                for (int m = 0; m < 4; ++m)
#pragma unroll
                    for (int n = 0; n < 2; ++n) acc[a][b][m][n] = (f32x4){0.f, 0.f, 0.f, 0.f};
        cur = nxt; cA = nA; cB = nB; ++ui;
        if constexpr (ALIGN_EPI) { if (wr == 1) PG8_BAR; }
    }
    PG8_WAIT_V(0);
    if constexpr (!ALIGN_EPI) { if (wr == 0) PG8_BAR; }
    PG8_BAR;
    if constexpr (Epi::AFTER_DRAIN) { E.fused(acc, cur, wr, wc, fr, fq, lds, wid, lane); S.done(cur); }
#undef PG8_SA
#undef PG8_SB
#undef PG8_STAGE
#undef PG8_STAGE_A
#undef PG8_GC_FROM
#undef PG8_LDA
#undef PG8_LDB
#undef PG8_MMA
#undef PG8_WAIT_V
#undef PG8_WAIT_L
#undef PG8_BAR
#undef PG8_SCHED
#undef PG8_KO
}
}

#ifndef PG8_SP2
#define PG8_SP2 true
#endif
#ifndef PG8_ALIGN
#define PG8_ALIGN true
#endif

#define GAS __attribute__((address_space(1)))
#define LAS __attribute__((address_space(3)))
typedef unsigned short bf16;
typedef unsigned v4u __attribute__((ext_vector_type(4)));
typedef float f32x4 __attribute__((ext_vector_type(4)));
typedef short bf16x8 __attribute__((ext_vector_type(8)));
typedef GAS unsigned gu32;
typedef GAS unsigned long long gu64;
#define RLX_AGENT __ATOMIC_RELAXED, __HIP_MEMORY_SCOPE_AGENT
#define LDS_WAIT() asm volatile("s_waitcnt lgkmcnt(0)" ::: "memory")
#define VM_WAIT() asm volatile("s_waitcnt vmcnt(0)" ::: "memory")
__device__ __forceinline__ unsigned long long rt() { return __builtin_amdgcn_s_memrealtime(); }
__device__ __forceinline__ unsigned f2bf(float f) { unsigned u = __builtin_bit_cast(unsigned, f); return (u + 0x7fffu + ((u >> 16) & 1u)) >> 16; }
__device__ __forceinline__ unsigned pk2(float lo, float hi) { return f2bf(lo) | (f2bf(hi) << 16); }

#define XB_TMO      128
#define XB_XCNT(j)  (256  + 64 * (j))
#define XB_XSUB(j)  (1280 + 64 * (j))
#define XB_XGEN(j)  (2304 + 64 * (j))
#define XB_TOP      3328
#define XB_TOPGEN   3392
#define XCD_BAR_WORDS 3456
#define XB_SPIN_CAP (1u << 18)

__device__ __forceinline__ unsigned xb_ld(unsigned* p)              { return __hip_atomic_load(p, __ATOMIC_RELAXED, __HIP_MEMORY_SCOPE_AGENT); }
__device__ __forceinline__ unsigned xb_add(unsigned* p, unsigned v) { return __hip_atomic_fetch_add(p, v, __ATOMIC_RELAXED, __HIP_MEMORY_SCOPE_AGENT); }
__device__ __forceinline__ unsigned xb_xcc_id() { return (unsigned)__builtin_amdgcn_s_getreg((3 << 11) | 20) & 0xFu; }
#define XB_SPIN(cond, bar) do { unsigned _sp = 0; while (cond) { __builtin_amdgcn_s_sleep(1); \
    if ((++_sp & 255u) == 0u) { if (xb_ld(&(bar)[XB_TMO])) break; if (_sp > XB_SPIN_CAP) { atomicAdd(&(bar)[XB_TMO], 1u); break; } } } } while (0)

struct XcdBarrier {
    unsigned* bar; unsigned x;
    volatile LAS unsigned* st;
};

__device__ __forceinline__ XcdBarrier xcd_barrier_post(unsigned* bar, volatile LAS unsigned* st) {
    XcdBarrier b; b.bar = bar; b.x = xb_xcc_id(); b.st = st;
    if (threadIdx.x == 0) (void)xb_add(&bar[XB_XCNT(b.x)], 1u);
    return b;
}
__device__ __forceinline__ void xcd_barrier_complete(unsigned* bar, unsigned x, unsigned& nloc, unsigned& nx) {
    const unsigned G = gridDim.x * gridDim.y * gridDim.z;
    unsigned sum, cnt, mine, sp = 0u;
    for (;;) {
        sum = 0u; cnt = 0u; mine = 0u;
#pragma unroll
        for (unsigned j = 0; j < 16; ++j) { const unsigned c = xb_ld(&bar[XB_XCNT(j)]); sum += c; cnt += (c > 0u) ? 1u : 0u; mine = (j == x) ? c : mine; }
        if (sum == G) break;
        __builtin_amdgcn_s_sleep(1);
        if ((++sp & 255u) == 0u) { if (xb_ld(&bar[XB_TMO])) break; if (sp > XB_SPIN_CAP) { atomicAdd(&bar[XB_TMO], 1u); break; } }
    }
    nloc = mine > 0u ? mine : 1u; nx = cnt > 0u ? cnt : 1u;
}

__device__ __forceinline__ void xcd_barrier(const XcdBarrier& b) {
    asm volatile("s_waitcnt vmcnt(0)" ::: "memory");
    __syncthreads();
    if (threadIdx.x == 0) {
        unsigned* bar = b.bar;
        __builtin_amdgcn_s_waitcnt(0);
        unsigned nloc = b.st[0], nx = b.st[1];
        if (nloc == 0u) { xcd_barrier_complete(bar, b.x, nloc, nx); b.st[0] = nloc; b.st[1] = nx; }
        const unsigned old = xb_add(&bar[XB_XSUB(b.x)], 1u);
        const unsigned gen = old / nloc;
        if (old + 1u == (gen + 1u) * nloc) {
            __builtin_amdgcn_fence(__ATOMIC_RELEASE, "agent");
            asm volatile("s_waitcnt vmcnt(0)" ::: "memory");
            const unsigned og = xb_add(&bar[XB_TOP], 1u);
            const unsigned tg = og / nx;
            if (og + 1u == (tg + 1u) * nx) xb_add(&bar[XB_TOPGEN], 1u);
            else XB_SPIN(xb_ld(&bar[XB_TOPGEN]) == tg, bar);
            __builtin_amdgcn_fence(__ATOMIC_ACQUIRE, "agent");
            xb_add(&bar[XB_XGEN(b.x)], 1u);
            asm volatile("s_waitcnt vmcnt(0)" ::: "memory");
        } else {
            XB_SPIN(xb_ld(&bar[XB_XGEN(b.x)]) == gen, bar);
            __builtin_amdgcn_fence(__ATOMIC_ACQUIRE, "agent");
            asm volatile("s_waitcnt vmcnt(0)" ::: "memory");
        }
    }
    __syncthreads();
}

#ifndef NLAYERS
#define NLAYERS 2
#endif
#ifndef EN_PRO
#define EN_PRO 1
#endif
#ifndef EN_MIX
#define EN_MIX 1
#endif
#ifndef EN_ATT
#define EN_ATT 1
#endif
#ifndef EN_SITES
#define EN_SITES 255
#endif
constexpr int NWAVES = 8, NTHREADS = 512;
constexpr int BATCH = 16, SEQ = 4096, DM = 1024, CTXL = 256;
constexpr int ML = BATCH * SEQ;
constexpr int MC = BATCH * CTXL;
constexpr int MA = ML + MC;
constexpr int SKV = SEQ + CTXL;
constexpr int INC = 8704;
constexpr int NBIG = 5632;
constexpr int DFF = 2816, NEXP = 8, DFE = 3584;
constexpr int MOE_CH = 192;
constexpr float EPS = 1e-6f;
constexpr float QSCALE = 0.125f * 1.4426950408889634f;

constexpr size_t MiB = 1u << 20;
constexpr size_t WS_CTL = 0, CTL_ZERO_BYTES = 1 * MiB;
constexpr size_t WS_MOD = 1 * MiB;
constexpr size_t WS_ROPE = 2 * MiB;
constexpr size_t WS_LAM = 2 * MiB + 16384;
constexpr size_t WS_AWS = 2 * MiB + 65536;
constexpr size_t WS_ROUTE = 4 * MiB;
constexpr size_t WS_RMAP = 6 * MiB;
constexpr size_t WS_WIN = 8 * MiB;
constexpr size_t WIN_BYTES = 17 * MiB;
constexpr size_t WS_WOUT = 42 * MiB;
constexpr size_t WOUT_BYTES = 6 * MiB;
constexpr size_t WS_WFU = 54 * MiB;
constexpr size_t WS_WFD = 65 * MiB;
constexpr size_t WS_X16 = 87 * MiB;
constexpr size_t WS_P0 = 223 * MiB, WS_P1 = 291 * MiB, WS_P2 = 359 * MiB, WS_P3 = 427 * MiB;
constexpr size_t WS_Q = 495 * MiB, WS_K = 631 * MiB, WS_V = 767 * MiB;
constexpr size_t WS_ACT0 = 223 * MiB;
constexpr size_t WS_MWU = 223 * MiB;
constexpr size_t WS_MWD = 335 * MiB;
constexpr size_t WS_HS = 391 * MiB;
constexpr size_t WS_MACT = 651 * MiB;
constexpr size_t WS_END = 1024 * MiB;
static_assert(WS_MACT + (size_t)MOE_CH * 256 * DFE * 2 <= WS_END, "ws map");
static_assert(WS_ACT0 + (size_t)MA * DFF * 2 <= WS_K, "ws map");
constexpr int CW_BAR = 4096;
constexpr int CW_CNT = 8192;

constexpr int LDS_BYTES = 147456;
constexpr int LDSCTL_OFF = LDS_BYTES - 256;

typedef float f32x2 __attribute__((ext_vector_type(2)));
typedef unsigned v2u __attribute__((ext_vector_type(2)));
__device__ __forceinline__ float bf2f(unsigned h) { return __builtin_bit_cast(float, h << 16); }
__device__ __forceinline__ float dpp_add(float v, int ctrl_sel) {
    const int x = __builtin_bit_cast(int, v); int y;
    if (ctrl_sel == 0) y = __builtin_amdgcn_update_dpp(0, x, 0xB1, 0xf, 0xf, false);
    else if (ctrl_sel == 1) y = __builtin_amdgcn_update_dpp(0, x, 0x4E, 0xf, 0xf, false);
    else if (ctrl_sel == 2) y = __builtin_amdgcn_update_dpp(0, x, 0x141, 0xf, 0xf, false);
    else y = __builtin_amdgcn_update_dpp(0, x, 0x140, 0xf, 0xf, false);
    return v + __builtin_bit_cast(float, y);
}
__device__ __forceinline__ float wave_sum(float v) {
    v = dpp_add(v, 0); v = dpp_add(v, 1); v = dpp_add(v, 2); v = dpp_add(v, 3);
    const int x = __builtin_bit_cast(int, v);
    const float s0 = __builtin_bit_cast(float, __builtin_amdgcn_readlane(x, 0)), s1 = __builtin_bit_cast(float, __builtin_amdgcn_readlane(x, 16)),
                s2 = __builtin_bit_cast(float, __builtin_amdgcn_readlane(x, 32)), s3 = __builtin_bit_cast(float, __builtin_amdgcn_readlane(x, 48));
    return (s0 + s1) + (s2 + s3);
}
__device__ __forceinline__ float fast_exp2(float x) { return __builtin_amdgcn_exp2f(x); }
__device__ __forceinline__ float fast_rcp(float x) { return __builtin_amdgcn_rcpf(x); }
__device__ __forceinline__ float sigmoid_f(float x) { return fast_rcp(1.f + fast_exp2(-1.4426950408889634f * x)); }
__device__ __forceinline__ float silu_f(float x) { return x * sigmoid_f(x); }
__device__ __forceinline__ float gelu_tanh_f(float x) { const float u = x * (1.f + 0.044715f * x * x); return x * fast_rcp(1.f + fast_exp2(-2.f * 0.7978845608028654f * 1.4426950408889634f * u)); }

__device__ __forceinline__ unsigned char* launder_ptr(unsigned char* p) { asm volatile("" : "+s"(p)); return p; }
struct Args { const float* in[29]; float* out; unsigned char* ws; int ph_lo, ph_hi; };
static_assert(sizeof(Args) == 256, "Args has no holes");
struct PhaseCtl { int lo, hi, ph; };
struct Ctx {
    LAS unsigned char* lds;
    gu32* ctl;
    int tid, lane, wave, vcu, G, gw, NGW;
};

__device__ __forceinline__ void tr_item(const float* W, int ldw, int scol0, bool perm, bf16* WT, int K, int drow0, int k0, LAS float* scr, int lane) {
    float tv[32];
#pragma unroll
    for (int i = 0; i < 32; ++i) { const int kk = 2 * i + (lane >> 5); tv[i] = W[(size_t)(k0 + kk) * ldw + scol0 + (lane & 31)]; }
#pragma unroll
    for (int i = 0; i < 32; ++i) { const int kk = 2 * i + (lane >> 5); scr[kk * 33 + (lane & 31)] = tv[i]; }
    LDS_WAIT(); asm volatile("" ::: "memory");
    const int c = lane & 7;
#pragma unroll
    for (int j = 0; j < 4; ++j) { const int n = (lane >> 3) + 8 * j; const int sn = perm ? ((n >> 1) + 16 * (n & 1)) : n;
        const LAS float* s = scr + (8 * c) * 33 + sn;
        v4u o; o.x = pk2(s[0 * 33], s[1 * 33]); o.y = pk2(s[2 * 33], s[3 * 33]); o.z = pk2(s[4 * 33], s[5 * 33]); o.w = pk2(s[6 * 33], s[7 * 33]);
        *(GAS v4u*)(WT + (size_t)(drow0 + n) * K + k0 + 8 * c) = o; }
    LDS_WAIT(); asm volatile("" ::: "memory");
}
__device__ __forceinline__ int win_src(int d, bool& perm) {
    perm = false;
    if (d < 1024) { perm = true; return 2560 + d; }
    if (d < 2048) { perm = true; return 3584 + (d - 1024); }
    if (d < 3072) return 4608 + (d - 2048);
    if (d < 3584) return d - 3072;
    if (d < 4096) return 512 + (d - 3584);
    if (d < 4608) return 1024 + (d - 4096);
    if (d < 5632) { const int x = d - 4608, j = x >> 8, w = x & 255; return (w < 128 ? 1536 : 2048) + 128 * j + (w & 127); }
    return d;
}
template <int MODE>
__device__ __forceinline__ void tr_matrix(const Ctx& C, const float* W, const float* W2, int ldw, int K, int ndst, bf16* WT) {
    LAS float* scr = (LAS float*)(C.lds + C.wave * 16384);
    const int nblk = ndst / 32, ni = (K / 64) * nblk;
    for (int it = C.gw; it < ni; it += C.NGW) {
        const int kb = it / nblk, db = it % nblk; const float* src = W; int scol0; bool perm = false;
        if (MODE == 0) scol0 = 32 * db;
        else if (MODE == 1) scol0 = win_src(32 * db, perm);
        else { const int j = db >> 3, w = db & 7; if (w >= 4) src = W2; scol0 = 128 * j + 32 * (w & 3); }
        tr_item(src, ldw, scol0, perm, WT, K, 32 * db, 64 * kb, scr, C.lane);
    }
}

__device__ __forceinline__ void mod_phase(const Ctx& C, const float* c, const float* cctx, const float* w_ada, const float* b_ada, float* mod) {
    LAS float* sc = (LAS float*)C.lds;
    LAS float* red = (LAS float*)(C.lds + 17 * 1024 * 4);
    for (int idx = C.tid; idx < 17 * 1024; idx += NTHREADS) { const int b = idx >> 10, k = idx & 1023; const float v = b < 16 ? c[b * 1024 + k] : cctx[k]; sc[idx] = v / (1.f + __expf(-v)); }
    __syncthreads();
    const int cl = C.tid & 31, ks = C.tid >> 5;
    for (int it = blockIdx.x; it < 2 * 192; it += C.G) {
        const int l = it / 192, cb = it % 192, col = cb * 32 + cl;
        float acc[17];
#pragma unroll
        for (int b = 0; b < 17; ++b) acc[b] = 0.f;
        const float* wp = w_ada + ((size_t)l * 1024 + ks * 64) * 6144 + col;
        for (int kk = 0; kk < 64; ++kk) { const float w = wp[(size_t)kk * 6144]; const int k = ks * 64 + kk;
#pragma unroll
            for (int b = 0; b < 17; ++b) acc[b] += sc[b * 1024 + k] * w; }
#pragma unroll
        for (int b = 0; b < 17; ++b) red[(ks * 17 + b) * 32 + cl] = acc[b];
        __syncthreads();
        for (int o = C.tid; o < 17 * 32; o += NTHREADS) { const int b = o >> 5, cc = o & 31; float s = b_ada[l * 6144 + cb * 32 + cc];
#pragma unroll
            for (int q = 0; q < 16; ++q) s += red[(q * 17 + b) * 32 + cc];
            mod[((size_t)l * 17 + b) * 6144 + cb * 32 + cc] = s; }
        __syncthreads();
    }
}
__device__ __forceinline__ void rope_lam_phase(const Ctx& C, const float* c_lambda, float* rope, float* lam) {
    if (blockIdx.x == 0) {
        for (int idx = C.tid; idx < 1024; idx += NTHREADS) {
            const int pos = idx >> 4, i = idx & 15;
            double th = 1.0; for (int q = 0; q < i; ++q) th *= 0.56234132519034908;
            double c1 = 1.0, s1 = th, tc = 1.0, ts = th; const double t2 = th * th;
            for (int n = 1; n <= 12; ++n) { tc *= -t2 / (double)((2 * n - 1) * (2 * n)); ts *= -t2 / (double)((2 * n) * (2 * n + 1)); c1 += tc; s1 += ts; }
            double cc = 1.0, ss = 0.0; for (int q = 0; q < pos; ++q) { const double nc = cc * c1 - ss * s1, ns = ss * c1 + cc * s1; cc = nc; ss = ns; }
            rope[idx * 2] = (float)cc; rope[idx * 2 + 1] = (float)ss;
        }
        if (C.tid < 2) { const int l = C.tid; const float* p = c_lambda + l * 256; float a = 0.f, b = 0.f;
            for (int d = 0; d < 64; ++d) { a += p[d] * p[64 + d]; b += p[128 + d] * p[192 + d]; }
            const float li = l == 0 ? 0.2f : (0.8f - 0.6f * 0.7408182206817179f);
            lam[l] = __expf(a) - __expf(b) + li; }
    }
}

template <bool XB> __device__ __forceinline__ f32x4 ldrow4(const void* row, int idx) {
    if constexpr (XB) { const v2u w = ((const GAS v2u*)row)[idx]; f32x4 a; a[0] = bf2f(w.x & 0xffffu); a[1] = bf2f(w.x >> 16); a[2] = bf2f(w.y & 0xffffu); a[3] = bf2f(w.y >> 16); return a; }
    else return ((const GAS f32x4*)row)[idx];
}
template <bool XB> __device__ __forceinline__ void modulate_row(const void* xr, const float* gn, const float* scv, const float* shv, bf16* orow, int lane, f32x4 (&y)[4]) {
    f32x4 v[4]; float ss = 0.f;
#pragma unroll
    for (int j = 0; j < 4; ++j) { v[j] = ldrow4<XB>(xr, lane + 64 * j); ss += (v[j].x * v[j].x + v[j].y * v[j].y) + (v[j].z * v[j].z + v[j].w * v[j].w); }
    const float rstd = 1.0f / sqrtf(wave_sum(ss) * (1.f / 1024.f) + EPS);
    GAS v2u* o8 = (GAS v2u*)orow + lane;
#pragma unroll
    for (int j = 0; j < 4; ++j) {
        const f32x4 g = ((const GAS f32x4*)gn)[lane + 64 * j], s = ((const GAS f32x4*)scv)[lane + 64 * j], h = ((const GAS f32x4*)shv)[lane + 64 * j];
        y[j] = (v[j] * rstd) * g * (s + 1.0f) + h;
        v2u w; w.x = pg8::cvt_pk_bf16(y[j].x, y[j].y); w.y = pg8::cvt_pk_bf16(y[j].z, y[j].w); o8[64 * j] = w; }
}
template <bool XB> struct RawSel { typedef f32x4 T; };
template <> struct RawSel<true> { typedef v2u T; };
template <bool XB> __device__ __forceinline__ typename RawSel<XB>::T ldraw4(const void* row, int idx) { return ((const GAS typename RawSel<XB>::T*)row)[idx]; }
__device__ __forceinline__ f32x4 cvraw4(const f32x4& r) { return r; }
__device__ __forceinline__ f32x4 cvraw4(const v2u& w) { f32x4 a; a[0] = bf2f(w.x & 0xffffu); a[1] = bf2f(w.x >> 16); a[2] = bf2f(w.y & 0xffffu); a[3] = bf2f(w.y >> 16); return a; }
template <bool XB> __device__ __forceinline__ void modulate_phase(const Ctx& C, const void* xl, const void* xcs, const float* gn, const float* modl, int shidx, int scidx, bf16* H, int nrows) {
    typedef typename RawSel<XB>::T RT;
    const int lane = C.lane;
    auto rowp = [&](int r) -> const void* {
        if constexpr (XB) return (const void*)((const bf16*)xl + (size_t)r * DM);
        else return r < ML ? (const void*)((const float*)xl + (size_t)r * DM) : (const void*)((const float*)xcs + (size_t)(r - ML) * DM); };
    f32x4 g[4];
#pragma unroll
    for (int j = 0; j < 4; ++j) g[j] = ((const GAS f32x4*)gn)[lane + 64 * j];
    int r0 = C.gw; if (r0 >= nrows) return;
    RT a0[4], a1[4];
    { const int r1 = r0 + C.NGW < nrows ? r0 + C.NGW : r0; const void* p0 = rowp(r0); const void* p1 = rowp(r1);
#pragma unroll
      for (int j = 0; j < 4; ++j) { a0[j] = ldraw4<XB>(p0, lane + 64 * j); a1[j] = ldraw4<XB>(p1, lane + 64 * j); } }
    for (; r0 < nrows; r0 += 2 * C.NGW) {
        const int r1 = r0 + C.NGW; const bool has1 = r1 < nrows; const int r1c = has1 ? r1 : r0;
        const int b0 = r0 < ML ? (r0 >> 12) : 16, b1 = r1c < ML ? (r1c >> 12) : 16;
        const float* m0 = modl + (size_t)b0 * 6144; const float* m1 = modl + (size_t)b1 * 6144;
        f32x4 sa[4], ha[4], sb[4], hb[4];
#pragma unroll
        for (int j = 0; j < 4; ++j) { sa[j] = ((const GAS f32x4*)(m0 + scidx * 1024))[lane + 64 * j]; ha[j] = ((const GAS f32x4*)(m0 + shidx * 1024))[lane + 64 * j];
                                      sb[j] = ((const GAS f32x4*)(m1 + scidx * 1024))[lane + 64 * j]; hb[j] = ((const GAS f32x4*)(m1 + shidx * 1024))[lane + 64 * j]; }
        RT n0[4], n1[4];
        { const int q0 = r0 + 2 * C.NGW < nrows ? r0 + 2 * C.NGW : r0, q1 = r0 + 3 * C.NGW < nrows ? r0 + 3 * C.NGW : r0; const void* p0 = rowp(q0); const void* p1 = rowp(q1);
#pragma unroll
          for (int j = 0; j < 4; ++j) { n0[j] = ldraw4<XB>(p0, lane + 64 * j); n1[j] = ldraw4<XB>(p1, lane + 64 * j); } }
        f32x4 v0[4], v1[4]; float s0 = 0.f, s1 = 0.f;
#pragma unroll
        for (int j = 0; j < 4; ++j) { v0[j] = cvraw4(a0[j]); v1[j] = cvraw4(a1[j]); }
#pragma unroll
        for (int j = 0; j < 4; ++j) { s0 += (v0[j].x * v0[j].x + v0[j].y * v0[j].y) + (v0[j].z * v0[j].z + v0[j].w * v0[j].w); s1 += (v1[j].x * v1[j].x + v1[j].y * v1[j].y) + (v1[j].z * v1[j].z + v1[j].w * v1[j].w); }
        const float rs0 = 1.0f / sqrtf(wave_sum(s0) * (1.f / 1024.f) + EPS), rs1 = 1.0f / sqrtf(wave_sum(s1) * (1.f / 1024.f) + EPS);
        GAS v2u* o0 = (GAS v2u*)(H + (size_t)r0 * DM) + lane; GAS v2u* o1 = (GAS v2u*)(H + (size_t)r1c * DM) + lane;
#pragma unroll
        for (int j = 0; j < 4; ++j) {
            const f32x4 ya = (v0[j] * rs0) * g[j] * (sa[j] + 1.0f) + ha[j];
            v2u w; w.x = pg8::cvt_pk_bf16(ya.x, ya.y); w.y = pg8::cvt_pk_bf16(ya.z, ya.w); o0[64 * j] = w;
            if (has1) { const f32x4 yb = (v1[j] * rs1) * g[j] * (sb[j] + 1.0f) + hb[j];
                v2u w2; w2.x = pg8::cvt_pk_bf16(yb.x, yb.y); w2.y = pg8::cvt_pk_bf16(yb.z, yb.w); o1[64 * j] = w2; }
        }
#pragma unroll
        for (int j = 0; j < 4; ++j) { a0[j] = n0[j]; a1[j] = n1[j]; }
    }
}

using pg8::f32x4; using pg8::u32x4; using pg8::Unit; using pg8::cvt_pk_bf16;
__device__ __forceinline__ u32x4 pack8(const f32x4& a, const f32x4& b) { u32x4 w; w.x = cvt_pk_bf16(a[0], a[1]); w.y = cvt_pk_bf16(a[2], a[3]); w.z = cvt_pk_bf16(b[0], b[1]); w.w = cvt_pk_bf16(b[2], b[3]); return w; }
__device__ __forceinline__ void unpack8(const u32x4& w, f32x4& a, f32x4& b) {
    a[0] = bf2f(w.x & 0xffffu); a[1] = bf2f(w.x >> 16); a[2] = bf2f(w.y & 0xffffu); a[3] = bf2f(w.y >> 16);
    b[0] = bf2f(w.z & 0xffffu); b[1] = bf2f(w.z >> 16); b[2] = bf2f(w.w & 0xffffu); b[3] = bf2f(w.w >> 16); }

#ifndef NT_BIG
#define NT_BIG 0
#endif
#if NT_BIG
#define ST16(p, v) __builtin_nontemporal_store((v), (p))
#else
#define ST16(p, v) (*(p) = (v))
#endif
struct EpiBig {
    static constexpr bool PERM = true, AFTER_DRAIN = false;
    unsigned char* wsb; const LAS float* rope;
    __device__ __forceinline__ void operator()(const f32x4 (&acc)[2][2][4][2], const Unit& u, int wr, int wc, int fr, int fq) const {
        const int R0 = u.pm * 256, pn = u.pn; const bool isctx = R0 >= ML;
        const int cin = 32 * wc + 8 * fq;
        if (pn < 12) {
            const int kind = pn >> 2;
            bf16* base = (bf16*)(wsb + WS_Q + (size_t)kind * (WS_K - WS_Q));
            long rowadd = 0;
            if (kind != 0) rowadd = isctx ? ((long)((R0 - ML) >> 8) * SKV + SEQ - R0) : ((long)(R0 >> 12) * (SKV - SEQ));
            const bool rot = (kind != 2) && !isctx; const int axis = wc & 1; const float qs = kind == 0 ? QSCALE : 1.f;
#pragma unroll
            for (int ai = 0; ai < 2; ++ai)
#pragma unroll
                for (int m = 0; m < 4; ++m) {
                    const int r = R0 + ai * 128 + wr * 64 + m * 16 + fr;
                    f32x4 t0 = {1.f, 0.f, 1.f, 0.f}, t1 = {1.f, 0.f, 1.f, 0.f};
                    if (rot) { const int t = r & 4095; const int pos = axis == 0 ? (t >> 6) : (t & 63); const LAS f32x4* tp = (const LAS f32x4*)(rope + (pos * 16 + 4 * fq) * 2); t0 = tp[0]; t1 = tp[1]; }
                    bf16* rowp = base + (size_t)((long)r + rowadd) * DM + (pn & 3) * 256 + cin;
#pragma unroll
                    for (int bj = 0; bj < 2; ++bj) {
                        const f32x4 a = acc[ai][bj][m][0], b = acc[ai][bj][m][1]; f32x4 oa, ob;
                        oa[0] = (a[0] * t0[0] - a[1] * t0[1]) * qs; oa[1] = (a[1] * t0[0] + a[0] * t0[1]) * qs; oa[2] = (a[2] * t0[2] - a[3] * t0[3]) * qs; oa[3] = (a[3] * t0[2] + a[2] * t0[3]) * qs;
                        ob[0] = (b[0] * t1[0] - b[1] * t1[1]) * qs; ob[1] = (b[1] * t1[0] + b[0] * t1[1]) * qs; ob[2] = (b[2] * t1[2] - b[3] * t1[3]) * qs; ob[3] = (b[3] * t1[2] + b[2] * t1[3]) * qs;
                        ST16((GAS u32x4*)(rowp + bj * 128), pack8(oa, ob)); }
                }
        } else if (pn < 18) {
            const int kind = (pn - 12) >> 1;
            bf16* base = (bf16*)(wsb + WS_P0 + (size_t)kind * (WS_P1 - WS_P0)); const int c0 = ((pn - 12) & 1) * 256 + cin;
#pragma unroll
            for (int ai = 0; ai < 2; ++ai)
#pragma unroll
                for (int m = 0; m < 4; ++m) {
                    const int r = R0 + ai * 128 + wr * 64 + m * 16 + fr; bf16* rowp = base + (size_t)r * 512 + c0;
#pragma unroll
                    for (int bj = 0; bj < 2; ++bj) {
                        f32x4 a = acc[ai][bj][m][0], b = acc[ai][bj][m][1];
                        if (kind < 2) {
#pragma unroll
                            for (int q = 0; q < 4; ++q) { a[q] = gelu_tanh_f(a[q]); b[q] = gelu_tanh_f(b[q]); } }
                        ST16((GAS u32x4*)(rowp + bj * 128), pack8(a, b)); }
                }
        } else {
            const int c0 = (pn - 18) * 128 + cin;
#pragma unroll
            for (int ai = 0; ai < 2; ++ai)
#pragma unroll
                for (int m = 0; m < 4; ++m) {
                    const int r = R0 + ai * 128 + wr * 64 + m * 16 + fr;
                    const f32x4 a = acc[ai][0][m][0] * acc[ai][1][m][0], b = acc[ai][0][m][1] * acc[ai][1][m][1];
                    ST16((GAS u32x4*)((bf16*)(wsb + WS_P3) + (size_t)r * 512 + c0), pack8(a, b)); }
        }
    }
};

struct EpiGate {
    static constexpr bool PERM = true, AFTER_DRAIN = false;
    unsigned char* wsb; const LAS float* bias;
    __device__ __forceinline__ void operator()(const f32x4 (&acc)[2][2][4][2], const Unit& u, int wr, int wc, int fr, int fq) const {
        const int R0 = u.pm * 256, pn = u.pn, br = pn >> 2, cin = 32 * wc + 8 * fq;
        const size_t boff = br == 0 ? WS_K : (br == 1 ? WS_V : ((pn & 2) ? WS_P3 : WS_P1));
        bf16* base = (bf16*)(wsb + boff); const int ld = br == 2 ? 512 : 1024, c0 = (br == 2 ? (pn & 1) : (pn & 3)) * 256 + cin;
        f32x4 bv[2][2];
#pragma unroll
        for (int bj = 0; bj < 2; ++bj)
#pragma unroll
            for (int n = 0; n < 2; ++n) bv[bj][n] = *(const LAS f32x4*)(bias + pn * 256 + bj * 128 + cin + 4 * n);
#pragma unroll
        for (int ai = 0; ai < 2; ++ai)
#pragma unroll
            for (int m = 0; m < 4; ++m) {
                const int r = R0 + ai * 128 + wr * 64 + m * 16 + fr; bf16* rowp = base + (size_t)r * ld + c0;
#pragma unroll
                for (int bj = 0; bj < 2; ++bj) {
                    f32x4 a = acc[ai][bj][m][0] + bv[bj][0], b = acc[ai][bj][m][1] + bv[bj][1];
#pragma unroll
                    for (int q = 0; q < 4; ++q) { a[q] = sigmoid_f(a[q]); b[q] = sigmoid_f(b[q]); }
                    ST16((GAS u32x4*)(rowp + bj * 128), pack8(a, b)); }
            }
    }
};

struct EpiMerge {
    static constexpr bool PERM = true, AFTER_DRAIN = false;
    bf16* Y; const bf16* G0; long g1off; int gld; int gsplit_tiles;
    int first; int dry;
    __device__ __forceinline__ void operator()(const f32x4 (&acc)[2][2][4][2], const Unit& u, int wr, int wc, int fr, int fq) const {
        const int R0 = u.pm * 256, pn = u.pn, cin = 32 * wc + 8 * fq;
        const bf16* gb = G0 + (pn < gsplit_tiles ? (long)pn * 256 : g1off + (long)(pn - gsplit_tiles) * 256);
#pragma unroll
        for (int ai = 0; ai < 2; ++ai)
#pragma unroll
            for (int m = 0; m < 4; ++m) {
                const int r = R0 + ai * 128 + wr * 64 + m * 16 + fr; bf16* yp = Y + (size_t)r * DM + pn * 256 + cin; const bf16* gp = gb + (size_t)r * gld + cin;
#pragma unroll
                for (int bj = 0; bj < 2; ++bj) {
                    const u32x4 gw = *(const GAS u32x4*)(gp + bj * 128); f32x4 ga, gb2; unpack8(gw, ga, gb2);
                    f32x4 a = acc[ai][bj][m][0] * ga, b = acc[ai][bj][m][1] * gb2;
                    if (!first) { const u32x4 yw = *(const GAS u32x4*)(yp + bj * 128); f32x4 ya, yb; unpack8(yw, ya, yb); a += ya; b += yb; }
                    if (!dry) *(GAS u32x4*)(yp + bj * 128) = pack8(a, b); }
            }
    }
};

template <bool INF32>
struct EpiResid {
    static constexpr bool PERM = true, AFTER_DRAIN = false;
    const void* xb; bf16* xo; long cbd; const float* modl; int slot; int dry;
    __device__ __forceinline__ void operator()(const f32x4 (&acc)[2][2][4][2], const Unit& u, int wr, int wc, int fr, int fq) const {
        const int R0 = u.pm * 256; const bool isctx = R0 >= ML; const int b = isctx ? 16 : (R0 >> 12);
        const int col0 = u.pn * 256 + wc * 32 + 8 * fq; const float* gp = modl + (size_t)b * 6144 + slot * 1024 + col0;
        f32x4 gv[2][2];
#pragma unroll
        for (int bj = 0; bj < 2; ++bj)
#pragma unroll
            for (int n = 0; n < 2; ++n) gv[bj][n] = *(const GAS f32x4*)(gp + bj * 128 + n * 4);
#pragma unroll
        for (int ai = 0; ai < 2; ++ai)
#pragma unroll
            for (int m = 0; m < 4; ++m) { const size_t off = (size_t)(R0 + ai * 128 + wr * 64 + m * 16 + fr) * DM + col0;
#pragma unroll
                for (int bj = 0; bj < 2; ++bj) {
                    f32x4 b0, b1;
                    if constexpr (INF32) { const float* base = (const float*)xb + (isctx ? cbd : 0l); b0 = *(const GAS f32x4*)(base + off + bj * 128); b1 = *(const GAS f32x4*)(base + off + bj * 128 + 4); }
                    else { const u32x4 w = *(const GAS u32x4*)((const bf16*)xb + off + bj * 128); unpack8(w, b0, b1); }
                    const f32x4 r0 = b0 + gv[bj][0] * acc[ai][bj][m][0], r1 = b1 + gv[bj][1] * acc[ai][bj][m][1];
                    u32x4 o; o.x = pg8::cvt_pk_bf16(r0[0], r0[1]); o.y = pg8::cvt_pk_bf16(r0[2], r0[3]); o.z = pg8::cvt_pk_bf16(r1[0], r1[1]); o.w = pg8::cvt_pk_bf16(r1[2], r1[3]);
                    if (!dry) *(GAS u32x4*)(xo + off + bj * 128) = o; }
            }
    }
};

struct EpiSwiGLU {
    static constexpr bool PERM = true, AFTER_DRAIN = false;
    bf16* ACT; int ld, pm0, npe;
    __device__ __forceinline__ void operator()(const f32x4 (&acc)[2][2][4][2], const Unit& u, int wr, int wc, int fr, int fq) const {
        const int R0 = (u.pm - pm0) * 256, jt = u.pn % npe, c0 = jt * 128 + 32 * wc + 8 * fq;
#pragma unroll
        for (int ai = 0; ai < 2; ++ai)
#pragma unroll
            for (int m = 0; m < 4; ++m) {
                const int r = R0 + ai * 128 + wr * 64 + m * 16 + fr; f32x4 a, b;
#pragma unroll
                for (int q = 0; q < 4; ++q) { a[q] = silu_f(acc[ai][0][m][0][q]) * acc[ai][1][m][0][q]; b[q] = silu_f(acc[ai][0][m][1][q]) * acc[ai][1][m][1][q]; }
#ifdef NT_ACT
                __builtin_nontemporal_store(pack8(a, b), (GAS u32x4*)(ACT + (size_t)r * ld + c0)); }
#else
                *(GAS u32x4*)(ACT + (size_t)r * ld + c0) = pack8(a, b); }
#endif
    }
};

struct EpiStoreBf16 {
    static constexpr bool PERM = true, AFTER_DRAIN = false;
    bf16* O; int ld, pm0, npe;
    __device__ __forceinline__ void operator()(const f32x4 (&acc)[2][2][4][2], const Unit& u, int wr, int wc, int fr, int fq) const {
        const int R0 = (pm0 + u.pm) * 256, c0 = (u.pn % npe) * 256 + 32 * wc + 8 * fq;
#pragma unroll
        for (int ai = 0; ai < 2; ++ai)
#pragma unroll
            for (int m = 0; m < 4; ++m) { bf16* rowp = O + (size_t)(R0 + ai * 128 + wr * 64 + m * 16 + fr) * ld + c0;
#pragma unroll
#ifdef NT_PAIR
                for (int bj = 0; bj < 2; ++bj) __builtin_nontemporal_store(pack8(acc[ai][bj][m][0], acc[ai][bj][m][1]), (GAS u32x4*)(rowp + bj * 128)); }
#else
                for (int bj = 0; bj < 2; ++bj) *(GAS u32x4*)(rowp + bj * 128) = pack8(acc[ai][bj][m][0], acc[ai][bj][m][1]); }
#endif
    }
};

struct MoeOrder {
    static constexpr bool GATHER = false;
    pg8::StaticOrder so; int tile0, npe; bool a_global; const volatile LAS int* offl;
    __device__ __forceinline__ bool next(int i, Unit& u) const {
        Unit v; if (!so.next(i, v)) return false;
        const int gt = tile0 + v.pm, row = gt * 256; int e = 0;
#pragma unroll
        for (int q = 1; q < 8; ++q) e += (offl[q] <= row) ? 1 : 0;
        u.pm = a_global ? gt : v.pm; u.pn = e * npe + v.pn; return true;
    }
    __device__ __forceinline__ void a_ready(const Unit&) const {}
    __device__ __forceinline__ void done(const Unit&) const {}
};

struct MoeOrderG {
    static constexpr bool GATHER = true;
    MoeOrder mo; const unsigned* rowmap;
    __device__ __forceinline__ bool next(int i, Unit& u) const { return mo.next(i, u); }
    __device__ __forceinline__ void a_ready(const Unit&) const {}
    __device__ __forceinline__ void done(const Unit&) const {}
};

struct GateOrder {
    static constexpr bool GATHER = false;
    pg8::StaticOrder so;
    __device__ __forceinline__ bool next(int i, Unit& u) const { Unit v; if (!so.next(i / 3, v)) return false; u.pm = v.pm; u.pn = v.pn + 4 * (i % 3); return true; }
    __device__ __forceinline__ void a_ready(const Unit&) const {}
    __device__ __forceinline__ void done(const Unit&) const {}
};

struct BigOrderL1 {
    static constexpr bool GATHER = false;
    pg8::StaticOrder so; int G, c;
    __device__ __forceinline__ bool next(int i, Unit& u) const {
        const int L = i * G + c, nlat = (ML / 256) * (NBIG / 256);
        if (L < nlat) return so.next(i, u);
        const int k = L - nlat; if (k >= (MC / 256) * 8) return false;
        u.pm = ML / 256 + (k >> 3); u.pn = 4 + (k & 7); return true;
    }
    __device__ __forceinline__ void a_ready(const Unit&) const {}
    __device__ __forceinline__ void done(const Unit&) const {}
};


namespace att {
using bf16x8 = __attribute__((ext_vector_type(8))) short;
using s16x4  = __attribute__((ext_vector_type(4))) short;
using f32x16 = __attribute__((ext_vector_type(16))) float;
constexpr int NW = 8, QBLK = 32, KVBLK = 64, LD = 1024;
constexpr int SHM_V = KVBLK * 128 * 2, SHM_K = KVBLK * 128 * 2, SHM_ATTN = 2 * SHM_V + 2 * SHM_K + NW * 64 * 4;
#define KSWZ(row, colB) ((row) * 256 + ((colB) ^ (((row) & 7) << 4)))
#define SBAR() __builtin_amdgcn_sched_barrier(0)
__device__ __forceinline__ int crow(int r, int hi) { return (r & 3) + 8 * (r >> 2) + 4 * hi; }
__device__ __forceinline__ unsigned cvtpk(float lo, float hi) { return pg8::cvt_pk_bf16(lo, hi); }

__device__ __forceinline__ void partialSM(f32x16& p0) {
#pragma unroll
  for (int r = 0; r < 16; ++r) p0[r] = __builtin_amdgcn_exp2f(p0[r]);
}
__device__ __forceinline__ void finishSM(f32x16& p0, f32x16& p1, float& l_reg, bf16x8& pa0, bf16x8& pa1, bf16x8& pa2, bf16x8& pa3) {
#pragma unroll
  for (int r = 0; r < 16; ++r) p1[r] = __builtin_amdgcn_exp2f(p1[r]);
  float ps = 0;
#pragma unroll
  for (int r = 0; r < 16; ++r) ps += p0[r];
#pragma unroll
  for (int r = 0; r < 16; ++r) ps += p1[r];
  l_reg += ps;
#define PK4(P, BASE, OUT) do { unsigned a0 = cvtpk(P[BASE + 0], P[BASE + 1]), a1 = cvtpk(P[BASE + 2], P[BASE + 3]);   \
    unsigned b0 = cvtpk(P[BASE + 4], P[BASE + 5]), b1 = cvtpk(P[BASE + 6], P[BASE + 7]);                              \
    auto r0 = __builtin_amdgcn_permlane32_swap(a0, b0, false, false); auto r1 = __builtin_amdgcn_permlane32_swap(a1, b1, false, false); \
    u32x4 w = {r0[0], r1[0], r0[1], r1[1]}; OUT = __builtin_bit_cast(bf16x8, w); } while (0)
  PK4(p0, 0, pa0); PK4(p0, 8, pa1); PK4(p1, 0, pa2); PK4(p1, 8, pa3);
#undef PK4
}
__device__ __forceinline__ void qkt(f32x16& p0, f32x16& p1, const LAS char* Ks, const bf16x8* qr, int r32, int hi, int mp) {
  p0 = f32x16{}; p1 = f32x16{};
#ifdef ATT_PRIO
  __builtin_amdgcn_s_setprio(1);
#endif
#pragma unroll
  for (int d0 = 0; d0 < 4; ++d0) { const int cb = (mp * 64 + d0 * 16 + hi * 8) * 2;
    const bf16x8 b0 = *(const LAS bf16x8*)(Ks + KSWZ(r32, cb));
    const bf16x8 b1 = *(const LAS bf16x8*)(Ks + KSWZ(32 + r32, cb));
    p0 = __builtin_amdgcn_mfma_f32_32x32x16_bf16(b0, qr[d0], p0, 0, 0, 0);
    p1 = __builtin_amdgcn_mfma_f32_32x32x16_bf16(b1, qr[d0], p1, 0, 0, 0); }
#ifdef ATT_PRIO
  __builtin_amdgcn_s_setprio(0);
#endif
}
__device__ __forceinline__ int v_st(int k, int c) { const int kk = (k & ~0xC) | ((k & 4) << 1) | ((k & 8) >> 1); return ((kk >> 3) * 4 + (c >> 5)) * 512 + ((kk & 7) * 32 + (c & 31)) * 2; }
__device__ __forceinline__ int v_rd_base(int lane) { return ((lane & 3) << 3) | (((lane >> 2) & 3) << 6) | (((lane >> 4) & 1) << 5) | (((lane >> 5) & 1) << 8); }
constexpr int v_rd_off(int d0, int ks, int half) { return d0 * 512 + ks * 4096 + half * 2048; }
template <int OFF> __device__ __forceinline__ s16x4 tr_read(int vb) {
  s16x4 r; asm volatile("ds_read_b64_tr_b16 %0, %1 offset:%2" : "=&v"(r) : "v"(vb), "i"(OFF) : "memory"); return r;
}
template <int D0> __device__ __forceinline__ void pv_one(f32x16& od, int vb, bf16x8 pa0, bf16x8 pa1, bf16x8 pa2, bf16x8 pa3) {
  const s16x4 l0 = tr_read<v_rd_off(D0, 0, 0)>(vb), h0 = tr_read<v_rd_off(D0, 0, 1)>(vb), l1 = tr_read<v_rd_off(D0, 1, 0)>(vb), h1 = tr_read<v_rd_off(D0, 1, 1)>(vb);
  const s16x4 l2 = tr_read<v_rd_off(D0, 2, 0)>(vb), h2 = tr_read<v_rd_off(D0, 2, 1)>(vb), l3 = tr_read<v_rd_off(D0, 3, 0)>(vb), h3 = tr_read<v_rd_off(D0, 3, 1)>(vb);
  asm volatile("s_waitcnt lgkmcnt(0)" ::: "memory"); SBAR();
#define PK(L, H) (bf16x8){L[0], L[1], L[2], L[3], H[0], H[1], H[2], H[3]}
  od = __builtin_amdgcn_mfma_f32_32x32x16_bf16(pa0, PK(l0, h0), od, 0, 0, 0);
  od = __builtin_amdgcn_mfma_f32_32x32x16_bf16(pa1, PK(l1, h1), od, 0, 0, 0);
  od = __builtin_amdgcn_mfma_f32_32x32x16_bf16(pa2, PK(l2, h2), od, 0, 0, 0);
  od = __builtin_amdgcn_mfma_f32_32x32x16_bf16(pa3, PK(l3, h3), od, 0, 0, 0);
#undef PK
}
__device__ __forceinline__ void pv_d0(f32x16* o, int vb, bf16x8 pa0, bf16x8 pa1, bf16x8 pa2, bf16x8 pa3) {
  pv_one<0>(o[0], vb, pa0, pa1, pa2, pa3); pv_one<1>(o[1], vb, pa0, pa1, pa2, pa3); pv_one<2>(o[2], vb, pa0, pa1, pa2, pa3); pv_one<3>(o[3], vb, pa0, pa1, pa2, pa3);
}

struct VFrag { s16x4 l0, h0, l1, h1, l2, h2, l3, h3; };
template <int D0> __device__ __forceinline__ void v_load(VFrag& f, int vb) {
  f.l0 = tr_read<v_rd_off(D0, 0, 0)>(vb); f.h0 = tr_read<v_rd_off(D0, 0, 1)>(vb); f.l1 = tr_read<v_rd_off(D0, 1, 0)>(vb); f.h1 = tr_read<v_rd_off(D0, 1, 1)>(vb);
  f.l2 = tr_read<v_rd_off(D0, 2, 0)>(vb); f.h2 = tr_read<v_rd_off(D0, 2, 1)>(vb); f.l3 = tr_read<v_rd_off(D0, 3, 0)>(vb); f.h3 = tr_read<v_rd_off(D0, 3, 1)>(vb);
}
__device__ __forceinline__ void pv_mma(f32x16& od, const VFrag& f, bf16x8 pa0, bf16x8 pa1, bf16x8 pa2, bf16x8 pa3) {
#define PK(L, H) (bf16x8){L[0], L[1], L[2], L[3], H[0], H[1], H[2], H[3]}
#ifdef ATT_PRIO
  __builtin_amdgcn_s_setprio(1);
#endif
  od = __builtin_amdgcn_mfma_f32_32x32x16_bf16(pa0, PK(f.l0, f.h0), od, 0, 0, 0);
  od = __builtin_amdgcn_mfma_f32_32x32x16_bf16(pa1, PK(f.l1, f.h1), od, 0, 0, 0);
  od = __builtin_amdgcn_mfma_f32_32x32x16_bf16(pa2, PK(f.l2, f.h2), od, 0, 0, 0);
  od = __builtin_amdgcn_mfma_f32_32x32x16_bf16(pa3, PK(f.l3, f.h3), od, 0, 0, 0);
#ifdef ATT_PRIO
  __builtin_amdgcn_s_setprio(0);
#endif
#undef PK
}
#define LWAIT(n) do { asm volatile("s_waitcnt lgkmcnt(" #n ")" ::: "memory"); SBAR(); } while (0)
__device__ __forceinline__ void pv_pipe(f32x16* o, int vb, VFrag& f0, bf16x8 pa0, bf16x8 pa1, bf16x8 pa2, bf16x8 pa3) {
  VFrag f1;
  v_load<1>(f1, vb); LWAIT(8); pv_mma(o[0], f0, pa0, pa1, pa2, pa3); SBAR();
  v_load<2>(f0, vb); LWAIT(8); pv_mma(o[1], f1, pa0, pa1, pa2, pa3); SBAR();
  v_load<3>(f1, vb); LWAIT(8); pv_mma(o[2], f0, pa0, pa1, pa2, pa3); SBAR();
  LWAIT(0); pv_mma(o[3], f1, pa0, pa1, pa2, pa3);
}

#ifndef ATT_VPIPE
#define ATT_VPIPE 1
#endif
#if ATT_VPIPE
#define ATT_STEP_BODY(b) qkt(p0, p1, K_lds + (b) * SHM_K, qr, r32, hi, mp); SBAR(); VFrag vf0; v_load<0>(vf0, vb0 + (b) * SHM_V); SBAR(); \
    partialSM(p0); finishSM(p0, p1, l_reg, pa0, pa1, pa2, pa3); SBAR(); pv_pipe(o, vb0 + (b) * SHM_V, vf0, pa0, pa1, pa2, pa3); SBAR();
#else
#define ATT_STEP_BODY(b) qkt(p0, p1, K_lds + (b) * SHM_K, qr, r32, hi, mp); partialSM(p0); finishSM(p0, p1, l_reg, pa0, pa1, pa2, pa3); SBAR(); pv_d0(o, vb0 + (b) * SHM_V, pa0, pa1, pa2, pa3); SBAR();
#endif
__device__ __forceinline__ void diff_attn_unit(const bf16* Qb_, const bf16* Kh_, const bf16* Vh_, bf16* Ob_, int NT,
                                               float lam, const float* subg_, float oml, LAS char* lds, bool dostore = true, int rot = 0) {
  const GAS bf16* Qb = (const GAS bf16*)Qb_; const GAS bf16* Kh = (const GAS bf16*)Kh_; const GAS bf16* Vh = (const GAS bf16*)Vh_; GAS bf16* Ob = (GAS bf16*)Ob_; const GAS float* subg = (const GAS float*)subg_;
  const int tid = threadIdx.x, wid = tid >> 6, lane = tid & 63, r32 = lane & 31, hi = lane >> 5, qg = wid >> 1, mp = wid & 1;
  LAS char* V_lds = lds; LAS char* K_lds = lds + 2 * SHM_V;
  LAS float* ws = (LAS float*)(lds + 2 * SHM_V + 2 * SHM_K) + wid * 64; LAS float* li_l = ws; LAS float* al_l = ws + 32;
  float l_reg = 0; f32x16 o[4] = {}; bf16x8 qr[4];
  const GAS bf16* Qw = Qb + (long)(qg * QBLK + r32) * LD + mp * 64 + hi * 8;
#pragma unroll
  for (int d0 = 0; d0 < 4; ++d0) qr[d0] = *(const GAS bf16x8*)(Qw + d0 * 16);
  const int vb0 = (int)(unsigned)(uintptr_t)V_lds + v_rd_base(lane);
  int offK[2], offV[2];
#pragma unroll
  for (int i = 0; i < 2; ++i) { const int c = wid * 2 + i;
    { const int row = 4 * c + (lane >> 4), p = (lane & 15) ^ (row & 7); offK[i] = row * LD + p * 8; }
    { const int st = 2 * c + (lane >> 5), li = lane & 31, kk = (st >> 2) * 8 + (li >> 2), col = (st & 3) * 32 + (li & 3) * 8, k = (kk & ~0xC) | ((kk & 8) >> 1) | ((kk & 4) << 1); offV[i] = k * LD + col; } }
#define DMA_TILE(b, k0) do { _Pragma("unroll") for (int i_ = 0; i_ < 2; ++i_) {                                                                              \
      __builtin_amdgcn_global_load_lds((const GAS unsigned*)(Kh + (long)(k0) * LD + offK[i_]), (LAS unsigned*)(K_lds + (b) * SHM_K + (wid * 2 + i_) * 1024), 16, 0, 0);  \
      __builtin_amdgcn_global_load_lds((const GAS unsigned*)(Vh + (long)(k0) * LD + offV[i_]), (LAS unsigned*)(V_lds + (b) * SHM_V + (wid * 2 + i_) * 1024), 16, 0, 0); } } while (0)
#define TILE_STEP(b, t) do { f32x16 p0, p1; bf16x8 pa0, pa1, pa2, pa3; SBAR();                                   \
    ATT_STEP_BODY(b)                                                                                              \
    asm volatile("s_waitcnt vmcnt(0)" ::: "memory"); __syncthreads();                                            \
    if ((t) + 2 < NT) DMA_TILE(b, KT((t) + 2) * KVBLK); } while (0)
#define KT(t_) (((t_) + rot) >= NT ? ((t_) + rot) - NT : ((t_) + rot))
  DMA_TILE(0, KT(0) * KVBLK); DMA_TILE(1, KT(1) * KVBLK); asm volatile("s_waitcnt vmcnt(0)" ::: "memory"); __syncthreads();
  for (int t = 0; t < NT; t += 2) { TILE_STEP(0, t); TILE_STEP(1, t + 1); }
#undef TILE_STEP
#undef DMA_TILE
#undef KT
  int lane_e = lane;
#if 1
  asm volatile("" : "+v"(lane_e));
#endif
  { auto rr = __builtin_amdgcn_permlane32_swap(__float_as_uint(l_reg), __float_as_uint(l_reg), false, false); l_reg = __uint_as_float(rr[0]) + __uint_as_float(rr[1]); }
  if (hi == 0) li_l[r32] = l_reg; asm volatile("s_waitcnt lgkmcnt(0)" ::: "memory");
  const int r32e = lane_e & 31, hie = lane_e >> 5;
  float rli[16];
#pragma unroll
  for (int r = 0; r < 16; ++r) rli[r] = __builtin_amdgcn_rcpf(li_l[crow(r, hie)]);
  __syncthreads();
  LAS float* X = (LAS float*)lds + qg * 4096;
  if (mp == 1) {
#pragma unroll
    for (int d0 = 0; d0 < 4; ++d0)
#pragma unroll
      for (int r = 0; r < 16; ++r) X[(d0 * 16 + r) * 64 + lane_e] = o[d0][r] * rli[r] * (-lam);
  }
  __syncthreads();
  if (mp == 0) {
#pragma unroll
    for (int d0 = 0; d0 < 4; ++d0) {
#pragma unroll
      for (int r = 0; r < 16; ++r) o[d0][r] = o[d0][r] * rli[r] + X[(d0 * 16 + r) * 64 + lane_e];
      asm volatile("" ::: "memory");
    }
    float g4[4];
#pragma unroll
    for (int d0 = 0; d0 < 4; ++d0) g4[d0] = subg[32 * d0 + r32e] * oml;
    GAS bf16* Ow = Ob + (long)(qg * QBLK) * LD;
#pragma unroll
    for (int r = 0; r < 16; ++r) {
      float ss = (o[0][r] * o[0][r] + o[1][r] * o[1][r]) + (o[2][r] * o[2][r] + o[3][r] * o[3][r]);
      ss += __shfl_xor(ss, 1); ss += __shfl_xor(ss, 2); ss += __shfl_xor(ss, 4); ss += __shfl_xor(ss, 8); ss += __shfl_xor(ss, 16);
      const float rs = 1.0f / sqrtf(ss * (1.f / 128.f) + EPS); const int orow = crow(r, hie);
#pragma unroll
      for (int d0 = 0; d0 < 4; ++d0) if (dostore) Ow[(long)orow * LD + d0 * 32 + r32e] = (bf16)f2bf(o[d0][r] * rs * g4[d0]);
    }
  }
  __syncthreads();
}

template <bool CTX>
__device__ __forceinline__ void diff_attn_units(const bf16* Q_, const bf16* K_, const bf16* V_, int first, int count, int stride,
                                                float lam, const float* subg_, float oml, LAS char* lds) {
  constexpr int NT = CTX ? CTXL / 64 : SKV / 64;
  if (first >= count) return;
  const GAS bf16* Qg = (const GAS bf16*)Q_; const GAS bf16* Kg = (const GAS bf16*)K_; const GAS bf16* Vg = (const GAS bf16*)V_; const GAS float* subg = (const GAS float*)subg_;
  const int tid = threadIdx.x, wid = tid >> 6, lane = tid & 63, r32 = lane & 31, hi = lane >> 5, qg = wid >> 1, mp = wid & 1;
  LAS char* V_lds = lds; LAS char* K_lds = lds + 2 * SHM_V;
  LAS float* ws = (LAS float*)(lds + 2 * SHM_V + 2 * SHM_K) + wid * 64; LAS float* li_l = ws;
  LAS float* X = (LAS float*)(lds + SHM_ATTN) + qg * 4096;
  const int vb0 = (int)(unsigned)(uintptr_t)V_lds + v_rd_base(lane);
  int offK[2], offV[2];
#pragma unroll
  for (int i = 0; i < 2; ++i) { const int c = wid * 2 + i;
    { const int row = 4 * c + (lane >> 4), p = (lane & 15) ^ (row & 7); offK[i] = row * LD + p * 8; }
    { const int st = 2 * c + (lane >> 5), li = lane & 31, kk = (st >> 2) * 8 + (li >> 2), col = (st & 3) * 32 + (li & 3) * 8, k = (kk & ~0xC) | ((kk & 8) >> 1) | ((kk & 4) << 1); offV[i] = k * LD + col; } }
#define UNIT_Q(u_) (CTX ? ((size_t)ML + ((u_) >> 4) * CTXL + ((u_) & 1) * 128) * DM + (((u_) >> 1) & 7) * 128 : ((size_t)((u_) >> 8) * SEQ + ((u_) & 31) * 128) * DM + (((u_) >> 5) & 7) * 128)
#define UNIT_K(u_) (CTX ? ((size_t)((u_) >> 4) * SKV + SEQ) * DM + (((u_) >> 1) & 7) * 128 : (size_t)((u_) >> 8) * SKV * DM + (((u_) >> 5) & 7) * 128)
#define UNIT_ROT(u_) (CTX ? 0 : ((u_) & 31) * 2)
#define DMA_TILE(b, k0) do { _Pragma("unroll") for (int i_ = 0; i_ < 2; ++i_) {                                                                              \
      __builtin_amdgcn_global_load_lds((const GAS unsigned*)(Kh + (long)(k0) * LD + offK[i_]), (LAS unsigned*)(K_lds + (b) * SHM_K + (wid * 2 + i_) * 1024), 16, 0, 0);  \
      __builtin_amdgcn_global_load_lds((const GAS unsigned*)(Vh + (long)(k0) * LD + offV[i_]), (LAS unsigned*)(V_lds + (b) * SHM_V + (wid * 2 + i_) * 1024), 16, 0, 0); } } while (0)
#define KT(t_) (((t_) + rot) >= NT ? ((t_) + rot) - NT : ((t_) + rot))
#define TILE_STEP(b, t) do { f32x16 p0, p1; bf16x8 pa0, pa1, pa2, pa3; SBAR();                                   \
    ATT_STEP_BODY(b)                                                                                              \
    asm volatile("s_waitcnt vmcnt(0)" ::: "memory"); __syncthreads();                                            \
    if ((t) + 2 < NT) DMA_TILE(b, KT((t) + 2) * KVBLK); } while (0)
  int u = first; int rot = UNIT_ROT(u);
  const GAS bf16* Kh = Kg + UNIT_K(u); const GAS bf16* Vh = Vg + UNIT_K(u); size_t qoff = UNIT_Q(u);
  bf16x8 qr[4];
  { const GAS bf16* Qw = Qg + qoff + (long)(qg * QBLK + r32) * LD + mp * 64 + hi * 8;
#pragma unroll
    for (int d0 = 0; d0 < 4; ++d0) qr[d0] = *(const GAS bf16x8*)(Qw + d0 * 16); }
  DMA_TILE(0, KT(0) * KVBLK); DMA_TILE(1, KT(1) * KVBLK); asm volatile("s_waitcnt vmcnt(0)" ::: "memory"); __syncthreads();
  for (;;) {
    float l_reg = 0; f32x16 o[4] = {};
    for (int t = 0; t < NT; t += 2) { TILE_STEP(0, t); TILE_STEP(1, t + 1); }
    GAS bf16* Ob = (GAS bf16*)Qg + qoff;
    const int un = u + stride; const bool has_next = un < count;
    if (has_next) {
      rot = UNIT_ROT(un); Kh = Kg + UNIT_K(un); Vh = Vg + UNIT_K(un); qoff = UNIT_Q(un);
      const GAS bf16* Qw = Qg + qoff + (long)(qg * QBLK + r32) * LD + mp * 64 + hi * 8;
#pragma unroll
      for (int d0 = 0; d0 < 4; ++d0) qr[d0] = *(const GAS bf16x8*)(Qw + d0 * 16);
      DMA_TILE(0, KT(0) * KVBLK); DMA_TILE(1, KT(1) * KVBLK);
    }
    int lane_e = lane; asm volatile("" : "+v"(lane_e));
    { auto rr = __builtin_amdgcn_permlane32_swap(__float_as_uint(l_reg), __float_as_uint(l_reg), false, false); l_reg = __uint_as_float(rr[0]) + __uint_as_float(rr[1]); }
    if (hi == 0) li_l[r32] = l_reg; asm volatile("s_waitcnt lgkmcnt(0)" ::: "memory");
    const int r32e = lane_e & 31, hie = lane_e >> 5;
    float rli[16];
#pragma unroll
    for (int r = 0; r < 16; ++r) rli[r] = __builtin_amdgcn_rcpf(li_l[crow(r, hie)]);
    if (mp == 1) {
#pragma unroll
      for (int d0 = 0; d0 < 4; ++d0)
#pragma unroll
        for (int r = 0; r < 16; ++r) X[(d0 * 16 + r) * 64 + lane_e] = o[d0][r] * rli[r] * (-lam);
    }
    asm volatile("s_waitcnt lgkmcnt(0)" ::: "memory"); __builtin_amdgcn_s_barrier(); asm volatile("" ::: "memory");
    if (mp == 0) {
#pragma unroll
      for (int d0 = 0; d0 < 4; ++d0) {
#pragma unroll
        for (int r = 0; r < 16; ++r) o[d0][r] = o[d0][r] * rli[r] + X[(d0 * 16 + r) * 64 + lane_e];
        asm volatile("" ::: "memory");
      }
      float g4[4];
#pragma unroll
      for (int d0 = 0; d0 < 4; ++d0) g4[d0] = subg[32 * d0 + r32e] * oml;
      GAS bf16* Ow = Ob + (long)(qg * QBLK) * LD;
#pragma unroll
      for (int r = 0; r < 16; ++r) {
        float ss = (o[0][r] * o[0][r] + o[1][r] * o[1][r]) + (o[2][r] * o[2][r] + o[3][r] * o[3][r]);
        ss += __shfl_xor(ss, 1); ss += __shfl_xor(ss, 2); ss += __shfl_xor(ss, 4); ss += __shfl_xor(ss, 8); ss += __shfl_xor(ss, 16);
        const float rs = 1.0f / sqrtf(ss * (1.f / 128.f) + EPS); const int orow = crow(r, hie);
#pragma unroll
        for (int d0 = 0; d0 < 4; ++d0) Ow[(long)orow * LD + d0 * 32 + r32e] = (bf16)f2bf(o[d0][r] * rs * g4[d0]);
      }
    }
    asm volatile("s_waitcnt vmcnt(0) lgkmcnt(0)" ::: "memory"); __syncthreads();
    if (!has_next) break;
    u = un;
  }
#undef TILE_STEP
#undef DMA_TILE
#undef KT
#undef UNIT_Q
#undef UNIT_K
#undef UNIT_ROT
}
#undef KSWZ
#undef SBAR
}

constexpr int VT_PITCH = 272;
constexpr int MIX_VT_BYTES = 512 * VT_PITCH;
constexpr int MIX_ST_OFF = MIX_VT_BYTES;
static_assert(MIX_ST_OFF + 1024 <= LDSCTL_OFF, "mixer LDS");
__device__ __forceinline__ void mixer_chunk(const Ctx& C, int ch, bf16* P0, const bf16* P1, bf16* P2, const bf16* P3,
                                            const float* ln_g, const float* ln_b, const bf16* aws  , const float* abs_  , const float* convw  , bool dostore = true) {
    const int row0 = ch * 128, tid = C.tid, lane = C.lane, wid = C.wave;
    LAS unsigned char* VT = C.lds; LAS f32x2* ST = (LAS f32x2*)(C.lds + MIX_ST_OFF);
#pragma unroll 2
    for (int i = 0; i < 16; ++i) {
        const int s = wid * 16 + i; const u32x4 w = *(const GAS u32x4*)(P1 + (size_t)(row0 + s) * 512 + lane * 8);
        f32x4 a, b; unpack8(w, a, b);
        const float mean = wave_sum((a[0] + a[1]) + (a[2] + a[3]) + (b[0] + b[1]) + (b[2] + b[3])) * (1.f / 512.f);
        a = a - mean; b = b - mean;
        const float var = wave_sum((a[0] * a[0] + a[1] * a[1]) + (a[2] * a[2] + a[3] * a[3]) + (b[0] * b[0] + b[1] * b[1]) + (b[2] * b[2] + b[3] * b[3])) * (1.f / 512.f);
        if (lane == 0) ST[s] = (f32x2){mean, 1.0f / sqrtf(var + EPS)};
    }
    __syncthreads();
    {
        const int s = tid & 127, q = tid >> 7; const f32x2 st = ST[s]; const bf16* src = P1 + (size_t)(row0 + s) * 512 + q * 128;
#pragma unroll 2
        for (int i = 0; i < 16; ++i) {
            const int c0 = q * 128 + i * 8; const u32x4 w = *(const GAS u32x4*)(src + i * 8); f32x4 a, b; unpack8(w, a, b);
            const f32x4 g0 = *(const GAS f32x4*)(ln_g + c0), g1 = *(const GAS f32x4*)(ln_g + c0 + 4), b0 = *(const GAS f32x4*)(ln_b + c0), b1 = *(const GAS f32x4*)(ln_b + c0 + 4);
            a = (a - st.x) * st.y * g0 + b0; b = (b - st.x) * st.y * g1 + b1;
#pragma unroll
            for (int e = 0; e < 4; ++e) { *(LAS bf16*)(VT + (c0 + e) * VT_PITCH + s * 2) = (bf16)f2bf(a[e]); *(LAS bf16*)(VT + (c0 + 4 + e) * VT_PITCH + s * 2) = (bf16)f2bf(b[e]); }
        }
    }
    __syncthreads();
    {
        const int g = wid, fr = lane & 15, fq = lane >> 4;
        const bf16* wg = aws + (size_t)g * 128 * 128;
#pragma unroll 1
        for (int th = 0; th < 2; ++th) {
            f32x4 acc[4][4];
#pragma unroll
            for (int ti = 0; ti < 4; ++ti)
#pragma unroll
                for (int ei = 0; ei < 4; ++ei) acc[ti][ei] = (f32x4){0.f, 0.f, 0.f, 0.f};
#pragma unroll 1
            for (int kk = 0; kk < 4; ++kk) {
                bf16x8 xf[4], yf[4];
#pragma unroll
                for (int ei = 0; ei < 4; ++ei) xf[ei] = *(const LAS bf16x8*)(VT + (g * 64 + 16 * ei + fr) * VT_PITCH + (32 * kk + 8 * fq) * 2);
#pragma unroll
                for (int ti = 0; ti < 4; ++ti) yf[ti] = *(const GAS bf16x8*)(wg + (size_t)(64 * th + 16 * ti + fr) * 128 + 32 * kk + 8 * fq);
#pragma unroll
                for (int ti = 0; ti < 4; ++ti)
#pragma unroll
                    for (int ei = 0; ei < 4; ++ei) acc[ti][ei] = __builtin_amdgcn_mfma_f32_16x16x32_bf16(xf[ei], yf[ti], acc[ti][ei], 0, 0, 0);
            }
#pragma unroll
            for (int ti = 0; ti < 4; ++ti) {
                const int t = 64 * th + 16 * ti + fr; const float bs = abs_[g * 128 + t];
#pragma unroll
                for (int ei = 0; ei < 4; ++ei) {
                    bf16* p = P0 + (size_t)(row0 + t) * 512 + g * 64 + 16 * ei + 4 * fq; const v2u uw = *(const GAS v2u*)p;
                    const f32x4 a = acc[ti][ei] + bs;
                    v2u ow; ow.x = cvt_pk_bf16(bf2f(uw.x & 0xffffu) * a[0], bf2f(uw.x >> 16) * a[1]); ow.y = cvt_pk_bf16(bf2f(uw.y & 0xffffu) * a[2], bf2f(uw.y >> 16) * a[3]);
                    if (dostore) *(GAS v2u*)p = ow; }
            }
        }
    }
    {
        const int c0 = lane * 8;
        f32x4 w0a = *(const GAS f32x4*)(convw + c0), w0b = *(const GAS f32x4*)(convw + c0 + 4), w1a = *(const GAS f32x4*)(convw + 512 + c0), w1b = *(const GAS f32x4*)(convw + 512 + c0 + 4),
              w2a = *(const GAS f32x4*)(convw + 1024 + c0), w2b = *(const GAS f32x4*)(convw + 1024 + c0 + 4);
#pragma unroll 2
        for (int i = 0; i < 16; ++i) {
            const int r = row0 + wid * 16 + i; const bool isctx = r >= ML; const int tseq = isctx ? ((r - ML) & 255) : (r & 4095), last = isctx ? 255 : 4095;
            const u32x4 zero = {0u, 0u, 0u, 0u};
            const u32x4 zm = tseq > 0 ? *(const GAS u32x4*)(P3 + (size_t)(r - 1) * 512 + c0) : zero;
            const u32x4 zc = *(const GAS u32x4*)(P3 + (size_t)r * 512 + c0);
            const u32x4 zp = tseq < last ? *(const GAS u32x4*)(P3 + (size_t)(r + 1) * 512 + c0) : zero;
            const u32x4 bw = *(const GAS u32x4*)(P2 + (size_t)r * 512 + c0);
            f32x4 ma, mb, ca, cb, pa, pb, ba, bb; unpack8(zm, ma, mb); unpack8(zc, ca, cb); unpack8(zp, pa, pb); unpack8(bw, ba, bb);
            const f32x4 ya = ba * (w0a * ma + w1a * ca + w2a * pa), yb = bb * (w0b * mb + w1b * cb + w2b * pb);
            if (dostore) *(GAS u32x4*)(P2 + (size_t)r * 512 + c0) = pack8(ya, yb);
        }
    }
    __syncthreads();
}

__device__ __forceinline__ void route_phase(const Ctx& C, const bf16* x, const float* gn, const float* modl, const float* w_router, bf16* H, unsigned* route, bool dry = false) {
    LAS float* Wl = (LAS float*)C.lds;
    for (int idx = C.tid; idx < 8192; idx += NTHREADS) { const int k = idx >> 3, e = idx & 7; Wl[((k & 3) + 4 * (k >> 8)) * 512 + ((k >> 2) & 63) * 8 + e] = w_router[idx]; }
    __syncthreads();
    const int RPW = (ML + C.NGW - 1) / C.NGW;
    const int lane = C.lane; const int r0 = C.gw * RPW;
    unsigned long long lc = 0ull;
    unsigned my_e = 0u, my_p = 0u; float my_w1 = 0.f, my_w2 = 0.f;
    f32x4 mg[4], msc[4], msh[4]; v2u raw[4];
    { const int bq = (r0 < ML ? r0 : 0) >> 12; const float* scv = modl + (size_t)bq * 6144 + 4 * 1024; const float* shv = modl + (size_t)bq * 6144 + 3 * 1024;
#pragma unroll
      for (int j = 0; j < 4; ++j) { mg[j] = ((const GAS f32x4*)gn)[lane + 64 * j]; msc[j] = ((const GAS f32x4*)scv)[lane + 64 * j]; msh[j] = ((const GAS f32x4*)shv)[lane + 64 * j]; }
      const int rq = r0 < ML ? r0 : 0;
#pragma unroll
      for (int j = 0; j < 4; ++j) raw[j] = ((const GAS v2u*)(x + (size_t)rq * DM))[lane + 64 * j]; }
    for (int it = 0; it < RPW; ++it) {
        const int r = r0 + it; if (r >= ML) break;
        if ((r >> 12) != (r0 >> 12) && (r & 4095) == 0) {
            const float* scv = modl + (size_t)(r >> 12) * 6144 + 4 * 1024; const float* shv = modl + (size_t)(r >> 12) * 6144 + 3 * 1024;
#pragma unroll
            for (int j = 0; j < 4; ++j) { msc[j] = ((const GAS f32x4*)scv)[lane + 64 * j]; msh[j] = ((const GAS f32x4*)shv)[lane + 64 * j]; } }
        v2u nraw[4]; const int rn = (it + 1 < RPW && r + 1 < ML) ? r + 1 : r;
#pragma unroll
        for (int j = 0; j < 4; ++j) nraw[j] = ((const GAS v2u*)(x + (size_t)rn * DM))[lane + 64 * j];
        f32x4 y[4];
        { f32x4 v[4]; float ss = 0.f;
#pragma unroll
          for (int j = 0; j < 4; ++j) { v[j][0] = bf2f(raw[j].x & 0xffffu); v[j][1] = bf2f(raw[j].x >> 16); v[j][2] = bf2f(raw[j].y & 0xffffu); v[j][3] = bf2f(raw[j].y >> 16);
              ss += (v[j].x * v[j].x + v[j].y * v[j].y) + (v[j].z * v[j].z + v[j].w * v[j].w); }
          const float rstd = 1.0f / sqrtf(wave_sum(ss) * (1.f / 1024.f) + EPS);
          GAS v2u* o8 = (GAS v2u*)(H + (size_t)r * DM) + lane;
#pragma unroll
          for (int j = 0; j < 4; ++j) { y[j] = (v[j] * rstd) * mg[j] * (msc[j] + 1.0f) + msh[j];
              v2u w; w.x = pg8::cvt_pk_bf16(y[j].x, y[j].y); w.y = pg8::cvt_pk_bf16(y[j].z, y[j].w); o8[64 * j] = w; }
#pragma unroll
          for (int j = 0; j < 4; ++j) raw[j] = nraw[j]; }
        float lg[8];
#pragma unroll
        for (int e = 0; e < 8; ++e) lg[e] = 0.f;
#pragma unroll
        for (int j = 0; j < 4; ++j)
#pragma unroll
            for (int i = 0; i < 4; ++i) { const LAS f32x4* wp = (const LAS f32x4*)(Wl + (i + 4 * j) * 512 + lane * 8); const f32x4 wa = wp[0], wb = wp[1]; const float v = y[j][i];
                lg[0] += v * wa[0]; lg[1] += v * wa[1]; lg[2] += v * wa[2]; lg[3] += v * wa[3]; lg[4] += v * wb[0]; lg[5] += v * wb[1]; lg[6] += v * wb[2]; lg[7] += v * wb[3]; }
#pragma unroll
        for (int e = 0; e < 8; ++e) lg[e] = wave_sum(lg[e]);
        int i1 = 0; float v1 = lg[0];
#pragma unroll
        for (int e = 1; e < 8; ++e) if (lg[e] > v1) { v1 = lg[e]; i1 = e; }
        int i2 = -1; float v2 = -3.0e38f;
#pragma unroll
        for (int e = 0; e < 8; ++e) if (e != i1 && lg[e] > v2) { v2 = lg[e]; i2 = e; }
        const float w1 = 1.f / (1.f + __expf(v2 - v1)), w2 = 1.f - w1;
        const unsigned p1 = (unsigned)(lc >> (8 * i1)) & 0xffu; lc += 1ull << (8 * i1);
        const unsigned p2 = (unsigned)(lc >> (8 * i2)) & 0xffu; lc += 1ull << (8 * i2);
        if (lane == it) { my_e = (unsigned)i1 | ((unsigned)i2 << 8); my_p = p1 | (p2 << 8); my_w1 = w1; my_w2 = w2; }
    }
    unsigned base = 0u;
    if (lane < 8 && !dry) { const unsigned n = (unsigned)(lc >> (8 * lane)) & 0xffu; base = __hip_atomic_fetch_add((unsigned*)(C.ctl + CW_CNT + 64 * lane), n, __ATOMIC_RELAXED, __HIP_MEMORY_SCOPE_AGENT); }
    const unsigned b1 = __shfl(base, (int)(my_e & 0xffu)), b2 = __shfl(base, (int)(my_e >> 8));
    const int r = r0 + lane;
    if (lane < RPW && r < ML && !dry) { u32x4 w; w.x = my_e; w.y = __float_as_uint(my_w1); w.z = __float_as_uint(my_w2); w.w = b1 + (my_p & 0xffu); *(GAS u32x4*)(route + (size_t)r * 8) = w; route[(size_t)r * 8 + 4] = b2 + (my_p >> 8); }
}
__device__ __forceinline__ void moe_offsets(const Ctx& C, volatile LAS int* offl) {
    if (C.tid == 0) { int o = 0;
        for (int e = 0; e < 8; ++e) { const int c = (int)__hip_atomic_load((unsigned*)(C.ctl + CW_CNT + 64 * e), __ATOMIC_RELAXED, __HIP_MEMORY_SCOPE_AGENT); offl[e] = o; offl[16 + e] = c; o += (c + 255) & ~255; }
        offl[8] = o; }
    __syncthreads();
}
__device__ __forceinline__ void gather_phase(const Ctx& C, const bf16* H, bf16* HS, unsigned* route, const volatile LAS int* offl) {
    const int lane = C.lane;
    u32x4 wn = {0u, 0u, 0u, 0u}; unsigned p2n = 0u;
    if (C.gw < ML) { wn = *(const GAS u32x4*)(route + (size_t)C.gw * 8); p2n = route[(size_t)C.gw * 8 + 4]; }
    for (int t = C.gw; t < ML; t += C.NGW) {
        const u32x4 w = wn; const unsigned p2 = p2n;
        const GAS u32x4* src = (const GAS u32x4*)(H + (size_t)t * DM) + lane; const u32x4 a = src[0], b = src[64];
        { const int tn = t + C.NGW < ML ? t + C.NGW : t; wn = *(const GAS u32x4*)(route + (size_t)tn * 8); p2n = route[(size_t)tn * 8 + 4]; }
        const int e1 = w.x & 0xff, e2 = (w.x >> 8) & 0xff; const int s1 = offl[e1] + (int)w.w, s2 = offl[e2] + (int)p2;
        GAS u32x4* d1 = (GAS u32x4*)(HS + (size_t)s1 * DM) + lane; GAS u32x4* d2 = (GAS u32x4*)(HS + (size_t)s2 * DM) + lane;
        d1[0] = a; d1[64] = b; d2[0] = a; d2[64] = b;
        if (lane == 0) { route[(size_t)t * 8 + 5] = (unsigned)s1; route[(size_t)t * 8 + 6] = (unsigned)s2; }
    }
    for (int v = C.gw; v < 8 * 256; v += C.NGW) { const int e = v >> 8, i = v & 255; const int row = offl[e] + offl[16 + e] + i;
        if (row < offl[e + 1]) { GAS u32x4* d = (GAS u32x4*)(HS + (size_t)row * DM) + lane; const u32x4 z = {0u, 0u, 0u, 0u}; d[0] = z; d[64] = z; } }
}
__device__ __forceinline__ void rowmap_phase(const Ctx& C, unsigned* rowmap, unsigned* route, const volatile LAS int* offl) {
    for (int t = C.vcu * NTHREADS + C.tid; t < ML; t += C.G * NTHREADS) {
        const u32x4 w = *(const GAS u32x4*)(route + (size_t)t * 8); const unsigned p2 = route[(size_t)t * 8 + 4];
        const int e1 = w.x & 0xff, e2 = (w.x >> 8) & 0xff; const int s1 = offl[e1] + (int)w.w, s2 = offl[e2] + (int)p2;
        rowmap[s1] = (unsigned)t; rowmap[s2] = (unsigned)t;
        route[(size_t)t * 8 + 5] = (unsigned)s1; route[(size_t)t * 8 + 6] = (unsigned)s2;
    }
    for (int v = C.vcu * NTHREADS + C.tid; v < 8 * 256; v += C.G * NTHREADS) { const int e = v >> 8, i = v & 255; const int row = offl[e] + offl[16 + e] + i;
        if (row < offl[e + 1]) rowmap[row] = 0u; }
}
__device__ __forceinline__ void final_phase(const Ctx& C, const bf16* x16, float* xo, const bf16* HS, const unsigned* route, const float* modl, const float* fg, bool dry = false) {
    const int lane = C.lane;
    f32x4 fgv[4];
#pragma unroll
    for (int h = 0; h < 2; ++h) { fgv[2 * h] = *(const GAS f32x4*)(fg + h * 512 + lane * 8); fgv[2 * h + 1] = *(const GAS f32x4*)(fg + h * 512 + lane * 8 + 4); }
    u32x4 wn = {0u, 0u, 0u, 0u}; unsigned s1n = 0u, s2n = 0u;
    if (C.gw < ML) { wn = *(const GAS u32x4*)(route + (size_t)C.gw * 8); s1n = route[(size_t)C.gw * 8 + 5]; s2n = route[(size_t)C.gw * 8 + 6]; }
    for (int t = C.gw; t < ML; t += C.NGW) {
        const u32x4 w = wn; const unsigned s1 = s1n, s2 = s2n;
        const float w1 = __uint_as_float(w.y), w2 = __uint_as_float(w.z); const int b = t >> 12;
        const float* g2 = modl + (size_t)b * 6144 + 5 * 1024;
        f32x4 v[4]; float ss = 0.f;
#pragma unroll
        for (int h = 0; h < 2; ++h) {
            const int c0 = h * 512 + lane * 8;
            const u32x4 oa = *(const GAS u32x4*)(HS + (size_t)s1 * DM + c0), ob = *(const GAS u32x4*)(HS + (size_t)s2 * DM + c0);
            f32x4 a0, a1, b0, b1; unpack8(oa, a0, a1); unpack8(ob, b0, b1);
            f32x4 x0, x1; { const u32x4 xw = *(const GAS u32x4*)(x16 + (size_t)t * DM + c0); unpack8(xw, x0, x1); }
            const f32x4 g0 = *(const GAS f32x4*)(g2 + c0), g1 = *(const GAS f32x4*)(g2 + c0 + 4);
            v[2 * h] = x0 + g0 * (a0 * w1 + b0 * w2); v[2 * h + 1] = x1 + g1 * (a1 * w1 + b1 * w2);
        }
        { const int tn = t + C.NGW < ML ? t + C.NGW : t; wn = *(const GAS u32x4*)(route + (size_t)tn * 8); s1n = route[(size_t)tn * 8 + 5]; s2n = route[(size_t)tn * 8 + 6]; }
#pragma unroll
        for (int j = 0; j < 4; ++j) ss += (v[j].x * v[j].x + v[j].y * v[j].y) + (v[j].z * v[j].z + v[j].w * v[j].w);
        const float rstd = 1.0f / sqrtf(wave_sum(ss) * (1.f / 1024.f) + EPS);
#pragma unroll
        for (int h = 0; h < 2; ++h) { const int c0 = h * 512 + lane * 8;
            if (!dry) { *(GAS f32x4*)(xo + (size_t)t * DM + c0) = v[2 * h] * rstd * fgv[2 * h]; *(GAS f32x4*)(xo + (size_t)t * DM + c0 + 4) = v[2 * h + 1] * rstd * fgv[2 * h + 1]; } }
    }
}

#ifdef PROBE
constexpr int PR_BASE = 12288;
__device__ __forceinline__ unsigned hsh(unsigned x) { x ^= x >> 16; x *= 0x7feb352du; x ^= x >> 15; x *= 0x846ca68bu; x ^= x >> 16; return x; }
__device__ __forceinline__ float bfr(float f) { return bf2f(f2bf(f)); }
__device__ __forceinline__ float wdot(const bf16* a, const float* W, int ldw, int col, int K, int lane) {
    float s = 0.f; for (int k = lane; k < K; k += 64) s += bf2f(a[k]) * bfr(W[(size_t)k * ldw + col]); return wave_sum(s);
}
struct Probe {
    gu32* ctl; int tid, lane, wave; LAS float* sh;
    __device__ __forceinline__ void rec(int id, float got, float ref, float tol = 0.03f) const {
        const float err = fabsf(got - ref) / (fabsf(ref) + 0.05f);
        if (!(err <= tol)) { unsigned expect = 0u; if (__hip_atomic_compare_exchange_strong((unsigned*)(ctl + PR_BASE), &expect, (unsigned)id, __ATOMIC_RELAXED, __ATOMIC_RELAXED, __HIP_MEMORY_SCOPE_AGENT)) __hip_atomic_store((unsigned*)(ctl + PR_BASE + 1), __float_as_uint(err > 1e6f ? 1e6f : err), __ATOMIC_RELAXED, __HIP_MEMORY_SCOPE_AGENT); }
        else atomicMax((unsigned*)(ctl + PR_BASE + 2), __float_as_uint(err));
    }
};
#define RAWP(r, col) wdot(Hb + (size_t)(r) * DM, win, INC, (col), 1024, P.lane)

template <int L>
__device__ __forceinline__ void probe_after_mod1(const Probe& P, const Args& args, unsigned char* ws) {
    const float* mod = (const float*)(ws + WS_MOD) + (size_t)L * 17 * 6144; const bf16* Hb = (const bf16*)(ws + WS_H);
    for (int sidx = P.wave; sidx < 48; sidx += 8) {
        const unsigned hh = hsh(sidx * 977u + 13u + L * 7919u); const int b = hh % 17, j = (hh >> 8) % 6144;
        float s = 0.f; for (int k = P.lane; k < 1024; k += 64) { const float v = b < 16 ? args.in[1][b * 1024 + k] : args.in[3][k]; s += v / (1.f + __expf(-v)) * args.in[4][((size_t)L * 1024 + k) * 6144 + j]; }
        s = wave_sum(s) + args.in[5][L * 6144 + j];
        if (P.lane == 0) P.rec(1 + 20 * L, mod[(size_t)b * 6144 + j], s, 0.002f);
    }
    for (int sidx = P.wave; sidx < 64; sidx += 8) {
        const unsigned hh = hsh(sidx * 31337u + 5u + L); int r = hh % MA; if (sidx < 8) r = ML + (hh % MC); const int c = (hh >> 10) & 1023; const int b = r < ML ? (r >> 12) : 16;
        const float* xr = r < ML ? (L == 0 ? args.in[0] : (const float*)args.out) + (size_t)r * DM : (L == 0 ? args.in[2] : (const float*)(ws + WS_XC)) + (size_t)(r - ML) * DM;
        float ss = 0.f; for (int k = P.lane; k < 1024; k += 64) ss += xr[k] * xr[k]; ss = wave_sum(ss);
        const float ref = xr[c] * (1.f / sqrtf(ss / 1024.f + EPS)) * args.in[6][L * 1024 + c] * (1.f + mod[(size_t)b * 6144 + 1024 + c]) + mod[(size_t)b * 6144 + c];
        if (P.lane == 0) P.rec(2 + 20 * L, bf2f(Hb[(size_t)r * DM + c]), ref, 0.01f);
    }
}
template <int L>
__device__ __forceinline__ void probe_after_big(const Probe& P, const Args& args, unsigned char* ws) {
    const bf16* Hb = (const bf16*)(ws + WS_H); const float* win = args.in[8] + (size_t)L * 1024 * INC;
    for (int sidx = P.wave; sidx < 96; sidx += 8) {
        const unsigned hh = hsh(sidx * 7001u + 77u + L * 3u); int r = hh % ML; if ((sidx & 3) == 3) r = ML + (hh % MC);
        const bool isctx = r >= ML; const int b = isctx ? (r - ML) / CTXL : (r >> 12); const int t = isctx ? 0 : (r & 4095);
        const long krow = isctx ? (long)b * SKV + SEQ + (r - ML) % CTXL : (long)b * SKV + t;
        const int h = (hh >> 17) & 7, m = (hh >> 20) & 1, d = (hh >> 21) & 63;
        for (int qk = 0; qk < 2; ++qk) {
            const int a = d >> 5, wi = d & 31, i = wi & 15, half = wi >> 4;
            const int cbase = (qk == 0 ? 2560 : 3584) + h * 128 + m * 64 + 32 * a;
            const float x0 = RAWP(r, cbase + i), x1 = RAWP(r, cbase + 16 + i);
            float cs = 1.f, sn = 0.f;
            if (!isctx) { const float pos = (float)(a == 0 ? (t >> 6) : (t & 63)); const float inv = exp2f(-(float)i * (13.287712379549449f / 16.f)); const float ang = pos * inv; cs = cosf(ang); sn = sinf(ang); }
            float ref = half == 0 ? x0 * cs - x1 * sn : x1 * cs + x0 * sn; if (qk == 0) ref *= QSCALE;
            const int p = 32 * a + 2 * i + half;
            const bf16* buf = (const bf16*)(ws + (qk == 0 ? WS_Q : WS_K)); const long row = qk == 0 ? (long)r : krow;
            if (P.lane == 0) P.rec(3 + qk + 20 * L, bf2f(buf[(size_t)row * DM + h * 128 + m * 64 + p]), ref, 0.03f);
        }
        const int e = (hh >> 20) & 127;
        { const float ref = RAWP(r, 4608 + h * 128 + e); if (P.lane == 0) P.rec(5 + 20 * L, bf2f(((const bf16*)(ws + WS_V))[(size_t)krow * DM + h * 128 + e]), ref, 0.03f); }
        const int c = (hh >> 9) & 511;
        { const float ref = gelu_tanh_f(RAWP(r, c)); if (P.lane == 0) P.rec(6 + 20 * L, bf2f(((const bf16*)(ws + WS_P0))[(size_t)r * 512 + c]), ref, 0.03f); }
        { const float ref = gelu_tanh_f(RAWP(r, 512 + c)); if (P.lane == 0) P.rec(7 + 20 * L, bf2f(((const bf16*)(ws + WS_P1))[(size_t)r * 512 + c]), ref, 0.03f); }
        { const float ref = RAWP(r, 1024 + c); if (P.lane == 0) P.rec(8 + 20 * L, bf2f(((const bf16*)(ws + WS_P2))[(size_t)r * 512 + c]), ref, 0.03f); }
        { const float ref = RAWP(r, 1536 + c) * RAWP(r, 2048 + c); if (P.lane == 0) P.rec(9 + 20 * L, bf2f(((const bf16*)(ws + WS_P3))[(size_t)r * 512 + c]), ref, 0.04f); }
    }
}
template <int L>
__device__ __forceinline__ void probe_after_mix(const Probe& P, const Args& args, unsigned char* ws) {
    const bf16* Hb = (const bf16*)(ws + WS_H); const float* win = args.in[8] + (size_t)L * 1024 * INC;
    const bf16* P1 = (const bf16*)(ws + WS_P1); const bf16* P3 = (const bf16*)(ws + WS_P3);
#if EN_MIX
    for (int sidx = 0; sidx < 6; ++sidx) {
        const unsigned hh = hsh(sidx * 1237u + 3u + L); int r = hh % (L == 0 ? MA : ML); if (sidx == 5 && L == 0) r = ML + (hh % MC);
        const int c = (hh >> 12) & 511, g = c >> 6, row0 = r & ~127, tt = r & 127;
        __syncthreads();
        if (P.tid < 128) { const bf16* vr = P1 + (size_t)(row0 + P.tid) * 512; float s = 0.f; for (int k = 0; k < 512; ++k) s += bf2f(vr[k]); const float mean = s / 512.f; float q = 0.f; for (int k = 0; k < 512; ++k) { const float dlt = bf2f(vr[k]) - mean; q += dlt * dlt; }
            const float ln = (bf2f(vr[c]) - mean) * (1.f / sqrtf(q / 512.f + EPS)) * args.in[10][L * 512 + c] + args.in[11][L * 512 + c];
            P.sh[P.tid] = args.in[12][(((size_t)L * 8 + g) * 128 + tt) * 128 + P.tid] * ln; }
        __syncthreads();
        if (P.wave == 0) { float s = P.sh[P.lane] + P.sh[64 + P.lane]; s = wave_sum(s) + args.in[13][(L * 8 + g) * 128 + tt];
            const float gu = gelu_tanh_f(RAWP(r, c)); if (P.lane == 0) P.rec(10 + 20 * L, bf2f(((const bf16*)(ws + WS_P0))[(size_t)r * 512 + c]), bfr(gu) * s, 0.04f); }
    }
    for (int sidx = P.wave; sidx < 64; sidx += 8) {
        const unsigned hh = hsh(sidx * 4447u + 9u + L); int r = hh % (L == 0 ? MA : ML); if (sidx < 8) r = (sidx & 1) ? ((hh % BATCH) * SEQ + (sidx & 2 ? 0 : SEQ - 1)) : r; if (sidx >= 8 && sidx < 12 && L == 0) r = ML + (hh % BATCH) * CTXL + (sidx & 1 ? 0 : CTXL - 1);
        const int c = (hh >> 11) & 511; const bool isctx = r >= ML; const int tseq = isctx ? ((r - ML) & 255) : (r & 4095), last = isctx ? 255 : 4095;
        const float zm = tseq > 0 ? bf2f(P3[(size_t)(r - 1) * 512 + c]) : 0.f, zc = bf2f(P3[(size_t)r * 512 + c]), zp = tseq < last ? bf2f(P3[(size_t)(r + 1) * 512 + c]) : 0.f;
        const float bg = bfr(RAWP(r, 1024 + c)); const float* cw = args.in[14] + L * 1536;
        const float ref = bg * (cw[c] * zm + cw[512 + c] * zc + cw[1024 + c] * zp);
        if (P.lane == 0) P.rec(11 + 20 * L, bf2f(((const bf16*)(ws + WS_P2))[(size_t)r * 512 + c]), ref, 0.04f);
    }
#endif
#if EN_ATT
    LAS float* qv = P.sh;
    LAS float* s0 = P.sh + 128;
    LAS float* s1 = P.sh + 128 + 4352;
    LAS float* red = P.sh + 128 + 2 * 4352;
    LAS float* ov = red + 64;
    const float lam = ((const float*)(ws + WS_LAM))[L]; const float oml = L == 0 ? 0.8f : (1.f - (0.8f - 0.6f * 0.7408182206817179f));
    for (int sidx = 0; sidx < (L == 0 ? 5 : 3); ++sidx) {
        const unsigned hh = hsh(sidx * 9173u + 21u + L); const bool isctx = (L == 0 && sidx >= 3); const int b = hh % BATCH, h = (hh >> 8) & 7;
        const int r = isctx ? ML + b * CTXL + ((hh >> 12) % CTXL) : b * SEQ + ((hh >> 12) & 4095); const int t = r & 4095;
        const int nk = isctx ? CTXL : SKV; const long k0 = isctx ? (long)b * SKV + SEQ : (long)b * SKV;
        __syncthreads();
        for (int q = P.wave; q < 128; q += 8) {
            const int m = q >> 6, p = q & 63, a = p >> 5, i = (p & 31) >> 1, half = p & 1; const int cbase = 2560 + h * 128 + m * 64 + 32 * a;
            const float x0 = RAWP(r, cbase + i), x1 = RAWP(r, cbase + 16 + i); float cs = 1.f, sn = 0.f;
            if (!isctx) { const float pos = (float)(a == 0 ? (t >> 6) : (t & 63)); const float inv = exp2f(-(float)i * (13.287712379549449f / 16.f)); cs = cosf(pos * inv); sn = sinf(pos * inv); }
            if (P.lane == 0) qv[q] = bfr((half == 0 ? x0 * cs - x1 * sn : x1 * cs + x0 * sn) * QSCALE);
        }
        __syncthreads();
        const bf16* Kb = (const bf16*)(ws + WS_K); const bf16* Vb = (const bf16*)(ws + WS_V);
        for (int k = P.tid; k < nk; k += NTHREADS) { const bf16* kr = Kb + (size_t)(k0 + k) * DM + h * 128; float a0 = 0.f, a1 = 0.f; for (int dd = 0; dd < 64; ++dd) { a0 += qv[dd] * bf2f(kr[dd]); a1 += qv[64 + dd] * bf2f(kr[64 + dd]); } s0[k] = a0; s1[k] = a1; }
        __syncthreads();
        float m0 = -1e30f, m1 = -1e30f; for (int k = P.tid; k < nk; k += NTHREADS) { m0 = fmaxf(m0, s0[k]); m1 = fmaxf(m1, s1[k]); }
        for (int o = 1; o < 64; o <<= 1) { m0 = fmaxf(m0, __shfl_xor(m0, o)); m1 = fmaxf(m1, __shfl_xor(m1, o)); }
        if (P.lane == 0) { red[P.wave] = m0; red[8 + P.wave] = m1; } __syncthreads();
        m0 = red[0]; m1 = red[8]; for (int w = 1; w < 8; ++w) { m0 = fmaxf(m0, red[w]); m1 = fmaxf(m1, red[8 + w]); } __syncthreads();
        float l0 = 0.f, l1 = 0.f; for (int k = P.tid; k < nk; k += NTHREADS) { const float e0 = exp2f(s0[k] - m0), e1 = exp2f(s1[k] - m1); s0[k] = e0; s1[k] = e1; l0 += e0; l1 += e1; }
        l0 = wave_sum(l0); l1 = wave_sum(l1); if (P.lane == 0) { red[16 + P.wave] = l0; red[24 + P.wave] = l1; } __syncthreads();
        l0 = 0.f; l1 = 0.f; for (int w = 0; w < 8; ++w) { l0 += red[16 + w]; l1 += red[24 + w]; }
        if (P.tid < 128) { float acc = 0.f; for (int k = 0; k < nk; ++k) acc += (s0[k] / l0 - lam * s1[k] / l1) * bf2f(Vb[(size_t)(k0 + k) * DM + h * 128 + P.tid]); ov[P.tid] = acc; }
        __syncthreads();
        if (P.tid < 128) { float ss = 0.f; for (int e = 0; e < 128; ++e) ss += ov[e] * ov[e]; const float ref = ov[P.tid] * (1.f / sqrtf(ss / 128.f + EPS)) * args.in[16][L * 128 + P.tid] * oml;
            if ((P.tid & 15) == (sidx & 15) || P.tid == 77) P.rec((isctx ? 13 : 12) + 20 * L, bf2f(((const bf16*)(ws + WS_Q))[(size_t)r * DM + h * 128 + P.tid]), ref, 0.06f); }
    }
#endif
    __syncthreads();
}
template <int L>
__device__ __forceinline__ void probe_after_gate(const Probe& P, const Args& args, unsigned char* ws) {
    const bf16* Hb = (const bf16*)(ws + WS_H); const float* win = args.in[8] + (size_t)L * 1024 * INC;
    const bf16* WINb = (const bf16*)(ws + WS_WIN + L * WIN_BYTES);
    if (P.tid < 400) P.sh[16 + P.tid] = 0.f;
    __syncthreads();
    for (int sidx = P.wave; sidx < 96; sidx += 8) {
        const unsigned hh = hsh(sidx * 3301u + 11u + L); const int row = 5632 + (sidx % 3) * 1024 + ((hh >> 4) & 1023), k = (hh >> 16) & 1023;
        if (P.lane == 0) P.rec(13 + 20 * L, bf2f(WINb[(size_t)row * 1024 + k]), bfr(win[(size_t)k * INC + row]), 0.001f);
    }
    __syncthreads();
    for (int br = 0; br < 3; ++br) {
        for (int sidx = P.wave; sidx < 64; sidx += 8) {
            const unsigned hh = hsh(sidx * 5501u + 1u + L + br * 77u); const int r = hh % (L == 0 ? MA : ML), n = (hh >> 12) & 1023;
            const float ref = sigmoid_f(RAWP(r, 5632 + br * 1024 + n) + args.in[9][L * 3072 + br * 1024 + n]);
            const bf16* g = br == 0 ? (const bf16*)(ws + WS_K) + (size_t)r * DM + n : (br == 1 ? (const bf16*)(ws + WS_V) + (size_t)r * DM + n : (const bf16*)(ws + (n < 512 ? WS_P1 : WS_P3)) + (size_t)r * 512 + (n & 511));
            if (P.lane == 0) {
                const float got = bf2f(*g);
                if (fabsf(got - ref) / (fabsf(ref) + 0.05f) > 0.03f) { P.sh[16] = 1.f; const int sl = P.wave * 8 + (sidx >> 3); P.sh[128 + 2 * sl] = __uint_as_float((unsigned)((uintptr_t)g & 0xffffffffu)); P.sh[129 + 2 * sl] = __uint_as_float((unsigned)((uintptr_t)g >> 32)); P.sh[300 + sl] = ref; }
                else P.rec(14 + br + 20 * L, got, ref, 0.03f);
            }
        }
        __syncthreads();
        if (P.sh[16] != 0.f) {
            const GAS u32x4* tp = (const GAS u32x4*)args.in[25] + P.tid; u32x4 acc_ = {0u, 0u, 0u, 0u};
            for (int q_ = 0; q_ < 3072; ++q_) { const u32x4 v_ = tp[(size_t)q_ * 512]; acc_.x ^= v_.x; acc_.y ^= v_.y; acc_.z ^= v_.z; acc_.w ^= v_.w; }
            if ((acc_.x ^ acc_.y ^ acc_.z ^ acc_.w) == 0x12345677u) P.sh[100] = 1.f;
            __syncthreads();
            if (P.tid == 0) { for (int q = 0; q < 64; ++q) { const unsigned lo_ = __float_as_uint(P.sh[128 + 2 * q]), hi_ = __float_as_uint(P.sh[129 + 2 * q]); if (lo_ == 0u && hi_ == 0u) continue;
                const bf16* gq = (const bf16*)(((uintptr_t)hi_ << 32) | lo_); const unsigned* gw = (const unsigned*)((uintptr_t)gq & ~(uintptr_t)3); const int sh = ((uintptr_t)gq & 2) ? 16 : 0;
                const float g1 = bf2f((__hip_atomic_load(gw, __ATOMIC_RELAXED, __HIP_MEMORY_SCOPE_AGENT) >> sh) & 0xffffu); const float ref = P.sh[300 + q];
                const bool ok1 = fabsf(g1 - ref) / (fabsf(ref) + 0.05f) <= 0.03f; if (!ok1 && br == 0) {
                    const size_t eo = (size_t)(gq - (const bf16*)(ws + WS_K)); const int kr = (int)(eo >> 10), nn = (int)(eo & 1023); const int bb = kr / SKV, key = kr % SKV; const bool cx = key >= SEQ;
                    const int tok = cx ? ML + bb * CTXL + (key - SEQ) : bb * SEQ + key; const int hh2 = nn >> 7, mm = (nn >> 6) & 1, pp = nn & 63, aa = pp >> 5, ii = (pp & 31) >> 1, hf = pp & 1;
                    const int cb2 = 3584 + hh2 * 128 + mm * 64 + 32 * aa; float x0 = 0.f, x1 = 0.f;
                    for (int k = 0; k < 1024; ++k) { const float hv = bf2f(Hb[(size_t)tok * DM + k]); x0 += hv * bfr(win[(size_t)k * INC + cb2 + ii]); x1 += hv * bfr(win[(size_t)k * INC + cb2 + 16 + ii]); }
                    float cs = 1.f, sn = 0.f; if (!cx) { const float pos = (float)(aa == 0 ? (key >> 6) : (key & 63)); const float inv = exp2f(-(float)ii * (13.287712379549449f / 16.f)); cs = cosf(pos * inv); sn = sinf(pos * inv); }
                    const float kold = hf == 0 ? x0 * cs - x1 * sn : x1 * cs + x0 * sn;
                    if (fabsf(kold - g1) <= 0.03f * (fabsf(kold) + 0.05f)) { unsigned e9 = 0u; __hip_atomic_compare_exchange_strong((unsigned*)(P.ctl + PR_BASE + 6), &e9, 1u, __ATOMIC_RELAXED, __ATOMIC_RELAXED, __HIP_MEMORY_SCOPE_AGENT); }
                }
                if (!ok1) { unsigned expect = 0u; if (__hip_atomic_compare_exchange_strong((unsigned*)(P.ctl + PR_BASE + 3), &expect, __float_as_uint(g1) | 1u, __ATOMIC_RELAXED, __ATOMIC_RELAXED, __HIP_MEMORY_SCOPE_AGENT)) { __hip_atomic_store((unsigned*)(P.ctl + PR_BASE + 4), (unsigned)br + 1u, __ATOMIC_RELAXED, __HIP_MEMORY_SCOPE_AGENT); __hip_atomic_store((unsigned*)(P.ctl + PR_BASE + 5), __float_as_uint(ref), __ATOMIC_RELAXED, __HIP_MEMORY_SCOPE_AGENT); {
                        const size_t eo2 = (size_t)(gq - (const bf16*)(ws + WS_K)); const bf16* rb = (const bf16*)(ws + WS_K) + (eo2 & ~(size_t)63); int cr = 0, cc = 0;
                        for (int q2 = 0; q2 < 64; ++q2) { const float v2 = bf2f(rb[q2]); if (!(v2 >= 0.f && v2 <= 1.f)) ++cr; }
                        const size_t rr2 = (eo2 >> 10) & ~(size_t)63, nn2 = eo2 & 1023;
                        for (int q2 = 0; q2 < 64; ++q2) { const float v2 = bf2f(((const bf16*)(ws + WS_K))[(rr2 + q2) * 1024 + nn2]); if (!(v2 >= 0.f && v2 <= 1.f)) ++cc; }
                        int c16 = 0, c8 = 0; const size_t r0b = eo2 >> 10;
                        for (int q2 = 0; q2 < 64; ++q2) { const float v2 = bf2f(((const bf16*)(ws + WS_K))[(rr2 + q2) * 1024 + nn2]); const bool bad = !(v2 >= 0.f && v2 <= 1.f); if (bad && ((rr2 + q2) & 15) == (r0b & 15)) ++c16; if (bad && ((rr2 + q2) >> 3) == (r0b >> 3)) ++c8; }
                        unsigned m8 = 0u, g8 = 0u; for (int q2 = 0; q2 < 64; ++q2) { const float v2 = bf2f(((const bf16*)(ws + WS_K))[(rr2 + q2) * 1024 + nn2]); const bool bad = !(v2 >= 0.f && v2 <= 1.f); if (bad && ((rr2 + q2) >> 3) == (r0b >> 3)) m8 |= 1u << ((rr2 + q2) & 7); if (bad) g8 |= 1u << (q2 >> 3); }
                        __hip_atomic_store((unsigned*)(P.ctl + PR_BASE + 10), m8 | (g8 << 8), __ATOMIC_RELAXED, __HIP_MEMORY_SCOPE_AGENT);
                        __hip_atomic_store((unsigned*)(P.ctl + PR_BASE + 9), (unsigned)(c16 | (c8 << 8)), __ATOMIC_RELAXED, __HIP_MEMORY_SCOPE_AGENT);
                        __hip_atomic_store((unsigned*)(P.ctl + PR_BASE + 8), (unsigned)(cr | (cc << 8)), __ATOMIC_RELAXED, __HIP_MEMORY_SCOPE_AGENT); }
                    __hip_atomic_store((unsigned*)(P.ctl + PR_BASE + 7), (unsigned)(gq - (const bf16*)(ws + (br == 0 ? WS_K : (br == 1 ? WS_V : WS_P1)))), __ATOMIC_RELAXED, __HIP_MEMORY_SCOPE_AGENT); } } } }
        }
        __syncthreads();
    }
}
template <int L>
__device__ __forceinline__ void probe_after_wo(const Probe& P, const Args& args, unsigned char* ws) {
    const bf16* Hb = (const bf16*)(ws + WS_H); const float* win = args.in[8] + (size_t)L * 1024 * INC;
    const bf16* Y = (const bf16*)(ws + WS_K);
    for (int sidx = P.wave; sidx < 64; sidx += 8) {
        const unsigned hh = hsh(sidx * 811u + 17u + L); int r = hh % (L == 0 ? MA : ML); if (L == 0 && sidx < 8) r = ML + hh % MC; const int n = (hh >> 12) & 1023;
        const float ga = sigmoid_f(RAWP(r, 5632 + n) + args.in[9][L * 3072 + n]), gb = sigmoid_f(RAWP(r, 5632 + 1024 + n) + args.in[9][L * 3072 + 1024 + n]), gc = sigmoid_f(RAWP(r, 5632 + 2048 + n) + args.in[9][L * 3072 + 2048 + n]);
        const float pa = wdot((const bf16*)(ws + WS_P0) + (size_t)r * 512, args.in[17] + (size_t)L * 512 * 1024, 1024, n, 512, P.lane);
        const float pb = wdot((const bf16*)(ws + WS_P2) + (size_t)r * 512, args.in[18] + (size_t)L * 512 * 1024, 1024, n, 512, P.lane);
        const float pc = wdot((const bf16*)(ws + WS_Q) + (size_t)r * DM, args.in[19] + (size_t)L * 1024 * 1024, 1024, n, 1024, P.lane);
        if (P.lane == 0) P.rec(17 + 20 * L, bf2f(Y[(size_t)r * DM + n]), ga * pa + gb * pb + gc * pc, 0.05f);
        const float o = wdot(Y + (size_t)r * DM, args.in[20] + (size_t)L * 1024 * 1024, 1024, n, 1024, P.lane);
        const int b = r < ML ? (r >> 12) : 16; const float g1 = ((const float*)(ws + WS_MOD))[((size_t)L * 17 + b) * 6144 + 2048 + n];
        if (L == 0) { const float x0 = r < ML ? args.in[0][(size_t)r * DM + n] : args.in[2][(size_t)(r - ML) * DM + n];
            const float got = r < ML ? args.out[(size_t)r * DM + n] : ((const float*)(ws + WS_XC))[(size_t)(r - ML) * DM + n];
            if (P.lane == 0) P.rec(18, got - x0, g1 * o, 0.03f); }
    }
}
__device__ __forceinline__ void probe_after_ffn0(const Probe& P, const Args& args, unsigned char* ws) {
    const bf16* Hb = (const bf16*)(ws + WS_H); const bf16* ACT = (const bf16*)(ws + WS_ACT0);
    for (int sidx = P.wave; sidx < 64; sidx += 8) {
        const unsigned hh = hsh(sidx * 60013u + 5u); int r = hh % MA; if (sidx < 8) r = ML + hh % MC; const int j = (hh >> 10) % DFF;
        const float gt = wdot(Hb + (size_t)r * DM, args.in[21], DFF, j, 1024, P.lane), up = wdot(Hb + (size_t)r * DM, args.in[22], DFF, j, 1024, P.lane);
        if (P.lane == 0) P.rec(19, bf2f(ACT[(size_t)r * DFF + j]), silu_f(gt) * up, 0.04f);
    }
}
#undef RAWP
#endif


#define WSB() unsigned char* ws = launder_ptr(args.ws)
#define W_MOD ((float*)(ws + WS_MOD))
#define W_ROPE ((float*)(ws + WS_ROPE))
#define W_LAM ((float*)(ws + WS_LAM))
#define W_AWS ((bf16*)(ws + WS_AWS))
#define W_ROUTE ((unsigned*)(ws + WS_ROUTE))
#define W_X16 ((bf16*)(ws + WS_X16))
#define W_H ((bf16*)args.out)
#define W_P0 ((bf16*)(ws + WS_P0))
#define W_P1 ((bf16*)(ws + WS_P1))
#define W_P2 ((bf16*)(ws + WS_P2))
#define W_P3 ((bf16*)(ws + WS_P3))
#define W_Q ((bf16*)(ws + WS_Q))
#define W_K ((bf16*)(ws + WS_K))
#define W_V ((bf16*)(ws + WS_V))
#define W_MODL (W_MOD + (size_t)L * 17 * 6144)
#define W_WIN ((const bf16*)(ws + WS_WIN + L * WIN_BYTES))
#define W_WOUT ((const bf16*)(ws + WS_WOUT + L * WOUT_BYTES))
#define PH_ON (P.lo <= P.ph && P.ph < P.hi)
#ifdef PTIME
#define SEAM() do { if (P.lo <= P.ph && P.ph + 1 < P.hi) xcd_barrier(bar); if (blockIdx.x == 0 && C.tid == 0 && P.ph < 40) ((unsigned long long*)(C.ctl + 16384))[1 + P.ph] = rt(); ++P.ph; } while (0)
#else
#define SEAM() do { if (P.lo <= P.ph && P.ph + 1 < P.hi) xcd_barrier(bar); ++P.ph; } while (0)
#endif
#define ELEM_DELTA(a, b) ((long)(((intptr_t)(a) - (intptr_t)(b)) / 4))

#ifdef PROBE
#define PROBE_HOOK(FN) do { if (P.lo < P.ph && P.ph <= P.hi) { if (blockIdx.x == 0) { WSB(); const Probe PR{C.ctl, C.tid, C.lane, C.wave, (LAS float*)C.lds}; FN(PR, args, ws); } xcd_barrier(bar); } } while (0)
#else
#define PROBE_HOOK(FN) do { } while (0)
#endif

#ifndef REP_BIG
#define REP_BIG 1
#endif
#ifndef REP_GATE
#define REP_GATE 1
#endif
#ifndef REP_UP
#define REP_UP 1
#endif
#ifndef REP_MOEUP
#define REP_MOEUP 1
#endif
#ifndef REP_MOEDN
#define REP_MOEDN 1
#endif
#ifndef MOE_GATHER
#define MOE_GATHER 1
#endif
#ifndef ATT_XPF
#define ATT_XPF 0
#endif
#ifndef ATT_ROT
#define ATT_ROT(qb) ((qb) * 2)
#endif
template <int L, int BR>
__device__ __forceinline__ void merge_phase(const Ctx& C, const Args& args, const XcdBarrier& bar, PhaseCtl& P) {
    constexpr int mrows = L == 0 ? MA : ML;
    if (PH_ON) { WSB();
#if (EN_SITES >> 2) & 1
        constexpr size_t aoff = BR == 0 ? WS_P0 : (BR == 1 ? WS_P2 : WS_Q), goff = BR == 0 ? WS_K : (BR == 1 ? WS_V : WS_P1);
        constexpr int K = BR == 2 ? 1024 : 512;
        const bf16* Bt = W_WOUT + (BR == 0 ? 0 : (BR == 1 ? 512 * 1024 : 1024 * 1024));
        pg8::Gemm g{(const bf16*)(ws + aoff), Bt, mrows, 1024, K}; pg8::StaticOrder S; S.init(mrows, 1024, C.G, (int)blockIdx.x);
        EpiMerge E{W_K, (const bf16*)(ws + goff), (long)((WS_P3 - WS_P1) / 2), BR == 2 ? 512 : 1024, BR == 2 ? 2 : 4, BR == 0 ? 1 : 0, 0};
#ifdef DUP_MERGE
        if (L == 0) { EpiMerge Ed = E; Ed.dry = P.hi < 5000 ? 1 : 0; pg8::gemm_phase<EpiMerge, pg8::StaticOrder, PG8_ALIGN, PG8_SP2>(C.lds, g, S, Ed); }
#endif
        pg8::gemm_phase<EpiMerge, pg8::StaticOrder, PG8_ALIGN, PG8_SP2>(C.lds, g, S, E);
#endif
    }
    if (BR == 2) SEAM(); else ++P.ph;
}

template <int L>
__device__ __forceinline__ void layer_body(const Ctx& C, const Args& args, const XcdBarrier& bar, PhaseCtl& P, volatile LAS int* offl) {
    constexpr int mrows = L == 0 ? MA : ML;
    if (PH_ON) { WSB(); if constexpr (L == 0) modulate_phase<false>(C, args.in[0], args.in[2], args.in[6], W_MODL, 0, 1, W_H, MA); else modulate_phase<true>(C, W_X16, nullptr, args.in[6] + 1024, W_MODL, 0, 1, W_H, MA);
#ifdef REP_MOD
        if (L == 0) modulate_phase<false>(C, args.in[0], args.in[2], args.in[6], W_MODL, 0, 1, W_H, MA);
#endif
    }
    SEAM();
    PROBE_HOOK(probe_after_mod1<L>);
    if (PH_ON) { WSB();
#if (EN_SITES >> 0) & 1
        LAS float* tab = (LAS float*)(C.lds + 131072);
        for (int i = C.tid; i < 2048; i += NTHREADS) tab[i] = W_ROPE[i];
        __syncthreads();
        pg8::Gemm g{W_H, W_WIN, MA, NBIG, 1024};
        EpiBig E{ws, tab};
        if constexpr (L == 0) { pg8::StaticOrder S; S.init(MA, NBIG, C.G, (int)blockIdx.x); pg8::gemm_phase<EpiBig, pg8::StaticOrder, PG8_ALIGN, PG8_SP2>(C.lds, g, S, E); }
        else { BigOrderL1 S; S.so.init(ML, NBIG, C.G, (int)blockIdx.x); S.G = C.G; S.c = (int)blockIdx.x; pg8::gemm_phase<EpiBig, BigOrderL1, PG8_ALIGN, PG8_SP2>(C.lds, g, S, E); }
#endif
    }
    SEAM();
    PROBE_HOOK(probe_after_big<L>);
    if (PH_ON) { WSB();
#ifdef PROBE_FILL2
        { GAS u32x4* kf = (GAS u32x4*)(ws + WS_K); const u32x4 pat = {0x46404640u, 0x46404640u, 0x46404640u, 0x46404640u};
          for (size_t i = (size_t)C.gw * 64 + C.lane; i < (size_t)MA * DM * 2 / 16; i += (size_t)C.NGW * 64) kf[i] = pat; }
#endif
#if EN_MIX
#ifdef DUP_MIX
        if (L == 0) for (int ch = C.vcu; ch < mrows / 128; ch += C.G)
            mixer_chunk(C, ch, W_P0, W_P1, W_P2, W_P3, args.in[10] + L * 512, args.in[11] + L * 512, W_AWS + (size_t)L * 8 * 128 * 128, args.in[13] + L * 8 * 128, args.in[14] + L * 3 * 512, P.hi > 5000);
#endif
        for (int ch = C.vcu; ch < mrows / 128; ch += C.G)
            mixer_chunk(C, ch, W_P0, W_P1, W_P2, W_P3, args.in[10] + L * 512, args.in[11] + L * 512, W_AWS + (size_t)L * 8 * 128 * 128, args.in[13] + L * 8 * 128, args.in[14] + L * 3 * 512);
#endif
#if EN_ATT
        const float lam = W_LAM[L]; constexpr float oml = L == 0 ? 0.8f : (1.f - (0.8f - 0.6f * 0.7408182206817179f)); const float* subg = args.in[16] + L * 128;
#if ATT_XPF
        att::diff_attn_units<false>(W_Q, W_K, W_V, C.vcu, BATCH * 8 * 32, C.G, lam, subg, oml, (LAS char*)C.lds);
        if (L == 0) att::diff_attn_units<true>(W_Q, W_K, W_V, C.vcu, BATCH * 8 * 2, C.G, lam, subg, oml, (LAS char*)C.lds);
#else
#ifdef DUP_ATT
        const int nrep = L == 0 ? 2 : 1;
        for (int rep = 0; rep < nrep; ++rep)
        for (int u = C.vcu; u < BATCH * 8 * 32; u += C.G) {
            const int bh = u >> 5, qb = u & 31, b = bh >> 3, h = bh & 7;
            bf16* qp = W_Q + ((size_t)b * SEQ + qb * 128) * DM + h * 128;
            att::diff_attn_unit(qp, W_K + (size_t)b * SKV * DM + h * 128, W_V + (size_t)b * SKV * DM + h * 128, qp, SKV / 64, lam, subg, oml, (LAS char*)C.lds, rep + 1 == nrep);
        }
#else
        for (int u = C.vcu; u < BATCH * 8 * 32; u += C.G) {
            const int bh = u >> 5, qb = u & 31, b = bh >> 3, h = bh & 7;
            bf16* qp = W_Q + ((size_t)b * SEQ + qb * 128) * DM + h * 128;
            att::diff_attn_unit(qp, W_K + (size_t)b * SKV * DM + h * 128, W_V + (size_t)b * SKV * DM + h * 128, qp, SKV / 64, lam, subg, oml, (LAS char*)C.lds, true, ATT_ROT(qb));
        }
#endif
        if (L == 0) {
            for (int u = C.vcu; u < BATCH * 8 * 2; u += C.G) {
                const int b = u >> 4, h = (u >> 1) & 7, qb = u & 1;
                bf16* qp = W_Q + ((size_t)ML + b * CTXL + qb * 128) * DM + h * 128;
                att::diff_attn_unit(qp, W_K + ((size_t)b * SKV + SEQ) * DM + h * 128, W_V + ((size_t)b * SKV + SEQ) * DM + h * 128, qp, CTXL / 64, lam, subg, oml, (LAS char*)C.lds);
            }
        }
#endif
#endif
    }
    SEAM();
    PROBE_HOOK(probe_after_mix<L>);
    if (PH_ON) { WSB();
#if (EN_SITES >> 1) & 1
        pg8::Gemm g{W_H, W_WIN + (size_t)NBIG * 1024, mrows, 3072, 1024};
        LAS float* tab = (LAS float*)(C.lds + 131072);
        for (int i = C.tid; i < 3072; i += NTHREADS) tab[i] = args.in[9][L * 3072 + i];
        __syncthreads();
        EpiGate E{ws, tab};
        if constexpr (L == 0) {
            pg8::StaticOrder S; S.init(mrows, 3072, C.G, (int)blockIdx.x);
            pg8::gemm_phase<EpiGate, pg8::StaticOrder, PG8_ALIGN, PG8_SP2>(C.lds, g, S, E);
        } else {
            GateOrder S; S.so.init(mrows, 1024, C.G, (int)blockIdx.x);
            pg8::gemm_phase<EpiGate, GateOrder, PG8_ALIGN, PG8_SP2>(C.lds, g, S, E);
        }
#endif
    }
    if (L == 0) SEAM(); else ++P.ph;
#ifdef PROBE_SCAN
    if (L == 0) { WSB(); unsigned cntk = 0u, cntv = 0u;
        const GAS u32x4* kp = (const GAS u32x4*)(ws + WS_K); const GAS u32x4* vp = (const GAS u32x4*)(ws + WS_V);
        for (size_t i = (size_t)C.gw * 64 + C.lane; i < (size_t)MA * DM * 2 / 16; i += (size_t)C.NGW * 64) {
            const u32x4 a = kp[i], b = vp[i]; f32x4 x0, x1; unpack8(a, x0, x1);
            for (int q = 0; q < 4; ++q) { if (!(x0[q] >= 0.f && x0[q] <= 1.f)) ++cntk; if (!(x1[q] >= 0.f && x1[q] <= 1.f)) ++cntk; }
            unpack8(b, x0, x1);
            for (int q = 0; q < 4; ++q) { if (!(x0[q] >= 0.f && x0[q] <= 1.f)) ++cntv; if (!(x1[q] >= 0.f && x1[q] <= 1.f)) ++cntv; } }
        if (cntk) atomicAdd((unsigned*)(C.ctl + PR_BASE + 12), cntk); if (cntv) atomicAdd((unsigned*)(C.ctl + PR_BASE + 13), cntv);
        xcd_barrier(bar); }
#endif
    merge_phase<L, 0>(C, args, bar, P);
    merge_phase<L, 1>(C, args, bar, P);
    merge_phase<L, 2>(C, args, bar, P);
    if (PH_ON) { WSB();
#if (EN_SITES >> 3) & 1
        pg8::Gemm g{W_K, W_WOUT + 2 * 1024 * 1024, mrows, 1024, 1024}; pg8::StaticOrder S; S.init(mrows, 1024, C.G, (int)blockIdx.x);
        if constexpr (L == 0) { EpiResid<true> E{args.in[0], W_X16, ELEM_DELTA(args.in[2], args.in[0]) - (long)ML * DM, W_MODL, 2, 0};
            pg8::gemm_phase<EpiResid<true>, pg8::StaticOrder, PG8_ALIGN, PG8_SP2>(C.lds, g, S, E); }
        else { EpiResid<false> E{W_X16, W_X16, 0l, W_MODL, 2, 0};
            pg8::gemm_phase<EpiResid<false>, pg8::StaticOrder, PG8_ALIGN, PG8_SP2>(C.lds, g, S, E); }
#endif
    }
    SEAM();
    PROBE_HOOK(probe_after_wo<L>);
    if (L == 0) {
        if (PH_ON) { WSB(); modulate_phase<true>(C, W_X16, nullptr, args.in[7], W_MODL, 3, 4, W_H, MA); }
        SEAM();
        if (PH_ON) { WSB();
#if (EN_SITES >> 4) & 1
            pg8::Gemm g{W_H, (const bf16*)(ws + WS_WFU), MA, 2 * DFF, 1024}; pg8::StaticOrder S; S.init(MA, 2 * DFF, C.G, (int)blockIdx.x);
            EpiSwiGLU E{(bf16*)(ws + WS_ACT0), DFF, 0, 22};
            pg8::gemm_phase<EpiSwiGLU, pg8::StaticOrder, PG8_ALIGN, PG8_SP2>(C.lds, g, S, E);
        if (REP_UP > 1) {
#ifdef REP_BARRIER
            xcd_barrier(bar);
#endif
            pg8::gemm_phase<EpiSwiGLU, pg8::StaticOrder, PG8_ALIGN, PG8_SP2>(C.lds, g, S, E); }
#endif
        }
        SEAM();
        PROBE_HOOK(probe_after_ffn0);
        if (PH_ON) { WSB();
#if (EN_SITES >> 5) & 1
            pg8::Gemm g{(const bf16*)(ws + WS_ACT0), (const bf16*)(ws + WS_WFD), MA, 1024, DFF}; pg8::StaticOrder S; S.init(MA, 1024, C.G, (int)blockIdx.x);
            EpiResid<false> E{W_X16, W_X16, 0l, W_MODL, 5, 0};
            pg8::gemm_phase<EpiResid<false>, pg8::StaticOrder, PG8_ALIGN, PG8_SP2>(C.lds, g, S, E);
#endif
        }
        SEAM();
    } else {
        if (PH_ON) { WSB();
#ifdef DUP_ROUTE
            route_phase(C, W_X16, args.in[7] + 1024, W_MODL, args.in[24], W_H, W_ROUTE, P.hi < 5000); __syncthreads();
#endif
            route_phase(C, W_X16, args.in[7] + 1024, W_MODL, args.in[24], W_H, W_ROUTE);
            __syncthreads();
#ifdef REP_MOECVT
            for (int rep_ = 0; rep_ < 2; ++rep_)
#endif
            for (int e = 0; e < NEXP; ++e) {
                tr_matrix<2>(C, args.in[25] + (size_t)e * 1024 * DFE, args.in[26] + (size_t)e * 1024 * DFE, DFE, 1024, 2 * DFE, (bf16*)(ws + WS_MWU) + (size_t)e * 2 * DFE * 1024);
                tr_matrix<0>(C, args.in[27] + (size_t)e * DFE * 1024, nullptr, 1024, DFE, 1024, (bf16*)(ws + WS_MWD) + (size_t)e * 1024 * DFE);
            }
        }
        SEAM();
        if (P.lo < P.ph + 8 && P.ph < P.hi) moe_offsets(C, offl);
#if MOE_GATHER
        if (PH_ON) { WSB(); gather_phase(C, W_H, (bf16*)(ws + WS_HS), W_ROUTE, offl); }
#else
        if (PH_ON) { WSB(); rowmap_phase(C, (unsigned*)(ws + WS_RMAP), W_ROUTE, offl); }
#endif
        SEAM();
        for (int ck = 0; ck < 3; ++ck) {
            const int ntall = offl[8] >> 8; int nt = ntall - ck * MOE_CH; nt = nt < 0 ? 0 : (nt > MOE_CH ? MOE_CH : nt);
            if (PH_ON) { WSB();
#if (EN_SITES >> 6) & 1
                EpiSwiGLU E{(bf16*)(ws + WS_MACT), DFE, ck * MOE_CH, 28};
#if MOE_GATHER
                pg8::Gemm g{(const bf16*)(ws + WS_HS), (const bf16*)(ws + WS_MWU), nt * 256, 2 * DFE, 1024};
                MoeOrder S; S.so.init(nt * 256, 2 * DFE, C.G, (int)blockIdx.x); S.tile0 = ck * MOE_CH; S.npe = 28; S.a_global = true; S.offl = offl;
                pg8::gemm_phase<EpiSwiGLU, MoeOrder, PG8_ALIGN, PG8_SP2>(C.lds, g, S, E);
#else
                pg8::Gemm g{W_H, (const bf16*)(ws + WS_MWU), nt * 256, 2 * DFE, 1024};
                MoeOrderG S; S.mo.so.init(nt * 256, 2 * DFE, C.G, (int)blockIdx.x); S.mo.tile0 = ck * MOE_CH; S.mo.npe = 28; S.mo.a_global = true; S.mo.offl = offl; S.rowmap = (const unsigned*)(ws + WS_RMAP);
                pg8::gemm_phase<EpiSwiGLU, MoeOrderG, PG8_ALIGN, PG8_SP2>(C.lds, g, S, E);
#endif
#endif
            }
            SEAM();
            if (PH_ON) { WSB();
#if (EN_SITES >> 7) & 1
                pg8::Gemm g{(const bf16*)(ws + WS_MACT), (const bf16*)(ws + WS_MWD), nt * 256, 1024, DFE};
                MoeOrder S; S.so.init(nt * 256, 1024, C.G, (int)blockIdx.x); S.tile0 = ck * MOE_CH; S.npe = 4; S.a_global = false; S.offl = offl;
                EpiStoreBf16 E{(bf16*)(ws + WS_HS), 1024, ck * MOE_CH, 4};
                pg8::gemm_phase<EpiStoreBf16, MoeOrder, PG8_ALIGN, PG8_SP2>(C.lds, g, S, E);
        if (REP_MOEDN > 1) { pg8::gemm_phase<EpiStoreBf16, MoeOrder, PG8_ALIGN, PG8_SP2>(C.lds, g, S, E); }
#endif
            }
            SEAM();
        }
        if (PH_ON) { WSB();
#ifdef DUP_FINAL
            final_phase(C, W_X16, args.out, (const bf16*)(ws + WS_HS), W_ROUTE, W_MODL, args.in[28], P.hi < 5000);
#endif
            final_phase(C, W_X16, args.out, (const bf16*)(ws + WS_HS), W_ROUTE, W_MODL, args.in[28]); }
        SEAM();
    }
}

__global__ void __launch_bounds__(NTHREADS, 2) fwd_kernel(Args args) {
    extern __shared__ __attribute__((aligned(16))) unsigned char lds_raw[];
    Ctx C;
    C.lds = (LAS unsigned char*)lds_raw; C.ctl = (gu32*)(args.ws + WS_CTL);
    C.tid = threadIdx.x; C.lane = C.tid & 63; C.wave = __builtin_amdgcn_readfirstlane(C.tid >> 6);
    C.G = gridDim.x; { const int bx = blockIdx.x; C.vcu = (C.G % 8 == 0) ? (bx % 8) * (C.G / 8) + bx / 8 : bx; }
    C.gw = C.vcu * NWAVES + C.wave; C.NGW = C.G * NWAVES;
    volatile LAS unsigned* MISC = (volatile LAS unsigned*)(C.lds + LDSCTL_OFF);
    volatile LAS int* offl = (volatile LAS int*)(C.lds + LDSCTL_OFF + 64);
    if (C.tid < 64) MISC[C.tid] = 0u;
    __syncthreads();
    const XcdBarrier bar = xcd_barrier_post((unsigned*)(C.ctl + CW_BAR), MISC);
    PhaseCtl P{args.ph_lo, args.ph_hi, 0};
#ifdef PTIME
    if (blockIdx.x == 0 && C.tid == 0) ((unsigned long long*)(C.ctl + 16384))[0] = rt();
#endif

#if EN_PRO
    if (PH_ON) { WSB();
#ifdef REP_PRO
        for (int rep_ = 0; rep_ < 2; ++rep_)
#endif
        for (int l = 0; l < 2; ++l) {
            tr_matrix<1>(C, args.in[8] + (size_t)l * 1024 * INC, nullptr, INC, 1024, INC, (bf16*)(ws + WS_WIN + l * WIN_BYTES));
            bf16* wo = (bf16*)(ws + WS_WOUT + l * WOUT_BYTES);
            tr_matrix<0>(C, args.in[17] + (size_t)l * 512 * 1024, nullptr, 1024, 512, 1024, wo);
            tr_matrix<0>(C, args.in[18] + (size_t)l * 512 * 1024, nullptr, 1024, 512, 1024, wo + 512 * 1024);
            tr_matrix<0>(C, args.in[19] + (size_t)l * 1024 * 1024, nullptr, 1024, 1024, 1024, wo + 1024 * 1024);
            tr_matrix<0>(C, args.in[20] + (size_t)l * 1024 * 1024, nullptr, 1024, 1024, 1024, wo + 2 * 1024 * 1024);
        }
        tr_matrix<2>(C, args.in[21], args.in[22], DFF, 1024, 2 * DFF, (bf16*)(ws + WS_WFU));
        tr_matrix<0>(C, args.in[23], nullptr, 1024, DFF, 1024, (bf16*)(ws + WS_WFD));
        for (int i = C.gw * 64 + C.lane; i < 2 * 8 * 128 * 128; i += C.NGW * 64) W_AWS[i] = (bf16)f2bf(args.in[12][i]);
        __syncthreads();
        mod_phase(C, args.in[1], args.in[3], args.in[4], args.in[5], W_MOD);
        rope_lam_phase(C, args.in[15], W_ROPE, W_LAM);
#ifdef PROBE_FILL
        { GAS u32x4* kf = (GAS u32x4*)(ws + WS_K); const u32x4 pat = {0x46404640u, 0x46404640u, 0x46404640u, 0x46404640u};
          for (size_t i = (size_t)C.gw * 64 + C.lane; i < (size_t)MA * DM * 2 / 16; i += (size_t)C.NGW * 64) kf[i] = pat; }
#endif
    }
#endif
    SEAM();
    layer_body<0>(C, args, bar, P, offl);
#if NLAYERS > 1
    layer_body<1>(C, args, bar, P, offl);
#endif
#ifdef PTIME
    {
        xcd_barrier(bar);
        const unsigned long long* T = (const unsigned long long*)(C.ctl + 16384);
        const float ta = (float)(__hip_atomic_load(T + 1 + PT_A1, __ATOMIC_RELAXED, __HIP_MEMORY_SCOPE_AGENT) - __hip_atomic_load(T + PT_A0, __ATOMIC_RELAXED, __HIP_MEMORY_SCOPE_AGENT)) * 0.01f;
        const float tb = (float)(__hip_atomic_load(T + 1 + PT_B1, __ATOMIC_RELAXED, __HIP_MEMORY_SCOPE_AGENT) - __hip_atomic_load(T + PT_B0, __ATOMIC_RELAXED, __HIP_MEMORY_SCOPE_AGENT)) * 0.01f;
        const float bv = 8.f * sqrtf(tb);
        for (size_t i = (size_t)C.gw * 64 + C.lane; i < (size_t)ML * DM; i += (size_t)C.NGW * 64) args.out[i] = i == 0 ? ta : ((i >= 1024 && i < 1024 + (1u << 20)) ? bv : 0.f);
    }
#endif
#ifdef PROBE
    {
        xcd_barrier(bar);
        const unsigned id = __hip_atomic_load((unsigned*)(C.ctl + PR_BASE), __ATOMIC_RELAXED, __HIP_MEMORY_SCOPE_AGENT);
        const float e1 = __uint_as_float(__hip_atomic_load((unsigned*)(C.ctl + PR_BASE + 1), __ATOMIC_RELAXED, __HIP_MEMORY_SCOPE_AGENT)), e2 = __uint_as_float(__hip_atomic_load((unsigned*)(C.ctl + PR_BASE + 2), __ATOMIC_RELAXED, __HIP_MEMORY_SCOPE_AGENT));
        const float err = id ? e1 : e2; float code = err < 0.05f ? 1000.f * err : 50.f + 100.f * (err > 4.5f ? 4.5f : err); const float bv = 8.f * sqrtf(code);
        const unsigned sv = __hip_atomic_load((unsigned*)(C.ctl + PR_BASE + 3), __ATOMIC_RELAXED, __HIP_MEMORY_SCOPE_AGENT), sb = __hip_atomic_load((unsigned*)(C.ctl + PR_BASE + 4), __ATOMIC_RELAXED, __HIP_MEMORY_SCOPE_AGENT);
        float a0 = 100.f * (float)id, bvv = bv;
        const unsigned eoff = __hip_atomic_load((unsigned*)(C.ctl + PR_BASE + 7), __ATOMIC_RELAXED, __HIP_MEMORY_SCOPE_AGENT);
#ifndef PROBE_SEL
#define PROBE_SEL 0
#endif
        if (PROBE_SEL == 8 && false) {} else if (sv && PROBE_SEL == 1) { const unsigned rr = eoff >> 10, nn = eoff & 1023u; a0 = 100.f * (float)(nn >> 4); bvv = 8.f * sqrtf((float)(rr >> 10)); }
        else if (sv && PROBE_SEL == 2) { const unsigned rr = eoff >> 10, nn = eoff & 1023u; a0 = 100.f * (float)(nn & 15u) + 50.f; bvv = 8.f * sqrtf((float)((rr >> 4) & 63u)); }
        else if (sv && PROBE_SEL == 4) { const unsigned cw = __hip_atomic_load((unsigned*)(C.ctl + PR_BASE + 8), __ATOMIC_RELAXED, __HIP_MEMORY_SCOPE_AGENT); a0 = 100.f * (float)(cw & 0xffu) + 50.f; bvv = 8.f * sqrtf((float)(cw >> 8)); }
        else if (sv && PROBE_SEL == 5) { const unsigned cw = __hip_atomic_load((unsigned*)(C.ctl + PR_BASE + 9), __ATOMIC_RELAXED, __HIP_MEMORY_SCOPE_AGENT); a0 = 100.f * (float)(cw & 0xffu) + 50.f; bvv = 8.f * sqrtf((float)(cw >> 8)); }
        else if (sv && PROBE_SEL == 6) { const unsigned cw = __hip_atomic_load((unsigned*)(C.ctl + PR_BASE + 10), __ATOMIC_RELAXED, __HIP_MEMORY_SCOPE_AGENT); a0 = 100.f * (float)((cw >> 4) & 15u) + 50.f; bvv = 8.f * sqrtf((float)(cw & 15u)); }
        else if (sv && PROBE_SEL == 7) { const unsigned cw = __hip_atomic_load((unsigned*)(C.ctl + PR_BASE + 10), __ATOMIC_RELAXED, __HIP_MEMORY_SCOPE_AGENT) >> 8; a0 = 100.f * (float)((cw >> 4) & 15u) + 50.f; bvv = 8.f * sqrtf((float)(cw & 15u)); }
        else if (PROBE_SEL == 8) { const unsigned ck = __hip_atomic_load((unsigned*)(C.ctl + PR_BASE + 12), __ATOMIC_RELAXED, __HIP_MEMORY_SCOPE_AGENT), cv = __hip_atomic_load((unsigned*)(C.ctl + PR_BASE + 13), __ATOMIC_RELAXED, __HIP_MEMORY_SCOPE_AGENT);
            a0 = 100.f * (float)ck; bvv = 8.f * sqrtf((float)cv); }
        else if (sv && PROBE_SEL == 3) { const unsigned rr = eoff >> 10; a0 = 100.f * (float)(rr & 15u) + 50.f; bvv = 0.f; }
        else if (sv) { const float val = __uint_as_float(sv); a0 = 1000.f * fabsf(val); const unsigned ko = __hip_atomic_load((unsigned*)(C.ctl + PR_BASE + 6), __ATOMIC_RELAXED, __HIP_MEMORY_SCOPE_AGENT); bvv = 8.f * sqrtf(10.f * (float)sb + (val < 0.f ? 5.f : 0.f) + (ko ? 100.f : 0.f)); }
        for (size_t i = (size_t)C.gw * 64 + C.lane; i < (size_t)ML * DM; i += (size_t)C.NGW * 64) args.out[i] = i == 0 ? a0 : ((i >= 1024 && i < 1024 + (1u << 20)) ? bvv : 0.f);
    }
#endif
}
#undef PH_ON
#undef SEAM
#undef WSB

extern "C" void kernel_launch(void* const* d_in, const int* in_sizes, int n_in, void* d_out, int out_size, void* d_ws, size_t ws_size, hipStream_t stream) {
    static int grid = 0;
    if (grid == 0) {
        if (n_in != 29 || in_sizes[0] != ML * DM || out_size != ML * DM || ws_size < WS_END) {
            fprintf(stderr, "kernel_launch: shape mismatch: n_in %d in0 %d out %d ws %zu (need %zu); nothing launched\n", n_in, n_in > 0 ? in_sizes[0] : -1, out_size, ws_size, (size_t)WS_END); grid = -1; return; }
        int dev = 0, cus = 0, per_cu = 0;
        if (hipGetDevice(&dev) != hipSuccess || hipDeviceGetAttribute(&cus, hipDeviceAttributeMultiprocessorCount, dev) != hipSuccess) { fprintf(stderr, "kernel_launch: device query failed\n"); grid = -1; return; }
        if (hipFuncSetAttribute((const void*)fwd_kernel, hipFuncAttributeMaxDynamicSharedMemorySize, LDS_BYTES) != hipSuccess) { fprintf(stderr, "kernel_launch: hipFuncSetAttribute failed\n"); grid = -1; return; }
        if (hipOccupancyMaxActiveBlocksPerMultiprocessor(&per_cu, (const void*)fwd_kernel, NTHREADS, LDS_BYTES) != hipSuccess || per_cu < 1)
            fprintf(stderr, "kernel_launch: note: occupancy query reports %d workgroups per CU\n", per_cu);
        (void)hipGetLastError();
        grid = cus;
    }
    if (grid < 0) return;
    if (hipMemsetAsync((char*)d_ws + WS_CTL, 0, CTL_ZERO_BYTES, stream) != hipSuccess) { fprintf(stderr, "kernel_launch: memset failed\n"); return; }
    Args a{};
    for (int i = 0; i < 29; ++i) a.in[i] = (const float*)d_in[i];
    a.out = (float*)d_out; a.ws = (unsigned char*)d_ws; a.ph_lo = 0; a.ph_hi = 1000;
    hipLaunchKernelGGL(fwd_kernel, dim3(grid), dim3(NTHREADS), LDS_BYTES, stream, a);
    const hipError_t le = hipPeekAtLastError();
    if (le != hipSuccess) fprintf(stderr, "kernel_launch: launch failed: %s\n", hipGetErrorName(le));
}
```

```cpp
#include <hip/hip_runtime.h>
#include <cstdio>
#include <cstdint>
namespace pg8 {
#define PG8_LAS __attribute__((address_space(3)))
typedef unsigned short bf16_t;
typedef short bf16x8 __attribute__((ext_vector_type(8)));
typedef float f32x4 __attribute__((ext_vector_type(4)));
typedef unsigned u32x4 __attribute__((ext_vector_type(4)));
constexpr int BM = 256, BK = 64, HALF = 128, HTB = HALF * BK * 2  , STAGE_BYTES = 8 * HTB, NXCD = 8, WGM = 8;

__host__ __device__ __forceinline__ int lds_byte(int r, int c) { const int st = (r >> 4) * 2 + (c >> 5), rr = r & 15, cc = c & 31, ob = rr * 64 + cc * 2; return st * 1024 + (ob ^ (((ob >> 9) & 1) << 5)); }
__host__ __device__ __forceinline__ void stage_rc(int b, int& R, int& C) { const int st = b / 1024, sb = b % 1024, swz = sb ^ (((sb >> 9) & 1) << 5); R = (st >> 1) * 16 + swz / 64; C = (st & 1) * 32 + (swz % 64) / 2; }
__host__ __device__ __forceinline__ int perm32(int rho) { const int n = rho >> 4, i = rho & 15; return 8 * (i >> 2) + 4 * n + (i & 3); }

struct Unit { int pm, pn; };
struct Gemm { const bf16_t* A; const bf16_t* Bt; int M, N, K; };

struct StaticOrder {
    static constexpr bool GATHER = false;
    int nM, nN, nwg, G, c;
    __host__ __device__ void init(int M, int N, int G_, int c_) { nM = M / BM; nN = N / BM; nwg = nM * nN; G = G_; c = c_; }
    __host__ __device__ bool next(int i, Unit& u) const {
        const long L = (long)i * G + c; if (L >= nwg) return false;
        int wgid = (int)L; { const int q = nwg / NXCD, r = nwg % NXCD, xcd = wgid % NXCD, off = wgid / NXCD; wgid = (xcd < r ? xcd * (q + 1) : r * (q + 1) + (xcd - r) * q) + off; }
        const int nig = WGM * nN, gid = wgid / nig, fm = gid * WGM, gsz = (nM - fm) < WGM ? (nM - fm) : WGM;
        u.pm = fm + ((wgid % nig) % gsz); u.pn = (wgid % nig) / gsz; return true;
    }
    __device__ __forceinline__ void a_ready(const Unit&) const {}
    __device__ __forceinline__ void done(const Unit&) const {}
};

typedef float cvt_f32x2 __attribute__((ext_vector_type(2))); typedef __bf16 cvt_bf16x2 __attribute__((ext_vector_type(2)));
__device__ __forceinline__ unsigned cvt_pk_bf16(float lo, float hi) { const cvt_f32x2 v = {lo, hi}; const cvt_bf16x2 b = __builtin_convertvector(v, cvt_bf16x2); return __builtin_bit_cast(unsigned, b); }
typedef float f32x2 __attribute__((ext_vector_type(2)));
__device__ __forceinline__ f32x2 gelu_pk(f32x2 v) {
    const f32x2 av = __builtin_elementwise_abs(v), d = av * 0.2316418882f + 1.0f;
    f32x2 t; t.x = __builtin_amdgcn_rcpf(d.x); t.y = __builtin_amdgcn_rcpf(d.y);
    f32x2 q = t * 0.5307027145f + (-0.7265760135f); q = q * t + 0.7107068705f; q = q * t + (-0.142248368f); q = q * t + 0.127414796f; q = q * t;
    const f32x2 s = (v * v) * (-0.72134752044f);
    f32x2 e; e.x = __builtin_amdgcn_exp2f(s.x); e.y = __builtin_amdgcn_exp2f(s.y);
    const f32x2 m = v * (q * e), r = v - m;
    f32x2 o; o.x = v.x < 0.f ? m.x : r.x; o.y = v.y < 0.f ? m.y : r.y; return o;
}


template <class Epi, class Sched, bool ALIGN_EPI = false, bool SP2 = false>
__device__ __forceinline__ void gemm_phase(PG8_LAS unsigned char* lds, const Gemm g, const Sched& S, const Epi& E) {
    const int tid = threadIdx.x, wid = __builtin_amdgcn_readfirstlane(tid >> 6), lane = tid & 63, wr = wid >> 2, wc = wid & 3, fr = lane & 15, fq = lane >> 4;
    const int K = g.K, nt = K / BK;
    unsigned voffA[2], voffB[2];
#pragma unroll
    for (int i = 0; i < 2; ++i) { int R, C; stage_rc(tid * 16 + i * 8192, R, C); const int Rb = Epi::PERM ? ((R & ~31) + perm32(R & 31)) : R;
        voffA[i] = (unsigned)(R * K + C) * 2u; voffB[i] = (unsigned)(Rb * K + C) * 2u; }
    const size_t kstep = (size_t)(BK * 2);
    constexpr bool GA = Sched::GATHER;
    unsigned gC[2][2]; int grow[2];
    PG8_LAS unsigned* const rmap_lds = (PG8_LAS unsigned*)(lds + 8 * HTB);
    if constexpr (GA) { int R, C; stage_rc(tid * 16, R, C); grow[0] = R; stage_rc(tid * 16 + 8192, R, C); grow[1] = R; }
#ifndef PG8_KROT
#define PG8_KROT 0
#endif
    static_assert(SP2 || !Sched::GATHER, "gathered A rows are written for the SP2 loop only");
    static_assert(SP2 || !PG8_KROT, "the K-slice rotation is written for the SP2 loop only");
    const int krot = PG8_KROT ? (int)((blockIdx.x >> 3) % (unsigned)(K / BK)) : 0;
#define PG8_KO(j) ((size_t)(((j) + krot) >= nt ? ((j) + krot) - nt : ((j) + krot)) * kstep)
    const size_t hstep = (size_t)HALF * K * 2;
    const size_t tstep = 2 * hstep;
    const unsigned ldsw = (unsigned)wid * 1024u;
    const int aoff = lds_byte(wr * 64 + fr, fq * 8), boff = lds_byte(wc * 32 + fr, fq * 8);
#define PG8_SA(b, h) (((b) * 2 + (h)) * HTB)
#define PG8_SB(b, h) ((4 + (b) * 2 + (h)) * HTB)
#define PG8_STAGE(bufoff, gbase, voff) do { _Pragma("unroll") for (int _i = 0; _i < 2; ++_i) \
        __builtin_amdgcn_global_load_lds((const unsigned*)((const char*)(gbase) + (voff)[_i]), (PG8_LAS unsigned*)(lds + (bufoff) + ldsw + _i * 8192), 16, 0, 0); } while (0)
#define PG8_STAGE_A(bufoff, base, h) do { if constexpr (GA) { PG8_STAGE(bufoff, base, gC[h]); } else { PG8_STAGE(bufoff, (base) + (h) * hstep, voffA); } } while (0)
#define PG8_GC_FROM(src, scale_) do { _Pragma("unroll") for (int h_ = 0; h_ < 2; ++h_) _Pragma("unroll") for (int i_ = 0; i_ < 2; ++i_) gC[h_][i_] = (src)[128 * h_ + grow[i_]] * (unsigned)(scale_) + (voffA[i_] - (unsigned)grow[i_] * (unsigned)(scale_)); } while (0)
#define PG8_LDA(dst, b, h) do { _Pragma("unroll") for (int m = 0; m < 4; ++m) _Pragma("unroll") for (int k = 0; k < 2; ++k) dst[m][k] = *(const PG8_LAS bf16x8*)(lds + PG8_SA(b, h) + aoff + m * 2048 + k * 1024); } while (0)
#define PG8_LDB(dst, b, h) do { _Pragma("unroll") for (int n = 0; n < 2; ++n) _Pragma("unroll") for (int k = 0; k < 2; ++k) dst[n][k] = *(const PG8_LAS bf16x8*)(lds + PG8_SB(b, h) + boff + n * 2048 + k * 1024); } while (0)
#define PG8_MMA(ai, bj, At, Bt) do { __builtin_amdgcn_s_setprio(1); _Pragma("unroll") for (int m = 0; m < 4; ++m) _Pragma("unroll") for (int n = 0; n < 2; ++n) _Pragma("unroll") for (int k = 0; k < 2; ++k) \
        acc[ai][bj][m][n] = __builtin_amdgcn_mfma_f32_16x16x32_bf16(Bt[n][k], At[m][k], acc[ai][bj][m][n], 0, 0, 0); __builtin_amdgcn_s_setprio(0); } while (0)
#define PG8_WAIT_V(n) asm volatile("s_waitcnt vmcnt(" #n ")" ::: "memory")
#define PG8_WAIT_L(n) asm volatile("s_waitcnt lgkmcnt(" #n ")" ::: "memory")
#define PG8_BAR __builtin_amdgcn_s_barrier()
#define PG8_SCHED __builtin_amdgcn_sched_barrier(0)
    Unit cur, nxt; int ui = 0;
    if (!S.next(0, cur)) return;
    f32x4 acc[2][2][4][2];
#pragma unroll
    for (int a = 0; a < 2; ++a)
#pragma unroll
        for (int b = 0; b < 2; ++b)
#pragma unroll
            for (int m = 0; m < 4; ++m)
#pragma unroll
                for (int n = 0; n < 2; ++n) acc[a][b][m][n] = (f32x4){0.f, 0.f, 0.f, 0.f};
    bf16x8 At[4][2], B0[2][2], B1[2][2];
    const char* cA = (const char*)g.A + (GA ? (size_t)0 : (size_t)cur.pm * tstep); const char* cB = (const char*)g.Bt + (size_t)cur.pn * tstep;
    if constexpr (GA) { const unsigned* rm = S.rowmap + (size_t)cur.pm * 256; PG8_GC_FROM(rm, K * 2); }
    S.a_ready(cur);
    if constexpr (SP2) {
        PG8_STAGE(PG8_SB(0, 0), cB + PG8_KO(0), voffB); PG8_STAGE(PG8_SB(0, 1), cB + hstep + PG8_KO(0), voffB); PG8_STAGE_A(PG8_SA(0, 0), cA + PG8_KO(0), 0); PG8_STAGE_A(PG8_SA(0, 1), cA + PG8_KO(0), 1);
        if (wr == 1) PG8_BAR;
        PG8_WAIT_V(2); PG8_BAR;
        PG8_STAGE(PG8_SB(1, 0), cB + PG8_KO(1), voffB); PG8_STAGE_A(PG8_SA(1, 0), cA + PG8_KO(1), 0); PG8_STAGE(PG8_SB(1, 1), cB + hstep + PG8_KO(1), voffB);
        PG8_WAIT_V(6); PG8_BAR;
    } else {
        PG8_STAGE(PG8_SB(0, 0), cB, voffB); PG8_STAGE(PG8_SA(0, 0), cA, voffA); PG8_STAGE(PG8_SB(0, 1), cB + hstep, voffB); PG8_STAGE(PG8_SA(0, 1), cA + hstep, voffA);
        if (wr == 1) PG8_BAR;
        PG8_WAIT_V(4); PG8_BAR;
        PG8_STAGE(PG8_SB(1, 0), cB + kstep, voffB); PG8_STAGE(PG8_SA(1, 0), cA + kstep, voffA); PG8_STAGE(PG8_SB(1, 1), cB + hstep + kstep, voffB);
        PG8_WAIT_V(6); PG8_BAR;
    }
    for (;;) {
        const bool has_next = S.next(ui + 1, nxt);
        const char* nA = (has_next && !GA) ? (const char*)g.A + (size_t)nxt.pm * tstep : cA; const char* nB = has_next ? (const char*)g.Bt + (size_t)nxt.pn * tstep : cB;
        if constexpr (GA) { if (has_next && wid < 4) __builtin_amdgcn_global_load_lds((const unsigned*)(S.rowmap + (size_t)nxt.pm * 256 + wid * 64 + lane), (PG8_LAS unsigned*)(rmap_lds + wid * 64), 4, 0, 0); }
        for (int t = 0; t < nt; t += 2) {
            const bool last = (t == nt - 2);
            const char* a1 = cA + PG8_KO(t + 1);
            const char* a2 = last ? nA + PG8_KO(0) : cA + PG8_KO(t + 2); const char* b2 = last ? nB + PG8_KO(0) : cB + PG8_KO(t + 2);
            const char* a3 = last ? nA + PG8_KO(1) : cA + PG8_KO(t + 3); const char* b3 = last ? nB + PG8_KO(1) : cB + PG8_KO(t + 3);
            if (last && has_next) S.a_ready(nxt);
            if constexpr (SP2) {
            PG8_LDB(B0, 0, 0); PG8_LDB(B1, 0, 1); PG8_SCHED; PG8_LDA(At, 0, 0); PG8_STAGE_A(PG8_SA(1, 1), a1, 1);
            if constexpr (GA) { if (last && has_next) PG8_GC_FROM(rmap_lds, K * 2); }
            PG8_WAIT_V(8); PG8_WAIT_L(0); PG8_BAR; PG8_MMA(0, 0, At, B0); PG8_MMA(0, 1, At, B1); PG8_BAR; PG8_SCHED;
            PG8_LDA(At, 0, 1); PG8_STAGE(PG8_SB(0, 0), b2, voffB); PG8_STAGE(PG8_SB(0, 1), b2 + hstep, voffB); PG8_STAGE_A(PG8_SA(0, 0), a2, 0);
            PG8_WAIT_V(8); PG8_WAIT_L(0); PG8_BAR; PG8_MMA(1, 0, At, B0); PG8_MMA(1, 1, At, B1); PG8_BAR; PG8_SCHED;
            PG8_LDB(B0, 1, 0); PG8_LDB(B1, 1, 1); PG8_SCHED; PG8_LDA(At, 1, 0); PG8_STAGE_A(PG8_SA(0, 1), a2, 1);
            PG8_WAIT_V(8); PG8_WAIT_L(0); PG8_BAR; PG8_MMA(0, 0, At, B0); PG8_MMA(0, 1, At, B1); PG8_BAR; PG8_SCHED;
            PG8_LDA(At, 1, 1); PG8_STAGE(PG8_SB(1, 0), b3, voffB); PG8_STAGE(PG8_SB(1, 1), b3 + hstep, voffB); PG8_STAGE_A(PG8_SA(1, 0), a3, 0);
            PG8_WAIT_V(8); PG8_WAIT_L(0); PG8_BAR; PG8_MMA(1, 0, At, B0); PG8_MMA(1, 1, At, B1); PG8_BAR; PG8_SCHED;
            } else {
            PG8_LDB(B0, 0, 0); PG8_SCHED; PG8_LDA(At, 0, 0); PG8_STAGE(PG8_SA(1, 1), a1 + hstep, voffA);
            PG8_WAIT_L(8); PG8_BAR; PG8_WAIT_L(0); PG8_MMA(0, 0, At, B0); PG8_BAR; PG8_SCHED;
            PG8_LDB(B1, 0, 1); PG8_STAGE(PG8_SB(0, 0), b2, voffB);
            PG8_BAR; PG8_WAIT_L(0); PG8_MMA(0, 1, At, B1); PG8_BAR;
            PG8_LDA(At, 0, 1); PG8_STAGE(PG8_SA(0, 0), a2, voffA);
            PG8_BAR; PG8_WAIT_L(0); PG8_MMA(1, 0, At, B0); PG8_BAR; PG8_SCHED;
            PG8_STAGE(PG8_SB(0, 1), b2 + hstep, voffB);
            PG8_WAIT_V(6); PG8_BAR; PG8_MMA(1, 1, At, B1); PG8_BAR;
            PG8_LDB(B0, 1, 0); PG8_SCHED; PG8_LDA(At, 1, 0); PG8_STAGE(PG8_SA(0, 1), a2 + hstep, voffA);
            PG8_WAIT_L(8); PG8_BAR; PG8_WAIT_L(0); PG8_MMA(0, 0, At, B0); PG8_BAR; PG8_SCHED;
            PG8_LDB(B1, 1, 1); PG8_STAGE(PG8_SB(1, 0), b3, voffB);
            PG8_BAR; PG8_WAIT_L(0); PG8_MMA(0, 1, At, B1); PG8_BAR;
            PG8_LDA(At, 1, 1); PG8_STAGE(PG8_SA(1, 0), a3, voffA);
            PG8_BAR; PG8_WAIT_L(0); PG8_MMA(1, 0, At, B0); PG8_BAR; PG8_SCHED;
            PG8_STAGE(PG8_SB(1, 1), b3 + hstep, voffB);
            PG8_WAIT_V(6); PG8_BAR; PG8_MMA(1, 1, At, B1); PG8_BAR;
            }
        }
        if constexpr (ALIGN_EPI) { if (wr == 0) PG8_BAR; }
        if constexpr (!Epi::AFTER_DRAIN) { E(acc, cur, wr, wc, fr, fq); S.done(cur); }
        if (!has_next) break;
#pragma unroll
        for (int a = 0; a < 2; ++a)
#pragma unroll
            for (int b = 0; b < 2; ++b)
#pragma unroll
                for (int m = 0; m < 4; ++m)
#pragma unroll
                    for (int n = 0; n < 2; ++n) acc[a][b][m][n] = (f32x4){0.f, 0.f, 0.f, 0.f};
        cur = nxt; cA = nA; cB = nB; ++ui;
        if constexpr (ALIGN_EPI) { if (wr == 1) PG8_BAR; }
    }
    PG8_WAIT_V(0);
    if constexpr (!ALIGN_EPI) { if (wr == 0) PG8_BAR; }
    PG8_BAR;
    if constexpr (Epi::AFTER_DRAIN) { E.fused(acc, cur, wr, wc, fr, fq, lds, wid, lane); S.done(cur); }
#undef PG8_SA
#undef PG8_SB
#undef PG8_STAGE
#undef PG8_STAGE_A
#undef PG8_GC_FROM
#undef PG8_LDA
#undef PG8_LDB
#undef PG8_MMA
#undef PG8_WAIT_V
#undef PG8_WAIT_L
#undef PG8_BAR
#undef PG8_SCHED
#undef PG8_KO
}
}

#ifndef PG8_SP2
#define PG8_SP2 true
#endif
#ifndef PG8_ALIGN
#define PG8_ALIGN true
#endif

#define GAS __attribute__((address_space(1)))
#define LAS __attribute__((address_space(3)))
typedef unsigned short bf16;
typedef unsigned v4u __attribute__((ext_vector_type(4)));
typedef float f32x4 __attribute__((ext_vector_type(4)));
typedef short bf16x8 __attribute__((ext_vector_type(8)));
typedef GAS unsigned gu32;
typedef GAS unsigned long long gu64;
#define RLX_AGENT __ATOMIC_RELAXED, __HIP_MEMORY_SCOPE_AGENT
#define LDS_WAIT() asm volatile("s_waitcnt lgkmcnt(0)" ::: "memory")
#define VM_WAIT() asm volatile("s_waitcnt vmcnt(0)" ::: "memory")
__device__ __forceinline__ unsigned long long rt() { return __builtin_amdgcn_s_memrealtime(); }
__device__ __forceinline__ unsigned f2bf(float f) { unsigned u = __builtin_bit_cast(unsigned, f); return (u + 0x7fffu + ((u >> 16) & 1u)) >> 16; }
__device__ __forceinline__ unsigned pk2(float lo, float hi) { return f2bf(lo) | (f2bf(hi) << 16); }

#define XB_TMO      128
#define XB_XCNT(j)  (256  + 64 * (j))
#define XB_XSUB(j)  (1280 + 64 * (j))
#define XB_XGEN(j)  (2304 + 64 * (j))
#define XB_TOP      3328
#define XB_TOPGEN   3392
#define XCD_BAR_WORDS 3456
#define XB_SPIN_CAP (1u << 18)

__device__ __forceinline__ unsigned xb_ld(unsigned* p)              { return __hip_atomic_load(p, __ATOMIC_RELAXED, __HIP_MEMORY_SCOPE_AGENT); }
__device__ __forceinline__ unsigned xb_add(unsigned* p, unsigned v) { return __hip_atomic_fetch_add(p, v, __ATOMIC_RELAXED, __HIP_MEMORY_SCOPE_AGENT); }
__device__ __forceinline__ unsigned xb_xcc_id() { return (unsigned)__builtin_amdgcn_s_getreg((3 << 11) | 20) & 0xFu; }
#define XB_SPIN(cond, bar) do { unsigned _sp = 0; while (cond) { __builtin_amdgcn_s_sleep(1); \
    if ((++_sp & 255u) == 0u) { if (xb_ld(&(bar)[XB_TMO])) break; if (_sp > XB_SPIN_CAP) { atomicAdd(&(bar)[XB_TMO], 1u); break; } } } } while (0)

struct XcdBarrier {
    unsigned* bar; unsigned x;
    volatile LAS unsigned* st;
};

__device__ __forceinline__ XcdBarrier xcd_barrier_post(unsigned* bar, volatile LAS unsigned* st) {
    XcdBarrier b; b.bar = bar; b.x = xb_xcc_id(); b.st = st;
    if (threadIdx.x == 0) (void)xb_add(&bar[XB_XCNT(b.x)], 1u);
    return b;
}
__device__ __forceinline__ void xcd_barrier_complete(unsigned* bar, unsigned x, unsigned& nloc, unsigned& nx) {
    const unsigned G = gridDim.x * gridDim.y * gridDim.z;
    unsigned sum, cnt, mine, sp = 0u;
    for (;;) {
        sum = 0u; cnt = 0u; mine = 0u;
#pragma unroll
        for (unsigned j = 0; j < 16; ++j) { const unsigned c = xb_ld(&bar[XB_XCNT(j)]); sum += c; cnt += (c > 0u) ? 1u : 0u; mine = (j == x) ? c : mine; }
        if (sum == G) break;
        __builtin_amdgcn_s_sleep(1);
        if ((++sp & 255u) == 0u) { if (xb_ld(&bar[XB_TMO])) break; if (sp > XB_SPIN_CAP) { atomicAdd(&bar[XB_TMO], 1u); break; } }
    }
    nloc = mine > 0u ? mine : 1u; nx = cnt > 0u ? cnt : 1u;
}

__device__ __forceinline__ void xcd_barrier(const XcdBarrier& b) {
    asm volatile("s_waitcnt vmcnt(0)" ::: "memory");
    __syncthreads();
    if (threadIdx.x == 0) {
        unsigned* bar = b.bar;
        __builtin_amdgcn_s_waitcnt(0);
        unsigned nloc = b.st[0], nx = b.st[1];
        if (nloc == 0u) { xcd_barrier_complete(bar, b.x, nloc, nx); b.st[0] = nloc; b.st[1] = nx; }
        const unsigned old = xb_add(&bar[XB_XSUB(b.x)], 1u);
        const unsigned gen = old / nloc;
        if (old + 1u == (gen + 1u) * nloc) {
            __builtin_amdgcn_fence(__ATOMIC_RELEASE, "agent");
            asm volatile("s_waitcnt vmcnt(0)" ::: "memory");
            const unsigned og = xb_add(&bar[XB_TOP], 1u);
            const unsigned tg = og / nx;
            if (og + 1u == (tg + 1u) * nx) xb_add(&bar[XB_TOPGEN], 1u);
            else XB_SPIN(xb_ld(&bar[XB_TOPGEN]) == tg, bar);
            __builtin_amdgcn_fence(__ATOMIC_ACQUIRE, "agent");
            xb_add(&bar[XB_XGEN(b.x)], 1u);
            asm volatile("s_waitcnt vmcnt(0)" ::: "memory");
        } else {
            XB_SPIN(xb_ld(&bar[XB_XGEN(b.x)]) == gen, bar);
            __builtin_amdgcn_fence(__ATOMIC_ACQUIRE, "agent");
            asm volatile("s_waitcnt vmcnt(0)" ::: "memory");
        }
    }
    __syncthreads();
}

#ifndef NLAYERS
#define NLAYERS 2
#endif
#ifndef EN_PRO
#define EN_PRO 1
#endif
#ifndef EN_MIX
#define EN_MIX 1
#endif
#ifndef EN_ATT
#define EN_ATT 1
#endif
#ifndef EN_SITES
#define EN_SITES 255
#endif
constexpr int NWAVES = 8, NTHREADS = 512;
constexpr int BATCH = 16, SEQ = 4096, DM = 1024, CTXL = 256;
constexpr int ML = BATCH * SEQ;
constexpr int MC = BATCH * CTXL;
constexpr int MA = ML + MC;
constexpr int SKV = SEQ + CTXL;
constexpr int INC = 8704;
constexpr int NBIG = 5632;
constexpr int DFF = 2816, NEXP = 8, DFE = 3584;
constexpr int MOE_CH = 192;
constexpr float EPS = 1e-6f;
constexpr float QSCALE = 0.125f * 1.4426950408889634f;

constexpr size_t MiB = 1u << 20;
constexpr size_t WS_CTL = 0, CTL_ZERO_BYTES = 1 * MiB;
constexpr size_t WS_MOD = 1 * MiB;
constexpr size_t WS_ROPE = 2 * MiB;
constexpr size_t WS_LAM = 2 * MiB + 16384;
constexpr size_t WS_AWS = 2 * MiB + 65536;
constexpr size_t WS_ROUTE = 4 * MiB;
constexpr size_t WS_CNTT = 7 * MiB;
constexpr size_t WS_RMAP = 6 * MiB;
constexpr size_t WS_WIN = 8 * MiB;
constexpr size_t WIN_BYTES = 17 * MiB;
constexpr size_t WS_WOUT = 42 * MiB;
constexpr size_t WOUT_BYTES = 6 * MiB;
constexpr size_t WS_WFU = 54 * MiB;
constexpr size_t WS_WFD = 65 * MiB;
constexpr size_t WS_X16 = 87 * MiB;
constexpr size_t WS_P0 = 223 * MiB, WS_P1 = 291 * MiB, WS_P2 = 359 * MiB, WS_P3 = 427 * MiB;
constexpr size_t WS_Q = 495 * MiB, WS_K = 631 * MiB, WS_V = 767 * MiB;
constexpr size_t WS_ACT0 = 223 * MiB;
constexpr size_t WS_MWU = 223 * MiB;
constexpr size_t WS_MWD = 335 * MiB;
constexpr size_t WS_HS = 391 * MiB;
constexpr size_t WS_MACT = 651 * MiB;
constexpr size_t WS_END = 1024 * MiB;
static_assert(WS_MACT + (size_t)MOE_CH * 256 * DFE * 2 <= WS_END, "ws map");
static_assert(WS_ACT0 + (size_t)MA * DFF * 2 <= WS_K, "ws map");
constexpr int CW_BAR = 4096;
constexpr int CW_CNT = 8192;

constexpr int LDS_BYTES = 147456;
constexpr int LDSCTL_OFF = LDS_BYTES - 256;

typedef float f32x2 __attribute__((ext_vector_type(2)));
typedef unsigned v2u __attribute__((ext_vector_type(2)));
__device__ __forceinline__ float bf2f(unsigned h) { return __builtin_bit_cast(float, h << 16); }
__device__ __forceinline__ float dpp_add(float v, int ctrl_sel) {
    const int x = __builtin_bit_cast(int, v); int y;
    if (ctrl_sel == 0) y = __builtin_amdgcn_update_dpp(0, x, 0xB1, 0xf, 0xf, false);
    else if (ctrl_sel == 1) y = __builtin_amdgcn_update_dpp(0, x, 0x4E, 0xf, 0xf, false);
    else if (ctrl_sel == 2) y = __builtin_amdgcn_update_dpp(0, x, 0x141, 0xf, 0xf, false);
    else y = __builtin_amdgcn_update_dpp(0, x, 0x140, 0xf, 0xf, false);
    return v + __builtin_bit_cast(float, y);
}
__device__ __forceinline__ float wave_sum(float v) {
    v = dpp_add(v, 0); v = dpp_add(v, 1); v = dpp_add(v, 2); v = dpp_add(v, 3);
    const int x = __builtin_bit_cast(int, v);
    const float s0 = __builtin_bit_cast(float, __builtin_amdgcn_readlane(x, 0)), s1 = __builtin_bit_cast(float, __builtin_amdgcn_readlane(x, 16)),
                s2 = __builtin_bit_cast(float, __builtin_amdgcn_readlane(x, 32)), s3 = __builtin_bit_cast(float, __builtin_amdgcn_readlane(x, 48));
    return (s0 + s1) + (s2 + s3);
}
__device__ __forceinline__ float fast_exp2(float x) { return __builtin_amdgcn_exp2f(x); }
__device__ __forceinline__ float fast_rcp(float x) { return __builtin_amdgcn_rcpf(x); }
__device__ __forceinline__ float sigmoid_f(float x) { return fast_rcp(1.f + fast_exp2(-1.4426950408889634f * x)); }
__device__ __forceinline__ float silu_f(float x) { return x * sigmoid_f(x); }
__device__ __forceinline__ float gelu_tanh_f(float x) { const float u = x * (1.f + 0.044715f * x * x); return x * fast_rcp(1.f + fast_exp2(-2.f * 0.7978845608028654f * 1.4426950408889634f * u)); }

__device__ __forceinline__ unsigned char* launder_ptr(unsigned char* p) { asm volatile("" : "+s"(p)); return p; }
struct Args { const float* in[29]; float* out; unsigned char* ws; int ph_lo, ph_hi; };
static_assert(sizeof(Args) == 256, "Args has no holes");
struct PhaseCtl { int lo, hi, ph; };
struct Ctx {
    LAS unsigned char* lds;
    gu32* ctl;
    int tid, lane, wave, vcu, G, gw, NGW;
};

__device__ __forceinline__ void tr_item(const float* W, int ldw, int scol0, bool perm, bf16* WT, int K, int drow0, int k0, LAS float* scr, int lane) {
    float tv[32];
#pragma unroll
    for (int i = 0; i < 32; ++i) { const int kk = 2 * i + (lane >> 5); tv[i] = W[(size_t)(k0 + kk) * ldw + scol0 + (lane & 31)]; }
#pragma unroll
    for (int i = 0; i < 32; ++i) { const int kk = 2 * i + (lane >> 5); scr[kk * 33 + (lane & 31)] = tv[i]; }
    LDS_WAIT(); asm volatile("" ::: "memory");
    const int c = lane & 7;
#pragma unroll
    for (int j = 0; j < 4; ++j) { const int n = (lane >> 3) + 8 * j; const int sn = perm ? ((n >> 1) + 16 * (n & 1)) : n;
        const LAS float* s = scr + (8 * c) * 33 + sn;
        v4u o; o.x = pk2(s[0 * 33], s[1 * 33]); o.y = pk2(s[2 * 33], s[3 * 33]); o.z = pk2(s[4 * 33], s[5 * 33]); o.w = pk2(s[6 * 33], s[7 * 33]);
        *(GAS v4u*)(WT + (size_t)(drow0 + n) * K + k0 + 8 * c) = o; }
    LDS_WAIT(); asm volatile("" ::: "memory");
}
__device__ __forceinline__ int win_src(int d, bool& perm) {
    perm = false;
    if (d < 1024) { perm = true; return 2560 + d; }
    if (d < 2048) { perm = true; return 3584 + (d - 1024); }
    if (d < 3072) return 4608 + (d - 2048);
    if (d < 3584) return d - 3072;
    if (d < 4096) return 512 + (d - 3584);
    if (d < 4608) return 1024 + (d - 4096);
    if (d < 5632) { const int x = d - 4608, j = x >> 8, w = x & 255; return (w < 128 ? 1536 : 2048) + 128 * j + (w & 127); }
    return d;
}
template <int MODE>
__device__ __forceinline__ void tr_matrix(const Ctx& C, const float* W, const float* W2, int ldw, int K, int ndst, bf16* WT) {
    LAS float* scr = (LAS float*)(C.lds + C.wave * 16384);
    const int nblk = ndst / 32, ni = (K / 64) * nblk;
    for (int it = C.gw; it < ni; it += C.NGW) {
        const int kb = it / nblk, db = it % nblk; const float* src = W; int scol0; bool perm = false;
        if (MODE == 0) scol0 = 32 * db;
        else if (MODE == 1) scol0 = win_src(32 * db, perm);
        else { const int j = db >> 3, w = db & 7; if (w >= 4) src = W2; scol0 = 128 * j + 32 * (w & 3); }
        tr_item(src, ldw, scol0, perm, WT, K, 32 * db, 64 * kb, scr, C.lane);
    }
}

__device__ __forceinline__ void mod_phase(const Ctx& C, const float* c, const float* cctx, const float* w_ada, const float* b_ada, float* mod) {
    LAS float* sc = (LAS float*)C.lds;
    LAS float* red = (LAS float*)(C.lds + 17 * 1024 * 4);
    for (int idx = C.tid; idx < 17 * 1024; idx += NTHREADS) { const int b = idx >> 10, k = idx & 1023; const float v = b < 16 ? c[b * 1024 + k] : cctx[k]; sc[idx] = v / (1.f + __expf(-v)); }
    __syncthreads();
    const int cl = C.tid & 31, ks = C.tid >> 5;
    for (int it = blockIdx.x; it < 2 * 192; it += C.G) {
        const int l = it / 192, cb = it % 192, col = cb * 32 + cl;
        float acc[17];
#pragma unroll
        for (int b = 0; b < 17; ++b) acc[b] = 0.f;
        const float* wp = w_ada + ((size_t)l * 1024 + ks * 64) * 6144 + col;
#pragma unroll 1
        for (int k0 = 0; k0 < 64; k0 += 32) {
            float wv[32];
#pragma unroll
            for (int kk = 0; kk < 32; ++kk) wv[kk] = wp[(size_t)(k0 + kk) * 6144];
#pragma unroll
            for (int kk = 0; kk < 32; ++kk) { const int k = ks * 64 + k0 + kk;
#pragma unroll
                for (int b = 0; b < 17; ++b) acc[b] += sc[b * 1024 + k] * wv[kk]; }
        }
#pragma unroll
        for (int b = 0; b < 17; ++b) red[(ks * 17 + b) * 32 + cl] = acc[b];
        __syncthreads();
        for (int o = C.tid; o < 17 * 32; o += NTHREADS) { const int b = o >> 5, cc = o & 31; float s = b_ada[l * 6144 + cb * 32 + cc];
#pragma unroll
            for (int q = 0; q < 16; ++q) s += red[(q * 17 + b) * 32 + cc];
            mod[((size_t)l * 17 + b) * 6144 + cb * 32 + cc] = s; }
        __syncthreads();
    }
}
__device__ __forceinline__ void rope_lam_phase(const Ctx& C, const float* c_lambda, float* rope, float* lam) {
    if (blockIdx.x == 0) {
        for (int idx = C.tid; idx < 1024; idx += NTHREADS) {
            const int pos = idx >> 4, i = idx & 15;
            double th = 1.0; for (int q = 0; q < i; ++q) th *= 0.56234132519034908;
            double c1 = 1.0, s1 = th, tc = 1.0, ts = th; const double t2 = th * th;
            for (int n = 1; n <= 12; ++n) { tc *= -t2 / (double)((2 * n - 1) * (2 * n)); ts *= -t2 / (double)((2 * n) * (2 * n + 1)); c1 += tc; s1 += ts; }
            double cc = 1.0, ss = 0.0; for (int q = 0; q < pos; ++q) { const double nc = cc * c1 - ss * s1, ns = ss * c1 + cc * s1; cc = nc; ss = ns; }
            rope[idx * 2] = (float)cc; rope[idx * 2 + 1] = (float)ss;
        }
        if (C.tid < 2) { const int l = C.tid; const float* p = c_lambda + l * 256; float a = 0.f, b = 0.f;
            for (int d = 0; d < 64; ++d) { a += p[d] * p[64 + d]; b += p[128 + d] * p[192 + d]; }
            const float li = l == 0 ? 0.2f : (0.8f - 0.6f * 0.7408182206817179f);
            lam[l] = __expf(a) - __expf(b) + li; }
    }
}

template <bool XB> __device__ __forceinline__ f32x4 ldrow4(const void* row, int idx) {
    if constexpr (XB) { const v2u w = ((const GAS v2u*)row)[idx]; f32x4 a; a[0] = bf2f(w.x & 0xffffu); a[1] = bf2f(w.x >> 16); a[2] = bf2f(w.y & 0xffffu); a[3] = bf2f(w.y >> 16); return a; }
    else return ((const GAS f32x4*)row)[idx];
}
template <bool XB> __device__ __forceinline__ void modulate_row(const void* xr, const float* gn, const float* scv, const float* shv, bf16* orow, int lane, f32x4 (&y)[4]) {
    f32x4 v[4]; float ss = 0.f;
#pragma unroll
    for (int j = 0; j < 4; ++j) { v[j] = ldrow4<XB>(xr, lane + 64 * j); ss += (v[j].x * v[j].x + v[j].y * v[j].y) + (v[j].z * v[j].z + v[j].w * v[j].w); }
    const float rstd = 1.0f / sqrtf(wave_sum(ss) * (1.f / 1024.f) + EPS);
    GAS v2u* o8 = (GAS v2u*)orow + lane;
#pragma unroll
    for (int j = 0; j < 4; ++j) {
        const f32x4 g = ((const GAS f32x4*)gn)[lane + 64 * j], s = ((const GAS f32x4*)scv)[lane + 64 * j], h = ((const GAS f32x4*)shv)[lane + 64 * j];
        y[j] = (v[j] * rstd) * g * (s + 1.0f) + h;
        v2u w; w.x = pg8::cvt_pk_bf16(y[j].x, y[j].y); w.y = pg8::cvt_pk_bf16(y[j].z, y[j].w); o8[64 * j] = w; }
}
template <bool XB> struct RawSel { typedef f32x4 T; };
template <> struct RawSel<true> { typedef v2u T; };
template <bool XB> __device__ __forceinline__ typename RawSel<XB>::T ldraw4(const void* row, int idx) { return ((const GAS typename RawSel<XB>::T*)row)[idx]; }
__device__ __forceinline__ f32x4 cvraw4(const f32x4& r) { return r; }
__device__ __forceinline__ f32x4 cvraw4(const v2u& w) { f32x4 a; a[0] = bf2f(w.x & 0xffffu); a[1] = bf2f(w.x >> 16); a[2] = bf2f(w.y & 0xffffu); a[3] = bf2f(w.y >> 16); return a; }
template <bool XB> __device__ __forceinline__ void modulate_phase(const Ctx& C, const void* xl, const void* xcs, const float* gn, const float* modl, int shidx, int scidx, bf16* H, int nrows) {
    typedef typename RawSel<XB>::T RT;
    const int lane = C.lane;
    auto rowp = [&](int r) -> const void* {
        if constexpr (XB) return (const void*)((const bf16*)xl + (size_t)r * DM);
        else return r < ML ? (const void*)((const float*)xl + (size_t)r * DM) : (const void*)((const float*)xcs + (size_t)(r - ML) * DM); };
    f32x4 g[4];
#pragma unroll
    for (int j = 0; j < 4; ++j) g[j] = ((const GAS f32x4*)gn)[lane + 64 * j];
    int r0 = C.gw; if (r0 >= nrows) return;
    RT a0[4], a1[4];
    { const int r1 = r0 + C.NGW < nrows ? r0 + C.NGW : r0; const void* p0 = rowp(r0); const void* p1 = rowp(r1);
#pragma unroll
      for (int j = 0; j < 4; ++j) { a0[j] = ldraw4<XB>(p0, lane + 64 * j); a1[j] = ldraw4<XB>(p1, lane + 64 * j); } }
    for (; r0 < nrows; r0 += 2 * C.NGW) {
        const int r1 = r0 + C.NGW; const bool has1 = r1 < nrows; const int r1c = has1 ? r1 : r0;
        const int b0 = r0 < ML ? (r0 >> 12) : 16, b1 = r1c < ML ? (r1c >> 12) : 16;
        const float* m0 = modl + (size_t)b0 * 6144; const float* m1 = modl + (size_t)b1 * 6144;
        f32x4 sa[4], ha[4], sb[4], hb[4];
#pragma unroll
        for (int j = 0; j < 4; ++j) { sa[j] = ((const GAS f32x4*)(m0 + scidx * 1024))[lane + 64 * j]; ha[j] = ((const GAS f32x4*)(m0 + shidx * 1024))[lane + 64 * j];
                                      sb[j] = ((const GAS f32x4*)(m1 + scidx * 1024))[lane + 64 * j]; hb[j] = ((const GAS f32x4*)(m1 + shidx * 1024))[lane + 64 * j]; }
        RT n0[4], n1[4];
        { const int q0 = r0 + 2 * C.NGW < nrows ? r0 + 2 * C.NGW : r0, q1 = r0 + 3 * C.NGW < nrows ? r0 + 3 * C.NGW : r0; const void* p0 = rowp(q0); const void* p1 = rowp(q1);
#pragma unroll
          for (int j = 0; j < 4; ++j) { n0[j] = ldraw4<XB>(p0, lane + 64 * j); n1[j] = ldraw4<XB>(p1, lane + 64 * j); } }
        f32x4 v0[4], v1[4]; float s0 = 0.f, s1 = 0.f;
#pragma unroll
        for (int j = 0; j < 4; ++j) { v0[j] = cvraw4(a0[j]); v1[j] = cvraw4(a1[j]); }
#pragma unroll
        for (int j = 0; j < 4; ++j) { s0 += (v0[j].x * v0[j].x + v0[j].y * v0[j].y) + (v0[j].z * v0[j].z + v0[j].w * v0[j].w); s1 += (v1[j].x * v1[j].x + v1[j].y * v1[j].y) + (v1[j].z * v1[j].z + v1[j].w * v1[j].w); }
        const float rs0 = 1.0f / sqrtf(wave_sum(s0) * (1.f / 1024.f) + EPS), rs1 = 1.0f / sqrtf(wave_sum(s1) * (1.f / 1024.f) + EPS);
        GAS v2u* o0 = (GAS v2u*)(H + (size_t)r0 * DM) + lane; GAS v2u* o1 = (GAS v2u*)(H + (size_t)r1c * DM) + lane;
#pragma unroll
        for (int j = 0; j < 4; ++j) {
            const f32x4 ya = (v0[j] * rs0) * g[j] * (sa[j] + 1.0f) + ha[j];
            v2u w; w.x = pg8::cvt_pk_bf16(ya.x, ya.y); w.y = pg8::cvt_pk_bf16(ya.z, ya.w); o0[64 * j] = w;
            if (has1) { const f32x4 yb = (v1[j] * rs1) * g[j] * (sb[j] + 1.0f) + hb[j];
                v2u w2; w2.x = pg8::cvt_pk_bf16(yb.x, yb.y); w2.y = pg8::cvt_pk_bf16(yb.z, yb.w); o1[64 * j] = w2; }
        }
#pragma unroll
        for (int j = 0; j < 4; ++j) { a0[j] = n0[j]; a1[j] = n1[j]; }
    }
}

using pg8::f32x4; using pg8::u32x4; using pg8::Unit; using pg8::cvt_pk_bf16;
__device__ __forceinline__ u32x4 pack8(const f32x4& a, const f32x4& b) { u32x4 w; w.x = cvt_pk_bf16(a[0], a[1]); w.y = cvt_pk_bf16(a[2], a[3]); w.z = cvt_pk_bf16(b[0], b[1]); w.w = cvt_pk_bf16(b[2], b[3]); return w; }
__device__ __forceinline__ void unpack8(const u32x4& w, f32x4& a, f32x4& b) {
    a[0] = bf2f(w.x & 0xffffu); a[1] = bf2f(w.x >> 16); a[2] = bf2f(w.y & 0xffffu); a[3] = bf2f(w.y >> 16);
    b[0] = bf2f(w.z & 0xffffu); b[1] = bf2f(w.z >> 16); b[2] = bf2f(w.w & 0xffffu); b[3] = bf2f(w.w >> 16); }

#ifndef NT_BIG
#define NT_BIG 0
#endif
#if NT_BIG
#define ST16(p, v) __builtin_nontemporal_store((v), (p))
#else
#define ST16(p, v) (*(p) = (v))
#endif
struct EpiBig {
    static constexpr bool PERM = true, AFTER_DRAIN = false;
    unsigned char* wsb; const LAS float* rope;
    __device__ __forceinline__ void operator()(const f32x4 (&acc)[2][2][4][2], const Unit& u, int wr, int wc, int fr, int fq) const {
        const int R0 = u.pm * 256, pn = u.pn; const bool isctx = R0 >= ML;
        const int cin = 32 * wc + 8 * fq;
        if (pn < 12) {
            const int kind = pn >> 2;
            bf16* base = (bf16*)(wsb + WS_Q + (size_t)kind * (WS_K - WS_Q));
            long rowadd = 0;
            if (kind != 0) rowadd = isctx ? ((long)((R0 - ML) >> 8) * SKV + SEQ - R0) : ((long)(R0 >> 12) * (SKV - SEQ));
            const bool rot = (kind != 2) && !isctx; const int axis = wc & 1; const float qs = kind == 0 ? QSCALE : 1.f;
#pragma unroll
            for (int ai = 0; ai < 2; ++ai)
#pragma unroll
                for (int m = 0; m < 4; ++m) {
                    const int r = R0 + ai * 128 + wr * 64 + m * 16 + fr;
                    f32x4 t0 = {1.f, 0.f, 1.f, 0.f}, t1 = {1.f, 0.f, 1.f, 0.f};
                    if (rot) { const int t = r & 4095; const int pos = axis == 0 ? (t >> 6) : (t & 63); const LAS f32x4* tp = (const LAS f32x4*)(rope + (pos * 16 + 4 * fq) * 2); t0 = tp[0]; t1 = tp[1]; }
                    bf16* rowp = base + (size_t)((long)r + rowadd) * DM + (pn & 3) * 256 + cin;
#pragma unroll
                    for (int bj = 0; bj < 2; ++bj) {
                        const f32x4 a = acc[ai][bj][m][0], b = acc[ai][bj][m][1]; f32x4 oa, ob;
                        oa[0] = (a[0] * t0[0] - a[1] * t0[1]) * qs; oa[1] = (a[1] * t0[0] + a[0] * t0[1]) * qs; oa[2] = (a[2] * t0[2] - a[3] * t0[3]) * qs; oa[3] = (a[3] * t0[2] + a[2] * t0[3]) * qs;
                        ob[0] = (b[0] * t1[0] - b[1] * t1[1]) * qs; ob[1] = (b[1] * t1[0] + b[0] * t1[1]) * qs; ob[2] = (b[2] * t1[2] - b[3] * t1[3]) * qs; ob[3] = (b[3] * t1[2] + b[2] * t1[3]) * qs;
                        ST16((GAS u32x4*)(rowp + bj * 128), pack8(oa, ob)); }
                }
        } else if (pn < 18) {
            const int kind = (pn - 12) >> 1;
            bf16* base = (bf16*)(wsb + WS_P0 + (size_t)kind * (WS_P1 - WS_P0)); const int c0 = ((pn - 12) & 1) * 256 + cin;
#pragma unroll
            for (int ai = 0; ai < 2; ++ai)
#pragma unroll
                for (int m = 0; m < 4; ++m) {
                    const int r = R0 + ai * 128 + wr * 64 + m * 16 + fr; bf16* rowp = base + (size_t)r * 512 + c0;
#pragma unroll
                    for (int bj = 0; bj < 2; ++bj) {
                        f32x4 a = acc[ai][bj][m][0], b = acc[ai][bj][m][1];
                        if (kind < 2) {
#pragma unroll
                            for (int q = 0; q < 4; ++q) { a[q] = gelu_tanh_f(a[q]); b[q] = gelu_tanh_f(b[q]); } }
                        ST16((GAS u32x4*)(rowp + bj * 128), pack8(a, b)); }
                }
        } else {
            const int c0 = (pn - 18) * 128 + cin;
#pragma unroll
            for (int ai = 0; ai < 2; ++ai)
#pragma unroll
                for (int m = 0; m < 4; ++m) {
                    const int r = R0 + ai * 128 + wr * 64 + m * 16 + fr;
                    const f32x4 a = acc[ai][0][m][0] * acc[ai][1][m][0], b = acc[ai][0][m][1] * acc[ai][1][m][1];
                    ST16((GAS u32x4*)((bf16*)(wsb + WS_P3) + (size_t)r * 512 + c0), pack8(a, b)); }
        }
    }
};

struct EpiGate {
    static constexpr bool PERM = true, AFTER_DRAIN = false;
    unsigned char* wsb; const LAS float* bias;
    __device__ __forceinline__ void operator()(const f32x4 (&acc)[2][2][4][2], const Unit& u, int wr, int wc, int fr, int fq) const {
        const int R0 = u.pm * 256, pn = u.pn, br = pn >> 2, cin = 32 * wc + 8 * fq;
        const size_t boff = br == 0 ? WS_K : (br == 1 ? WS_V : ((pn & 2) ? WS_P3 : WS_P1));
        bf16* base = (bf16*)(wsb + boff); const int ld = br == 2 ? 512 : 1024, c0 = (br == 2 ? (pn & 1) : (pn & 3)) * 256 + cin;
        f32x4 bv[2][2];
#pragma unroll
        for (int bj = 0; bj < 2; ++bj)
#pragma unroll
            for (int n = 0; n < 2; ++n) bv[bj][n] = *(const LAS f32x4*)(bias + pn * 256 + bj * 128 + cin + 4 * n);
#pragma unroll
        for (int ai = 0; ai < 2; ++ai)
#pragma unroll
            for (int m = 0; m < 4; ++m) {
                const int r = R0 + ai * 128 + wr * 64 + m * 16 + fr; bf16* rowp = base + (size_t)r * ld + c0;
#pragma unroll
                for (int bj = 0; bj < 2; ++bj) {
                    f32x4 a = acc[ai][bj][m][0] + bv[bj][0], b = acc[ai][bj][m][1] + bv[bj][1];
#pragma unroll
                    for (int q = 0; q < 4; ++q) { a[q] = sigmoid_f(a[q]); b[q] = sigmoid_f(b[q]); }
                    ST16((GAS u32x4*)(rowp + bj * 128), pack8(a, b)); }
            }
    }
};

struct EpiMerge {
    static constexpr bool PERM = true, AFTER_DRAIN = false;
    bf16* Y; const bf16* G0; long g1off; int gld; int gsplit_tiles;
    int first; int dry;
    __device__ __forceinline__ void operator()(const f32x4 (&acc)[2][2][4][2], const Unit& u, int wr, int wc, int fr, int fq) const {
        const int R0 = u.pm * 256, pn = u.pn, cin = 32 * wc + 8 * fq;
        const bf16* gb = G0 + (pn < gsplit_tiles ? (long)pn * 256 : g1off + (long)(pn - gsplit_tiles) * 256);
#pragma unroll
        for (int ai = 0; ai < 2; ++ai)
#pragma unroll
            for (int m = 0; m < 4; ++m) {
                const int r = R0 + ai * 128 + wr * 64 + m * 16 + fr; bf16* yp = Y + (size_t)r * DM + pn * 256 + cin; const bf16* gp = gb + (size_t)r * gld + cin;
#pragma unroll
                for (int bj = 0; bj < 2; ++bj) {
                    const u32x4 gw = *(const GAS u32x4*)(gp + bj * 128); f32x4 ga, gb2; unpack8(gw, ga, gb2);
                    f32x4 a = acc[ai][bj][m][0] * ga, b = acc[ai][bj][m][1] * gb2;
                    if (!first) { const u32x4 yw = *(const GAS u32x4*)(yp + bj * 128); f32x4 ya, yb; unpack8(yw, ya, yb); a += ya; b += yb; }
                    if (!dry) *(GAS u32x4*)(yp + bj * 128) = pack8(a, b); }
            }
    }
};

template <bool INF32>
struct EpiResid {
    static constexpr bool PERM = true, AFTER_DRAIN = false;
    const void* xb; bf16* xo; long cbd; const float* modl; int slot; int dry;
    __device__ __forceinline__ void operator()(const f32x4 (&acc)[2][2][4][2], const Unit& u, int wr, int wc, int fr, int fq) const {
        const int R0 = u.pm * 256; const bool isctx = R0 >= ML; const int b = isctx ? 16 : (R0 >> 12);
        const int col0 = u.pn * 256 + wc * 32 + 8 * fq; const float* gp = modl + (size_t)b * 6144 + slot * 1024 + col0;
        f32x4 gv[2][2];
#pragma unroll
        for (int bj = 0; bj < 2; ++bj)
#pragma unroll
            for (int n = 0; n < 2; ++n) gv[bj][n] = *(const GAS f32x4*)(gp + bj * 128 + n * 4);
#pragma unroll
        for (int ai = 0; ai < 2; ++ai)
#pragma unroll
            for (int m = 0; m < 4; ++m) { const size_t off = (size_t)(R0 + ai * 128 + wr * 64 + m * 16 + fr) * DM + col0;
#pragma unroll
                for (int bj = 0; bj < 2; ++bj) {
                    f32x4 b0, b1;
                    if constexpr (INF32) { const float* base = (const float*)xb + (isctx ? cbd : 0l); b0 = *(const GAS f32x4*)(base + off + bj * 128); b1 = *(const GAS f32x4*)(base + off + bj * 128 + 4); }
                    else { const u32x4 w = *(const GAS u32x4*)((const bf16*)xb + off + bj * 128); unpack8(w, b0, b1); }
                    const f32x4 r0 = b0 + gv[bj][0] * acc[ai][bj][m][0], r1 = b1 + gv[bj][1] * acc[ai][bj][m][1];
                    u32x4 o; o.x = pg8::cvt_pk_bf16(r0[0], r0[1]); o.y = pg8::cvt_pk_bf16(r0[2], r0[3]); o.z = pg8::cvt_pk_bf16(r1[0], r1[1]); o.w = pg8::cvt_pk_bf16(r1[2], r1[3]);
                    if (!dry) *(GAS u32x4*)(xo + off + bj * 128) = o; }
            }
    }
};

struct EpiSwiGLU {
    static constexpr bool PERM = true, AFTER_DRAIN = false;
    bf16* ACT; int ld, pm0, npe;
    __device__ __forceinline__ void operator()(const f32x4 (&acc)[2][2][4][2], const Unit& u, int wr, int wc, int fr, int fq) const {
        const int R0 = (u.pm - pm0) * 256, jt = u.pn % npe, c0 = jt * 128 + 32 * wc + 8 * fq;
#pragma unroll
        for (int ai = 0; ai < 2; ++ai)
#pragma unroll
            for (int m = 0; m < 4; ++m) {
                const int r = R0 + ai * 128 + wr * 64 + m * 16 + fr; f32x4 a, b;
#pragma unroll
                for (int q = 0; q < 4; ++q) { a[q] = silu_f(acc[ai][0][m][0][q]) * acc[ai][1][m][0][q]; b[q] = silu_f(acc[ai][0][m][1][q]) * acc[ai][1][m][1][q]; }
#ifdef NT_ACT
                __builtin_nontemporal_store(pack8(a, b), (GAS u32x4*)(ACT + (size_t)r * ld + c0)); }
#else
                *(GAS u32x4*)(ACT + (size_t)r * ld + c0) = pack8(a, b); }
#endif
    }
};

struct EpiStoreBf16 {
    static constexpr bool PERM = true, AFTER_DRAIN = false;
    bf16* O; int ld, pm0, npe;
    __device__ __forceinline__ void operator()(const f32x4 (&acc)[2][2][4][2], const Unit& u, int wr, int wc, int fr, int fq) const {
        const int R0 = (pm0 + u.pm) * 256, c0 = (u.pn % npe) * 256 + 32 * wc + 8 * fq;
#pragma unroll
        for (int ai = 0; ai < 2; ++ai)
#pragma unroll
            for (int m = 0; m < 4; ++m) { bf16* rowp = O + (size_t)(R0 + ai * 128 + wr * 64 + m * 16 + fr) * ld + c0;
#pragma unroll
#ifdef NT_PAIR
                for (int bj = 0; bj < 2; ++bj) __builtin_nontemporal_store(pack8(acc[ai][bj][m][0], acc[ai][bj][m][1]), (GAS u32x4*)(rowp + bj * 128)); }
#else
                for (int bj = 0; bj < 2; ++bj) *(GAS u32x4*)(rowp + bj * 128) = pack8(acc[ai][bj][m][0], acc[ai][bj][m][1]); }
#endif
    }
};

struct MoeOrder {
    static constexpr bool GATHER = false;
    pg8::StaticOrder so; int tile0, npe; bool a_global; const volatile LAS int* offl;
    __device__ __forceinline__ bool next(int i, Unit& u) const {
        Unit v; if (!so.next(i, v)) return false;
        const int gt = tile0 + v.pm, row = gt * 256; int e = 0;
#pragma unroll
        for (int q = 1; q < 8; ++q) e += (offl[q] <= row) ? 1 : 0;
        u.pm = a_global ? gt : v.pm; u.pn = e * npe + v.pn; return true;
    }
    __device__ __forceinline__ void a_ready(const Unit&) const {}
    __device__ __forceinline__ void done(const Unit&) const {}
};

struct MoeOrderG {
    static constexpr bool GATHER = true;
    MoeOrder mo; const unsigned* rowmap;
    __device__ __forceinline__ bool next(int i, Unit& u) const { return mo.next(i, u); }
    __device__ __forceinline__ void a_ready(const Unit&) const {}
    __device__ __forceinline__ void done(const Unit&) const {}
};

struct GateOrder {
    static constexpr bool GATHER = false;
    pg8::StaticOrder so;
    __device__ __forceinline__ bool next(int i, Unit& u) const { Unit v; if (!so.next(i / 3, v)) return false; u.pm = v.pm; u.pn = v.pn + 4 * (i % 3); return true; }
    __device__ __forceinline__ void a_ready(const Unit&) const {}
    __device__ __forceinline__ void done(const Unit&) const {}
};

struct BigOrderL1 {
    static constexpr bool GATHER = false;
    pg8::StaticOrder so; int G, c;
    __device__ __forceinline__ bool next(int i, Unit& u) const {
        const int L = i * G + c, nlat = (ML / 256) * (NBIG / 256);
        if (L < nlat) return so.next(i, u);
        const int k = L - nlat; if (k >= (MC / 256) * 8) return false;
        u.pm = ML / 256 + (k >> 3); u.pn = 4 + (k & 7); return true;
    }
    __device__ __forceinline__ void a_ready(const Unit&) const {}
    __device__ __forceinline__ void done(const Unit&) const {}
};


namespace att {
using bf16x8 = __attribute__((ext_vector_type(8))) short;
using s16x4  = __attribute__((ext_vector_type(4))) short;
using f32x16 = __attribute__((ext_vector_type(16))) float;
constexpr int NW = 8, QBLK = 32, KVBLK = 64, LD = 1024;
constexpr int SHM_V = KVBLK * 128 * 2, SHM_K = KVBLK * 128 * 2, SHM_ATTN = 2 * SHM_V + 2 * SHM_K + NW * 64 * 4;
#define KSWZ(row, colB) ((row) * 256 + ((colB) ^ (((row) & 7) << 4)))
#define SBAR() __builtin_amdgcn_sched_barrier(0)
__device__ __forceinline__ int crow(int r, int hi) { return (r & 3) + 8 * (r >> 2) + 4 * hi; }
__device__ __forceinline__ unsigned cvtpk(float lo, float hi) { return pg8::cvt_pk_bf16(lo, hi); }

__device__ __forceinline__ void partialSM(f32x16& p0) {
#pragma unroll
  for (int r = 0; r < 16; ++r) p0[r] = __builtin_amdgcn_exp2f(p0[r]);
}
__device__ __forceinline__ void finishSM(f32x16& p0, f32x16& p1, float& l_reg, bf16x8& pa0, bf16x8& pa1, bf16x8& pa2, bf16x8& pa3) {
#pragma unroll
  for (int r = 0; r < 16; ++r) p1[r] = __builtin_amdgcn_exp2f(p1[r]);
  float ps = 0;
#pragma unroll
  for (int r = 0; r < 16; ++r) ps += p0[r];
#pragma unroll
  for (int r = 0; r < 16; ++r) ps += p1[r];
  l_reg += ps;
#define PK4(P, BASE, OUT) do { unsigned a0 = cvtpk(P[BASE + 0], P[BASE + 1]), a1 = cvtpk(P[BASE + 2], P[BASE + 3]);   \
    unsigned b0 = cvtpk(P[BASE + 4], P[BASE + 5]), b1 = cvtpk(P[BASE + 6], P[BASE + 7]);                              \
    auto r0 = __builtin_amdgcn_permlane32_swap(a0, b0, false, false); auto r1 = __builtin_amdgcn_permlane32_swap(a1, b1, false, false); \
    u32x4 w = {r0[0], r1[0], r0[1], r1[1]}; OUT = __builtin_bit_cast(bf16x8, w); } while (0)
  PK4(p0, 0, pa0); PK4(p0, 8, pa1); PK4(p1, 0, pa2); PK4(p1, 8, pa3);
#undef PK4
}
__device__ __forceinline__ void qkt(f32x16& p0, f32x16& p1, const LAS char* Ks, const bf16x8* qr, int r32, int hi, int mp) {
  p0 = f32x16{}; p1 = f32x16{};
#ifdef ATT_PRIO
  __builtin_amdgcn_s_setprio(1);
#endif
#pragma unroll
  for (int d0 = 0; d0 < 4; ++d0) { const int cb = (mp * 64 + d0 * 16 + hi * 8) * 2;
    const bf16x8 b0 = *(const LAS bf16x8*)(Ks + KSWZ(r32, cb));
    const bf16x8 b1 = *(const LAS bf16x8*)(Ks + KSWZ(32 + r32, cb));
    p0 = __builtin_amdgcn_mfma_f32_32x32x16_bf16(b0, qr[d0], p0, 0, 0, 0);
    p1 = __builtin_amdgcn_mfma_f32_32x32x16_bf16(b1, qr[d0], p1, 0, 0, 0); }
#ifdef ATT_PRIO
  __builtin_amdgcn_s_setprio(0);
#endif
}
__device__ __forceinline__ int v_st(int k, int c) { const int kk = (k & ~0xC) | ((k & 4) << 1) | ((k & 8) >> 1); return ((kk >> 3) * 4 + (c >> 5)) * 512 + ((kk & 7) * 32 + (c & 31)) * 2; }
__device__ __forceinline__ int v_rd_base(int lane) { return ((lane & 3) << 3) | (((lane >> 2) & 3) << 6) | (((lane >> 4) & 1) << 5) | (((lane >> 5) & 1) << 8); }
constexpr int v_rd_off(int d0, int ks, int half) { return d0 * 512 + ks * 4096 + half * 2048; }
template <int OFF> __device__ __forceinline__ s16x4 tr_read(int vb) {
  s16x4 r; asm volatile("ds_read_b64_tr_b16 %0, %1 offset:%2" : "=&v"(r) : "v"(vb), "i"(OFF) : "memory"); return r;
}
template <int D0> __device__ __forceinline__ void pv_one(f32x16& od, int vb, bf16x8 pa0, bf16x8 pa1, bf16x8 pa2, bf16x8 pa3) {
  const s16x4 l0 = tr_read<v_rd_off(D0, 0, 0)>(vb), h0 = tr_read<v_rd_off(D0, 0, 1)>(vb), l1 = tr_read<v_rd_off(D0, 1, 0)>(vb), h1 = tr_read<v_rd_off(D0, 1, 1)>(vb);
  const s16x4 l2 = tr_read<v_rd_off(D0, 2, 0)>(vb), h2 = tr_read<v_rd_off(D0, 2, 1)>(vb), l3 = tr_read<v_rd_off(D0, 3, 0)>(vb), h3 = tr_read<v_rd_off(D0, 3, 1)>(vb);
  asm volatile("s_waitcnt lgkmcnt(0)" ::: "memory"); SBAR();
#define PK(L, H) (bf16x8){L[0], L[1], L[2], L[3], H[0], H[1], H[2], H[3]}
  od = __builtin_amdgcn_mfma_f32_32x32x16_bf16(pa0, PK(l0, h0), od, 0, 0, 0);
  od = __builtin_amdgcn_mfma_f32_32x32x16_bf16(pa1, PK(l1, h1), od, 0, 0, 0);
  od = __builtin_amdgcn_mfma_f32_32x32x16_bf16(pa2, PK(l2, h2), od, 0, 0, 0);
  od = __builtin_amdgcn_mfma_f32_32x32x16_bf16(pa3, PK(l3, h3), od, 0, 0, 0);
#undef PK
}
__device__ __forceinline__ void pv_d0(f32x16* o, int vb, bf16x8 pa0, bf16x8 pa1, bf16x8 pa2, bf16x8 pa3) {
  pv_one<0>(o[0], vb, pa0, pa1, pa2, pa3); pv_one<1>(o[1], vb, pa0, pa1, pa2, pa3); pv_one<2>(o[2], vb, pa0, pa1, pa2, pa3); pv_one<3>(o[3], vb, pa0, pa1, pa2, pa3);
}

struct VFrag { s16x4 l0, h0, l1, h1, l2, h2, l3, h3; };
template <int D0> __device__ __forceinline__ void v_load(VFrag& f, int vb) {
  f.l0 = tr_read<v_rd_off(D0, 0, 0)>(vb); f.h0 = tr_read<v_rd_off(D0, 0, 1)>(vb); f.l1 = tr_read<v_rd_off(D0, 1, 0)>(vb); f.h1 = tr_read<v_rd_off(D0, 1, 1)>(vb);
  f.l2 = tr_read<v_rd_off(D0, 2, 0)>(vb); f.h2 = tr_read<v_rd_off(D0, 2, 1)>(vb); f.l3 = tr_read<v_rd_off(D0, 3, 0)>(vb); f.h3 = tr_read<v_rd_off(D0, 3, 1)>(vb);
}
__device__ __forceinline__ void pv_mma(f32x16& od, const VFrag& f, bf16x8 pa0, bf16x8 pa1, bf16x8 pa2, bf16x8 pa3) {
#define PK(L, H) (bf16x8){L[0], L[1], L[2], L[3], H[0], H[1], H[2], H[3]}
#ifdef ATT_PRIO
  __builtin_amdgcn_s_setprio(1);
#endif
  od = __builtin_amdgcn_mfma_f32_32x32x16_bf16(pa0, PK(f.l0, f.h0), od, 0, 0, 0);
  od = __builtin_amdgcn_mfma_f32_32x32x16_bf16(pa1, PK(f.l1, f.h1), od, 0, 0, 0);
  od = __builtin_amdgcn_mfma_f32_32x32x16_bf16(pa2, PK(f.l2, f.h2), od, 0, 0, 0);
  od = __builtin_amdgcn_mfma_f32_32x32x16_bf16(pa3, PK(f.l3, f.h3), od, 0, 0, 0);
#ifdef ATT_PRIO
  __builtin_amdgcn_s_setprio(0);
#endif
#undef PK
}
#define LWAIT(n) do { asm volatile("s_waitcnt lgkmcnt(" #n ")" ::: "memory"); SBAR(); } while (0)
__device__ __forceinline__ void pv_pipe(f32x16* o, int vb, VFrag& f0, bf16x8 pa0, bf16x8 pa1, bf16x8 pa2, bf16x8 pa3) {
  VFrag f1;
  v_load<1>(f1, vb); LWAIT(8); pv_mma(o[0], f0, pa0, pa1, pa2, pa3); SBAR();
  v_load<2>(f0, vb); LWAIT(8); pv_mma(o[1], f1, pa0, pa1, pa2, pa3); SBAR();
  v_load<3>(f1, vb); LWAIT(8); pv_mma(o[2], f0, pa0, pa1, pa2, pa3); SBAR();
  LWAIT(0); pv_mma(o[3], f1, pa0, pa1, pa2, pa3);
}

#ifndef ATT_VPIPE
#define ATT_VPIPE 1
#endif
#if ATT_VPIPE
#define ATT_STEP_BODY(b) qkt(p0, p1, K_lds + (b) * SHM_K, qr, r32, hi, mp); SBAR(); VFrag vf0; v_load<0>(vf0, vb0 + (b) * SHM_V); SBAR(); \
    partialSM(p0); finishSM(p0, p1, l_reg, pa0, pa1, pa2, pa3); SBAR(); pv_pipe(o, vb0 + (b) * SHM_V, vf0, pa0, pa1, pa2, pa3); SBAR();
#else
#define ATT_STEP_BODY(b) qkt(p0, p1, K_lds + (b) * SHM_K, qr, r32, hi, mp); partialSM(p0); finishSM(p0, p1, l_reg, pa0, pa1, pa2, pa3); SBAR(); pv_d0(o, vb0 + (b) * SHM_V, pa0, pa1, pa2, pa3); SBAR();
#endif
__device__ __forceinline__ void diff_attn_unit(const bf16* Qb_, const bf16* Kh_, const bf16* Vh_, bf16* Ob_, int NT,
                                               float lam, const float* subg_, float oml, LAS char* lds, bool dostore = true, int rot = 0) {
  const GAS bf16* Qb = (const GAS bf16*)Qb_; const GAS bf16* Kh = (const GAS bf16*)Kh_; const GAS bf16* Vh = (const GAS bf16*)Vh_; GAS bf16* Ob = (GAS bf16*)Ob_; const GAS float* subg = (const GAS float*)subg_;
  const int tid = threadIdx.x, wid = tid >> 6, lane = tid & 63, r32 = lane & 31, hi = lane >> 5, qg = wid >> 1, mp = wid & 1;
  LAS char* V_lds = lds; LAS char* K_lds = lds + 2 * SHM_V;
  LAS float* ws = (LAS float*)(lds + 2 * SHM_V + 2 * SHM_K) + wid * 64; LAS float* li_l = ws; LAS float* al_l = ws + 32;
  float l_reg = 0; f32x16 o[4] = {}; bf16x8 qr[4];
  const GAS bf16* Qw = Qb + (long)(qg * QBLK + r32) * LD + mp * 64 + hi * 8;
#pragma unroll
  for (int d0 = 0; d0 < 4; ++d0) qr[d0] = *(const GAS bf16x8*)(Qw + d0 * 16);
  const int vb0 = (int)(unsigned)(uintptr_t)V_lds + v_rd_base(lane);
  int offK[2], offV[2];
#pragma unroll
  for (int i = 0; i < 2; ++i) { const int c = wid * 2 + i;
    { const int row = 4 * c + (lane >> 4), p = (lane & 15) ^ (row & 7); offK[i] = row * LD + p * 8; }
    { const int st = 2 * c + (lane >> 5), li = lane & 31, kk = (st >> 2) * 8 + (li >> 2), col = (st & 3) * 32 + (li & 3) * 8, k = (kk & ~0xC) | ((kk & 8) >> 1) | ((kk & 4) << 1); offV[i] = k * LD + col; } }
#define DMA_TILE(b, k0) do { _Pragma("unroll") for (int i_ = 0; i_ < 2; ++i_) {                                                                              \
      __builtin_amdgcn_global_load_lds((const GAS unsigned*)(Kh + (long)(k0) * LD + offK[i_]), (LAS unsigned*)(K_lds + (b) * SHM_K + (wid * 2 + i_) * 1024), 16, 0, 0);  \
      __builtin_amdgcn_global_load_lds((const GAS unsigned*)(Vh + (long)(k0) * LD + offV[i_]), (LAS unsigned*)(V_lds + (b) * SHM_V + (wid * 2 + i_) * 1024), 16, 0, 0); } } while (0)
#define TILE_STEP(b, t) do { f32x16 p0, p1; bf16x8 pa0, pa1, pa2, pa3; SBAR();                                   \
    ATT_STEP_BODY(b)                                                                                              \
    asm volatile("s_waitcnt vmcnt(0)" ::: "memory"); __syncthreads();                                            \
    if ((t) + 2 < NT) DMA_TILE(b, KT((t) + 2) * KVBLK); } while (0)
#define KT(t_) (((t_) + rot) >= NT ? ((t_) + rot) - NT : ((t_) + rot))
  DMA_TILE(0, KT(0) * KVBLK); DMA_TILE(1, KT(1) * KVBLK); asm volatile("s_waitcnt vmcnt(0)" ::: "memory"); __syncthreads();
  for (int t = 0; t < NT; t += 2) { TILE_STEP(0, t); TILE_STEP(1, t + 1); }
#undef TILE_STEP
#undef DMA_TILE
#undef KT
  int lane_e = lane;
#if 1
  asm volatile("" : "+v"(lane_e));
#endif
  { auto rr = __builtin_amdgcn_permlane32_swap(__float_as_uint(l_reg), __float_as_uint(l_reg), false, false); l_reg = __uint_as_float(rr[0]) + __uint_as_float(rr[1]); }
  if (hi == 0) li_l[r32] = l_reg; asm volatile("s_waitcnt lgkmcnt(0)" ::: "memory");
  const int r32e = lane_e & 31, hie = lane_e >> 5;
  float rli[16];
#pragma unroll
  for (int r = 0; r < 16; ++r) rli[r] = __builtin_amdgcn_rcpf(li_l[crow(r, hie)]);
  __syncthreads();
  LAS float* X = (LAS float*)lds + qg * 4096;
  if (mp == 1) {
#pragma unroll
    for (int d0 = 0; d0 < 4; ++d0)
#pragma unroll
      for (int r = 0; r < 16; ++r) X[(d0 * 16 + r) * 64 + lane_e] = o[d0][r] * rli[r] * (-lam);
  }
  __syncthreads();
  if (mp == 0) {
#pragma unroll
    for (int d0 = 0; d0 < 4; ++d0) {
#pragma unroll
      for (int r = 0; r < 16; ++r) o[d0][r] = o[d0][r] * rli[r] + X[(d0 * 16 + r) * 64 + lane_e];
      asm volatile("" ::: "memory");
    }
    float g4[4];
#pragma unroll
    for (int d0 = 0; d0 < 4; ++d0) g4[d0] = subg[32 * d0 + r32e] * oml;
    GAS bf16* Ow = Ob + (long)(qg * QBLK) * LD;
#pragma unroll
    for (int r = 0; r < 16; ++r) {
      float ss = (o[0][r] * o[0][r] + o[1][r] * o[1][r]) + (o[2][r] * o[2][r] + o[3][r] * o[3][r]);
      ss += __shfl_xor(ss, 1); ss += __shfl_xor(ss, 2); ss += __shfl_xor(ss, 4); ss += __shfl_xor(ss, 8); ss += __shfl_xor(ss, 16);
      const float rs = 1.0f / sqrtf(ss * (1.f / 128.f) + EPS); const int orow = crow(r, hie);
#pragma unroll
      for (int d0 = 0; d0 < 4; ++d0) if (dostore) Ow[(long)orow * LD + d0 * 32 + r32e] = (bf16)f2bf(o[d0][r] * rs * g4[d0]);
    }
  }
  __syncthreads();
}

template <bool CTX>
__device__ __forceinline__ void diff_attn_units(const bf16* Q_, const bf16* K_, const bf16* V_, int first, int count, int stride,
                                                float lam, const float* subg_, float oml, LAS char* lds) {
  constexpr int NT = CTX ? CTXL / 64 : SKV / 64;
  if (first >= count) return;
  const GAS bf16* Qg = (const GAS bf16*)Q_; const GAS bf16* Kg = (const GAS bf16*)K_; const GAS bf16* Vg = (const GAS bf16*)V_; const GAS float* subg = (const GAS float*)subg_;
  const int tid = threadIdx.x, wid = tid >> 6, lane = tid & 63, r32 = lane & 31, hi = lane >> 5, qg = wid >> 1, mp = wid & 1;
  LAS char* V_lds = lds; LAS char* K_lds = lds + 2 * SHM_V;
  LAS float* ws = (LAS float*)(lds + 2 * SHM_V + 2 * SHM_K) + wid * 64; LAS float* li_l = ws;
  LAS float* X = (LAS float*)(lds + SHM_ATTN) + qg * 4096;
  const int vb0 = (int)(unsigned)(uintptr_t)V_lds + v_rd_base(lane);
  int offK[2], offV[2];
#pragma unroll
  for (int i = 0; i < 2; ++i) { const int c = wid * 2 + i;
    { const int row = 4 * c + (lane >> 4), p = (lane & 15) ^ (row & 7); offK[i] = row * LD + p * 8; }
    { const int st = 2 * c + (lane >> 5), li = lane & 31, kk = (st >> 2) * 8 + (li >> 2), col = (st & 3) * 32 + (li & 3) * 8, k = (kk & ~0xC) | ((kk & 8) >> 1) | ((kk & 4) << 1); offV[i] = k * LD + col; } }
#define UNIT_Q(u_) (CTX ? ((size_t)ML + ((u_) >> 4) * CTXL + ((u_) & 1) * 128) * DM + (((u_) >> 1) & 7) * 128 : ((size_t)((u_) >> 8) * SEQ + ((u_) & 31) * 128) * DM + (((u_) >> 5) & 7) * 128)
#define UNIT_K(u_) (CTX ? ((size_t)((u_) >> 4) * SKV + SEQ) * DM + (((u_) >> 1) & 7) * 128 : (size_t)((u_) >> 8) * SKV * DM + (((u_) >> 5) & 7) * 128)
#define UNIT_ROT(u_) (CTX ? 0 : ((u_) & 31) * 2)
#define DMA_TILE(b, k0) do { _Pragma("unroll") for (int i_ = 0; i_ < 2; ++i_) {                                                                              \
      __builtin_amdgcn_global_load_lds((const GAS unsigned*)(Kh + (long)(k0) * LD + offK[i_]), (LAS unsigned*)(K_lds + (b) * SHM_K + (wid * 2 + i_) * 1024), 16, 0, 0);  \
      __builtin_amdgcn_global_load_lds((const GAS unsigned*)(Vh + (long)(k0) * LD + offV[i_]), (LAS unsigned*)(V_lds + (b) * SHM_V + (wid * 2 + i_) * 1024), 16, 0, 0); } } while (0)
#define KT(t_) (((t_) + rot) >= NT ? ((t_) + rot) - NT : ((t_) + rot))
#define TILE_STEP(b, t) do { f32x16 p0, p1; bf16x8 pa0, pa1, pa2, pa3; SBAR();                                   \
    ATT_STEP_BODY(b)                                                                                              \
    asm volatile("s_waitcnt vmcnt(0)" ::: "memory"); __syncthreads();                                            \
    if ((t) + 2 < NT) DMA_TILE(b, KT((t) + 2) * KVBLK); } while (0)
  int u = first; int rot = UNIT_ROT(u);
  const GAS bf16* Kh = Kg + UNIT_K(u); const GAS bf16* Vh = Vg + UNIT_K(u); size_t qoff = UNIT_Q(u);
  bf16x8 qr[4];
  { const GAS bf16* Qw = Qg + qoff + (long)(qg * QBLK + r32) * LD + mp * 64 + hi * 8;
#pragma unroll
    for (int d0 = 0; d0 < 4; ++d0) qr[d0] = *(const GAS bf16x8*)(Qw + d0 * 16); }
  DMA_TILE(0, KT(0) * KVBLK); DMA_TILE(1, KT(1) * KVBLK); asm volatile("s_waitcnt vmcnt(0)" ::: "memory"); __syncthreads();
  for (;;) {
    float l_reg = 0; f32x16 o[4] = {};
    for (int t = 0; t < NT; t += 2) { TILE_STEP(0, t); TILE_STEP(1, t + 1); }
    GAS bf16* Ob = (GAS bf16*)Qg + qoff;
    const int un = u + stride; const bool has_next = un < count;
    if (has_next) {
      rot = UNIT_ROT(un); Kh = Kg + UNIT_K(un); Vh = Vg + UNIT_K(un); qoff = UNIT_Q(un);
      const GAS bf16* Qw = Qg + qoff + (long)(qg * QBLK + r32) * LD + mp * 64 + hi * 8;
#pragma unroll
      for (int d0 = 0; d0 < 4; ++d0) qr[d0] = *(const GAS bf16x8*)(Qw + d0 * 16);
      DMA_TILE(0, KT(0) * KVBLK); DMA_TILE(1, KT(1) * KVBLK);
    }
    int lane_e = lane; asm volatile("" : "+v"(lane_e));
    { auto rr = __builtin_amdgcn_permlane32_swap(__float_as_uint(l_reg), __float_as_uint(l_reg), false, false); l_reg = __uint_as_float(rr[0]) + __uint_as_float(rr[1]); }
    if (hi == 0) li_l[r32] = l_reg; asm volatile("s_waitcnt lgkmcnt(0)" ::: "memory");
    const int r32e = lane_e & 31, hie = lane_e >> 5;
    float rli[16];
#pragma unroll
    for (int r = 0; r < 16; ++r) rli[r] = __builtin_amdgcn_rcpf(li_l[crow(r, hie)]);
    if (mp == 1) {
#pragma unroll
      for (int d0 = 0; d0 < 4; ++d0)
#pragma unroll
        for (int r = 0; r < 16; ++r) X[(d0 * 16 + r) * 64 + lane_e] = o[d0][r] * rli[r] * (-lam);
    }
    asm volatile("s_waitcnt lgkmcnt(0)" ::: "memory"); __builtin_amdgcn_s_barrier(); asm volatile("" ::: "memory");
    if (mp == 0) {
#pragma unroll
      for (int d0 = 0; d0 < 4; ++d0) {
#pragma unroll
        for (int r = 0; r < 16; ++r) o[d0][r] = o[d0][r] * rli[r] + X[(d0 * 16 + r) * 64 + lane_e];
        asm volatile("" ::: "memory");
      }
      float g4[4];
#pragma unroll
      for (int d0 = 0; d0 < 4; ++d0) g4[d0] = subg[32 * d0 + r32e] * oml;
      GAS bf16* Ow = Ob + (long)(qg * QBLK) * LD;
#pragma unroll
      for (int r = 0; r < 16; ++r) {
        float ss = (o[0][r] * o[0][r] + o[1][r] * o[1][r]) + (o[2][r] * o[2][r] + o[3][r] * o[3][r]);
        ss += __shfl_xor(ss, 1); ss += __shfl_xor(ss, 2); ss += __shfl_xor(ss, 4); ss += __shfl_xor(ss, 8); ss += __shfl_xor(ss, 16);
        const float rs = 1.0f / sqrtf(ss * (1.f / 128.f) + EPS); const int orow = crow(r, hie);
#pragma unroll
        for (int d0 = 0; d0 < 4; ++d0) Ow[(long)orow * LD + d0 * 32 + r32e] = (bf16)f2bf(o[d0][r] * rs * g4[d0]);
      }
    }
    asm volatile("s_waitcnt vmcnt(0) lgkmcnt(0)" ::: "memory"); __syncthreads();
    if (!has_next) break;
    u = un;
  }
#undef TILE_STEP
#undef DMA_TILE
#undef KT
#undef UNIT_Q
#undef UNIT_K
#undef UNIT_ROT
}
#undef KSWZ
#undef SBAR
}

constexpr int VT_PITCH = 272;
constexpr int MIX_VT_BYTES = 512 * VT_PITCH;
constexpr int MIX_ST_OFF = MIX_VT_BYTES;
static_assert(MIX_ST_OFF + 1024 <= LDSCTL_OFF, "mixer LDS");
__device__ __forceinline__ void mixer_chunk(const Ctx& C, int ch, bf16* P0, const bf16* P1, bf16* P2, const bf16* P3,
                                            const float* ln_g, const float* ln_b, const bf16* aws  , const float* abs_  , const float* convw  , bool dostore = true) {
    const int row0 = ch * 128, tid = C.tid, lane = C.lane, wid = C.wave;
    LAS unsigned char* VT = C.lds; LAS f32x2* ST = (LAS f32x2*)(C.lds + MIX_ST_OFF);
#pragma unroll 2
    for (int i = 0; i < 16; ++i) {
        const int s = wid * 16 + i; const u32x4 w = *(const GAS u32x4*)(P1 + (size_t)(row0 + s) * 512 + lane * 8);
        f32x4 a, b; unpack8(w, a, b);
        const float mean = wave_sum((a[0] + a[1]) + (a[2] + a[3]) + (b[0] + b[1]) + (b[2] + b[3])) * (1.f / 512.f);
        a = a - mean; b = b - mean;
        const float var = wave_sum((a[0] * a[0] + a[1] * a[1]) + (a[2] * a[2] + a[3] * a[3]) + (b[0] * b[0] + b[1] * b[1]) + (b[2] * b[2] + b[3] * b[3])) * (1.f / 512.f);
        if (lane == 0) ST[s] = (f32x2){mean, 1.0f / sqrtf(var + EPS)};
    }
    __syncthreads();
    {
        const int s = tid & 127, q = tid >> 7; const f32x2 st = ST[s]; const bf16* src = P1 + (size_t)(row0 + s) * 512 + q * 128;
#pragma unroll 2
        for (int i = 0; i < 16; ++i) {
            const int c0 = q * 128 + i * 8; const u32x4 w = *(const GAS u32x4*)(src + i * 8); f32x4 a, b; unpack8(w, a, b);
            const f32x4 g0 = *(const GAS f32x4*)(ln_g + c0), g1 = *(const GAS f32x4*)(ln_g + c0 + 4), b0 = *(const GAS f32x4*)(ln_b + c0), b1 = *(const GAS f32x4*)(ln_b + c0 + 4);
            a = (a - st.x) * st.y * g0 + b0; b = (b - st.x) * st.y * g1 + b1;
#pragma unroll
            for (int e = 0; e < 4; ++e) { *(LAS bf16*)(VT + (c0 + e) * VT_PITCH + s * 2) = (bf16)f2bf(a[e]); *(LAS bf16*)(VT + (c0 + 4 + e) * VT_PITCH + s * 2) = (bf16)f2bf(b[e]); }
        }
    }
    __syncthreads();
    {
        const int g = wid, fr = lane & 15, fq = lane >> 4;
        const bf16* wg = aws + (size_t)g * 128 * 128;
#pragma unroll 1
        for (int th = 0; th < 2; ++th) {
            f32x4 acc[4][4];
#pragma unroll
            for (int ti = 0; ti < 4; ++ti)
#pragma unroll
                for (int ei = 0; ei < 4; ++ei) acc[ti][ei] = (f32x4){0.f, 0.f, 0.f, 0.f};
#pragma unroll 1
            for (int kk = 0; kk < 4; ++kk) {
                bf16x8 xf[4], yf[4];
#pragma unroll
                for (int ei = 0; ei < 4; ++ei) xf[ei] = *(const LAS bf16x8*)(VT + (g * 64 + 16 * ei + fr) * VT_PITCH + (32 * kk + 8 * fq) * 2);
#pragma unroll
                for (int ti = 0; ti < 4; ++ti) yf[ti] = *(const GAS bf16x8*)(wg + (size_t)(64 * th + 16 * ti + fr) * 128 + 32 * kk + 8 * fq);
#pragma unroll
                for (int ti = 0; ti < 4; ++ti)
#pragma unroll
                    for (int ei = 0; ei < 4; ++ei) acc[ti][ei] = __builtin_amdgcn_mfma_f32_16x16x32_bf16(xf[ei], yf[ti], acc[ti][ei], 0, 0, 0);
            }
#pragma unroll
            for (int ti = 0; ti < 4; ++ti) {
                const int t = 64 * th + 16 * ti + fr; const float bs = abs_[g * 128 + t];
#pragma unroll
                for (int ei = 0; ei < 4; ++ei) {
                    bf16* p = P0 + (size_t)(row0 + t) * 512 + g * 64 + 16 * ei + 4 * fq; const v2u uw = *(const GAS v2u*)p;
                    const f32x4 a = acc[ti][ei] + bs;
                    v2u ow; ow.x = cvt_pk_bf16(bf2f(uw.x & 0xffffu) * a[0], bf2f(uw.x >> 16) * a[1]); ow.y = cvt_pk_bf16(bf2f(uw.y & 0xffffu) * a[2], bf2f(uw.y >> 16) * a[3]);
                    if (dostore) *(GAS v2u*)p = ow; }
            }
        }
    }
    {
        const int c0 = lane * 8;
        f32x4 w0a = *(const GAS f32x4*)(convw + c0), w0b = *(const GAS f32x4*)(convw + c0 + 4), w1a = *(const GAS f32x4*)(convw + 512 + c0), w1b = *(const GAS f32x4*)(convw + 512 + c0 + 4),
              w2a = *(const GAS f32x4*)(convw + 1024 + c0), w2b = *(const GAS f32x4*)(convw + 1024 + c0 + 4);
#pragma unroll 2
        for (int i = 0; i < 16; ++i) {
            const int r = row0 + wid * 16 + i; const bool isctx = r >= ML; const int tseq = isctx ? ((r - ML) & 255) : (r & 4095), last = isctx ? 255 : 4095;
            const u32x4 zero = {0u, 0u, 0u, 0u};
            const u32x4 zm = tseq > 0 ? *(const GAS u32x4*)(P3 + (size_t)(r - 1) * 512 + c0) : zero;
            const u32x4 zc = *(const GAS u32x4*)(P3 + (size_t)r * 512 + c0);
            const u32x4 zp = tseq < last ? *(const GAS u32x4*)(P3 + (size_t)(r + 1) * 512 + c0) : zero;
            const u32x4 bw = *(const GAS u32x4*)(P2 + (size_t)r * 512 + c0);
            f32x4 ma, mb, ca, cb, pa, pb, ba, bb; unpack8(zm, ma, mb); unpack8(zc, ca, cb); unpack8(zp, pa, pb); unpack8(bw, ba, bb);
            const f32x4 ya = ba * (w0a * ma + w1a * ca + w2a * pa), yb = bb * (w0b * mb + w1b * cb + w2b * pb);
            if (dostore) *(GAS u32x4*)(P2 + (size_t)r * 512 + c0) = pack8(ya, yb);
        }
    }
    __syncthreads();
}

__device__ __forceinline__ void route_phase(const Ctx& C, const bf16* x, const float* gn, const float* modl, const float* w_router, bf16* H, unsigned* route, unsigned long long* cnt_tab, bool dry = false) {
    LAS float* Wl = (LAS float*)C.lds;
    for (int idx = C.tid; idx < 8192; idx += NTHREADS) { const int k = idx >> 3, e = idx & 7; Wl[((k & 3) + 4 * (k >> 8)) * 512 + ((k >> 2) & 63) * 8 + e] = w_router[idx]; }
    __syncthreads();
    const int RPW = (ML + C.NGW - 1) / C.NGW;
    const int lane = C.lane; const int r0 = C.gw * RPW;
    unsigned long long lc = 0ull;
    unsigned my_e = 0u, my_p = 0u; float my_w1 = 0.f, my_w2 = 0.f;
    f32x4 mg[4], msc[4], msh[4]; v2u raw[4];
    { const int bq = (r0 < ML ? r0 : 0) >> 12; const float* scv = modl + (size_t)bq * 6144 + 4 * 1024; const float* shv = modl + (size_t)bq * 6144 + 3 * 1024;
#pragma unroll
      for (int j = 0; j < 4; ++j) { mg[j] = ((const GAS f32x4*)gn)[lane + 64 * j]; msc[j] = ((const GAS f32x4*)scv)[lane + 64 * j]; msh[j] = ((const GAS f32x4*)shv)[lane + 64 * j]; }
      const int rq = r0 < ML ? r0 : 0;
#pragma unroll
      for (int j = 0; j < 4; ++j) raw[j] = ((const GAS v2u*)(x + (size_t)rq * DM))[lane + 64 * j]; }
    for (int it = 0; it < RPW; ++it) {
        const int r = r0 + it; if (r >= ML) break;
        if ((r >> 12) != (r0 >> 12) && (r & 4095) == 0) {
            const float* scv = modl + (size_t)(r >> 12) * 6144 + 4 * 1024; const float* shv = modl + (size_t)(r >> 12) * 6144 + 3 * 1024;
#pragma unroll
            for (int j = 0; j < 4; ++j) { msc[j] = ((const GAS f32x4*)scv)[lane + 64 * j]; msh[j] = ((const GAS f32x4*)shv)[lane + 64 * j]; } }
        v2u nraw[4]; const int rn = (it + 1 < RPW && r + 1 < ML) ? r + 1 : r;
#pragma unroll
        for (int j = 0; j < 4; ++j) nraw[j] = ((const GAS v2u*)(x + (size_t)rn * DM))[lane + 64 * j];
        f32x4 y[4];
        { f32x4 v[4]; float ss = 0.f;
#pragma unroll
          for (int j = 0; j < 4; ++j) { v[j][0] = bf2f(raw[j].x & 0xffffu); v[j][1] = bf2f(raw[j].x >> 16); v[j][2] = bf2f(raw[j].y & 0xffffu); v[j][3] = bf2f(raw[j].y >> 16);
              ss += (v[j].x * v[j].x + v[j].y * v[j].y) + (v[j].z * v[j].z + v[j].w * v[j].w); }
          const float rstd = 1.0f / sqrtf(wave_sum(ss) * (1.f / 1024.f) + EPS);
          GAS v2u* o8 = (GAS v2u*)(H + (size_t)r * DM) + lane;
#pragma unroll
          for (int j = 0; j < 4; ++j) { y[j] = (v[j] * rstd) * mg[j] * (msc[j] + 1.0f) + msh[j];
              v2u w; w.x = pg8::cvt_pk_bf16(y[j].x, y[j].y); w.y = pg8::cvt_pk_bf16(y[j].z, y[j].w); o8[64 * j] = w; }
#pragma unroll
          for (int j = 0; j < 4; ++j) raw[j] = nraw[j]; }
        float lg[8];
#pragma unroll
        for (int e = 0; e < 8; ++e) lg[e] = 0.f;
#pragma unroll
        for (int j = 0; j < 4; ++j)
#pragma unroll
            for (int i = 0; i < 4; ++i) { const LAS f32x4* wp = (const LAS f32x4*)(Wl + (i + 4 * j) * 512 + lane * 8); const f32x4 wa = wp[0], wb = wp[1]; const float v = y[j][i];
                lg[0] += v * wa[0]; lg[1] += v * wa[1]; lg[2] += v * wa[2]; lg[3] += v * wa[3]; lg[4] += v * wb[0]; lg[5] += v * wb[1]; lg[6] += v * wb[2]; lg[7] += v * wb[3]; }
#pragma unroll
        for (int e = 0; e < 8; ++e) lg[e] = wave_sum(lg[e]);
        int i1 = 0; float v1 = lg[0];
#pragma unroll
        for (int e = 1; e < 8; ++e) if (lg[e] > v1) { v1 = lg[e]; i1 = e; }
        int i2 = -1; float v2 = -3.0e38f;
#pragma unroll
        for (int e = 0; e < 8; ++e) if (e != i1 && lg[e] > v2) { v2 = lg[e]; i2 = e; }
        const float w1 = 1.f / (1.f + __expf(v2 - v1)), w2 = 1.f - w1;
        const unsigned p1 = (unsigned)(lc >> (8 * i1)) & 0xffu; lc += 1ull << (8 * i1);
        const unsigned p2 = (unsigned)(lc >> (8 * i2)) & 0xffu; lc += 1ull << (8 * i2);
        if (lane == it) { my_e = (unsigned)i1 | ((unsigned)i2 << 8); my_p = p1 | (p2 << 8); my_w1 = w1; my_w2 = w2; }
    }
    if (lane == 0 && !dry) cnt_tab[C.gw] = lc;
    const int r = r0 + lane;
    if (lane < RPW && r < ML && !dry) { u32x4 w; w.x = my_e; w.y = __float_as_uint(my_w1); w.z = __float_as_uint(my_w2); w.w = my_p & 0xffu; *(GAS u32x4*)(route + (size_t)r * 8) = w; route[(size_t)r * 8 + 4] = my_p >> 8; }
}
__device__ __forceinline__ void moe_offsets(const Ctx& C, const unsigned long long* cnt_tab, volatile LAS int* offl) {
    LAS unsigned* pre = (LAS unsigned*)C.lds; LAS unsigned* wsum = (LAS unsigned*)(C.lds + 98304);
    const int NG = C.NGW, per = (NG + NTHREADS - 1) / NTHREADS, lane = C.lane;
    unsigned tot[8], inc[8];
#pragma unroll
    for (int q = 0; q < 8; ++q) tot[q] = 0u;
    for (int i = 0; i < per; ++i) { const int g = C.tid * per + i; const unsigned long long c = g < NG ? cnt_tab[g] : 0ull;
#pragma unroll
        for (int q = 0; q < 8; ++q) tot[q] += (unsigned)(c >> (8 * q)) & 0xffu; }
#pragma unroll
    for (int q = 0; q < 8; ++q) { unsigned v = tot[q];
#pragma unroll
        for (int off = 1; off < 64; off <<= 1) { const unsigned o = __shfl_up(v, off); if (lane >= off) v += o; }
        inc[q] = v; }
    if (lane == 63) {
#pragma unroll
        for (int q = 0; q < 8; ++q) wsum[C.wave * 8 + q] = inc[q]; }
    __syncthreads();
    unsigned run[8];
#pragma unroll
    for (int q = 0; q < 8; ++q) { unsigned wb = 0u; for (int w = 0; w < C.wave; ++w) wb += wsum[w * 8 + q]; run[q] = wb + inc[q] - tot[q]; }
    for (int i = 0; i < per; ++i) { const int g = C.tid * per + i; if (g < NG) { const unsigned long long c = cnt_tab[g];
#pragma unroll
        for (int q = 0; q < 8; ++q) { pre[g * 8 + q] = run[q]; run[q] += (unsigned)(c >> (8 * q)) & 0xffu; } } }
    if (C.tid == NTHREADS - 1) { int o = 0;
#pragma unroll
        for (int q = 0; q < 8; ++q) { const int c = (int)run[q]; offl[q] = o; offl[16 + q] = c; o += (c + 255) & ~255; }
        offl[8] = o; }
    __syncthreads();
}
__device__ __forceinline__ void gather_phase(const Ctx& C, const bf16* H, bf16* HS, unsigned* route, const volatile LAS int* offl) {
    const int lane = C.lane; const LAS unsigned* pre = (const LAS unsigned*)C.lds; const int RPW = (ML + C.NGW - 1) / C.NGW;
    u32x4 wn = {0u, 0u, 0u, 0u}; unsigned p2n = 0u;
    if (C.gw < ML) { wn = *(const GAS u32x4*)(route + (size_t)C.gw * 8); p2n = route[(size_t)C.gw * 8 + 4]; }
    for (int t = C.gw; t < ML; t += C.NGW) {
        const u32x4 w = wn; const unsigned p2 = p2n;
        const GAS u32x4* src = (const GAS u32x4*)(H + (size_t)t * DM) + lane; const u32x4 a = src[0], b = src[64];
        { const int tn = t + C.NGW < ML ? t + C.NGW : t; wn = *(const GAS u32x4*)(route + (size_t)tn * 8); p2n = route[(size_t)tn * 8 + 4]; }
        const int e1 = w.x & 0xff, e2 = (w.x >> 8) & 0xff; const int g = t / RPW; const int s1 = offl[e1] + (int)pre[g * 8 + e1] + (int)w.w, s2 = offl[e2] + (int)pre[g * 8 + e2] + (int)p2;
        GAS u32x4* d1 = (GAS u32x4*)(HS + (size_t)s1 * DM) + lane; GAS u32x4* d2 = (GAS u32x4*)(HS + (size_t)s2 * DM) + lane;
        d1[0] = a; d1[64] = b; d2[0] = a; d2[64] = b;
        if (lane == 0) { route[(size_t)t * 8 + 5] = (unsigned)s1; route[(size_t)t * 8 + 6] = (unsigned)s2; }
    }
    for (int v = C.gw; v < 8 * 256; v += C.NGW) { const int e = v >> 8, i = v & 255; const int row = offl[e] + offl[16 + e] + i;
        if (row < offl[e + 1]) { GAS u32x4* d = (GAS u32x4*)(HS + (size_t)row * DM) + lane; const u32x4 z = {0u, 0u, 0u, 0u}; d[0] = z; d[64] = z; } }
}
__device__ __forceinline__ void rowmap_phase(const Ctx& C, unsigned* rowmap, unsigned* route, const volatile LAS int* offl) {
    const LAS unsigned* pre = (const LAS unsigned*)C.lds; const int RPW = (ML + C.NGW - 1) / C.NGW;
    for (int t = C.vcu * NTHREADS + C.tid; t < ML; t += C.G * NTHREADS) {
        const u32x4 w = *(const GAS u32x4*)(route + (size_t)t * 8); const unsigned p2 = route[(size_t)t * 8 + 4];
        const int e1 = w.x & 0xff, e2 = (w.x >> 8) & 0xff; const int g = t / RPW; const int s1 = offl[e1] + (int)pre[g * 8 + e1] + (int)w.w, s2 = offl[e2] + (int)pre[g * 8 + e2] + (int)p2;
        rowmap[s1] = (unsigned)t; rowmap[s2] = (unsigned)t;
        route[(size_t)t * 8 + 5] = (unsigned)s1; route[(size_t)t * 8 + 6] = (unsigned)s2;
    }
    for (int v = C.vcu * NTHREADS + C.tid; v < 8 * 256; v += C.G * NTHREADS) { const int e = v >> 8, i = v & 255; const int row = offl[e] + offl[16 + e] + i;
        if (row < offl[e + 1]) rowmap[row] = 0u; }
}
__device__ __forceinline__ void final_phase(const Ctx& C, const bf16* x16, float* xo, const bf16* HS, const unsigned* route, const float* modl, const float* fg, bool dry = false) {
    const int lane = C.lane;
    f32x4 fgv[4];
#pragma unroll
    for (int h = 0; h < 2; ++h) { fgv[2 * h] = *(const GAS f32x4*)(fg + h * 512 + lane * 8); fgv[2 * h + 1] = *(const GAS f32x4*)(fg + h * 512 + lane * 8 + 4); }
    u32x4 wn = {0u, 0u, 0u, 0u}; unsigned s1n = 0u, s2n = 0u;
    if (C.gw < ML) { wn = *(const GAS u32x4*)(route + (size_t)C.gw * 8); s1n = route[(size_t)C.gw * 8 + 5]; s2n = route[(size_t)C.gw * 8 + 6]; }
    for (int t = C.gw; t < ML; t += C.NGW) {
        const u32x4 w = wn; const unsigned s1 = s1n, s2 = s2n;
        const float w1 = __uint_as_float(w.y), w2 = __uint_as_float(w.z); const int b = t >> 12;
        const float* g2 = modl + (size_t)b * 6144 + 5 * 1024;
        f32x4 v[4]; float ss = 0.f;
#pragma unroll
        for (int h = 0; h < 2; ++h) {
            const int c0 = h * 512 + lane * 8;
            const u32x4 oa = *(const GAS u32x4*)(HS + (size_t)s1 * DM + c0), ob = *(const GAS u32x4*)(HS + (size_t)s2 * DM + c0);
            f32x4 a0, a1, b0, b1; unpack8(oa, a0, a1); unpack8(ob, b0, b1);
            f32x4 x0, x1; { const u32x4 xw = *(const GAS u32x4*)(x16 + (size_t)t * DM + c0); unpack8(xw, x0, x1); }
            const f32x4 g0 = *(const GAS f32x4*)(g2 + c0), g1 = *(const GAS f32x4*)(g2 + c0 + 4);
            v[2 * h] = x0 + g0 * (a0 * w1 + b0 * w2); v[2 * h + 1] = x1 + g1 * (a1 * w1 + b1 * w2);
        }
        { const int tn = t + C.NGW < ML ? t + C.NGW : t; wn = *(const GAS u32x4*)(route + (size_t)tn * 8); s1n = route[(size_t)tn * 8 + 5]; s2n = route[(size_t)tn * 8 + 6]; }
#pragma unroll
        for (int j = 0; j < 4; ++j) ss += (v[j].x * v[j].x + v[j].y * v[j].y) + (v[j].z * v[j].z + v[j].w * v[j].w);
        const float rstd = 1.0f / sqrtf(wave_sum(ss) * (1.f / 1024.f) + EPS);
#pragma unroll
        for (int h = 0; h < 2; ++h) { const int c0 = h * 512 + lane * 8;
            if (!dry) { *(GAS f32x4*)(xo + (size_t)t * DM + c0) = v[2 * h] * rstd * fgv[2 * h]; *(GAS f32x4*)(xo + (size_t)t * DM + c0 + 4) = v[2 * h + 1] * rstd * fgv[2 * h + 1]; } }
    }
}

#ifdef PROBE
constexpr int PR_BASE = 12288;
__device__ __forceinline__ unsigned hsh(unsigned x) { x ^= x >> 16; x *= 0x7feb352du; x ^= x >> 15; x *= 0x846ca68bu; x ^= x >> 16; return x; }
__device__ __forceinline__ float bfr(float f) { return bf2f(f2bf(f)); }
__device__ __forceinline__ float wdot(const bf16* a, const float* W, int ldw, int col, int K, int lane) {
    float s = 0.f; for (int k = lane; k < K; k += 64) s += bf2f(a[k]) * bfr(W[(size_t)k * ldw + col]); return wave_sum(s);
}
struct Probe {
    gu32* ctl; int tid, lane, wave; LAS float* sh;
    __device__ __forceinline__ void rec(int id, float got, float ref, float tol = 0.03f) const {
        const float err = fabsf(got - ref) / (fabsf(ref) + 0.05f);
        if (!(err <= tol)) { unsigned expect = 0u; if (__hip_atomic_compare_exchange_strong((unsigned*)(ctl + PR_BASE), &expect, (unsigned)id, __ATOMIC_RELAXED, __ATOMIC_RELAXED, __HIP_MEMORY_SCOPE_AGENT)) __hip_atomic_store((unsigned*)(ctl + PR_BASE + 1), __float_as_uint(err > 1e6f ? 1e6f : err), __ATOMIC_RELAXED, __HIP_MEMORY_SCOPE_AGENT); }
        else atomicMax((unsigned*)(ctl + PR_BASE + 2), __float_as_uint(err));
    }
};
#define RAWP(r, col) wdot(Hb + (size_t)(r) * DM, win, INC, (col), 1024, P.lane)

template <int L>
__device__ __forceinline__ void probe_after_mod1(const Probe& P, const Args& args, unsigned char* ws) {
    const float* mod = (const float*)(ws + WS_MOD) + (size_t)L * 17 * 6144; const bf16* Hb = (const bf16*)(ws + WS_H);
    for (int sidx = P.wave; sidx < 48; sidx += 8) {
        const unsigned hh = hsh(sidx * 977u + 13u + L * 7919u); const int b = hh % 17, j = (hh >> 8) % 6144;
        float s = 0.f; for (int k = P.lane; k < 1024; k += 64) { const float v = b < 16 ? args.in[1][b * 1024 + k] : args.in[3][k]; s += v / (1.f + __expf(-v)) * args.in[4][((size_t)L * 1024 + k) * 6144 + j]; }
        s = wave_sum(s) + args.in[5][L * 6144 + j];
        if (P.lane == 0) P.rec(1 + 20 * L, mod[(size_t)b * 6144 + j], s, 0.002f);
    }
    for (int sidx = P.wave; sidx < 64; sidx += 8) {
        const unsigned hh = hsh(sidx * 31337u + 5u + L); int r = hh % MA; if (sidx < 8) r = ML + (hh % MC); const int c = (hh >> 10) & 1023; const int b = r < ML ? (r >> 12) : 16;
        const float* xr = r < ML ? (L == 0 ? args.in[0] : (const float*)args.out) + (size_t)r * DM : (L == 0 ? args.in[2] : (const float*)(ws + WS_XC)) + (size_t)(r - ML) * DM;
        float ss = 0.f; for (int k = P.lane; k < 1024; k += 64) ss += xr[k] * xr[k]; ss = wave_sum(ss);
        const float ref = xr[c] * (1.f / sqrtf(ss / 1024.f + EPS)) * args.in[6][L * 1024 + c] * (1.f + mod[(size_t)b * 6144 + 1024 + c]) + mod[(size_t)b * 6144 + c];
        if (P.lane == 0) P.rec(2 + 20 * L, bf2f(Hb[(size_t)r * DM + c]), ref, 0.01f);
    }
}
template <int L>
__device__ __forceinline__ void probe_after_big(const Probe& P, const Args& args, unsigned char* ws) {
    const bf16* Hb = (const bf16*)(ws + WS_H); const float* win = args.in[8] + (size_t)L * 1024 * INC;
    for (int sidx = P.wave; sidx < 96; sidx += 8) {
        const unsigned hh = hsh(sidx * 7001u + 77u + L * 3u); int r = hh % ML; if ((sidx & 3) == 3) r = ML + (hh % MC);
        const bool isctx = r >= ML; const int b = isctx ? (r - ML) / CTXL : (r >> 12); const int t = isctx ? 0 : (r & 4095);
        const long krow = isctx ? (long)b * SKV + SEQ + (r - ML) % CTXL : (long)b * SKV + t;
        const int h = (hh >> 17) & 7, m = (hh >> 20) & 1, d = (hh >> 21) & 63;
        for (int qk = 0; qk < 2; ++qk) {
            const int a = d >> 5, wi = d & 31, i = wi & 15, half = wi >> 4;
            const int cbase = (qk == 0 ? 2560 : 3584) + h * 128 + m * 64 + 32 * a;
            const float x0 = RAWP(r, cbase + i), x1 = RAWP(r, cbase + 16 + i);
            float cs = 1.f, sn = 0.f;
            if (!isctx) { const float pos = (float)(a == 0 ? (t >> 6) : (t & 63)); const float inv = exp2f(-(float)i * (13.287712379549449f / 16.f)); const float ang = pos * inv; cs = cosf(ang); sn = sinf(ang); }
            float ref = half == 0 ? x0 * cs - x1 * sn : x1 * cs + x0 * sn; if (qk == 0) ref *= QSCALE;
            const int p = 32 * a + 2 * i + half;
            const bf16* buf = (const bf16*)(ws + (qk == 0 ? WS_Q : WS_K)); const long row = qk == 0 ? (long)r : krow;
            if (P.lane == 0) P.rec(3 + qk + 20 * L, bf2f(buf[(size_t)row * DM + h * 128 + m * 64 + p]), ref, 0.03f);
        }
        const int e = (hh >> 20) & 127;
        { const float ref = RAWP(r, 4608 + h * 128 + e); if (P.lane == 0) P.rec(5 + 20 * L, bf2f(((const bf16*)(ws + WS_V))[(size_t)krow * DM + h * 128 + e]), ref, 0.03f); }
        const int c = (hh >> 9) & 511;
        { const float ref = gelu_tanh_f(RAWP(r, c)); if (P.lane == 0) P.rec(6 + 20 * L, bf2f(((const bf16*)(ws + WS_P0))[(size_t)r * 512 + c]), ref, 0.03f); }
        { const float ref = gelu_tanh_f(RAWP(r, 512 + c)); if (P.lane == 0) P.rec(7 + 20 * L, bf2f(((const bf16*)(ws + WS_P1))[(size_t)r * 512 + c]), ref, 0.03f); }
        { const float ref = RAWP(r, 1024 + c); if (P.lane == 0) P.rec(8 + 20 * L, bf2f(((const bf16*)(ws + WS_P2))[(size_t)r * 512 + c]), ref, 0.03f); }
        { const float ref = RAWP(r, 1536 + c) * RAWP(r, 2048 + c); if (P.lane == 0) P.rec(9 + 20 * L, bf2f(((const bf16*)(ws + WS_P3))[(size_t)r * 512 + c]), ref, 0.04f); }
    }
}
template <int L>
__device__ __forceinline__ void probe_after_mix(const Probe& P, const Args& args, unsigned char* ws) {
    const bf16* Hb = (const bf16*)(ws + WS_H); const float* win = args.in[8] + (size_t)L * 1024 * INC;
    const bf16* P1 = (const bf16*)(ws + WS_P1); const bf16* P3 = (const bf16*)(ws + WS_P3);
#if EN_MIX
    for (int sidx = 0; sidx < 6; ++sidx) {
        const unsigned hh = hsh(sidx * 1237u + 3u + L); int r = hh % (L == 0 ? MA : ML); if (sidx == 5 && L == 0) r = ML + (hh % MC);
        const int c = (hh >> 12) & 511, g = c >> 6, row0 = r & ~127, tt = r & 127;
        __syncthreads();
        if (P.tid < 128) { const bf16* vr = P1 + (size_t)(row0 + P.tid) * 512; float s = 0.f; for (int k = 0; k < 512; ++k) s += bf2f(vr[k]); const float mean = s / 512.f; float q = 0.f; for (int k = 0; k < 512; ++k) { const float dlt = bf2f(vr[k]) - mean; q += dlt * dlt; }
            const float ln = (bf2f(vr[c]) - mean) * (1.f / sqrtf(q / 512.f + EPS)) * args.in[10][L * 512 + c] + args.in[11][L * 512 + c];
            P.sh[P.tid] = args.in[12][(((size_t)L * 8 + g) * 128 + tt) * 128 + P.tid] * ln; }
        __syncthreads();
        if (P.wave == 0) { float s = P.sh[P.lane] + P.sh[64 + P.lane]; s = wave_sum(s) + args.in[13][(L * 8 + g) * 128 + tt];
            const float gu = gelu_tanh_f(RAWP(r, c)); if (P.lane == 0) P.rec(10 + 20 * L, bf2f(((const bf16*)(ws + WS_P0))[(size_t)r * 512 + c]), bfr(gu) * s, 0.04f); }
    }
    for (int sidx = P.wave; sidx < 64; sidx += 8) {
        const unsigned hh = hsh(sidx * 4447u + 9u + L); int r = hh % (L == 0 ? MA : ML); if (sidx < 8) r = (sidx & 1) ? ((hh % BATCH) * SEQ + (sidx & 2 ? 0 : SEQ - 1)) : r; if (sidx >= 8 && sidx < 12 && L == 0) r = ML + (hh % BATCH) * CTXL + (sidx & 1 ? 0 : CTXL - 1);
        const int c = (hh >> 11) & 511; const bool isctx = r >= ML; const int tseq = isctx ? ((r - ML) & 255) : (r & 4095), last = isctx ? 255 : 4095;
        const float zm = tseq > 0 ? bf2f(P3[(size_t)(r - 1) * 512 + c]) : 0.f, zc = bf2f(P3[(size_t)r * 512 + c]), zp = tseq < last ? bf2f(P3[(size_t)(r + 1) * 512 + c]) : 0.f;
        const float bg = bfr(RAWP(r, 1024 + c)); const float* cw = args.in[14] + L * 1536;
        const float ref = bg * (cw[c] * zm + cw[512 + c] * zc + cw[1024 + c] * zp);
        if (P.lane == 0) P.rec(11 + 20 * L, bf2f(((const bf16*)(ws + WS_P2))[(size_t)r * 512 + c]), ref, 0.04f);
    }
#endif
#if EN_ATT
    LAS float* qv = P.sh;
    LAS float* s0 = P.sh + 128;
    LAS float* s1 = P.sh + 128 + 4352;
    LAS float* red = P.sh + 128 + 2 * 4352;
    LAS float* ov = red + 64;
    const float lam = ((const float*)(ws + WS_LAM))[L]; const float oml = L == 0 ? 0.8f : (1.f - (0.8f - 0.6f * 0.7408182206817179f));
    for (int sidx = 0; sidx < (L == 0 ? 5 : 3); ++sidx) {
        const unsigned hh = hsh(sidx * 9173u + 21u + L); const bool isctx = (L == 0 && sidx >= 3); const int b = hh % BATCH, h = (hh >> 8) & 7;
        const int r = isctx ? ML + b * CTXL + ((hh >> 12) % CTXL) : b * SEQ + ((hh >> 12) & 4095); const int t = r & 4095;
        const int nk = isctx ? CTXL : SKV; const long k0 = isctx ? (long)b * SKV + SEQ : (long)b * SKV;
        __syncthreads();
        for (int q = P.wave; q < 128; q += 8) {
            const int m = q >> 6, p = q & 63, a = p >> 5, i = (p & 31) >> 1, half = p & 1; const int cbase = 2560 + h * 128 + m * 64 + 32 * a;
            const float x0 = RAWP(r, cbase + i), x1 = RAWP(r, cbase + 16 + i); float cs = 1.f, sn = 0.f;
            if (!isctx) { const float pos = (float)(a == 0 ? (t >> 6) : (t & 63)); const float inv = exp2f(-(float)i * (13.287712379549449f / 16.f)); cs = cosf(pos * inv); sn = sinf(pos * inv); }
            if (P.lane == 0) qv[q] = bfr((half == 0 ? x0 * cs - x1 * sn : x1 * cs + x0 * sn) * QSCALE);
        }
        __syncthreads();
        const bf16* Kb = (const bf16*)(ws + WS_K); const bf16* Vb = (const bf16*)(ws + WS_V);
        for (int k = P.tid; k < nk; k += NTHREADS) { const bf16* kr = Kb + (size_t)(k0 + k) * DM + h * 128; float a0 = 0.f, a1 = 0.f; for (int dd = 0; dd < 64; ++dd) { a0 += qv[dd] * bf2f(kr[dd]); a1 += qv[64 + dd] * bf2f(kr[64 + dd]); } s0[k] = a0; s1[k] = a1; }
        __syncthreads();
        float m0 = -1e30f, m1 = -1e30f; for (int k = P.tid; k < nk; k += NTHREADS) { m0 = fmaxf(m0, s0[k]); m1 = fmaxf(m1, s1[k]); }
        for (int o = 1; o < 64; o <<= 1) { m0 = fmaxf(m0, __shfl_xor(m0, o)); m1 = fmaxf(m1, __shfl_xor(m1, o)); }
        if (P.lane == 0) { red[P.wave] = m0; red[8 + P.wave] = m1; } __syncthreads();
        m0 = red[0]; m1 = red[8]; for (int w = 1; w < 8; ++w) { m0 = fmaxf(m0, red[w]); m1 = fmaxf(m1, red[8 + w]); } __syncthreads();
        float l0 = 0.f, l1 = 0.f; for (int k = P.tid; k < nk; k += NTHREADS) { const float e0 = exp2f(s0[k] - m0), e1 = exp2f(s1[k] - m1); s0[k] = e0; s1[k] = e1; l0 += e0; l1 += e1; }
        l0 = wave_sum(l0); l1 = wave_sum(l1); if (P.lane == 0) { red[16 + P.wave] = l0; red[24 + P.wave] = l1; } __syncthreads();
        l0 = 0.f; l1 = 0.f; for (int w = 0; w < 8; ++w) { l0 += red[16 + w]; l1 += red[24 + w]; }
        if (P.tid < 128) { float acc = 0.f; for (int k = 0; k < nk; ++k) acc += (s0[k] / l0 - lam * s1[k] / l1) * bf2f(Vb[(size_t)(k0 + k) * DM + h * 128 + P.tid]); ov[P.tid] = acc; }
        __syncthreads();
        if (P.tid < 128) { float ss = 0.f; for (int e = 0; e < 128; ++e) ss += ov[e] * ov[e]; const float ref = ov[P.tid] * (1.f / sqrtf(ss / 128.f + EPS)) * args.in[16][L * 128 + P.tid] * oml;
            if ((P.tid & 15) == (sidx & 15) || P.tid == 77) P.rec((isctx ? 13 : 12) + 20 * L, bf2f(((const bf16*)(ws + WS_Q))[(size_t)r * DM + h * 128 + P.tid]), ref, 0.06f); }
    }
#endif
    __syncthreads();
}
template <int L>
__device__ __forceinline__ void probe_after_gate(const Probe& P, const Args& args, unsigned char* ws) {
    const bf16* Hb = (const bf16*)(ws + WS_H); const float* win = args.in[8] + (size_t)L * 1024 * INC;
    const bf16* WINb = (const bf16*)(ws + WS_WIN + L * WIN_BYTES);
    if (P.tid < 400) P.sh[16 + P.tid] = 0.f;
    __syncthreads();
    for (int sidx = P.wave; sidx < 96; sidx += 8) {
        const unsigned hh = hsh(sidx * 3301u + 11u + L); const int row = 5632 + (sidx % 3) * 1024 + ((hh >> 4) & 1023), k = (hh >> 16) & 1023;
        if (P.lane == 0) P.rec(13 + 20 * L, bf2f(WINb[(size_t)row * 1024 + k]), bfr(win[(size_t)k * INC + row]), 0.001f);
    }
    __syncthreads();
    for (int br = 0; br < 3; ++br) {
        for (int sidx = P.wave; sidx < 64; sidx += 8) {
            const unsigned hh = hsh(sidx * 5501u + 1u + L + br * 77u); const int r = hh % (L == 0 ? MA : ML), n = (hh >> 12) & 1023;
            const float ref = sigmoid_f(RAWP(r, 5632 + br * 1024 + n) + args.in[9][L * 3072 + br * 1024 + n]);
            const bf16* g = br == 0 ? (const bf16*)(ws + WS_K) + (size_t)r * DM + n : (br == 1 ? (const bf16*)(ws + WS_V) + (size_t)r * DM + n : (const bf16*)(ws + (n < 512 ? WS_P1 : WS_P3)) + (size_t)r * 512 + (n & 511));
            if (P.lane == 0) {
                const float got = bf2f(*g);
                if (fabsf(got - ref) / (fabsf(ref) + 0.05f) > 0.03f) { P.sh[16] = 1.f; const int sl = P.wave * 8 + (sidx >> 3); P.sh[128 + 2 * sl] = __uint_as_float((unsigned)((uintptr_t)g & 0xffffffffu)); P.sh[129 + 2 * sl] = __uint_as_float((unsigned)((uintptr_t)g >> 32)); P.sh[300 + sl] = ref; }
                else P.rec(14 + br + 20 * L, got, ref, 0.03f);
            }
        }
        __syncthreads();
        if (P.sh[16] != 0.f) {
            const GAS u32x4* tp = (const GAS u32x4*)args.in[25] + P.tid; u32x4 acc_ = {0u, 0u, 0u, 0u};
            for (int q_ = 0; q_ < 3072; ++q_) { const u32x4 v_ = tp[(size_t)q_ * 512]; acc_.x ^= v_.x; acc_.y ^= v_.y; acc_.z ^= v_.z; acc_.w ^= v_.w; }
            if ((acc_.x ^ acc_.y ^ acc_.z ^ acc_.w) == 0x12345677u) P.sh[100] = 1.f;
            __syncthreads();
            if (P.tid == 0) { for (int q = 0; q < 64; ++q) { const unsigned lo_ = __float_as_uint(P.sh[128 + 2 * q]), hi_ = __float_as_uint(P.sh[129 + 2 * q]); if (lo_ == 0u && hi_ == 0u) continue;
                const bf16* gq = (const bf16*)(((uintptr_t)hi_ << 32) | lo_); const unsigned* gw = (const unsigned*)((uintptr_t)gq & ~(uintptr_t)3); const int sh = ((uintptr_t)gq & 2) ? 16 : 0;
                const float g1 = bf2f((__hip_atomic_load(gw, __ATOMIC_RELAXED, __HIP_MEMORY_SCOPE_AGENT) >> sh) & 0xffffu); const float ref = P.sh[300 + q];
                const bool ok1 = fabsf(g1 - ref) / (fabsf(ref) + 0.05f) <= 0.03f; if (!ok1 && br == 0) {
                    const size_t eo = (size_t)(gq - (const bf16*)(ws + WS_K)); const int kr = (int)(eo >> 10), nn = (int)(eo & 1023); const int bb = kr / SKV, key = kr % SKV; const bool cx = key >= SEQ;
                    const int tok = cx ? ML + bb * CTXL + (key - SEQ) : bb * SEQ + key; const int hh2 = nn >> 7, mm = (nn >> 6) & 1, pp = nn & 63, aa = pp >> 5, ii = (pp & 31) >> 1, hf = pp & 1;
                    const int cb2 = 3584 + hh2 * 128 + mm * 64 + 32 * aa; float x0 = 0.f, x1 = 0.f;
                    for (int k = 0; k < 1024; ++k) { const float hv = bf2f(Hb[(size_t)tok * DM + k]); x0 += hv * bfr(win[(size_t)k * INC + cb2 + ii]); x1 += hv * bfr(win[(size_t)k * INC + cb2 + 16 + ii]); }
                    float cs = 1.f, sn = 0.f; if (!cx) { const float pos = (float)(aa == 0 ? (key >> 6) : (key & 63)); const float inv = exp2f(-(float)ii * (13.287712379549449f / 16.f)); cs = cosf(pos * inv); sn = sinf(pos * inv); }
                    const float kold = hf == 0 ? x0 * cs - x1 * sn : x1 * cs + x0 * sn;
                    if (fabsf(kold - g1) <= 0.03f * (fabsf(kold) + 0.05f)) { unsigned e9 = 0u; __hip_atomic_compare_exchange_strong((unsigned*)(P.ctl + PR_BASE + 6), &e9, 1u, __ATOMIC_RELAXED, __ATOMIC_RELAXED, __HIP_MEMORY_SCOPE_AGENT); }
                }
                if (!ok1) { unsigned expect = 0u; if (__hip_atomic_compare_exchange_strong((unsigned*)(P.ctl + PR_BASE + 3), &expect, __float_as_uint(g1) | 1u, __ATOMIC_RELAXED, __ATOMIC_RELAXED, __HIP_MEMORY_SCOPE_AGENT)) { __hip_atomic_store((unsigned*)(P.ctl + PR_BASE + 4), (unsigned)br + 1u, __ATOMIC_RELAXED, __HIP_MEMORY_SCOPE_AGENT); __hip_atomic_store((unsigned*)(P.ctl + PR_BASE + 5), __float_as_uint(ref), __ATOMIC_RELAXED, __HIP_MEMORY_SCOPE_AGENT); {
                        const size_t eo2 = (size_t)(gq - (const bf16*)(ws + WS_K)); const bf16* rb = (const bf16*)(ws + WS_K) + (eo2 & ~(size_t)63); int cr = 0, cc = 0;
                        for (int q2 = 0; q2 < 64; ++q2) { const float v2 = bf2f(rb[q2]); if (!(v2 >= 0.f && v2 <= 1.f)) ++cr; }
                        const size_t rr2 = (eo2 >> 10) & ~(size_t)63, nn2 = eo2 & 1023;
                        for (int q2 = 0; q2 < 64; ++q2) { const float v2 = bf2f(((const bf16*)(ws + WS_K))[(rr2 + q2) * 1024 + nn2]); if (!(v2 >= 0.f && v2 <= 1.f)) ++cc; }
                        int c16 = 0, c8 = 0; const size_t r0b = eo2 >> 10;
                        for (int q2 = 0; q2 < 64; ++q2) { const float v2 = bf2f(((const bf16*)(ws + WS_K))[(rr2 + q2) * 1024 + nn2]); const bool bad = !(v2 >= 0.f && v2 <= 1.f); if (bad && ((rr2 + q2) & 15) == (r0b & 15)) ++c16; if (bad && ((rr2 + q2) >> 3) == (r0b >> 3)) ++c8; }
                        unsigned m8 = 0u, g8 = 0u; for (int q2 = 0; q2 < 64; ++q2) { const float v2 = bf2f(((const bf16*)(ws + WS_K))[(rr2 + q2) * 1024 + nn2]); const bool bad = !(v2 >= 0.f && v2 <= 1.f); if (bad && ((rr2 + q2) >> 3) == (r0b >> 3)) m8 |= 1u << ((rr2 + q2) & 7); if (bad) g8 |= 1u << (q2 >> 3); }
                        __hip_atomic_store((unsigned*)(P.ctl + PR_BASE + 10), m8 | (g8 << 8), __ATOMIC_RELAXED, __HIP_MEMORY_SCOPE_AGENT);
                        __hip_atomic_store((unsigned*)(P.ctl + PR_BASE + 9), (unsigned)(c16 | (c8 << 8)), __ATOMIC_RELAXED, __HIP_MEMORY_SCOPE_AGENT);
                        __hip_atomic_store((unsigned*)(P.ctl + PR_BASE + 8), (unsigned)(cr | (cc << 8)), __ATOMIC_RELAXED, __HIP_MEMORY_SCOPE_AGENT); }
                    __hip_atomic_store((unsigned*)(P.ctl + PR_BASE + 7), (unsigned)(gq - (const bf16*)(ws + (br == 0 ? WS_K : (br == 1 ? WS_V : WS_P1)))), __ATOMIC_RELAXED, __HIP_MEMORY_SCOPE_AGENT); } } } }
        }
        __syncthreads();
    }
}
template <int L>
__device__ __forceinline__ void probe_after_wo(const Probe& P, const Args& args, unsigned char* ws) {
    const bf16* Hb = (const bf16*)(ws + WS_H); const float* win = args.in[8] + (size_t)L * 1024 * INC;
    const bf16* Y = (const bf16*)(ws + WS_K);
    for (int sidx = P.wave; sidx < 64; sidx += 8) {
        const unsigned hh = hsh(sidx * 811u + 17u + L); int r = hh % (L == 0 ? MA : ML); if (L == 0 && sidx < 8) r = ML + hh % MC; const int n = (hh >> 12) & 1023;
        const float ga = sigmoid_f(RAWP(r, 5632 + n) + args.in[9][L * 3072 + n]), gb = sigmoid_f(RAWP(r, 5632 + 1024 + n) + args.in[9][L * 3072 + 1024 + n]), gc = sigmoid_f(RAWP(r, 5632 + 2048 + n) + args.in[9][L * 3072 + 2048 + n]);
        const float pa = wdot((const bf16*)(ws + WS_P0) + (size_t)r * 512, args.in[17] + (size_t)L * 512 * 1024, 1024, n, 512, P.lane);
        const float pb = wdot((const bf16*)(ws + WS_P2) + (size_t)r * 512, args.in[18] + (size_t)L * 512 * 1024, 1024, n, 512, P.lane);
        const float pc = wdot((const bf16*)(ws + WS_Q) + (size_t)r * DM, args.in[19] + (size_t)L * 1024 * 1024, 1024, n, 1024, P.lane);
        if (P.lane == 0) P.rec(17 + 20 * L, bf2f(Y[(size_t)r * DM + n]), ga * pa + gb * pb + gc * pc, 0.05f);
        const float o = wdot(Y + (size_t)r * DM, args.in[20] + (size_t)L * 1024 * 1024, 1024, n, 1024, P.lane);
        const int b = r < ML ? (r >> 12) : 16; const float g1 = ((const float*)(ws + WS_MOD))[((size_t)L * 17 + b) * 6144 + 2048 + n];
        if (L == 0) { const float x0 = r < ML ? args.in[0][(size_t)r * DM + n] : args.in[2][(size_t)(r - ML) * DM + n];
            const float got = r < ML ? args.out[(size_t)r * DM + n] : ((const float*)(ws + WS_XC))[(size_t)(r - ML) * DM + n];
            if (P.lane == 0) P.rec(18, got - x0, g1 * o, 0.03f); }
    }
}
__device__ __forceinline__ void probe_after_ffn0(const Probe& P, const Args& args, unsigned char* ws) {
    const bf16* Hb = (const bf16*)(ws + WS_H); const bf16* ACT = (const bf16*)(ws + WS_ACT0);
    for (int sidx = P.wave; sidx < 64; sidx += 8) {
        const unsigned hh = hsh(sidx * 60013u + 5u); int r = hh % MA; if (sidx < 8) r = ML + hh % MC; const int j = (hh >> 10) % DFF;
        const float gt = wdot(Hb + (size_t)r * DM, args.in[21], DFF, j, 1024, P.lane), up = wdot(Hb + (size_t)r * DM, args.in[22], DFF, j, 1024, P.lane);
        if (P.lane == 0) P.rec(19, bf2f(ACT[(size_t)r * DFF + j]), silu_f(gt) * up, 0.04f);
    }
}
#undef RAWP
#endif


#define WSB() unsigned char* ws = launder_ptr(args.ws)
#define W_MOD ((float*)(ws + WS_MOD))
#define W_ROPE ((float*)(ws + WS_ROPE))
#define W_LAM ((float*)(ws + WS_LAM))
#define W_AWS ((bf16*)(ws + WS_AWS))
#define W_ROUTE ((unsigned*)(ws + WS_ROUTE))
#define W_X16 ((bf16*)(ws + WS_X16))
#define W_H ((bf16*)args.out)
#define W_P0 ((bf16*)(ws + WS_P0))
#define W_P1 ((bf16*)(ws + WS_P1))
#define W_P2 ((bf16*)(ws + WS_P2))
#define W_P3 ((bf16*)(ws + WS_P3))
#define W_Q ((bf16*)(ws + WS_Q))
#define W_K ((bf16*)(ws + WS_K))
#define W_V ((bf16*)(ws + WS_V))
#define W_MODL (W_MOD + (size_t)L * 17 * 6144)
#define W_WIN ((const bf16*)(ws + WS_WIN + L * WIN_BYTES))
#define W_WOUT ((const bf16*)(ws + WS_WOUT + L * WOUT_BYTES))
#define PH_ON (P.lo <= P.ph && P.ph < P.hi)
#ifdef PTIME
#define SEAM() do { if (P.lo <= P.ph && P.ph + 1 < P.hi) xcd_barrier(bar); if (blockIdx.x == 0 && C.tid == 0 && P.ph < 40) ((unsigned long long*)(C.ctl + 16384))[1 + P.ph] = rt(); ++P.ph; } while (0)
#else
#define SEAM() do { if (P.lo <= P.ph && P.ph + 1 < P.hi) xcd_barrier(bar); ++P.ph; } while (0)
#endif
#define ELEM_DELTA(a, b) ((long)(((intptr_t)(a) - (intptr_t)(b)) / 4))

#ifdef PROBE
#define PROBE_HOOK(FN) do { if (P.lo < P.ph && P.ph <= P.hi) { if (blockIdx.x == 0) { WSB(); const Probe PR{C.ctl, C.tid, C.lane, C.wave, (LAS float*)C.lds}; FN(PR, args, ws); } xcd_barrier(bar); } } while (0)
#else
#define PROBE_HOOK(FN) do { } while (0)
#endif

#ifndef REP_BIG
#define REP_BIG 1
#endif
#ifndef REP_GATE
#define REP_GATE 1
#endif
#ifndef REP_UP
#define REP_UP 1
#endif
#ifndef REP_MOEUP
#define REP_MOEUP 1
#endif
#ifndef REP_MOEDN
#define REP_MOEDN 1
#endif
#ifndef MOE_GATHER
#define MOE_GATHER 0
#endif
#ifndef ATT_XPF
#define ATT_XPF 0
#endif
#ifndef ATT_ROT
#define ATT_ROT(qb) ((qb) * 2)
#endif
template <int L, int BR>
__device__ __forceinline__ void merge_phase(const Ctx& C, const Args& args, const XcdBarrier& bar, PhaseCtl& P) {
    constexpr int mrows = L == 0 ? MA : ML;
    if (PH_ON) { WSB();
#if (EN_SITES >> 2) & 1
        constexpr size_t aoff = BR == 0 ? WS_P0 : (BR == 1 ? WS_P2 : WS_Q), goff = BR == 0 ? WS_K : (BR == 1 ? WS_V : WS_P1);
        constexpr int K = BR == 2 ? 1024 : 512;
        const bf16* Bt = W_WOUT + (BR == 0 ? 0 : (BR == 1 ? 512 * 1024 : 1024 * 1024));
        pg8::Gemm g{(const bf16*)(ws + aoff), Bt, mrows, 1024, K}; pg8::StaticOrder S; S.init(mrows, 1024, C.G, (int)blockIdx.x);
        EpiMerge E{W_K, (const bf16*)(ws + goff), (long)((WS_P3 - WS_P1) / 2), BR == 2 ? 512 : 1024, BR == 2 ? 2 : 4, BR == 0 ? 1 : 0, 0};
#ifdef DUP_MERGE
        if (L == 0) { EpiMerge Ed = E; Ed.dry = P.hi < 5000 ? 1 : 0; pg8::gemm_phase<EpiMerge, pg8::StaticOrder, PG8_ALIGN, PG8_SP2>(C.lds, g, S, Ed); }
#endif
        pg8::gemm_phase<EpiMerge, pg8::StaticOrder, PG8_ALIGN, PG8_SP2>(C.lds, g, S, E);
#endif
    }
    if (BR == 2) SEAM(); else ++P.ph;
}

template <int L>
__device__ __forceinline__ void layer_body(const Ctx& C, const Args& args, const XcdBarrier& bar, PhaseCtl& P, volatile LAS int* offl) {
    constexpr int mrows = L == 0 ? MA : ML;
    if (PH_ON) { WSB(); if constexpr (L == 0) modulate_phase<false>(C, args.in[0], args.in[2], args.in[6], W_MODL, 0, 1, W_H, MA); else modulate_phase<true>(C, W_X16, nullptr, args.in[6] + 1024, W_MODL, 0, 1, W_H, MA);
#ifdef REP_MOD
        if (L == 0) modulate_phase<false>(C, args.in[0], args.in[2], args.in[6], W_MODL, 0, 1, W_H, MA);
#endif
    }
    SEAM();
    PROBE_HOOK(probe_after_mod1<L>);
    if (PH_ON) { WSB();
#if (EN_SITES >> 0) & 1
        LAS float* tab = (LAS float*)(C.lds + 131072);
        for (int i = C.tid; i < 2048; i += NTHREADS) tab[i] = W_ROPE[i];
        __syncthreads();
        pg8::Gemm g{W_H, W_WIN, MA, NBIG, 1024};
        EpiBig E{ws, tab};
        if constexpr (L == 0) { pg8::StaticOrder S; S.init(MA, NBIG, C.G, (int)blockIdx.x); pg8::gemm_phase<EpiBig, pg8::StaticOrder, PG8_ALIGN, PG8_SP2>(C.lds, g, S, E); }
        else { BigOrderL1 S; S.so.init(ML, NBIG, C.G, (int)blockIdx.x); S.G = C.G; S.c = (int)blockIdx.x; pg8::gemm_phase<EpiBig, BigOrderL1, PG8_ALIGN, PG8_SP2>(C.lds, g, S, E); }
#endif
    }
    SEAM();
    PROBE_HOOK(probe_after_big<L>);
    if (PH_ON) { WSB();
#ifdef PROBE_FILL2
        { GAS u32x4* kf = (GAS u32x4*)(ws + WS_K); const u32x4 pat = {0x46404640u, 0x46404640u, 0x46404640u, 0x46404640u};
          for (size_t i = (size_t)C.gw * 64 + C.lane; i < (size_t)MA * DM * 2 / 16; i += (size_t)C.NGW * 64) kf[i] = pat; }
#endif
#if EN_MIX
#ifdef DUP_MIX
        if (L == 0) for (int ch = C.vcu; ch < mrows / 128; ch += C.G)
            mixer_chunk(C, ch, W_P0, W_P1, W_P2, W_P3, args.in[10] + L * 512, args.in[11] + L * 512, W_AWS + (size_t)L * 8 * 128 * 128, args.in[13] + L * 8 * 128, args.in[14] + L * 3 * 512, P.hi > 5000);
#endif
        for (int ch = C.vcu; ch < mrows / 128; ch += C.G)
            mixer_chunk(C, ch, W_P0, W_P1, W_P2, W_P3, args.in[10] + L * 512, args.in[11] + L * 512, W_AWS + (size_t)L * 8 * 128 * 128, args.in[13] + L * 8 * 128, args.in[14] + L * 3 * 512);
#endif
#if EN_ATT
        const float lam = W_LAM[L]; constexpr float oml = L == 0 ? 0.8f : (1.f - (0.8f - 0.6f * 0.7408182206817179f)); const float* subg = args.in[16] + L * 128;
#if ATT_XPF
        att::diff_attn_units<false>(W_Q, W_K, W_V, C.vcu, BATCH * 8 * 32, C.G, lam, subg, oml, (LAS char*)C.lds);
        if (L == 0) att::diff_attn_units<true>(W_Q, W_K, W_V, C.vcu, BATCH * 8 * 2, C.G, lam, subg, oml, (LAS char*)C.lds);
#else
#ifdef DUP_ATT
        const int nrep = L == 0 ? 2 : 1;
        for (int rep = 0; rep < nrep; ++rep)
        for (int u = C.vcu; u < BATCH * 8 * 32; u += C.G) {
            const int bh = u >> 5, qb = u & 31, b = bh >> 3, h = bh & 7;
            bf16* qp = W_Q + ((size_t)b * SEQ + qb * 128) * DM + h * 128;
            att::diff_attn_unit(qp, W_K + (size_t)b * SKV * DM + h * 128, W_V + (size_t)b * SKV * DM + h * 128, qp, SKV / 64, lam, subg, oml, (LAS char*)C.lds, rep + 1 == nrep);
        }
#else
        for (int u = C.vcu; u < BATCH * 8 * 32; u += C.G) {
            const int bh = u >> 5, qb = u & 31, b = bh >> 3, h = bh & 7;
            bf16* qp = W_Q + ((size_t)b * SEQ + qb * 128) * DM + h * 128;
            att::diff_attn_unit(qp, W_K + (size_t)b * SKV * DM + h * 128, W_V + (size_t)b * SKV * DM + h * 128, qp, SKV / 64, lam, subg, oml, (LAS char*)C.lds, true, ATT_ROT(qb));
        }
#endif
        if (L == 0) {
            for (int u = C.vcu; u < BATCH * 8 * 2; u += C.G) {
                const int b = u >> 4, h = (u >> 1) & 7, qb = u & 1;
                bf16* qp = W_Q + ((size_t)ML + b * CTXL + qb * 128) * DM + h * 128;
                att::diff_attn_unit(qp, W_K + ((size_t)b * SKV + SEQ) * DM + h * 128, W_V + ((size_t)b * SKV + SEQ) * DM + h * 128, qp, CTXL / 64, lam, subg, oml, (LAS char*)C.lds);
            }
        }
#endif
#endif
    }
    SEAM();
    PROBE_HOOK(probe_after_mix<L>);
    if (PH_ON) { WSB();
#if (EN_SITES >> 1) & 1
        pg8::Gemm g{W_H, W_WIN + (size_t)NBIG * 1024, mrows, 3072, 1024};
        LAS float* tab = (LAS float*)(C.lds + 131072);
        for (int i = C.tid; i < 3072; i += NTHREADS) tab[i] = args.in[9][L * 3072 + i];
        __syncthreads();
        EpiGate E{ws, tab};
        if constexpr (L == 0) {
            pg8::StaticOrder S; S.init(mrows, 3072, C.G, (int)blockIdx.x);
            pg8::gemm_phase<EpiGate, pg8::StaticOrder, PG8_ALIGN, PG8_SP2>(C.lds, g, S, E);
        } else {
            GateOrder S; S.so.init(mrows, 1024, C.G, (int)blockIdx.x);
            pg8::gemm_phase<EpiGate, GateOrder, PG8_ALIGN, PG8_SP2>(C.lds, g, S, E);
        }
#endif
    }
    if (L == 0) SEAM(); else ++P.ph;
#ifdef PROBE_SCAN
    if (L == 0) { WSB(); unsigned cntk = 0u, cntv = 0u;
        const GAS u32x4* kp = (const GAS u32x4*)(ws + WS_K); const GAS u32x4* vp = (const GAS u32x4*)(ws + WS_V);
        for (size_t i = (size_t)C.gw * 64 + C.lane; i < (size_t)MA * DM * 2 / 16; i += (size_t)C.NGW * 64) {
            const u32x4 a = kp[i], b = vp[i]; f32x4 x0, x1; unpack8(a, x0, x1);
            for (int q = 0; q < 4; ++q) { if (!(x0[q] >= 0.f && x0[q] <= 1.f)) ++cntk; if (!(x1[q] >= 0.f && x1[q] <= 1.f)) ++cntk; }
            unpack8(b, x0, x1);
            for (int q = 0; q < 4; ++q) { if (!(x0[q] >= 0.f && x0[q] <= 1.f)) ++cntv; if (!(x1[q] >= 0.f && x1[q] <= 1.f)) ++cntv; } }
        if (cntk) atomicAdd((unsigned*)(C.ctl + PR_BASE + 12), cntk); if (cntv) atomicAdd((unsigned*)(C.ctl + PR_BASE + 13), cntv);
        xcd_barrier(bar); }
#endif
    merge_phase<L, 0>(C, args, bar, P);
    merge_phase<L, 1>(C, args, bar, P);
    merge_phase<L, 2>(C, args, bar, P);
    if (PH_ON) { WSB();
#if (EN_SITES >> 3) & 1
        pg8::Gemm g{W_K, W_WOUT + 2 * 1024 * 1024, mrows, 1024, 1024}; pg8::StaticOrder S; S.init(mrows, 1024, C.G, (int)blockIdx.x);
        if constexpr (L == 0) { EpiResid<true> E{args.in[0], W_X16, ELEM_DELTA(args.in[2], args.in[0]) - (long)ML * DM, W_MODL, 2, 0};
            pg8::gemm_phase<EpiResid<true>, pg8::StaticOrder, PG8_ALIGN, PG8_SP2>(C.lds, g, S, E); }
        else { EpiResid<false> E{W_X16, W_X16, 0l, W_MODL, 2, 0};
            pg8::gemm_phase<EpiResid<false>, pg8::StaticOrder, PG8_ALIGN, PG8_SP2>(C.lds, g, S, E); }
#endif
    }
    SEAM();
    PROBE_HOOK(probe_after_wo<L>);
    if (L == 0) {
        if (PH_ON) { WSB(); modulate_phase<true>(C, W_X16, nullptr, args.in[7], W_MODL, 3, 4, W_H, MA); }
        SEAM();
        if (PH_ON) { WSB();
#if (EN_SITES >> 4) & 1
            pg8::Gemm g{W_H, (const bf16*)(ws + WS_WFU), MA, 2 * DFF, 1024}; pg8::StaticOrder S; S.init(MA, 2 * DFF, C.G, (int)blockIdx.x);
            EpiSwiGLU E{(bf16*)(ws + WS_ACT0), DFF, 0, 22};
            pg8::gemm_phase<EpiSwiGLU, pg8::StaticOrder, PG8_ALIGN, PG8_SP2>(C.lds, g, S, E);
        if (REP_UP > 1) {
#ifdef REP_BARRIER
            xcd_barrier(bar);
#endif
            pg8::gemm_phase<EpiSwiGLU, pg8::StaticOrder, PG8_ALIGN, PG8_SP2>(C.lds, g, S, E); }
#endif
        }
        SEAM();
        PROBE_HOOK(probe_after_ffn0);
        if (PH_ON) { WSB();
#if (EN_SITES >> 5) & 1
            pg8::Gemm g{(const bf16*)(ws + WS_ACT0), (const bf16*)(ws + WS_WFD), MA, 1024, DFF}; pg8::StaticOrder S; S.init(MA, 1024, C.G, (int)blockIdx.x);
            EpiResid<false> E{W_X16, W_X16, 0l, W_MODL, 5, 0};
            pg8::gemm_phase<EpiResid<false>, pg8::StaticOrder, PG8_ALIGN, PG8_SP2>(C.lds, g, S, E);
#endif
        }
        SEAM();
    } else {
        if (PH_ON) { WSB();
#ifdef DUP_ROUTE
            route_phase(C, W_X16, args.in[7] + 1024, W_MODL, args.in[24], W_H, W_ROUTE, (unsigned long long*)(ws + WS_CNTT), P.hi < 5000); __syncthreads();
#endif
            route_phase(C, W_X16, args.in[7] + 1024, W_MODL, args.in[24], W_H, W_ROUTE, (unsigned long long*)(ws + WS_CNTT));
            __syncthreads();
#ifdef REP_MOECVT
            for (int rep_ = 0; rep_ < 2; ++rep_)
#endif
            for (int e = 0; e < NEXP; ++e) {
                tr_matrix<2>(C, args.in[25] + (size_t)e * 1024 * DFE, args.in[26] + (size_t)e * 1024 * DFE, DFE, 1024, 2 * DFE, (bf16*)(ws + WS_MWU) + (size_t)e * 2 * DFE * 1024);
                tr_matrix<0>(C, args.in[27] + (size_t)e * DFE * 1024, nullptr, 1024, DFE, 1024, (bf16*)(ws + WS_MWD) + (size_t)e * 1024 * DFE);
            }
        }
        SEAM();
        if (P.lo < P.ph + 8 && P.ph < P.hi) { WSB(); moe_offsets(C, (const unsigned long long*)(ws + WS_CNTT), offl); }
#if MOE_GATHER
        if (PH_ON) { WSB(); gather_phase(C, W_H, (bf16*)(ws + WS_HS), W_ROUTE, offl); }
#else
        if (PH_ON) { WSB(); rowmap_phase(C, (unsigned*)(ws + WS_RMAP), W_ROUTE, offl); }
#endif
        SEAM();
        for (int ck = 0; ck < 3; ++ck) {
            const int ntall = offl[8] >> 8; int nt = ntall - ck * MOE_CH; nt = nt < 0 ? 0 : (nt > MOE_CH ? MOE_CH : nt);
            if (PH_ON) { WSB();
#if (EN_SITES >> 6) & 1
                EpiSwiGLU E{(bf16*)(ws + WS_MACT), DFE, ck * MOE_CH, 28};
#if MOE_GATHER
                pg8::Gemm g{(const bf16*)(ws + WS_HS), (const bf16*)(ws + WS_MWU), nt * 256, 2 * DFE, 1024};
                MoeOrder S; S.so.init(nt * 256, 2 * DFE, C.G, (int)blockIdx.x); S.tile0 = ck * MOE_CH; S.npe = 28; S.a_global = true; S.offl = offl;
                pg8::gemm_phase<EpiSwiGLU, MoeOrder, PG8_ALIGN, PG8_SP2>(C.lds, g, S, E);
#else
                pg8::Gemm g{W_H, (const bf16*)(ws + WS_MWU), nt * 256, 2 * DFE, 1024};
                MoeOrderG S; S.mo.so.init(nt * 256, 2 * DFE, C.G, (int)blockIdx.x); S.mo.tile0 = ck * MOE_CH; S.mo.npe = 28; S.mo.a_global = true; S.mo.offl = offl; S.rowmap = (const unsigned*)(ws + WS_RMAP);
                pg8::gemm_phase<EpiSwiGLU, MoeOrderG, PG8_ALIGN, PG8_SP2>(C.lds, g, S, E);
#endif
#endif
            }
            SEAM();
            if (PH_ON) { WSB();
#if (EN_SITES >> 7) & 1
                pg8::Gemm g{(const bf16*)(ws + WS_MACT), (const bf16*)(ws + WS_MWD), nt * 256, 1024, DFE};
                MoeOrder S; S.so.init(nt * 256, 1024, C.G, (int)blockIdx.x); S.tile0 = ck * MOE_CH; S.npe = 4; S.a_global = false; S.offl = offl;
                EpiStoreBf16 E{(bf16*)(ws + WS_HS), 1024, ck * MOE_CH, 4};
                pg8::gemm_phase<EpiStoreBf16, MoeOrder, PG8_ALIGN, PG8_SP2>(C.lds, g, S, E);
        if (REP_MOEDN > 1) { pg8::gemm_phase<EpiStoreBf16, MoeOrder, PG8_ALIGN, PG8_SP2>(C.lds, g, S, E); }
#endif
            }
            SEAM();
        }
        if (PH_ON) { WSB();
#ifdef DUP_FINAL
            final_phase(C, W_X16, args.out, (const bf16*)(ws + WS_HS), W_ROUTE, W_MODL, args.in[28], P.hi < 5000);
#endif
            final_phase(C, W_X16, args.out, (const bf16*)(ws + WS_HS), W_ROUTE, W_MODL, args.in[28]); }
        SEAM();
    }
}

__global__ void __launch_bounds__(NTHREADS, 2) fwd_kernel(Args args) {
    extern __shared__ __attribute__((aligned(16))) unsigned char lds_raw[];
    Ctx C;
    C.lds = (LAS unsigned char*)lds_raw; C.ctl = (gu32*)(args.ws + WS_CTL);
    C.tid = threadIdx.x; C.lane = C.tid & 63; C.wave = __builtin_amdgcn_readfirstlane(C.tid >> 6);
    C.G = gridDim.x; { const int bx = blockIdx.x; C.vcu = (C.G % 8 == 0) ? (bx % 8) * (C.G / 8) + bx / 8 : bx; }
    C.gw = C.vcu * NWAVES + C.wave; C.NGW = C.G * NWAVES;
    volatile LAS unsigned* MISC = (volatile LAS unsigned*)(C.lds + LDSCTL_OFF);
    volatile LAS int* offl = (volatile LAS int*)(C.lds + LDSCTL_OFF + 64);
    if (C.tid < 64) MISC[C.tid] = 0u;
    __syncthreads();
    const XcdBarrier bar = xcd_barrier_post((unsigned*)(C.ctl + CW_BAR), MISC);
    PhaseCtl P{args.ph_lo, args.ph_hi, 0};
#ifdef PTIME
    if (blockIdx.x == 0 && C.tid == 0) ((unsigned long long*)(C.ctl + 16384))[0] = rt();
#endif

#if EN_PRO
    if (PH_ON) { WSB();
#ifdef REP_PRO
        for (int rep_ = 0; rep_ < 2; ++rep_)
#endif
        for (int l = 0; l < 2; ++l) {
            tr_matrix<1>(C, args.in[8] + (size_t)l * 1024 * INC, nullptr, INC, 1024, INC, (bf16*)(ws + WS_WIN + l * WIN_BYTES));
            bf16* wo = (bf16*)(ws + WS_WOUT + l * WOUT_BYTES);
            tr_matrix<0>(C, args.in[17] + (size_t)l * 512 * 1024, nullptr, 1024, 512, 1024, wo);
            tr_matrix<0>(C, args.in[18] + (size_t)l * 512 * 1024, nullptr, 1024, 512, 1024, wo + 512 * 1024);
            tr_matrix<0>(C, args.in[19] + (size_t)l * 1024 * 1024, nullptr, 1024, 1024, 1024, wo + 1024 * 1024);
            tr_matrix<0>(C, args.in[20] + (size_t)l * 1024 * 1024, nullptr, 1024, 1024, 1024, wo + 2 * 1024 * 1024);
        }
        tr_matrix<2>(C, args.in[21], args.in[22], DFF, 1024, 2 * DFF, (bf16*)(ws + WS_WFU));
        tr_matrix<0>(C, args.in[23], nullptr, 1024, DFF, 1024, (bf16*)(ws + WS_WFD));
        for (int i = C.gw * 64 + C.lane; i < 2 * 8 * 128 * 128; i += C.NGW * 64) W_AWS[i] = (bf16)f2bf(args.in[12][i]);
        __syncthreads();
        mod_phase(C, args.in[1], args.in[3], args.in[4], args.in[5], W_MOD);
        rope_lam_phase(C, args.in[15], W_ROPE, W_LAM);
#ifdef PROBE_FILL
        { GAS u32x4* kf = (GAS u32x4*)(ws + WS_K); const u32x4 pat = {0x46404640u, 0x46404640u, 0x46404640u, 0x46404640u};
          for (size_t i = (size_t)C.gw * 64 + C.lane; i < (size_t)MA * DM * 2 / 16; i += (size_t)C.NGW * 64) kf[i] = pat; }
#endif
    }
#endif
    SEAM();
    layer_body<0>(C, args, bar, P, offl);
#if NLAYERS > 1
    layer_body<1>(C, args, bar, P, offl);
#endif
#ifdef PTIME
    {
        xcd_barrier(bar);
        const unsigned long long* T = (const unsigned long long*)(C.ctl + 16384);
        const float ta = (float)(__hip_atomic_load(T + 1 + PT_A1, __ATOMIC_RELAXED, __HIP_MEMORY_SCOPE_AGENT) - __hip_atomic_load(T + PT_A0, __ATOMIC_RELAXED, __HIP_MEMORY_SCOPE_AGENT)) * 0.01f;
        const float tb = (float)(__hip_atomic_load(T + 1 + PT_B1, __ATOMIC_RELAXED, __HIP_MEMORY_SCOPE_AGENT) - __hip_atomic_load(T + PT_B0, __ATOMIC_RELAXED, __HIP_MEMORY_SCOPE_AGENT)) * 0.01f;
        const float bv = 8.f * sqrtf(tb);
        for (size_t i = (size_t)C.gw * 64 + C.lane; i < (size_t)ML * DM; i += (size_t)C.NGW * 64) args.out[i] = i == 0 ? ta : ((i >= 1024 && i < 1024 + (1u << 20)) ? bv : 0.f);
    }
#endif
#ifdef PROBE
    {
        xcd_barrier(bar);
        const unsigned id = __hip_atomic_load((unsigned*)(C.ctl + PR_BASE), __ATOMIC_RELAXED, __HIP_MEMORY_SCOPE_AGENT);
        const float e1 = __uint_as_float(__hip_atomic_load((unsigned*)(C.ctl + PR_BASE + 1), __ATOMIC_RELAXED, __HIP_MEMORY_SCOPE_AGENT)), e2 = __uint_as_float(__hip_atomic_load((unsigned*)(C.ctl + PR_BASE + 2), __ATOMIC_RELAXED, __HIP_MEMORY_SCOPE_AGENT));
        const float err = id ? e1 : e2; float code = err < 0.05f ? 1000.f * err : 50.f + 100.f * (err > 4.5f ? 4.5f : err); const float bv = 8.f * sqrtf(code);
        const unsigned sv = __hip_atomic_load((unsigned*)(C.ctl + PR_BASE + 3), __ATOMIC_RELAXED, __HIP_MEMORY_SCOPE_AGENT), sb = __hip_atomic_load((unsigned*)(C.ctl + PR_BASE + 4), __ATOMIC_RELAXED, __HIP_MEMORY_SCOPE_AGENT);
        float a0 = 100.f * (float)id, bvv = bv;
        const unsigned eoff = __hip_atomic_load((unsigned*)(C.ctl + PR_BASE + 7), __ATOMIC_RELAXED, __HIP_MEMORY_SCOPE_AGENT);
#ifndef PROBE_SEL
#define PROBE_SEL 0
#endif
        if (PROBE_SEL == 8 && false) {} else if (sv && PROBE_SEL == 1) { const unsigned rr = eoff >> 10, nn = eoff & 1023u; a0 = 100.f * (float)(nn >> 4); bvv = 8.f * sqrtf((float)(rr >> 10)); }
        else if (sv && PROBE_SEL == 2) { const unsigned rr = eoff >> 10, nn = eoff & 1023u; a0 = 100.f * (float)(nn & 15u) + 50.f; bvv = 8.f * sqrtf((float)((rr >> 4) & 63u)); }
        else if (sv && PROBE_SEL == 4) { const unsigned cw = __hip_atomic_load((unsigned*)(C.ctl + PR_BASE + 8), __ATOMIC_RELAXED, __HIP_MEMORY_SCOPE_AGENT); a0 = 100.f * (float)(cw & 0xffu) + 50.f; bvv = 8.f * sqrtf((float)(cw >> 8)); }
        else if (sv && PROBE_SEL == 5) { const unsigned cw = __hip_atomic_load((unsigned*)(C.ctl + PR_BASE + 9), __ATOMIC_RELAXED, __HIP_MEMORY_SCOPE_AGENT); a0 = 100.f * (float)(cw & 0xffu) + 50.f; bvv = 8.f * sqrtf((float)(cw >> 8)); }
        else if (sv && PROBE_SEL == 6) { const unsigned cw = __hip_atomic_load((unsigned*)(C.ctl + PR_BASE + 10), __ATOMIC_RELAXED, __HIP_MEMORY_SCOPE_AGENT); a0 = 100.f * (float)((cw >> 4) & 15u) + 50.f; bvv = 8.f * sqrtf((float)(cw & 15u)); }
        else if (sv && PROBE_SEL == 7) { const unsigned cw = __hip_atomic_load((unsigned*)(C.ctl + PR_BASE + 10), __ATOMIC_RELAXED, __HIP_MEMORY_SCOPE_AGENT) >> 8; a0 = 100.f * (float)((cw >> 4) & 15u) + 50.f; bvv = 8.f * sqrtf((float)(cw & 15u)); }
        else if (PROBE_SEL == 8) { const unsigned ck = __hip_atomic_load((unsigned*)(C.ctl + PR_BASE + 12), __ATOMIC_RELAXED, __HIP_MEMORY_SCOPE_AGENT), cv = __hip_atomic_load((unsigned*)(C.ctl + PR_BASE + 13), __ATOMIC_RELAXED, __HIP_MEMORY_SCOPE_AGENT);
            a0 = 100.f * (float)ck; bvv = 8.f * sqrtf((float)cv); }
        else if (sv && PROBE_SEL == 3) { const unsigned rr = eoff >> 10; a0 = 100.f * (float)(rr & 15u) + 50.f; bvv = 0.f; }
        else if (sv) { const float val = __uint_as_float(sv); a0 = 1000.f * fabsf(val); const unsigned ko = __hip_atomic_load((unsigned*)(C.ctl + PR_BASE + 6), __ATOMIC_RELAXED, __HIP_MEMORY_SCOPE_AGENT); bvv = 8.f * sqrtf(10.f * (float)sb + (val < 0.f ? 5.f : 0.f) + (ko ? 100.f : 0.f)); }
        for (size_t i = (size_t)C.gw * 64 + C.lane; i < (size_t)ML * DM; i += (size_t)C.NGW * 64) args.out[i] = i == 0 ? a0 : ((i >= 1024 && i < 1024 + (1u << 20)) ? bvv : 0.f);
    }
#endif
}
#undef PH_ON
#undef SEAM
#undef WSB

extern "C" void kernel_launch(void* const* d_in, const int* in_sizes, int n_in, void* d_out, int out_size, void* d_ws, size_t ws_size, hipStream_t stream) {
    static int grid = 0;
    if (grid == 0) {
        if (n_in != 29 || in_sizes[0] != ML * DM || out_size != ML * DM || ws_size < WS_END) {
            fprintf(stderr, "kernel_launch: shape mismatch: n_in %d in0 %d out %d ws %zu (need %zu); nothing launched\n", n_in, n_in > 0 ? in_sizes[0] : -1, out_size, ws_size, (size_t)WS_END); grid = -1; return; }
        int dev = 0, cus = 0, per_cu = 0;
        if (hipGetDevice(&dev) != hipSuccess || hipDeviceGetAttribute(&cus, hipDeviceAttributeMultiprocessorCount, dev) != hipSuccess) { fprintf(stderr, "kernel_launch: device query failed\n"); grid = -1; return; }
        if (hipFuncSetAttribute((const void*)fwd_kernel, hipFuncAttributeMaxDynamicSharedMemorySize, LDS_BYTES) != hipSuccess) { fprintf(stderr, "kernel_launch: hipFuncSetAttribute failed\n"); grid = -1; return; }
        if (hipOccupancyMaxActiveBlocksPerMultiprocessor(&per_cu, (const void*)fwd_kernel, NTHREADS, LDS_BYTES) != hipSuccess || per_cu < 1)
            fprintf(stderr, "kernel_launch: note: occupancy query reports %d workgroups per CU\n", per_cu);
        (void)hipGetLastError();
        grid = cus;
    }
    if (grid < 0) return;
    if (hipMemsetAsync((char*)d_ws + WS_CTL, 0, CTL_ZERO_BYTES, stream) != hipSuccess) { fprintf(stderr, "kernel_launch: memset failed\n"); return; }
    Args a{};
    for (int i = 0; i < 29; ++i) a.in[i] = (const float*)d_in[i];
    a.out = (float*)d_out; a.ws = (unsigned char*)d_ws; a.ph_lo = 0; a.ph_hi = 1000;
    hipLaunchKernelGGL(fwd_kernel, dim3(grid), dim3(NTHREADS), LDS_BYTES, stream, a);
    const hipError_t le = hipPeekAtLastError();
    if (le != hipSuccess) fprintf(stderr, "kernel_launch: launch failed: %s\n", hipGetErrorName(le));
}
```
